# Optimizing an MI355X kernel written in HIP

```python
import jax, jax.numpy as jnp
from jax import lax
import numpy as np

D_MODEL = 1024
BATCH = 4
SEQ = 4096
DEPTH = 2

D_MIX = D_MODEL
D_CONV = D_MIX // 2
CONV_WIDTH = 31
CONV_GROUPS = 8
SB_HEADS = 8
SB_HEAD_DIM = (D_MIX // 2) // SB_HEADS
SB_BLOCK = 128
GLA_HEADS = 4
GLA_DV = (D_MIX // 2) // GLA_HEADS
GLA_DK = GLA_DV // 2
GLA_RANK = 16
GLA_TAU = 16.0
GLA_CHUNK = 64
D_POOL = D_MIX // 2
POOL_WINDOWS = (2, 4, 8, 16)
POOL_GROUPS = 4
N_EXPERTS = 16
N_EXPERT_GROUPS = 4
TOP_K = 2
D_EXPERT = D_MODEL // 2
RMS_EPS = 1e-6
LN_EPS = 1e-5

D_IN_EVEN = 2 * D_CONV + 3 * SB_HEADS * SB_HEAD_DIM
D_CAT_EVEN = D_CONV + SB_HEADS * SB_HEAD_DIM
D_IN_ODD = 2 * GLA_HEADS * GLA_DK + 2 * GLA_HEADS * GLA_DV + GLA_RANK + D_POOL
D_CAT_ODD = GLA_HEADS * GLA_DV + D_POOL

kernel_name = "hybrid_conv_stickbreak_gla_pool_moe"


def rmsnorm(x, g):
    xf = x.astype(jnp.float32)
    y = xf * lax.rsqrt(jnp.mean(xf * xf, axis=-1, keepdims=True) + RMS_EPS)
    return (y * g.astype(jnp.float32)).astype(x.dtype)


def conformer_conv(u, conv_w, conv_b, norm_g, norm_b):
    val, gate = jnp.split(u, 2, axis=-1)
    y = val * jax.nn.sigmoid(gate)
    y = lax.conv_general_dilated(
        y, conv_w[:, None, :], window_strides=(1,),
        padding=((CONV_WIDTH - 1, 0),),
        dimension_numbers=('NWC', 'WIO', 'NWC'),
        feature_group_count=D_CONV) + conv_b
    bsz, s, _ = y.shape
    yf = y.astype(jnp.float32).reshape(bsz, s, CONV_GROUPS, D_CONV // CONV_GROUPS)
    mu = jnp.mean(yf, axis=-1, keepdims=True)
    var = jnp.mean(jnp.square(yf - mu), axis=-1, keepdims=True)
    yn = ((yf - mu) * lax.rsqrt(var + LN_EPS)).reshape(bsz, s, D_CONV) * norm_g + norm_b
    return jax.nn.silu(yn).astype(u.dtype)


def stick_breaking_attention(q, k, v):
    bsz, s_len, h, d = q.shape
    q = q.transpose(0, 2, 1, 3) * (d ** -0.5)
    k = k.transpose(0, 2, 1, 3)
    v = v.transpose(0, 2, 1, 3)
    outs = []
    for blk in range(s_len // SB_BLOCK):
        start = blk * SB_BLOCK
        end = start + SB_BLOCK
        z = jnp.einsum('bhqd,bhkd->bhqk', q[:, :, start:end], k[:, :, :end]).astype(jnp.float32)
        t_pos = start + jnp.arange(SB_BLOCK)[:, None]
        s_pos = jnp.arange(end)[None, :]
        strict = s_pos < t_pos
        log_keep = jnp.where(strict, jax.nn.log_sigmoid(-z), 0.0)
        later = lax.cumsum(log_keep, axis=3, reverse=True) - log_keep
        a = jnp.where(strict, jnp.exp(jax.nn.log_sigmoid(z) + later), 0.0)
        outs.append(jnp.einsum('bhqk,bhkd->bhqd', a.astype(v.dtype), v[:, :, :end]))
    o = jnp.concatenate(outs, axis=2)
    return o.transpose(0, 2, 1, 3).reshape(bsz, s_len, h * d)


def gla_chunked(q, k, v, log_a):
    bsz, s_len, h, dk = q.shape
    dv = v.shape[-1]
    n = s_len // GLA_CHUNK

    def chunks(t):
        return t.reshape(bsz, n, GLA_CHUNK, h, t.shape[-1]).transpose(1, 0, 3, 2, 4)

    q, k, v, log_a = chunks(q), chunks(k), chunks(v), chunks(log_a)
    b = jnp.cumsum(log_a, axis=3)
    b_last = b[:, :, :, -1:, :]
    q_in = q * jnp.exp(b)
    k_in = k * jnp.exp(-b)
    k_dec = k * jnp.exp(b_last - b)
    causal = jnp.tril(jnp.ones((GLA_CHUNK, GLA_CHUNK), dtype=bool))
    scores = jnp.where(causal, jnp.einsum('nbhid,nbhjd->nbhij', q_in, k_in), 0.0)
    o_intra = jnp.einsum('nbhij,nbhjv->nbhiv', scores, v)

    def step(state, inp):
        q_n, k_n, v_n, decay_n = inp
        o_n = jnp.einsum('bhid,bhdv->bhiv', q_n, state)
        state = state * jnp.exp(decay_n)[..., None] + jnp.einsum('bhjd,bhjv->bhdv', k_n, v_n)
        return state, o_n

    state0 = jnp.zeros((bsz, h, dk, dv), jnp.float32)
    _, o_inter = lax.scan(step, state0, (q_in, k_dec, v, b_last[:, :, :, 0, :]))
    o = o_intra + o_inter
    return o.transpose(1, 0, 3, 2, 4).reshape(bsz, s_len, h, dv)


def multiscale_pool(u, pool_w, pool_b, pool_scale):
    bsz, s_len, _ = u.shape
    uf = u.astype(jnp.float32).reshape(bsz, s_len, POOL_GROUPS, D_POOL // POOL_GROUPS)
    cs = jnp.cumsum(uf, axis=1)
    pos = jnp.arange(1, s_len + 1, dtype=jnp.float32)
    pooled = []
    for gi, w in enumerate(POOL_WINDOWS):
        cs_g = cs[:, :, gi]
        prev = jnp.pad(cs_g, ((0, 0), (w, 0), (0, 0)))[:, :s_len]
        mean = (cs_g - prev) / jnp.minimum(pos, w)[None, :, None]
        pooled.append(mean - uf[:, :, gi])
    p = jnp.stack(pooled, axis=2)
    y = jnp.einsum('bsgc,gcd->bsgd', p, pool_w.astype(jnp.float32)) + pool_b
    return (y.reshape(bsz, s_len, D_POOL) * pool_scale).astype(u.dtype)


def even_mixer(h, w_in, w_out, conv_w, conv_b, conv_norm_g, conv_norm_b):
    bsz, s_len, _ = h.shape
    u = h @ w_in
    u_conv, u_sb = jnp.split(u, [2 * D_CONV], axis=-1)
    a_out = conformer_conv(u_conv, conv_w, conv_b, conv_norm_g, conv_norm_b)
    q, k, v = [t.reshape(bsz, s_len, SB_HEADS, SB_HEAD_DIM) for t in jnp.split(u_sb, 3, axis=-1)]
    b_out = stick_breaking_attention(q, k, v)
    return jnp.concatenate([a_out, b_out], axis=-1) @ w_out


def odd_mixer(h, w_in, w_out, gla_gate_w, gla_gate_b, gla_norm_g, pool_w, pool_b, pool_scale):
    bsz, s_len, _ = h.shape
    u = h @ w_in
    dkt = GLA_HEADS * GLA_DK
    dvt = GLA_HEADS * GLA_DV
    q, k, v, r, a_low, u_pool = jnp.split(
        u, [dkt, 2 * dkt, 2 * dkt + dvt, 2 * dkt + 2 * dvt, 2 * dkt + 2 * dvt + GLA_RANK], axis=-1)
    log_a = jax.nn.log_sigmoid((a_low @ gla_gate_w + gla_gate_b).astype(jnp.float32)) / GLA_TAU
    qh = q.astype(jnp.float32).reshape(bsz, s_len, GLA_HEADS, GLA_DK) * (GLA_DK ** -0.5)
    kh = k.astype(jnp.float32).reshape(bsz, s_len, GLA_HEADS, GLA_DK)
    vh = v.astype(jnp.float32).reshape(bsz, s_len, GLA_HEADS, GLA_DV)
    ah = log_a.reshape(bsz, s_len, GLA_HEADS, GLA_DK)
    o = gla_chunked(qh, kh, vh, ah)
    o = o * lax.rsqrt(jnp.mean(o * o, axis=-1, keepdims=True) + RMS_EPS)
    o = o * gla_norm_g.astype(jnp.float32).reshape(GLA_HEADS, GLA_DV)
    c_out = (o.reshape(bsz, s_len, dvt) * jax.nn.silu(r.astype(jnp.float32))).astype(h.dtype)
    d_out = multiscale_pool(u_pool, pool_w, pool_b, pool_scale)
    return jnp.concatenate([c_out, d_out], axis=-1) @ w_out


def grouped_moe(h, router_w, router_bias, w_gate, w_up, w_down):
    bsz, s_len, d = h.shape
    n_tok = bsz * s_len
    hf = h.reshape(n_tok, d)
    scores = jax.nn.softmax((hf @ router_w).astype(jnp.float32), axis=-1)
    sel = scores + router_bias.astype(jnp.float32)
    per_group = N_EXPERTS // N_EXPERT_GROUPS
    sel_g = sel.reshape(n_tok, N_EXPERT_GROUPS, per_group)
    group_score = lax.top_k(sel_g, TOP_K)[0].sum(axis=-1)
    g_idx = jnp.argmax(group_score, axis=-1)
    in_group = sel_g[jnp.arange(n_tok), g_idx]
    _, local = lax.top_k(in_group, TOP_K)
    expert_idx = g_idx[:, None] * per_group + local
    w = jnp.take_along_axis(scores, expert_idx, axis=-1)
    w = w / jnp.sum(w, axis=-1, keepdims=True)
    combine = jnp.sum(jax.nn.one_hot(expert_idx, N_EXPERTS, dtype=jnp.float32) * w[..., None], axis=1)
    y = jnp.zeros_like(hf)
    for e in range(N_EXPERTS):
        act = jax.nn.silu(hf @ w_gate[e]) * (hf @ w_up[e])
        y = y + combine[:, e:e + 1].astype(hf.dtype) * (act @ w_down[e])
    return y.reshape(bsz, s_len, d)


def setup_inputs(seed: int = 0) -> dict:
    key = jax.random.key(seed)
    ks = iter(jax.random.split(key, 32))

    def nrm(shape, scale):
        return jax.random.normal(next(ks), shape, jnp.float32) * scale

    n_even = (DEPTH + 1) // 2
    n_odd = DEPTH // 2
    d = D_MODEL
    return {
        'x': nrm((BATCH, SEQ, d), 1.0),
        'c': nrm((BATCH, d), 1.0),
        'ada_w': nrm((DEPTH, d, 6 * d), 0.5 * d ** -0.5),
        'ada_b': nrm((DEPTH, 6 * d), 0.02),
        'norm_mix': 1.0 + nrm((DEPTH, d), 0.02),
        'norm_ffn': 1.0 + nrm((DEPTH, d), 0.02),
        'w_in_even': nrm((n_even, d, D_IN_EVEN), d ** -0.5),
        'w_out_even': nrm((n_even, D_CAT_EVEN, d), D_CAT_EVEN ** -0.5),
        'conv_w': nrm((n_even, CONV_WIDTH, D_CONV), CONV_WIDTH ** -0.5),
        'conv_b': nrm((n_even, D_CONV), 0.02),
        'conv_norm_g': 1.0 + nrm((n_even, D_CONV), 0.02),
        'conv_norm_b': nrm((n_even, D_CONV), 0.02),
        'w_in_odd': nrm((n_odd, d, D_IN_ODD), d ** -0.5),
        'w_out_odd': nrm((n_odd, D_CAT_ODD, d), D_CAT_ODD ** -0.5),
        'gla_gate_w': nrm((n_odd, GLA_RANK, GLA_HEADS * GLA_DK), GLA_RANK ** -0.5),
        'gla_gate_b': nrm((n_odd, GLA_HEADS * GLA_DK), 0.1),
        'gla_norm_g': 1.0 + nrm((n_odd, GLA_HEADS * GLA_DV), 0.02),
        'pool_w': nrm((n_odd, POOL_GROUPS, D_POOL // POOL_GROUPS, D_POOL // POOL_GROUPS), (D_POOL // POOL_GROUPS) ** -0.5),
        'pool_b': nrm((n_odd, POOL_GROUPS, D_POOL // POOL_GROUPS), 0.02),
        'pool_scale': 1.0 + nrm((n_odd, D_POOL), 0.02),
        'router_w': nrm((d, N_EXPERTS), d ** -0.5),
        'router_bias': nrm((N_EXPERTS,), 0.01),
        'moe_w_gate': nrm((DEPTH, N_EXPERTS, d, D_EXPERT), d ** -0.5),
        'moe_w_up': nrm((DEPTH, N_EXPERTS, d, D_EXPERT), d ** -0.5),
        'moe_w_down': nrm((DEPTH, N_EXPERTS, D_EXPERT, d), D_EXPERT ** -0.5),
        'final_norm': 1.0 + nrm((d,), 0.02),
    }


def reference(x, c, ada_w, ada_b, norm_mix, norm_ffn,
              w_in_even, w_out_even, conv_w, conv_b, conv_norm_g, conv_norm_b,
              w_in_odd, w_out_odd, gla_gate_w, gla_gate_b, gla_norm_g,
              pool_w, pool_b, pool_scale,
              router_w, router_bias, moe_w_gate, moe_w_up, moe_w_down, final_norm):
    cond = jax.nn.silu(c)
    for l in range(DEPTH):
        mod = (cond @ ada_w[l] + ada_b[l])[:, None, :]
        sh1, sc1, g1, sh2, sc2, g2 = jnp.split(mod, 6, axis=-1)
        h = rmsnorm(x, norm_mix[l]) * (1.0 + sc1) + sh1
        i = l // 2
        if l % 2 == 0:
            mix = even_mixer(h, w_in_even[i], w_out_even[i], conv_w[i], conv_b[i],
                             conv_norm_g[i], conv_norm_b[i])
        else:
            mix = odd_mixer(h, w_in_odd[i], w_out_odd[i], gla_gate_w[i], gla_gate_b[i],
                            gla_norm_g[i], pool_w[i], pool_b[i], pool_scale[i])
        x = x + g1 * mix
        h = rmsnorm(x, norm_ffn[l]) * (1.0 + sc2) + sh2
        x = x + g2 * grouped_moe(h, router_w, router_bias, moe_w_gate[l], moe_w_up[l], moe_w_down[l])
    return rmsnorm(x, final_norm)
```

```cpp
#include <hip/hip_runtime.h>
#include <stdint.h>

constexpr int D = 1024, NB = 4, S = 4096, T = NB * S;
constexpr int DIN0 = 2560, DIN1 = 2064, NE = 16, DE = 512;

__device__ __forceinline__ float wave_sum(float v) {
#pragma unroll
    for (int o = 1; o < 64; o <<= 1) v += __shfl_xor(v, o);
    return v;
}
__device__ __forceinline__ float sigmoidf_(float x) { return 1.f / (1.f + expf(-x)); }
__device__ __forceinline__ float siluf_(float x) { return x / (1.f + expf(-x)); }
__device__ __forceinline__ float softplusf_(float z) { return fmaxf(z, 0.f) + log1pf(expf(-fabsf(z))); }

__global__ void __launch_bounds__(256) k_mod(const float* __restrict__ c, const float* __restrict__ ada_w, const float* __restrict__ ada_b, float* __restrict__ mod) {
    __shared__ float cs[4][1024];
    for (int i = threadIdx.x; i < 4096; i += 256) { float v = c[i]; cs[i >> 10][i & 1023] = siluf_(v); }
    __syncthreads();
    const int l = blockIdx.y, j = blockIdx.x * 256 + threadIdx.x;
    const float* w = ada_w + (size_t)l * 1024 * 6144 + j;
    float a0 = 0.f, a1 = 0.f, a2 = 0.f, a3 = 0.f;
    for (int k = 0; k < 1024; ++k) { const float wv = w[(size_t)k * 6144]; a0 += cs[0][k] * wv; a1 += cs[1][k] * wv; a2 += cs[2][k] * wv; a3 += cs[3][k] * wv; }
    const float bb = ada_b[l * 6144 + j];
    mod[(l * 4 + 0) * 6144 + j] = a0 + bb; mod[(l * 4 + 1) * 6144 + j] = a1 + bb; mod[(l * 4 + 2) * 6144 + j] = a2 + bb; mod[(l * 4 + 3) * 6144 + j] = a3 + bb;
}

__global__ void __launch_bounds__(256) k_normmod(const float* __restrict__ X, const float* __restrict__ g, const float* __restrict__ modl, int sh_off, int sc_off, float* __restrict__ out) {
    const int lane = threadIdx.x & 63, t = blockIdx.x * 4 + (threadIdx.x >> 6), b = t / S;
    const float4* xr = (const float4*)(X + (size_t)t * D) + lane;
    float4 v[4]; float s = 0.f;
#pragma unroll
    for (int j = 0; j < 4; ++j) { v[j] = xr[64 * j]; s += v[j].x * v[j].x + v[j].y * v[j].y + v[j].z * v[j].z + v[j].w * v[j].w; }
    const float r = rsqrtf(wave_sum(s) * (1.f / D) + 1e-6f);
    float4* o = (float4*)(out + (size_t)t * D) + lane;
#pragma unroll
    for (int j = 0; j < 4; ++j) {
        const int c = 4 * lane + 256 * j;
        const float4 gg = *(const float4*)(g + c);
        float4 y = make_float4(v[j].x * r * gg.x, v[j].y * r * gg.y, v[j].z * r * gg.z, v[j].w * r * gg.w);
        if (modl) {
            const float4 sc = *(const float4*)(modl + b * 6144 + sc_off + c), sh = *(const float4*)(modl + b * 6144 + sh_off + c);
            y = make_float4(y.x * (1.f + sc.x) + sh.x, y.y * (1.f + sc.y) + sh.y, y.z * (1.f + sc.z) + sh.z, y.w * (1.f + sc.w) + sh.w);
        }
        o[64 * j] = y;
    }
}

template <class AL, class EP, bool DUAL>
__global__ void __launch_bounds__(256) k_gemm(int N, int K, const float* __restrict__ B1, const float* __restrict__ B2, int ldb, AL al, EP ep) {
    __shared__ float As[16][68];
    __shared__ float Bs[16][64];
    __shared__ float Bs2[DUAL ? 16 : 1][64];
    const int tid = threadIdx.x, tx = tid & 15, ty = tid >> 4, z = blockIdx.z;
    const int m0 = blockIdx.x * 64, n0 = blockIdx.y * 64;
    const int nrows = al.rows(z);
    if (m0 >= nrows) return;
    const size_t bo = al.bofs(z);
    const float* Bg1 = B1 + bo; const float* Bg2 = DUAL ? B2 + bo : nullptr;
    const int ar = tid >> 2, kq = (tid & 3) * 4;
    const float* ap = (m0 + ar < nrows) ? al.rowptr(z, m0 + ar) : nullptr;
    const int bk = tid >> 4, bn = (tid & 15) * 4; const bool bval = (n0 + bn) < N;
    float acc[4][4], acc2[4][4];
#pragma unroll
    for (int i = 0; i < 4; ++i)
#pragma unroll
        for (int j = 0; j < 4; ++j) { acc[i][j] = 0.f; acc2[i][j] = 0.f; }
    for (int k0 = 0; k0 < K; k0 += 16) {
        float4 a = make_float4(0.f, 0.f, 0.f, 0.f), b = a, b2 = a;
        if (ap) a = *(const float4*)(ap + k0 + kq);
        if (bval) b = *(const float4*)(Bg1 + (size_t)(k0 + bk) * ldb + n0 + bn);
        if (DUAL) { if (bval) b2 = *(const float4*)(Bg2 + (size_t)(k0 + bk) * ldb + n0 + bn); }
        __syncthreads();
        As[kq + 0][ar] = a.x; As[kq + 1][ar] = a.y; As[kq + 2][ar] = a.z; As[kq + 3][ar] = a.w;
        *(float4*)&Bs[bk][bn] = b;
        if (DUAL) *(float4*)&Bs2[bk][bn] = b2;
        __syncthreads();
#pragma unroll
        for (int kk = 0; kk < 16; ++kk) {
            const float4 av = *(const float4*)&As[kk][ty * 4];
            const float4 bv = *(const float4*)&Bs[kk][tx * 4];
            const float aa[4] = {av.x, av.y, av.z, av.w}, bb[4] = {bv.x, bv.y, bv.z, bv.w};
#pragma unroll
            for (int i = 0; i < 4; ++i)
#pragma unroll
                for (int j = 0; j < 4; ++j) acc[i][j] += aa[i] * bb[j];
            if (DUAL) {
                const float4 cv = *(const float4*)&Bs2[kk][tx * 4];
                const float cc[4] = {cv.x, cv.y, cv.z, cv.w};
#pragma unroll
                for (int i = 0; i < 4; ++i)
#pragma unroll
                    for (int j = 0; j < 4; ++j) acc2[i][j] += aa[i] * cc[j];
            }
        }
    }
#pragma unroll
    for (int i = 0; i < 4; ++i)
#pragma unroll
        for (int j = 0; j < 4; ++j) { const int r = m0 + ty * 4 + i, c = n0 + tx * 4 + j; if (r < nrows && c < N) ep(z, r, c, acc[i][j], acc2[i][j]); }
}
struct ALDense { const float* A; int lda; int M;
    __device__ int rows(int) const { return M; } __device__ size_t bofs(int) const { return 0; }
    __device__ const float* rowptr(int, int r) const { return A + (size_t)r * lda; } };
struct EPStore { float* C; int ldc; int pad; __device__ void operator()(int, int r, int c, float v, float) const { C[(size_t)r * ldc + c] = v; } };
struct EPResid { const float* Xin; float* Xout; const float* gate;
    __device__ void operator()(int, int r, int c, float v, float) const { const int b = r / S; Xout[(size_t)r * D + c] = Xin[(size_t)r * D + c] + gate[b * 6144 + c] * v; } };
struct ALMoeUp { const float* H; const int* off; const int* perm; size_t wstride;
    __device__ int rows(int z) const { return off[z + 1] - off[z]; } __device__ size_t bofs(int z) const { return (size_t)z * wstride; }
    __device__ const float* rowptr(int z, int r) const { return H + (size_t)(perm[off[z] + r] >> 1) * D; } };
struct EPMoeUp { float* ACT; const int* off;
    __device__ void operator()(int z, int r, int c, float g, float u) const { ACT[(size_t)(off[z] + r) * DE + c] = siluf_(g) * u; } };
struct ALMoeDown { const float* ACT; const int* off; size_t wstride;
    __device__ int rows(int z) const { return off[z + 1] - off[z]; } __device__ size_t bofs(int z) const { return (size_t)z * wstride; }
    __device__ const float* rowptr(int z, int r) const { return ACT + (size_t)(off[z] + r) * DE; } };
struct EPMoeDown { float* X; const int* off; const int* perm; const float* ew; const float* gate; int kk; int pad;
    __device__ void operator()(int z, int r, int c, float v, float) const {
        const int slot = perm[off[z] + r]; if ((slot & 1) != kk) return;
        const int t = slot >> 1, b = t / S; X[(size_t)t * D + c] += gate[b * 6144 + c] * ew[slot] * v; } };

__global__ void __launch_bounds__(512) k_conv(const float* __restrict__ U, const float* __restrict__ cw, const float* __restrict__ cb, const float* __restrict__ ng, const float* __restrict__ nb, float* __restrict__ CAT) {
    const int t = blockIdx.x, b = t / S, tt = t % S, c = threadIdx.x;
    float acc = cb[c];
    for (int j = 0; j < 31; ++j) { const int ts = tt - 30 + j; if (ts >= 0) { const float* row = U + (size_t)(b * S + ts) * DIN0; const float y = row[c] * sigmoidf_(row[512 + c]); acc += y * cw[j * 512 + c]; } }
    const float mean = wave_sum(acc) * (1.f / 64.f); const float d = acc - mean; const float var = wave_sum(d * d) * (1.f / 64.f);
    const float yn = d * rsqrtf(var + 1e-5f) * ng[c] + nb[c];
    CAT[(size_t)t * D + c] = siluf_(yn);
}

__global__ void __launch_bounds__(256) k_sb(const float* __restrict__ U, float* __restrict__ CAT) {
    const int lane = threadIdx.x & 63, idx = blockIdx.x * 4 + (threadIdx.x >> 6);
    const int bh = idx / S, tq = idx % S, b = bh >> 3, h = bh & 7;
    const float* qp = U + (size_t)(b * S + tq) * DIN0 + 1024 + h * 64;
    float q[64];
#pragma unroll
    for (int i = 0; i < 16; ++i) { const float4 v = *(const float4*)(qp + 4 * i); q[4 * i] = v.x * 0.125f; q[4 * i + 1] = v.y * 0.125f; q[4 * i + 2] = v.z * 0.125f; q[4 * i + 3] = v.w * 0.125f; }
    const float* Kb = U + (size_t)(b * S) * DIN0 + 1536 + h * 64;
    const float* Vb = U + (size_t)(b * S) * DIN0 + 2048 + h * 64;
    float o = 0.f, carry = 0.f;
    for (int s0 = tq - 1; s0 >= 0; s0 -= 64) {
        const int s = s0 - lane; const bool valid = s >= 0;
        float z = 0.f;
        if (valid) { const float* kp = Kb + (size_t)s * DIN0;
#pragma unroll
            for (int i = 0; i < 16; ++i) { const float4 v = *(const float4*)(kp + 4 * i); z += q[4 * i] * v.x + q[4 * i + 1] * v.y + q[4 * i + 2] * v.z + q[4 * i + 3] * v.w; } }
        const float sp = valid ? softplusf_(z) : 0.f;
        float incl = sp;
#pragma unroll
        for (int d = 1; d < 64; d <<= 1) { const float n = __shfl_up(incl, d); if (lane >= d) incl += n; }
        const float a = valid ? expf(z - sp - (incl - sp) - carry) : 0.f;
        carry += __shfl(incl, 63);
        const int nv = min(64, s0 + 1);
        for (int j = 0; j < nv; ++j) { const float aj = __shfl(a, j); o += aj * Vb[(size_t)(s0 - j) * DIN0 + lane]; }
    }
    CAT[(size_t)(b * S + tq) * D + 512 + h * 64 + lane] = o;
}

__global__ void __launch_bounds__(256) k_loga(const float* __restrict__ U1, const float* __restrict__ gw, const float* __restrict__ gb, float* __restrict__ LOGA) {
    const int t = blockIdx.x, j = threadIdx.x; const float* al = U1 + (size_t)t * DIN1 + 1536;
    float x = gb[j];
#pragma unroll
    for (int r = 0; r < 16; ++r) x += al[r] * gw[r * 256 + j];
    LOGA[(size_t)t * 256 + j] = -softplusf_(-x) * (1.f / 16.f);
}
__global__ void __launch_bounds__(128) k_gla(const float* __restrict__ U1, const float* __restrict__ LOGA, float* __restrict__ OG) {
    __shared__ float qs[32][64], ks[32][64], as[32][64], vs[32][128];
    const int b = blockIdx.x >> 2, h = blockIdx.x & 3, v = threadIdx.x;
    float st[64];
#pragma unroll
    for (int d = 0; d < 64; ++d) st[d] = 0.f;
    for (int t0 = 0; t0 < S; t0 += 32) {
        __syncthreads();
        for (int i = v; i < 32 * 64; i += 128) { const int tt = i >> 6, d = i & 63; const size_t row = (size_t)(b * S + t0 + tt);
            qs[tt][d] = U1[row * DIN1 + h * 64 + d] * 0.125f; ks[tt][d] = U1[row * DIN1 + 256 + h * 64 + d]; as[tt][d] = expf(LOGA[row * 256 + h * 64 + d]); }
        for (int i = v; i < 32 * 128; i += 128) { const int tt = i >> 7, d = i & 127; vs[tt][d] = U1[(size_t)(b * S + t0 + tt) * DIN1 + 512 + h * 128 + d]; }
        __syncthreads();
        for (int tt = 0; tt < 32; ++tt) {
            const float vv = vs[tt][v];
            float o = 0.f;
#pragma unroll
            for (int d = 0; d < 64; ++d) { st[d] = as[tt][d] * st[d] + ks[tt][d] * vv; o += qs[tt][d] * st[d]; }
            OG[(size_t)(b * S + t0 + tt) * 512 + h * 128 + v] = o;
        }
    }
}
__global__ void __launch_bounds__(256) k_gla_post(const float* __restrict__ U1, const float* __restrict__ OG, const float* __restrict__ gng, float* __restrict__ CAT) {
    const int lane = threadIdx.x & 63, h = threadIdx.x >> 6, t = blockIdx.x;
    const float o0 = OG[(size_t)t * 512 + h * 128 + lane], o1 = OG[(size_t)t * 512 + h * 128 + 64 + lane];
    const float r = rsqrtf(wave_sum(o0 * o0 + o1 * o1) * (1.f / 128.f) + 1e-6f);
    const float r0 = U1[(size_t)t * DIN1 + 1024 + h * 128 + lane], r1 = U1[(size_t)t * DIN1 + 1024 + h * 128 + 64 + lane];
    CAT[(size_t)t * D + h * 128 + lane] = o0 * r * gng[h * 128 + lane] * siluf_(r0);
    CAT[(size_t)t * D + h * 128 + 64 + lane] = o1 * r * gng[h * 128 + 64 + lane] * siluf_(r1);
}
__global__ void __launch_bounds__(512) k_pool(const float* __restrict__ U1, const float* __restrict__ pw, const float* __restrict__ pb, const float* __restrict__ ps, float* __restrict__ CAT) {
    __shared__ float p[512];
    const int t = blockIdx.x, tt = t % S, tid = threadIdx.x, g = tid >> 7, c = tid & 127;
    const int w = 2 << g, n = min(tt + 1, w);
    float sum = 0.f;
    for (int i = 0; i < n; ++i) sum += U1[(size_t)(t - i) * DIN1 + 1552 + tid];
    p[tid] = sum / (float)n - U1[(size_t)t * DIN1 + 1552 + tid];
    __syncthreads();
    float y = pb[tid];
    for (int cc = 0; cc < 128; ++cc) y += p[g * 128 + cc] * pw[(size_t)(g * 128 + cc) * 128 + c];
    CAT[(size_t)t * D + 512 + tid] = y * ps[tid];
}

__global__ void __launch_bounds__(256) k_router(const float* __restrict__ H, const float* __restrict__ rw, const float* __restrict__ rb, int* __restrict__ eidx, float* __restrict__ ew, int* __restrict__ spos, int* __restrict__ cnt) {
    const int lane = threadIdx.x & 63, t = blockIdx.x * 4 + (threadIdx.x >> 6);
    float acc[16];
#pragma unroll
    for (int e = 0; e < 16; ++e) acc[e] = 0.f;
    for (int i = 0; i < 16; ++i) { const int c = lane + 64 * i; const float hv = H[(size_t)t * D + c]; const float4* w4 = (const float4*)(rw + c * 16);
#pragma unroll
        for (int q = 0; q < 4; ++q) { const float4 w = w4[q]; acc[4 * q] += hv * w.x; acc[4 * q + 1] += hv * w.y; acc[4 * q + 2] += hv * w.z; acc[4 * q + 3] += hv * w.w; } }
#pragma unroll
    for (int e = 0; e < 16; ++e) acc[e] = wave_sum(acc[e]);
    float m = acc[0];
#pragma unroll
    for (int e = 1; e < 16; ++e) m = fmaxf(m, acc[e]);
    float sc[16], ssum = 0.f;
#pragma unroll
    for (int e = 0; e < 16; ++e) { sc[e] = expf(acc[e] - m); ssum += sc[e]; }
    float sel[16];
#pragma unroll
    for (int e = 0; e < 16; ++e) { sc[e] = sc[e] / ssum; sel[e] = sc[e] + rb[e]; }
    int gi = 0; float gbest = -1e30f; int l0s[4], l1s[4];
#pragma unroll
    for (int g = 0; g < 4; ++g) {
        int i0 = 0; float v0 = sel[4 * g];
#pragma unroll
        for (int i = 1; i < 4; ++i) if (sel[4 * g + i] > v0) { v0 = sel[4 * g + i]; i0 = i; }
        int i1 = -1; float v1 = -1e30f;
#pragma unroll
        for (int i = 0; i < 4; ++i) if (i != i0 && sel[4 * g + i] > v1) { v1 = sel[4 * g + i]; i1 = i; }
        l0s[g] = i0; l1s[g] = i1;
        const float gs = v0 + v1; if (gs > gbest) { gbest = gs; gi = g; }
    }
    int e0 = 0, e1 = 0;
#pragma unroll
    for (int g = 0; g < 4; ++g) if (g == gi) { e0 = 4 * g + l0s[g]; e1 = 4 * g + l1s[g]; }
    float w0 = 0.f, w1 = 0.f;
#pragma unroll
    for (int e = 0; e < 16; ++e) { if (e == e0) w0 = sc[e]; if (e == e1) w1 = sc[e]; }
    const float ws = w0 + w1;
    if (lane == 0) {
        eidx[2 * t] = e0; eidx[2 * t + 1] = e1; ew[2 * t] = w0 / ws; ew[2 * t + 1] = w1 / ws;
        spos[2 * t] = atomicAdd(&cnt[e0], 1); spos[2 * t + 1] = atomicAdd(&cnt[e1], 1);
    }
}
__global__ void __launch_bounds__(256) k_scatter(const int* __restrict__ eidx, const int* __restrict__ spos, const int* __restrict__ cnt, int* __restrict__ off, int* __restrict__ perm) {
    __shared__ int o[17];
    if (threadIdx.x == 0) { int a = 0; for (int e = 0; e < 16; ++e) { o[e] = a; a += cnt[e]; } o[16] = a; }
    __syncthreads();
    if (blockIdx.x == 0 && threadIdx.x < 17) off[threadIdx.x] = o[threadIdx.x];
    const int slot = blockIdx.x * 256 + threadIdx.x;
    if (slot < 2 * T) perm[o[eidx[slot]] + spos[slot]] = slot;
}

extern "C" void kernel_launch(void* const* d_in, const int* in_sizes, int n_in, void* d_out, int out_size, void* d_ws, size_t ws_size, hipStream_t stream) {
    const float* x = (const float*)d_in[0]; const float* c = (const float*)d_in[1]; const float* ada_w = (const float*)d_in[2]; const float* ada_b = (const float*)d_in[3];
    const float* norm_mix = (const float*)d_in[4]; const float* norm_ffn = (const float*)d_in[5];
    const float* w_in_even = (const float*)d_in[6]; const float* w_out_even = (const float*)d_in[7];
    const float* conv_w = (const float*)d_in[8]; const float* conv_b = (const float*)d_in[9]; const float* conv_ng = (const float*)d_in[10]; const float* conv_nb = (const float*)d_in[11];
    const float* w_in_odd = (const float*)d_in[12]; const float* w_out_odd = (const float*)d_in[13];
    const float* gla_gw = (const float*)d_in[14]; const float* gla_gb = (const float*)d_in[15]; const float* gla_ng = (const float*)d_in[16];
    const float* pool_w = (const float*)d_in[17]; const float* pool_b = (const float*)d_in[18]; const float* pool_s = (const float*)d_in[19];
    const float* router_w = (const float*)d_in[20]; const float* router_b = (const float*)d_in[21];
    const float* moe_wg = (const float*)d_in[22]; const float* moe_wu = (const float*)d_in[23]; const float* moe_wd = (const float*)d_in[24];
    const float* final_norm = (const float*)d_in[25];
    float* out = (float*)d_out;

    char* ws = (char*)d_ws;
    size_t o = 0;
    auto carve = [&](size_t bytes) { char* p = ws + o; o += (bytes + 255) & ~(size_t)255; return p; };
    float* mod = (float*)carve(2 * 4 * 6144 * 4);
    int* cnt = (int*)carve(256); int* off = (int*)carve(256);
    int* eidx = (int*)carve(2 * T * 4); float* ew = (float*)carve(2 * T * 4); int* spos = (int*)carve(2 * T * 4); int* perm = (int*)carve(2 * T * 4);
    float* XA = (float*)carve((size_t)T * D * 4);
    float* H = (float*)carve((size_t)T * D * 4);
    float* CAT = H;
    float* U = (float*)carve((size_t)T * DIN1 * 4 + (size_t)T * 256 * 4 + (size_t)T * 512 * 4);
    float* LOGA = U + (size_t)T * DIN1; float* OG = LOGA + (size_t)T * 256;
    float* ACT = U;
    if (o > ws_size) return;

    k_mod<<<dim3(24, 2), 256, 0, stream>>>(c, ada_w, ada_b, mod);
    for (int l = 0; l < 2; ++l) {
        const float* modl = mod + l * 4 * 6144;
        const float* xin = (l == 0) ? x : XA;
        k_normmod<<<T / 4, 256, 0, stream>>>(xin, norm_mix + l * D, modl, 0, 1024, H);
        if (l == 0) {
            k_gemm<ALDense, EPStore, false><<<dim3(T / 64, DIN0 / 64, 1), 256, 0, stream>>>(DIN0, D, w_in_even, nullptr, DIN0, ALDense{H, D, T}, EPStore{U, DIN0, 0});
            k_conv<<<T, 512, 0, stream>>>(U, conv_w, conv_b, conv_ng, conv_nb, CAT);
            k_sb<<<NB * 8 * S / 4, 256, 0, stream>>>(U, CAT);
            k_gemm<ALDense, EPResid, false><<<dim3(T / 64, D / 64, 1), 256, 0, stream>>>(D, D, w_out_even, nullptr, D, ALDense{CAT, D, T}, EPResid{xin, XA, modl + 2048});
        } else {
            k_gemm<ALDense, EPStore, false><<<dim3(T / 64, (DIN1 + 63) / 64, 1), 256, 0, stream>>>(DIN1, D, w_in_odd, nullptr, DIN1, ALDense{H, D, T}, EPStore{U, DIN1, 0});
            k_loga<<<T, 256, 0, stream>>>(U, gla_gw, gla_gb, LOGA);
            k_gla<<<16, 128, 0, stream>>>(U, LOGA, OG);
            k_gla_post<<<T, 256, 0, stream>>>(U, OG, gla_ng, CAT);
            k_pool<<<T, 512, 0, stream>>>(U, pool_w, pool_b, pool_s, CAT);
            k_gemm<ALDense, EPResid, false><<<dim3(T / 64, D / 64, 1), 256, 0, stream>>>(D, D, w_out_odd, nullptr, D, ALDense{CAT, D, T}, EPResid{xin, XA, modl + 2048});
        }
        k_normmod<<<T / 4, 256, 0, stream>>>(XA, norm_ffn + l * D, modl, 3072, 4096, H);
        (void)hipMemsetAsync(cnt, 0, 256, stream);
        k_router<<<T / 4, 256, 0, stream>>>(H, router_w, router_b, eidx, ew, spos, cnt);
        k_scatter<<<2 * T / 256, 256, 0, stream>>>(eidx, spos, cnt, off, perm);
        const size_t wgu = (size_t)l * NE * D * DE;
        k_gemm<ALMoeUp, EPMoeUp, true><<<dim3(2 * T / 64, DE / 64, NE), 256, 0, stream>>>(DE, D, moe_wg + wgu, moe_wu + wgu, DE, ALMoeUp{H, off, perm, (size_t)D * DE}, EPMoeUp{ACT, off});
        for (int kk = 0; kk < 2; ++kk)
            k_gemm<ALMoeDown, EPMoeDown, false><<<dim3(2 * T / 64, D / 64, NE), 256, 0, stream>>>(D, DE, moe_wd + wgu, nullptr, D, ALMoeDown{ACT, off, (size_t)DE * D}, EPMoeDown{XA, off, perm, ew, modl + 5120, kk, 0});
    }
    k_normmod<<<T / 4, 256, 0, stream>>>(XA, final_norm, nullptr, 0, 0, out);
}
```

```cpp
#include <hip/hip_runtime.h>
#include <cstdint>
#include <cstdio>

constexpr int D = 1024, NB = 4, S = 4096, T = NB * S, NE = 16, DE = 512;
constexpr int NIN0 = 2560, NIN1 = 2048, QW = 2048;
constexpr float QSCALE0 = 0.125f * 1.4426950408889634f;

#define GAS __attribute__((address_space(1)))
#define LAS __attribute__((address_space(3)))
typedef unsigned short bf16;
typedef unsigned v4u __attribute__((ext_vector_type(4)));
typedef unsigned v2u __attribute__((ext_vector_type(2)));
typedef float f32x4 __attribute__((ext_vector_type(4)));
typedef short bf16x8 __attribute__((ext_vector_type(8)));
typedef GAS unsigned gu32;
#define RLX_AGENT __ATOMIC_RELAXED, __HIP_MEMORY_SCOPE_AGENT
#define LDS_WAIT() asm volatile("s_waitcnt lgkmcnt(0)" ::: "memory")
#define VM_WAIT() asm volatile("s_waitcnt vmcnt(0)" ::: "memory")

__device__ __forceinline__ unsigned f2bf(float f) { unsigned u = __builtin_bit_cast(unsigned, f); return (u + 0x7fffu + ((u >> 16) & 1u)) >> 16; }
__device__ __forceinline__ unsigned pk2(float lo, float hi) { unsigned r; asm volatile("v_cvt_pk_bf16_f32 %0, %1, %2" : "=v"(r) : "v"(lo), "v"(hi)); return r; }
__device__ __forceinline__ float bflo(unsigned u) { return __uint_as_float(u << 16); }
__device__ __forceinline__ float bfhi(unsigned u) { return __uint_as_float(u & 0xffff0000u); }
__device__ __forceinline__ float bf2f(bf16 h) { return __uint_as_float((unsigned)h << 16); }
__device__ __forceinline__ int lane_id() { int l; asm volatile("v_mbcnt_lo_u32_b32 %0, -1, 0\n\tv_mbcnt_hi_u32_b32 %0, -1, %0" : "=v"(l)); return l; }
template <int CTRL> __device__ __forceinline__ float dpp_add(float v) { return v + __int_as_float(__builtin_amdgcn_update_dpp(0, __float_as_int(v), CTRL, 0xF, 0xF, false)); }
__device__ __forceinline__ float row_sum16(float v) {
    v = dpp_add<0xB1>(v); v = dpp_add<0x4E>(v); v = dpp_add<0x141>(v); v = dpp_add<0x140>(v); return v; }
__device__ __forceinline__ float rdlane(float v, int l) { return __int_as_float(__builtin_amdgcn_readlane(__float_as_int(v), l)); }
__device__ __forceinline__ float wave_sum(float v) { v = row_sum16(v); return (rdlane(v, 0) + rdlane(v, 16)) + (rdlane(v, 32) + rdlane(v, 48)); }
__device__ __forceinline__ float xor16_add(float v) { auto rr = __builtin_amdgcn_permlane16_swap(__float_as_uint(v), __float_as_uint(v), false, false); return __uint_as_float(rr[0]) + __uint_as_float(rr[1]); }
__device__ __forceinline__ int wave_sum_i(int v) { return (int)wave_sum((float)v); }
__device__ __forceinline__ int wave_scan_i(int v) { const int l = lane_id();
#pragma unroll
    for (int d = 1; d < 64; d <<= 1) { const int n = __builtin_amdgcn_ds_bpermute((l - d) << 2, v); if (l >= d) v += n; }
    return v; }
__device__ __forceinline__ float sigmoidf_(float x) { return __builtin_amdgcn_rcpf(1.f + __builtin_amdgcn_exp2f(-1.4426950408889634f * x)); }
__device__ __forceinline__ float siluf_(float x) { return x * __builtin_amdgcn_rcpf(1.f + __builtin_amdgcn_exp2f(-1.4426950408889634f * x)); }
__device__ __forceinline__ float softplusf_(float z) { return fmaxf(z, 0.f) + 0.6931471805599453f * __builtin_amdgcn_logf(1.f + __builtin_amdgcn_exp2f(-1.4426950408889634f * fabsf(z))); }

namespace pg8 {
#define PG8_LAS __attribute__((address_space(3)))
typedef unsigned short bf16_t;
typedef short bf16x8 __attribute__((ext_vector_type(8)));
typedef float f32x4 __attribute__((ext_vector_type(4)));
typedef unsigned u32x4 __attribute__((ext_vector_type(4)));
constexpr int BM = 256, BK = 64, HALF = 128, HTB = HALF * BK * 2, STAGE_BYTES = 8 * HTB, NXCD = 8, WGM = 8;

__host__ __device__ __forceinline__ int lds_byte(int r, int c) { const int st = (r >> 4) * 2 + (c >> 5), rr = r & 15, cc = c & 31, ob = rr * 64 + cc * 2; return st * 1024 + (ob ^ (((ob >> 9) & 1) << 5)); }
__host__ __device__ __forceinline__ void stage_rc(int b, int& R, int& C) { const int st = b / 1024, sb = b % 1024, swz = sb ^ (((sb >> 9) & 1) << 5); R = (st >> 1) * 16 + swz / 64; C = (st & 1) * 32 + (swz % 64) / 2; }
__host__ __device__ __forceinline__ int perm32(int rho) { const int n = rho >> 4, i = rho & 15; return 8 * (i >> 2) + 4 * n + (i & 3); }

struct Unit { int pm, pn, e, li, nr, r0; };

struct DenseSched {
    const bf16_t* A; const bf16_t* Bt; int K; int nM, nN, nwg, G, c; unsigned* pcnt = nullptr; unsigned* acnt = nullptr; unsigned aneed = 0;
    __device__ void init(const bf16_t* A_, const bf16_t* Bt_, int M, int N, int K_, int G_, int c_) { A = A_; Bt = Bt_; K = K_; nM = M / BM; nN = N / BM; nwg = nM * nN; G = G_; c = c_; }
    __device__ __forceinline__ bool next(int i, Unit& u) const {
        const long L = (long)i * G + c; if (L >= nwg) return false;
        int wgid = (int)L; { const int q = nwg / NXCD, r = nwg % NXCD, xcd = wgid % NXCD, off = wgid / NXCD; wgid = (xcd < r ? xcd * (q + 1) : r * (q + 1) + (xcd - r) * q) + off; }
        const int nig = WGM * nN, gid = wgid / nig, fm = gid * WGM, gsz = (nM - fm) < WGM ? (nM - fm) : WGM;
        u.pm = fm + ((wgid % nig) % gsz); u.pn = (wgid % nig) / gsz; u.e = 0; u.li = i; u.nr = 256; u.r0 = u.pm * BM; return true;
    }
    __device__ __forceinline__ const char* a_base(const Unit& u) const { return (const char*)A + (size_t)u.pm * BM * K * 2; }
    __device__ __forceinline__ const char* b_base(const Unit& u) const { return (const char*)Bt + (size_t)u.pn * BM * K * 2; }
    static constexpr bool GATHER = false;
    __device__ __forceinline__ void a_ready(const Unit& u, int wid, int lane) const {
        if (acnt) {
            if (wid == 0) { unsigned sp = 0;
                while ((unsigned)__builtin_amdgcn_readfirstlane(__hip_atomic_load(acnt + 64 * u.pm, __ATOMIC_RELAXED, __HIP_MEMORY_SCOPE_AGENT)) < aneed) { __builtin_amdgcn_s_sleep(2); if (++sp > (1u << 20)) break; }
                __builtin_amdgcn_fence(__ATOMIC_ACQUIRE, "agent");
                asm volatile("s_waitcnt vmcnt(0)" ::: "memory"); }
            asm volatile("" ::: "memory"); __builtin_amdgcn_s_barrier(); asm volatile("" ::: "memory");
        }
    }
    __device__ __forceinline__ void publish(int pm, int lane) const { if (pcnt && lane == 0) __hip_atomic_fetch_add(pcnt + 64 * pm, 1u, __ATOMIC_RELAXED, __HIP_MEMORY_SCOPE_AGENT); }
    __device__ __forceinline__ void a_off(const Unit&, int tid, unsigned (&v)[4]) const {
#pragma unroll
        for (int i = 0; i < 2; ++i) { int R, C; stage_rc(tid * 16 + i * 8192, R, C);
#pragma unroll
            for (int h = 0; h < 2; ++h) v[2 * h + i] = (unsigned)((h * HALF + R) * K + C) * 2u; }
    }
};

template <class Epi, class Sched, bool ALIGN_EPI>
__device__ __forceinline__ void gemm_phase(PG8_LAS unsigned char* lds, const int K, const Sched& S, const Epi& E, const int wave_id) {
    int wid_ = wave_id; asm volatile("" : "+s"(wid_));
    const int wid = wid_, lane = lane_id(), tid = wid * 64 + lane,
        wr = wid >> 2, wc = wid & 3, fr = lane & 15, fq = lane >> 4;
    const int nt = K / BK;
    unsigned voffB[2];
#pragma unroll
    for (int i = 0; i < 2; ++i) { int R, C; stage_rc(tid * 16 + i * 8192, R, C); const int Rb = Epi::PERM ? ((R & ~31) + perm32(R & 31)) : R; voffB[i] = (unsigned)(Rb * K + C) * 2u; }
    const size_t kstep = (size_t)(BK * 2);
    const size_t hstep = (size_t)HALF * K * 2;
    const unsigned ldsw = (unsigned)wid * 1024u;
    const int aoff = lds_byte(wr * 64 + fr, fq * 8), boff = lds_byte(wc * 32 + fr, fq * 8);
#define PG8_SA(b, h) (((b) * 2 + (h)) * HTB)
#define PG8_SB(b, h) ((4 + (b) * 2 + (h)) * HTB)
#define PG8_STAGE2(bufoff, gbase, o0, o1) do { \
        __builtin_amdgcn_global_load_lds((const unsigned*)((const char*)(gbase) + (o0)), (PG8_LAS unsigned*)(lds + (bufoff) + ldsw), 16, 0, 0); \
        __builtin_amdgcn_global_load_lds((const unsigned*)((const char*)(gbase) + (o1)), (PG8_LAS unsigned*)(lds + (bufoff) + ldsw + 8192), 16, 0, 0); } while (0)
#define PG8_STAGEB(bufoff, gbase) PG8_STAGE2(bufoff, gbase, voffB[0], voffB[1])
#define PG8_LDA(dst, b, h) do { _Pragma("unroll") for (int m = 0; m < 4; ++m) _Pragma("unroll") for (int k = 0; k < 2; ++k) dst[m][k] = *(const PG8_LAS bf16x8*)(lds + PG8_SA(b, h) + aoff + m * 2048 + k * 1024); } while (0)
#define PG8_LDB(dst, b, h) do { _Pragma("unroll") for (int n = 0; n < 2; ++n) _Pragma("unroll") for (int k = 0; k < 2; ++k) dst[n][k] = *(const PG8_LAS bf16x8*)(lds + PG8_SB(b, h) + boff + n * 2048 + k * 1024); } while (0)
#define PG8_MMA(ai, bj, At, Bt) do { __builtin_amdgcn_s_setprio(1); _Pragma("unroll") for (int m = 0; m < 4; ++m) _Pragma("unroll") for (int n = 0; n < 2; ++n) _Pragma("unroll") for (int k = 0; k < 2; ++k) \
        acc[ai][bj][m][n] = __builtin_amdgcn_mfma_f32_16x16x32_bf16(Bt[n][k], At[m][k], acc[ai][bj][m][n], 0, 0, 0); __builtin_amdgcn_s_setprio(0); } while (0)
#define PG8_WAIT_V(n) asm volatile("s_waitcnt vmcnt(" #n ")" ::: "memory")
#define PG8_WAIT_L(n) asm volatile("s_waitcnt lgkmcnt(" #n ")" ::: "memory")
#define PG8_BAR __builtin_amdgcn_s_barrier()
#define PG8_SCHED __builtin_amdgcn_sched_barrier(0)
    Unit cur, nxt; int ui = 0;
    if (!S.next(0, cur)) return;
    f32x4 acc[2][2][4][2];
#pragma unroll
    for (int a = 0; a < 2; ++a)
#pragma unroll
        for (int b = 0; b < 2; ++b)
#pragma unroll
            for (int m = 0; m < 4; ++m)
#pragma unroll
                for (int n = 0; n < 2; ++n) acc[a][b][m][n] = (f32x4){0.f, 0.f, 0.f, 0.f};
    bf16x8 At[4][2], B0[2][2], B1[2][2];
    unsigned vc[4];
    S.a_ready(cur, wid, lane);
    S.a_off(cur, tid, vc);
    const char* cA = S.a_base(cur); const char* cB = S.b_base(cur);
    PG8_STAGEB(PG8_SB(0, 0), cB); PG8_STAGEB(PG8_SB(0, 1), cB + hstep); PG8_STAGE2(PG8_SA(0, 0), cA, vc[0], vc[1]); PG8_STAGE2(PG8_SA(0, 1), cA, vc[2], vc[3]);
    if (wr == 1) PG8_BAR;
    PG8_WAIT_V(2); PG8_BAR;
    PG8_STAGEB(PG8_SB(1, 0), cB + kstep); PG8_STAGE2(PG8_SA(1, 0), cA + kstep, vc[0], vc[1]); PG8_STAGEB(PG8_SB(1, 1), cB + hstep + kstep);
    PG8_WAIT_V(6); PG8_BAR;
    int pend = -1;
    for (;;) {
        const bool has_next = S.next(ui + 1, nxt);
        const char* nA = cA; const char* nB = cB;
        if (has_next) { nA = S.a_base(nxt); nB = S.b_base(nxt); }
        for (int t = 0; t < nt; t += 2) {
            const bool last = (t == nt - 2);
            if (last && has_next) S.a_ready(nxt, wid, lane);
            const char* a1 = cA + (size_t)(t + 1) * kstep;
            const char* a2 = last ? nA : cA + (size_t)(t + 2) * kstep; const char* b2 = last ? nB : cB + (size_t)(t + 2) * kstep;
            const char* a3 = a2 + kstep; const char* b3 = b2 + kstep;
            PG8_LDB(B0, 0, 0); PG8_LDB(B1, 0, 1); PG8_SCHED; PG8_LDA(At, 0, 0); PG8_STAGE2(PG8_SA(1, 1), a1, vc[2], vc[3]);
            if constexpr (Sched::GATHER) { if (last && has_next) S.a_off(nxt, tid, vc); }
            PG8_WAIT_V(8); PG8_WAIT_L(0); PG8_BAR; PG8_MMA(0, 0, At, B0); PG8_MMA(0, 1, At, B1); PG8_BAR; PG8_SCHED;
            PG8_LDA(At, 0, 1); PG8_STAGEB(PG8_SB(0, 0), b2); PG8_STAGEB(PG8_SB(0, 1), b2 + hstep); PG8_STAGE2(PG8_SA(0, 0), a2, vc[0], vc[1]);
            PG8_WAIT_V(8);
            if (pend >= 0) { S.publish(pend, lane); pend = -1; }
            PG8_WAIT_L(0); PG8_BAR; PG8_MMA(1, 0, At, B0); PG8_MMA(1, 1, At, B1); PG8_BAR; PG8_SCHED;
            PG8_LDB(B0, 1, 0); PG8_LDB(B1, 1, 1); PG8_SCHED; PG8_LDA(At, 1, 0); PG8_STAGE2(PG8_SA(0, 1), a2, vc[2], vc[3]);
            PG8_WAIT_V(8); PG8_WAIT_L(0); PG8_BAR; PG8_MMA(0, 0, At, B0); PG8_MMA(0, 1, At, B1); PG8_BAR; PG8_SCHED;
            PG8_LDA(At, 1, 1); PG8_STAGEB(PG8_SB(1, 0), b3); PG8_STAGEB(PG8_SB(1, 1), b3 + hstep); PG8_STAGE2(PG8_SA(1, 0), a3, vc[0], vc[1]);
            PG8_WAIT_V(8); PG8_WAIT_L(0); PG8_BAR; PG8_MMA(1, 0, At, B0); PG8_MMA(1, 1, At, B1); PG8_BAR; PG8_SCHED;
        }
        if constexpr (ALIGN_EPI) { if (wr == 0) PG8_BAR; }
        E(acc, cur, wr, wc, fr, fq);
        pend = cur.pm;
        if (!has_next) break;
#pragma unroll
        for (int a = 0; a < 2; ++a)
#pragma unroll
            for (int b = 0; b < 2; ++b)
#pragma unroll
                for (int m = 0; m < 4; ++m)
#pragma unroll
                    for (int n = 0; n < 2; ++n) acc[a][b][m][n] = (f32x4){0.f, 0.f, 0.f, 0.f};
        cur = nxt; cA = nA; cB = nB; ++ui;
        if constexpr (ALIGN_EPI) { if (wr == 1) PG8_BAR; }
    }
    PG8_WAIT_V(0);
    if (pend >= 0) S.publish(pend, lane);
    if constexpr (!ALIGN_EPI) { if (wr == 0) PG8_BAR; }
    PG8_BAR;
#undef PG8_SA
#undef PG8_SB
#undef PG8_STAGE2
#undef PG8_STAGEB
#undef PG8_LDA
#undef PG8_LDB
#undef PG8_MMA
#undef PG8_WAIT_V
#undef PG8_WAIT_L
#undef PG8_BAR
#undef PG8_SCHED
}
}

constexpr size_t MiB = 1u << 20;
constexpr size_t WS_CTL = 0, CTL_ZERO_BYTES = 1 * MiB;
constexpr size_t WS_MOD = 1 * MiB;
constexpr size_t WS_ALOWW = WS_MOD + 256 * 1024;
constexpr size_t WS_CNTW = WS_ALOWW + 64 * 1024;
constexpr size_t WS_EIDX = WS_CNTW + 16 * 1024;
constexpr size_t WS_EW = WS_EIDX + (size_t)2 * T * 4;
constexpr size_t WS_LOC = WS_EW + (size_t)2 * T * 4;
constexpr size_t WS_ALOW = WS_LOC + 1 * MiB;
constexpr size_t WS_WPT = WS_ALOW + 1 * MiB;
constexpr size_t WS_WIN0 = 5 * MiB;
constexpr size_t WS_WOUT0 = WS_WIN0 + (size_t)NIN0 * D * 2;
constexpr size_t WS_WIN1 = WS_WOUT0 + (size_t)D * D * 2;
constexpr size_t WS_WOUT1 = WS_WIN1 + (size_t)NIN1 * D * 2;
constexpr size_t WS_WGU = WS_WOUT1 + (size_t)D * D * 2;
constexpr size_t WS_WD = WS_WGU + (size_t)2 * NE * 1024 * D * 2;
constexpr size_t WS_X1 = WS_WD + (size_t)2 * NE * D * DE * 2;
constexpr size_t WS_XN = WS_X1 + (size_t)T * D * 2;
constexpr size_t WS_QKVY = WS_XN + (size_t)T * D * 2;
constexpr size_t WS_CAT = WS_QKVY + (size_t)T * QW * 2;
constexpr size_t WS_END = WS_CAT + (size_t)(2 * T + 256) * DE * 2;
static_assert(WS_WPT + 128 * 1024 <= WS_WIN0, "small tables fit below the weights");
static_assert(WS_END <= 346000000, "workspace budget");
constexpr int CW_BAR = 4096;
constexpr int CW_APANEL = 98304;
constexpr int CW_PANEL = 65536;

constexpr int RING_BYTES = 131072;
constexpr int LDSCTL_OFF = RING_BYTES;
constexpr int L_MISC = LDSCTL_OFF;
constexpr int L_NE = L_MISC + 256;
constexpr int L_ROWTAB = L_NE + 512;
constexpr int LDS_BYTES = 147456;
static_assert(L_ROWTAB + 8192 <= LDS_BYTES, "LDS map");

#define XB_TMO      128
#define XB_XCNT(j)  (256  + 64 * (j))
#define XB_XSUB(j)  (1280 + 64 * (j))
#define XB_XGEN(j)  (2304 + 64 * (j))
#define XB_TOP      3328
#define XB_TOPGEN   3392
#define XCD_BAR_WORDS 3456
#define XB_SPIN_CAP (1u << 18)
__device__ __forceinline__ unsigned xb_ld(unsigned* p)              { return __hip_atomic_load(p, __ATOMIC_RELAXED, __HIP_MEMORY_SCOPE_AGENT); }
__device__ __forceinline__ unsigned xb_add(unsigned* p, unsigned v) { return __hip_atomic_fetch_add(p, v, __ATOMIC_RELAXED, __HIP_MEMORY_SCOPE_AGENT); }
__device__ __forceinline__ unsigned xb_xcc_id() { return (unsigned)__builtin_amdgcn_s_getreg((3 << 11) | 20) & 0xFu; }
#define XB_SPIN(cond, bar) do { unsigned _sp = 0; while (cond) { __builtin_amdgcn_s_sleep(1); \
    if ((++_sp & 255u) == 0u) { if (xb_ld(&(bar)[XB_TMO])) break; if (_sp > XB_SPIN_CAP) { atomicAdd(&(bar)[XB_TMO], 1u); break; } } } } while (0)
struct XcdBarrier { unsigned* bar; unsigned x; volatile LAS unsigned* st; int wave; };
__device__ __forceinline__ XcdBarrier xcd_barrier_post(unsigned* bar, volatile LAS unsigned* st, int wave) {
    XcdBarrier b; b.bar = bar; b.x = xb_xcc_id(); b.st = st; b.wave = wave;
    if (wave == 0 && lane_id() == 0) (void)xb_add(&bar[XB_XCNT(b.x)], 1u);
    return b;
}
__device__ __forceinline__ void xcd_barrier_complete(unsigned* bar, unsigned x, unsigned& nloc, unsigned& nx) {
    const unsigned G = gridDim.x * gridDim.y * gridDim.z;
    unsigned sum, cnt, mine, sp = 0u;
    for (;;) {
        sum = 0u; cnt = 0u; mine = 0u;
#pragma unroll
        for (unsigned j = 0; j < 16; ++j) { const unsigned c = xb_ld(&bar[XB_XCNT(j)]); sum += c; cnt += (c > 0u) ? 1u : 0u; mine = (j == x) ? c : mine; }
        if (sum == G) break;
        __builtin_amdgcn_s_sleep(1);
        if ((++sp & 255u) == 0u) { if (xb_ld(&bar[XB_TMO])) break; if (sp > XB_SPIN_CAP) { atomicAdd(&bar[XB_TMO], 1u); break; } }
    }
    nloc = mine > 0u ? mine : 1u; nx = cnt > 0u ? cnt : 1u;
}
__device__ __forceinline__ void xcd_barrier(const XcdBarrier& b) {
    asm volatile("s_waitcnt vmcnt(0)" ::: "memory");
    __syncthreads();
    if (b.wave == 0 && lane_id() == 0) {
        unsigned* bar = b.bar;
        __builtin_amdgcn_s_waitcnt(0);
        unsigned nloc = b.st[0], nx = b.st[1];
        if (nloc == 0u) { xcd_barrier_complete(bar, b.x, nloc, nx); b.st[0] = nloc; b.st[1] = nx; }
        const unsigned old = xb_add(&bar[XB_XSUB(b.x)], 1u);
        const unsigned gen = old / nloc;
        if (old + 1u == (gen + 1u) * nloc) {
            __builtin_amdgcn_fence(__ATOMIC_RELEASE, "agent");
            asm volatile("s_waitcnt vmcnt(0)" ::: "memory");
            const unsigned og = xb_add(&bar[XB_TOP], 1u);
            const unsigned tg = og / nx;
            if (og + 1u == (tg + 1u) * nx) xb_add(&bar[XB_TOPGEN], 1u);
            else XB_SPIN(xb_ld(&bar[XB_TOPGEN]) == tg, bar);
            __builtin_amdgcn_fence(__ATOMIC_ACQUIRE, "agent");
            xb_add(&bar[XB_XGEN(b.x)], 1u);
            asm volatile("s_waitcnt vmcnt(0)" ::: "memory");
        } else {
            XB_SPIN(xb_ld(&bar[XB_XGEN(b.x)]) == gen, bar);
            __builtin_amdgcn_fence(__ATOMIC_ACQUIRE, "agent");
            asm volatile("s_waitcnt vmcnt(0)" ::: "memory");
        }
    }
    __syncthreads();
}

struct Args { const float* in[26]; float* out; unsigned char* ws; };
struct Frame {
    LAS unsigned char* lds; unsigned char* ws;
    int tid, lane, wave, vcu, G, bx;
};
typedef const __attribute__((address_space(4))) Args* KA;
__device__ __forceinline__ KA kargs() { auto p = __builtin_amdgcn_kernarg_segment_ptr(); asm volatile("" : "+s"(p)); return (KA)p; }
#define INP(k) (args->in[k])

struct P0Item { const float* s; bf16* d; int ldw, Kd; };
__device__ __forceinline__ void p0_load(const P0Item& it, float (&r)[32], int lane) {
#pragma unroll
    for (int i = 0; i < 32; ++i) r[i] = __builtin_nontemporal_load(it.s + (size_t)(2 * i + (lane >> 5)) * it.ldw + (lane & 31));
}
__device__ __forceinline__ void p0_store(const P0Item& it, const float (&r)[32], LAS float* scr, int lane) {
#pragma unroll
    for (int i = 0; i < 32; ++i) scr[(2 * i + (lane >> 5)) * 33 + (lane & 31)] = r[i];
    LDS_WAIT(); asm volatile("" ::: "memory");
    const int c = lane & 7;
#pragma unroll
    for (int j = 0; j < 4; ++j) { const int n = (lane >> 3) + 8 * j; const LAS float* sp = scr + (8 * c) * 33 + n;
        v4u o; o.x = pk2(sp[0 * 33], sp[1 * 33]); o.y = pk2(sp[2 * 33], sp[3 * 33]); o.z = pk2(sp[4 * 33], sp[5 * 33]); o.w = pk2(sp[6 * 33], sp[7 * 33]);
        __builtin_nontemporal_store(o, (GAS v4u*)(it.d + (size_t)n * it.Kd + 8 * c)); }
    LDS_WAIT(); asm volatile("" ::: "memory");
}
template <class DMap>
__device__ __forceinline__ P0Item p0_matrix(const float* W, int ldw, int K, int scol0, int ncols, bf16* WT, const DMap& dmap, int it) {
    const int nblk = ncols / 32, kb = it / nblk, nb = it % nblk, n0 = 32 * nb;
    return P0Item{W + (size_t)(64 * kb) * ldw + scol0 + n0, WT + (size_t)(dmap(n0 >> 7) + (n0 & 127)) * K + 64 * kb, ldw, K};
}
struct MapId { int base; __device__ int operator()(int g) const { return base + 128 * g; } };
struct MapGlu { int second; __device__ int operator()(int g) const { return 256 * g + second; } };

constexpr int P0_I_IN0A = 16 * 16, P0_I_IN0Q = 16 * 48, P0_I_OUT = 16 * 32, P0_I_IN1A = 16 * 48, P0_I_IN1P = 16 * 16, P0_I_G = 16 * 16, P0_I_D = 8 * 32;
constexpr int P0_I_MOE = 2 * P0_I_G + P0_I_D;
constexpr int P0_I_PW = 4 * 8;
constexpr int P0_NITEMS = 2 * P0_I_IN0A + P0_I_IN0Q + 2 * P0_I_OUT + P0_I_IN1A + P0_I_IN1P + P0_I_PW + 32 * P0_I_MOE;
constexpr int P0_NFILL = 8 * P0_I_MOE;
__device__ __forceinline__ void p0_items(KA args, Frame& F, int first, int last, int widx, int nw) {
    LAS float* scr = (LAS float*)(F.lds + F.wave * 16384);
    auto decode = [&](int it) -> P0Item {
        KA args = kargs();
        unsigned char* ws = args->ws;
        bf16* win0 = (bf16*)(ws + WS_WIN0); bf16* wout0 = (bf16*)(ws + WS_WOUT0); bf16* win1 = (bf16*)(ws + WS_WIN1); bf16* wout1 = (bf16*)(ws + WS_WOUT1);
        int r = it;
        if (r < P0_I_IN0A) return p0_matrix(INP(6), NIN0, D, 0, 512, win0, MapGlu{0}, r); r -= P0_I_IN0A;
        if (r < P0_I_IN0A) return p0_matrix(INP(6), NIN0, D, 512, 512, win0, MapGlu{128}, r); r -= P0_I_IN0A;
        if (r < P0_I_IN0Q) return p0_matrix(INP(6), NIN0, D, 1024, 1536, win0, MapId{1024}, r); r -= P0_I_IN0Q;
        if (r < P0_I_OUT) return p0_matrix(INP(7), D, D, 0, 1024, wout0, MapId{0}, r); r -= P0_I_OUT;
        if (r < P0_I_IN1A) return p0_matrix(INP(12), 2064, D, 0, 1536, win1, MapId{0}, r); r -= P0_I_IN1A;
        if (r < P0_I_IN1P) return p0_matrix(INP(12), 2064, D, 1552, 512, win1, MapId{1536}, r); r -= P0_I_IN1P;
        if (r < P0_I_OUT) return p0_matrix(INP(13), D, D, 0, 1024, wout1, MapId{0}, r); r -= P0_I_OUT;
        if (r < P0_I_PW) { const int g = r >> 3; return p0_matrix(INP(17) + (size_t)g * 128 * 128, 128, 128, 0, 128, (bf16*)(ws + WS_WPT) + (size_t)g * 128 * 128, MapId{0}, r & 7); } r -= P0_I_PW;
        const int le = r / P0_I_MOE; r -= le * P0_I_MOE;
        bf16* wgu = (bf16*)(ws + WS_WGU) + (size_t)le * 1024 * D; bf16* wd = (bf16*)(ws + WS_WD) + (size_t)le * D * DE;
        if (r < P0_I_G) return p0_matrix(INP(22) + (size_t)le * D * DE, DE, D, 0, 512, wgu, MapGlu{0}, r); r -= P0_I_G;
        if (r < P0_I_G) return p0_matrix(INP(23) + (size_t)le * D * DE, DE, D, 0, 512, wgu, MapGlu{128}, r); r -= P0_I_G;
        return p0_matrix(INP(24) + (size_t)le * DE * D, D, DE, 0, 1024, wd, MapId{0}, r);
    };
    const int i0 = first + widx;
    if (i0 < last) {
        P0Item cur = decode(i0); float rc[32]; p0_load(cur, rc, F.lane);
        for (int it = i0; it < last; it += nw) {
            P0Item nx = cur; float rn[32];
            if (it + nw < last) { nx = decode(it + nw); p0_load(nx, rn, F.lane); }
            p0_store(cur, rc, scr, F.lane);
            if (it + nw < last) { cur = nx;
#pragma unroll
                for (int i = 0; i < 32; ++i) rc[i] = rn[i]; }
        }
    }
}
__device__ __forceinline__ void p0_prologue(KA args, Frame& F) {
    unsigned char* ws = F.ws;
    if (F.vcu < 192) {
        LAS float* cs = (LAS float*)F.lds;
        LAS float* part = (LAS float*)(F.lds + 16384);
        const float* c = INP(1);
        for (int i = F.tid; i < 4096; i += 512) cs[i] = siluf_(c[i]);
        __syncthreads();
        const int l = F.vcu / 96, cg = F.vcu % 96;
        const int c4 = F.lane & 15, kq = F.lane >> 4;
        const f32x4* wp = (const f32x4*)(INP(2) + (size_t)l * 1024 * 6144 + 64 * cg) + c4;
        f32x4 a0 = {0.f, 0.f, 0.f, 0.f}, a1 = a0, a2 = a0, a3 = a0;
#pragma unroll 8
        for (int kk = 0; kk < 32; ++kk) { const int k = 128 * F.wave + 4 * kk + kq; const f32x4 wv = __builtin_nontemporal_load(wp + (size_t)k * 1536);
            a0 += cs[k] * wv; a1 += cs[1024 + k] * wv; a2 += cs[2048 + k] * wv; a3 += cs[3072 + k] * wv; }
        f32x4 av[4] = {a0, a1, a2, a3};
#pragma unroll
        for (int b4 = 0; b4 < 4; ++b4)
#pragma unroll
            for (int q = 0; q < 4; ++q) { float v = xor16_add(av[b4][q]); auto rr = __builtin_amdgcn_permlane32_swap(__float_as_uint(v), __float_as_uint(v), false, false); av[b4][q] = __uint_as_float(rr[0]) + __uint_as_float(rr[1]); }
        if (F.lane < 16) {
#pragma unroll
            for (int b4 = 0; b4 < 4; ++b4) *(LAS f32x4*)(part + (F.wave * 4 + b4) * 64 + 4 * c4) = av[b4]; }
        __syncthreads();
        float* mod = (float*)(ws + WS_MOD);
        if (F.tid < 256) { const int b = F.tid >> 6, col = F.tid & 63; float sm = INP(3)[l * 6144 + 64 * cg + col];
#pragma unroll
            for (int w = 0; w < 8; ++w) sm += part[(w * 4 + b) * 64 + col];
            mod[(l * 4 + b) * 6144 + 64 * cg + col] = sm; }
        __syncthreads();
    }
    { float* aw = (float*)(ws + WS_ALOWW); const float* w1 = INP(12);
      for (int i = F.vcu * 512 + F.tid; i < 1024 * 16; i += F.G * 512) aw[i] = w1[(size_t)(i >> 4) * 2064 + 1536 + (i & 15)]; }
    p0_items(args, F, 0, P0_NITEMS - P0_NFILL, F.vcu * 8 + F.wave, F.G * 8);
}

__device__ __forceinline__ void norm_row(f32x4 (&v)[4], int lane, const float* g, const float* sc, const float* sh) {
    float s = 0.f;
#pragma unroll
    for (int j = 0; j < 4; ++j) s += (v[j].x * v[j].x + v[j].y * v[j].y) + (v[j].z * v[j].z + v[j].w * v[j].w);
    const float r = rsqrtf(wave_sum(s) * (1.f / D) + 1e-6f);
#pragma unroll
    for (int j = 0; j < 4; ++j) { const int c = 4 * lane + 256 * j; const f32x4 gg = *(const f32x4*)(g + c);
        v[j] = v[j] * r * gg;
        if (sc) { const f32x4 s1 = *(const f32x4*)(sc + c), s0 = *(const f32x4*)(sh + c); v[j] = v[j] * (1.f + s1) + s0; } }
}
__device__ __forceinline__ void store_row_bf16(const f32x4 (&v)[4], int lane, bf16* orow) {
    GAS v2u* o = (GAS v2u*)orow + lane;
#pragma unroll
    for (int j = 0; j < 4; ++j) { v2u w; w.x = pk2(v[j].x, v[j].y); w.y = pk2(v[j].z, v[j].w); o[64 * j] = w; }
}


__device__ __forceinline__ void load_row_bf16(const bf16* row, int lane, f32x4 (&v)[4]) {
    const GAS v2u* p = (const GAS v2u*)row + lane;
#pragma unroll
    for (int j = 0; j < 4; ++j) { const v2u w = p[64 * j]; v[j] = (f32x4){bflo(w.x), bfhi(w.x), bflo(w.y), bfhi(w.y)}; }
}
constexpr int W16_PITCH = 20;
__device__ __forceinline__ void stage_w16(LAS float* tabw, const float* w, int tid) {
    for (int i = tid; i < 1024 * 4; i += 512) { const int c = i >> 2, k4 = i & 3; const f32x4 v = *(const f32x4*)(w + c * 16 + 4 * k4);
        const int sidx = ((c >> 8) * 4 + (c & 3)) * 64 + ((c >> 2) & 63); *(LAS f32x4*)(tabw + sidx * W16_PITCH + 4 * k4) = v; }
}
__device__ __forceinline__ void dot16(const f32x4 (&v)[4], const LAS float* tabw, int lane, float (&lg)[16]) {
    float a[16];
#pragma unroll
    for (int e = 0; e < 16; ++e) a[e] = 0.f;
#pragma unroll
    for (int j = 0; j < 4; ++j)
#pragma unroll
        for (int q = 0; q < 4; ++q) { const float hv = v[j][q]; const LAS float* p = tabw + ((j * 4 + q) * 64 + lane) * W16_PITCH;
#pragma unroll
            for (int k = 0; k < 4; ++k) { const f32x4 w = *(const LAS f32x4*)(p + 4 * k); a[4 * k] += hv * w.x; a[4 * k + 1] += hv * w.y; a[4 * k + 2] += hv * w.z; a[4 * k + 3] += hv * w.w; } }
    float b[8], c[4];
#pragma unroll
    for (int i = 0; i < 8; ++i) { auto rr = __builtin_amdgcn_permlane32_swap(__float_as_uint(a[i]), __float_as_uint(a[i + 8]), false, false); b[i] = __uint_as_float(rr[0]) + __uint_as_float(rr[1]); }
#pragma unroll
    for (int i = 0; i < 4; ++i) { auto rr = __builtin_amdgcn_permlane16_swap(__float_as_uint(b[i]), __float_as_uint(b[i + 4]), false, false); c[i] = row_sum16(__uint_as_float(rr[0]) + __uint_as_float(rr[1])); }
#pragma unroll
    for (int e = 0; e < 16; ++e) lg[e] = rdlane(c[e & 3], 16 * (e >> 2));
}

__device__ __forceinline__ void store16_wt(void* p, v4u v) { asm volatile("global_store_dwordx4 %0, %1, off sc1\n\ts_nop 1" :: "v"(p), "v"(v) : "memory"); }

struct EpiIn0 {
    static constexpr bool PERM = true;
    bf16* O;
    __device__ __forceinline__ void operator()(const f32x4 (&acc)[2][2][4][2], const pg8::Unit& u, int wr, int wc, int fr, int fq) const {
        const int row0 = u.pm * 256 + wr * 64 + fr;
        if (u.pn < 4) {
            const int col0 = u.pn * 128 + wc * 32 + 8 * fq;
#pragma unroll
            for (int ai = 0; ai < 2; ++ai)
#pragma unroll
                for (int m = 0; m < 4; ++m) { bf16* rowp = O + (size_t)(row0 + ai * 128 + m * 16) * QW + col0;
                    const f32x4 a0 = acc[ai][0][m][0], a1 = acc[ai][0][m][1], g0 = acc[ai][1][m][0], g1 = acc[ai][1][m][1];
                    v4u w; w.x = pk2(a0[0] * sigmoidf_(g0[0]), a0[1] * sigmoidf_(g0[1])); w.y = pk2(a0[2] * sigmoidf_(g0[2]), a0[3] * sigmoidf_(g0[3]));
                    w.z = pk2(a1[0] * sigmoidf_(g1[0]), a1[1] * sigmoidf_(g1[1])); w.w = pk2(a1[2] * sigmoidf_(g1[2]), a1[3] * sigmoidf_(g1[3]));
                    *(v4u*)rowp = w; }
        } else {
            const float sc = (u.pn < 6) ? QSCALE0 : 1.f;
            const int col0 = 512 + (u.pn - 4) * 256 + wc * 32 + 8 * fq;
#pragma unroll
            for (int ai = 0; ai < 2; ++ai)
#pragma unroll
                for (int m = 0; m < 4; ++m) { bf16* rowp = O + (size_t)(row0 + ai * 128 + m * 16) * QW + col0;
#pragma unroll
                    for (int bj = 0; bj < 2; ++bj) { const f32x4 v0 = acc[ai][bj][m][0] * sc, v1 = acc[ai][bj][m][1] * sc;
                        v4u w; w.x = pk2(v0[0], v0[1]); w.y = pk2(v0[2], v0[3]); w.z = pk2(v1[0], v1[1]); w.w = pk2(v1[2], v1[3]);
                        *(v4u*)(rowp + bj * 128) = w; } }
        }
    }
};
struct EpiIn1 {
    static constexpr bool PERM = true;
    bf16* O;
    __device__ __forceinline__ void operator()(const f32x4 (&acc)[2][2][4][2], const pg8::Unit& u, int wr, int wc, int fr, int fq) const {
        const int row0 = u.pm * 256 + wr * 64 + fr;
        const float sc = (u.pn == 0) ? 0.125f : 1.f;
        const int col0 = u.pn * 256 + wc * 32 + 8 * fq;
#pragma unroll
        for (int ai = 0; ai < 2; ++ai)
#pragma unroll
            for (int m = 0; m < 4; ++m) { bf16* rowp = O + (size_t)(row0 + ai * 128 + m * 16) * QW + col0;
#pragma unroll
                for (int bj = 0; bj < 2; ++bj) { const f32x4 v0 = acc[ai][bj][m][0] * sc, v1 = acc[ai][bj][m][1] * sc;
                    v4u w; w.x = pk2(v0[0], v0[1]); w.y = pk2(v0[2], v0[3]); w.z = pk2(v1[0], v1[1]); w.w = pk2(v1[2], v1[3]);
                    *(v4u*)(rowp + bj * 128) = w; } }
    }
};
template <bool XIN_F32> struct EpiOut {
    static constexpr bool PERM = true;
    const void* xin; bf16* xout; const float* gate;
    __device__ __forceinline__ void operator()(const f32x4 (&acc)[2][2][4][2], const pg8::Unit& u, int wr, int wc, int fr, int fq) const {
        const int row0 = u.pm * 256 + wr * 64 + fr, col0 = u.pn * 256 + wc * 32 + 8 * fq;
        const float* gb = gate + ((u.pm * 256) / S) * 6144 + col0;
        f32x4 gv[2][2];
#pragma unroll
        for (int bj = 0; bj < 2; ++bj)
#pragma unroll
            for (int n = 0; n < 2; ++n) gv[bj][n] = *(const f32x4*)(gb + bj * 128 + 4 * n);
#pragma unroll
        for (int ai = 0; ai < 2; ++ai)
#pragma unroll
            for (int m = 0; m < 4; ++m) { const size_t off = (size_t)(row0 + ai * 128 + m * 16) * D + col0;
#pragma unroll
                for (int bj = 0; bj < 2; ++bj) { f32x4 x0, x1;
                    if (XIN_F32) { const float* xp = (const float*)xin + off + bj * 128; x0 = *(const f32x4*)xp; x1 = *(const f32x4*)(xp + 4); }
                    else { const v4u w = *(const v4u*)((const bf16*)xin + off + bj * 128); x0 = (f32x4){bflo(w.x), bfhi(w.x), bflo(w.y), bfhi(w.y)}; x1 = (f32x4){bflo(w.z), bfhi(w.z), bflo(w.w), bfhi(w.w)}; }
                    x0 += gv[bj][0] * acc[ai][bj][m][0]; x1 += gv[bj][1] * acc[ai][bj][m][1];
                    v4u o; o.x = pk2(x0[0], x0[1]); o.y = pk2(x0[2], x0[3]); o.z = pk2(x1[0], x1[1]); o.w = pk2(x1[2], x1[3]);
                    store16_wt(xout + off + bj * 128, o); } }
    }
};

constexpr int CW_MOECNT = 32768;
__device__ __forceinline__ int moe_unit_index(int mode, int i, int c, int G, int U, int nlow, int nfull) {
    if (i >= 4) return -1;
    int X;
    if (mode == 1) X = i * G + c;
    else if (c >= nfull) { const int j = c - nfull; X = (i == 0) ? j : (i == 1) ? j + nlow : 2 * nlow + c + (i - 2) * G; }
    else X = 2 * nlow + c + i * G;
    return X < U ? X : -1;
}
template <int MODE> struct MoeSched {
    const bf16* A; const bf16* Bt; int K; size_t bstride;
    LAS int* tab; LAS int* rowtab;
    unsigned* cnt; int G, c;
    static constexpr bool GATHER = (MODE == 1);
    __device__ __forceinline__ bool next(int i, pg8::Unit& u) const {
        const int U = __builtin_amdgcn_readfirstlane(tab[49]);
        const int X = moe_unit_index(MODE, i, c, G, U, __builtin_amdgcn_readfirstlane(tab[61]), __builtin_amdgcn_readfirstlane(tab[62]));
        if (X < 0) return false;
        int e = 0;
#pragma unroll
        for (int j = 1; j < 16; ++j) if (X >= __builtin_amdgcn_readfirstlane(tab[33 + j])) e = j;
        const int r = X - __builtin_amdgcn_readfirstlane(tab[33 + e]); const int rt = r >> 2, ct = r & 3;
        u.pm = X >> 2; u.pn = ct; u.e = e; u.li = (MODE == 1 ? 0 : 4) + i; u.r0 = __builtin_amdgcn_readfirstlane(tab[16 + e]) + 256 * rt; u.nr = min(256, __builtin_amdgcn_readfirstlane(tab[e]) - 256 * rt); return true;
    }
    __device__ __forceinline__ const char* a_base(const pg8::Unit& u) const { return GATHER ? (const char*)A : (const char*)A + (size_t)u.r0 * K * 2; }
    __device__ __forceinline__ const char* b_base(const pg8::Unit& u) const { return (const char*)Bt + (size_t)u.e * bstride + (size_t)u.pn * 256 * K * 2; }
    __device__ __forceinline__ void a_off(const pg8::Unit& u, int tid, unsigned (&v)[4]) const {
#pragma unroll
        for (int i = 0; i < 2; ++i) { int R, C; pg8::stage_rc(tid * 16 + i * 8192, R, C);
#pragma unroll
            for (int h = 0; h < 2; ++h) {
                if (GATHER) v[2 * h + i] = (unsigned)(rowtab[u.li * 256 + h * 128 + R] >> 1) * (unsigned)(K * 2) + (unsigned)C * 2u;
                else v[2 * h + i] = (unsigned)((h * 128 + R) * K + C) * 2u;
            } }
    }
    __device__ __forceinline__ void a_ready(const pg8::Unit& u, int wid, int lane) const {
        if (MODE == 2) {
            if (wid == 0) { unsigned sp = 0;
                while ((unsigned)__builtin_amdgcn_readfirstlane(__hip_atomic_load(cnt + 64 * u.pm, __ATOMIC_RELAXED, __HIP_MEMORY_SCOPE_AGENT)) < 32u) { __builtin_amdgcn_s_sleep(2); if (++sp > (1u << 20)) break; }
                __builtin_amdgcn_fence(__ATOMIC_ACQUIRE, "agent");
                asm volatile("s_waitcnt vmcnt(0)" ::: "memory"); }
            asm volatile("" ::: "memory"); __builtin_amdgcn_s_barrier(); asm volatile("" ::: "memory");
        }
    }
    __device__ __forceinline__ void publish(int rtg, int lane) const {
        if (MODE == 1) { if (lane == 0) __hip_atomic_fetch_add(cnt + 64 * rtg, 1u, __ATOMIC_RELAXED, __HIP_MEMORY_SCOPE_AGENT); }
    }
};
__device__ __forceinline__ void moe_plan(Frame& F, const int* cntw, const int* loc, int c) {
    LAS int* tab = (LAS int*)(F.lds + L_NE); LAS int* rowtab = (LAS int*)(F.lds + L_ROWTAB);
    __syncthreads();
    for (int ee = 0; ee < 2; ++ee) { const int e = 2 * F.wave + ee; int s = 0;
#pragma unroll
        for (int i = 0; i < 4; ++i) s += cntw[(F.lane + 64 * i) * 16 + e];
        s = wave_sum_i(s); if (F.lane == 0) tab[e] = s; }
    for (int i = F.tid; i < 2048; i += 512) rowtab[i] = 0;
    __syncthreads();
    if (F.tid == 0) { int a = 0, ub = 0; for (int e = 0; e < 16; ++e) { tab[16 + e] = a; tab[33 + e] = ub; a += tab[e]; ub += 4 * ((tab[e] + 255) >> 8); } tab[32] = a; tab[49] = ub;
        const int R = 1 + (ub > F.G) + (ub > 2 * F.G) + (ub > 3 * F.G), nfull = ub - (R - 1) * F.G;
        tab[60] = R; tab[61] = F.G - nfull; tab[62] = nfull; }
    __syncthreads();
    const int li = F.wave;
    const int X = moe_unit_index(li < 4 ? 1 : 2, li & 3, c, F.G, tab[49], tab[61], tab[62]);
    if (X >= 0) {
        int e = 0;
        for (int j = 1; j < 16; ++j) if (X >= tab[33 + j]) e = j;
        const int rt = (X - tab[33 + e]) >> 2;
        int cw[4], tot = 0;
#pragma unroll
        for (int i = 0; i < 4; ++i) { cw[i] = cntw[(4 * F.lane + i) * 16 + e]; tot += cw[i]; }
        const int incl = wave_scan_i(tot);
        int start = incl - tot - 256 * rt;
#pragma unroll
        for (int i = 0; i < 4; ++i) { if (start < 256 && start + cw[i] > 0) { for (int j = 0; j < cw[i]; ++j) { const int rank = start + j; if (rank >= 0 && rank < 256) rowtab[li * 256 + rank] = loc[((4 * F.lane + i) * 16 + e) * 64 + j]; } } start += cw[i]; }
    }
    __syncthreads();
}
struct EpiM1 {
    static constexpr bool PERM = true;
    bf16* ACT; const float* ew; LAS int* rowtab;
    __device__ __forceinline__ void operator()(const f32x4 (&acc)[2][2][4][2], const pg8::Unit& u, int wr, int wc, int fr, int fq) const {
        const int col0 = u.pn * 128 + wc * 32 + 8 * fq;
#pragma unroll
        for (int ai = 0; ai < 2; ++ai)
#pragma unroll
            for (int m = 0; m < 4; ++m) { const int r = ai * 128 + wr * 64 + m * 16 + fr;
                if (r < u.nr) { const float w8 = ew[rowtab[u.li * 256 + r]];
                    const f32x4 g0 = acc[ai][0][m][0], g1 = acc[ai][0][m][1], u0 = acc[ai][1][m][0], u1 = acc[ai][1][m][1];
                    v4u w; w.x = pk2(siluf_(g0[0]) * u0[0] * w8, siluf_(g0[1]) * u0[1] * w8); w.y = pk2(siluf_(g0[2]) * u0[2] * w8, siluf_(g0[3]) * u0[3] * w8);
                    w.z = pk2(siluf_(g1[0]) * u1[0] * w8, siluf_(g1[1]) * u1[1] * w8); w.w = pk2(siluf_(g1[2]) * u1[2] * w8, siluf_(g1[3]) * u1[3] * w8);
                    store16_wt(ACT + (size_t)(u.r0 + r) * DE + col0, w); } }
    }
};
struct EpiM2 {
    static constexpr bool PERM = true;
    bf16* YS; LAS int* rowtab;
    __device__ __forceinline__ void operator()(const f32x4 (&acc)[2][2][4][2], const pg8::Unit& u, int wr, int wc, int fr, int fq) const {
        const int col0 = u.pn * 256 + wc * 32 + 8 * fq;
#pragma unroll
        for (int ai = 0; ai < 2; ++ai)
#pragma unroll
            for (int m = 0; m < 4; ++m) { const int r = ai * 128 + wr * 64 + m * 16 + fr;
                if (r < u.nr) { bf16* rowp = YS + (size_t)rowtab[u.li * 256 + r] * D + col0;
#pragma unroll
                    for (int bj = 0; bj < 2; ++bj) { const f32x4 v0 = acc[ai][bj][m][0], v1 = acc[ai][bj][m][1];
                        v4u w; w.x = pk2(v0[0], v0[1]); w.y = pk2(v0[2], v0[3]); w.z = pk2(v1[0], v1[1]); w.w = pk2(v1[2], v1[3]);
                        *(v4u*)(rowp + bj * 128) = w; } } }
    }
};

constexpr int MX_PITCH = 520;
__device__ __forceinline__ void stage_rows(LAS bf16* dst, const bf16* QKVY, int col0, int t0, int halo, int tid) {
    const int tt0 = t0 % S, nrow = 64 + halo;
    for (int p = tid; p < nrow * 64; p += 512) { const int row = p >> 6, c8 = (p & 63) * 8; v4u v = {0u, 0u, 0u, 0u};
        if (tt0 - halo + row >= 0) v = *(const v4u*)(QKVY + (size_t)(t0 - halo + row) * QW + col0 + c8);
        *(LAS v4u*)(dst + row * MX_PITCH + c8) = v; }
}
__device__ __forceinline__ void conv_phase(KA args, Frame& F, const bf16* QKVY, bf16* CAT) {
    typedef float f2 __attribute__((ext_vector_type(2)));
    LAS bf16* ys = (LAS bf16*)F.lds;
    const int half = F.tid >> 8, cp = (F.tid & 255) * 2;
    const float* cw = INP(8);
    f2 w[31];
#pragma unroll
    for (int j = 0; j < 31; ++j) w[j] = *(const f2*)(cw + j * 512 + cp);
    const f2 bb = *(const f2*)(INP(9) + cp), gg = *(const f2*)(INP(10) + cp), nn = *(const f2*)(INP(11) + cp);
    for (int chunk = F.vcu; chunk < T / 64; chunk += F.G) {
        const int t0 = chunk * 64;
        __syncthreads();
        stage_rows(ys, QKVY, 0, t0, 30, F.tid);
        __syncthreads();
        for (int blk = 0; blk < 4; ++blk) { const int tok0 = half * 32 + blk * 8;
            f2 y[38];
#pragma unroll
            for (int r = 0; r < 38; ++r) { const unsigned u = *(const LAS unsigned*)(ys + (tok0 + r) * MX_PITCH + cp); y[r] = (f2){bflo(u), bfhi(u)}; }
#pragma unroll
            for (int i = 0; i < 8; ++i) { f2 a = bb;
#pragma unroll
                for (int j = 0; j < 31; ++j) a = y[i + j] * w[j] + a;
                float s = xor16_add(row_sum16(a.x + a.y));
                const float mean = s * (1.f / 64.f); const f2 d = a - mean;
                float q = xor16_add(row_sum16(d.x * d.x + d.y * d.y));
                const float rs = rsqrtf(q * (1.f / 64.f) + 1e-5f);
                const f2 yn = d * rs * gg + nn;
                *(unsigned*)(CAT + (size_t)(t0 + tok0 + i) * D + cp) = pk2(siluf_(yn.x), siluf_(yn.y)); }
        }
    }
}
__device__ __forceinline__ void pool_phase(KA args, Frame& F, const bf16* QKVY, const bf16* WPT, bf16* CAT) {
    typedef float f32x16 __attribute__((ext_vector_type(16)));
    LAS bf16* us = (LAS bf16*)F.lds;
    const int g = (F.wave < 4) ? 3 - (F.wave >> 1) : ((F.wave - 4) >> 1), tt = F.wave & 1, r32 = F.lane & 31, hi = F.lane >> 5, win = 2 << g;
    const float* pb = INP(18); const float* ps = INP(19);
    for (int chunk = F.vcu; chunk < T / 64; chunk += F.G) {
        const int t0 = chunk * 64, tt0 = t0 % S;
        __syncthreads();
        stage_rows(us, QKVY, 1536, t0, 15, F.tid);
        __syncthreads();
        const int tok = tt * 32 + r32;
        const float inv = 1.f / (float)min(tt0 + tok + 1, win);
        f32x16 acc[4];
#pragma unroll
        for (int ct = 0; ct < 4; ++ct) acc[ct] = (f32x16){};
        for (int ks = 0; ks < 8; ++ks) {
            const LAS bf16* col = us + (tok + 15) * MX_PITCH + g * 128 + 16 * ks + 8 * hi;
            float sm[8];
#pragma unroll
            for (int e = 0; e < 8; ++e) sm[e] = 0.f;
            for (int j = 0; j < win; ++j) { const v4u u = *(const LAS v4u*)(col - j * MX_PITCH);
                sm[0] += bflo(u.x); sm[1] += bfhi(u.x); sm[2] += bflo(u.y); sm[3] += bfhi(u.y); sm[4] += bflo(u.z); sm[5] += bfhi(u.z); sm[6] += bflo(u.w); sm[7] += bfhi(u.w); }
            const v4u c = *(const LAS v4u*)col;
            v4u pa; pa.x = pk2(sm[0] * inv - bflo(c.x), sm[1] * inv - bfhi(c.x)); pa.y = pk2(sm[2] * inv - bflo(c.y), sm[3] * inv - bfhi(c.y));
            pa.z = pk2(sm[4] * inv - bflo(c.z), sm[5] * inv - bfhi(c.z)); pa.w = pk2(sm[6] * inv - bflo(c.w), sm[7] * inv - bfhi(c.w));
            const bf16x8 af = __builtin_bit_cast(bf16x8, pa);
#pragma unroll
            for (int ct = 0; ct < 4; ++ct) { const bf16x8 bfr = *(const bf16x8*)(WPT + (size_t)(g * 128 + 32 * ct + r32) * 128 + 16 * ks + 8 * hi);
                acc[ct] = __builtin_amdgcn_mfma_f32_32x32x16_bf16(af, bfr, acc[ct], 0, 0, 0); }
        }
#pragma unroll
        for (int ct = 0; ct < 4; ++ct) { const int n = g * 128 + 32 * ct + r32; const float bb = pb[n], sc = ps[n];
#pragma unroll
            for (int r = 0; r < 16; ++r) { const int row = tt * 32 + (r & 3) + 8 * (r >> 2) + 4 * hi;
                CAT[(size_t)(t0 + row) * D + 512 + n] = (bf16)(pk2((acc[ct][r] + bb) * sc, 0.f) & 0xffffu); } }
    }
}

namespace sba {
typedef short bf16x8 __attribute__((ext_vector_type(8)));
typedef short s16x4 __attribute__((ext_vector_type(4)));
typedef short v4i16_t __attribute__((ext_vector_type(4)));
typedef _Float16 h8 __attribute__((ext_vector_type(8)));
typedef _Float16 h2 __attribute__((ext_vector_type(2)));
typedef float f2 __attribute__((ext_vector_type(2)));
typedef float f32x16 __attribute__((ext_vector_type(16)));
typedef unsigned u32x4 __attribute__((ext_vector_type(4)));
typedef __bf16 bf16x2_t __attribute__((ext_vector_type(2)));
constexpr int KVB = 64, SLOTB = 8192;
constexpr float THR = 160.f;
__device__ __forceinline__ void glds16(const void* gsrc, unsigned lds_dst) { unsigned keep;
    asm volatile("s_mov_b32 %0, m0\n\ts_mov_b32 m0, %2\n\ts_nop 0\n\tglobal_load_lds_dwordx4 %1, off\n\ts_mov_b32 m0, %0" : "=&s"(keep) : "v"(gsrc), "s"(lds_dst) : "memory"); }
__device__ __forceinline__ unsigned cvtpk_bf(float lo, float hi) { f2 v = {lo, hi}; bf16x2_t b = __builtin_convertvector(v, bf16x2_t); return __builtin_bit_cast(unsigned, b); }
__device__ __forceinline__ unsigned cvtpk_h(float lo, float hi) { f2 v = {lo, hi}; h2 b = __builtin_convertvector(v, h2); return __builtin_bit_cast(unsigned, b); }
__device__ __forceinline__ float min30(float a) { float r; asm("v_min_f32_e32 %0, 0x41f00000, %1" : "=v"(r) : "v"(a)); return r; }
__device__ __forceinline__ float maxf_(float a, float b) { float r; asm("v_max_f32_e32 %0, %1, %2" : "=v"(r) : "v"(a), "v"(b)); return r; }
typedef __attribute__((address_space(3))) const char* lds_cptr;
__device__ __forceinline__ s16x4 vtr(lds_cptr p) { return __builtin_bit_cast(s16x4, __builtin_amdgcn_ds_read_tr16_b64_v4i16((__attribute__((address_space(3))) v4i16_t*)p)); }
#define SBA_H(x) __builtin_bit_cast(h8, x)
#define SBA_P(x) __builtin_bit_cast(bf16x8, x)

template <bool DIAG> __device__ __forceinline__ void tile(f32x16& p0, f32x16& p1, f32x16& o0, f32x16& o1, float& C, const h8& T0, const h8& T1, const h8& ONES, int kvb, int hi, lds_cptr vp) {
    const float z0 = p0[0];
    u32x4 lf0, lf1, lf2, lf3;
    {
        float l[16];
#pragma unroll
        for (int r = 0; r < 16; ++r) { const float z = p0[r]; float v = maxf_(__builtin_amdgcn_logf(1.f + __builtin_amdgcn_exp2f(min30(z))), z);
            if (DIAG) { if (kvb + (r & 3) + 8 * (r >> 2) >= 0) v = 0.f; } l[r] = v; }
        lf0 = (u32x4){cvtpk_h(l[0], l[1]), cvtpk_h(l[2], l[3]), cvtpk_h(l[4], l[5]), cvtpk_h(l[6], l[7])};
        lf1 = (u32x4){cvtpk_h(l[8], l[9]), cvtpk_h(l[10], l[11]), cvtpk_h(l[12], l[13]), cvtpk_h(l[14], l[15])};
#pragma unroll
        for (int r = 0; r < 16; ++r) { const float z = p1[r]; float v = maxf_(__builtin_amdgcn_logf(1.f + __builtin_amdgcn_exp2f(min30(z))), z);
            if (DIAG) { if (kvb + 32 + (r & 3) + 8 * (r >> 2) >= 0) v = 0.f; } l[r] = v; }
        if (!DIAG) l[15] += hi ? C : 0.f;
        lf2 = (u32x4){cvtpk_h(l[0], l[1]), cvtpk_h(l[2], l[3]), cvtpk_h(l[4], l[5]), cvtpk_h(l[6], l[7])};
        lf3 = (u32x4){cvtpk_h(l[8], l[9]), cvtpk_h(l[10], l[11]), cvtpk_h(l[12], l[13]), cvtpk_h(l[14], l[15])};
    }
    p0 = __builtin_amdgcn_mfma_f32_32x32x16_f16(T0, SBA_H(lf0), p0, 0, 0, 0);
    p0 = __builtin_amdgcn_mfma_f32_32x32x16_f16(T1, SBA_H(lf1), p0, 0, 0, 0);
    p0 = __builtin_amdgcn_mfma_f32_32x32x16_f16(ONES, SBA_H(lf2), p0, 0, 0, 0);
    p0 = __builtin_amdgcn_mfma_f32_32x32x16_f16(ONES, SBA_H(lf3), p0, 0, 0, 0);
    p1 = __builtin_amdgcn_mfma_f32_32x32x16_f16(T0, SBA_H(lf2), p1, 0, 0, 0);
    p1 = __builtin_amdgcn_mfma_f32_32x32x16_f16(T1, SBA_H(lf3), p1, 0, 0, 0);
    float cn = z0 - p0[0];
    { auto rr = __builtin_amdgcn_permlane32_swap(__float_as_uint(cn), __float_as_uint(cn), false, false); cn = __uint_as_float(rr[0]); }
    C = cn;
    u32x4 pw0, pw1, pw2, pw3;
    {
        float a[16];
#pragma unroll
        for (int r = 0; r < 16; ++r) { float v = __builtin_amdgcn_exp2f(p0[r]); if (DIAG) { if (kvb + (r & 3) + 8 * (r >> 2) >= 0) v = 0.f; } a[r] = v; }
        pw0 = (u32x4){cvtpk_bf(a[0], a[1]), cvtpk_bf(a[2], a[3]), cvtpk_bf(a[4], a[5]), cvtpk_bf(a[6], a[7])};
        pw1 = (u32x4){cvtpk_bf(a[8], a[9]), cvtpk_bf(a[10], a[11]), cvtpk_bf(a[12], a[13]), cvtpk_bf(a[14], a[15])};
#pragma unroll
        for (int r = 0; r < 16; ++r) { float v = __builtin_amdgcn_exp2f(p1[r]); if (DIAG) { if (kvb + 32 + (r & 3) + 8 * (r >> 2) >= 0) v = 0.f; } a[r] = v; }
        pw2 = (u32x4){cvtpk_bf(a[0], a[1]), cvtpk_bf(a[2], a[3]), cvtpk_bf(a[4], a[5]), cvtpk_bf(a[6], a[7])};
        pw3 = (u32x4){cvtpk_bf(a[8], a[9]), cvtpk_bf(a[10], a[11]), cvtpk_bf(a[12], a[13]), cvtpk_bf(a[14], a[15])};
    }
#define SBA_VFR(i) ({ const s16x4 lo_ = vtr(vp + (((i) >> 2) * 4096 + ((i) & 3) * 1024)); const s16x4 hi_ = vtr(vp + (((i) >> 2) * 4096 + ((i) & 3) * 1024 + 512)); (bf16x8){lo_[0], lo_[1], lo_[2], lo_[3], hi_[0], hi_[1], hi_[2], hi_[3]}; })
    o0 = __builtin_amdgcn_mfma_f32_32x32x16_bf16(SBA_P(pw0), SBA_VFR(0), o0, 0, 0, 0);
    o1 = __builtin_amdgcn_mfma_f32_32x32x16_bf16(SBA_P(pw0), SBA_VFR(4), o1, 0, 0, 0);
    o0 = __builtin_amdgcn_mfma_f32_32x32x16_bf16(SBA_P(pw1), SBA_VFR(1), o0, 0, 0, 0);
    o1 = __builtin_amdgcn_mfma_f32_32x32x16_bf16(SBA_P(pw1), SBA_VFR(5), o1, 0, 0, 0);
    o0 = __builtin_amdgcn_mfma_f32_32x32x16_bf16(SBA_P(pw2), SBA_VFR(2), o0, 0, 0, 0);
    o1 = __builtin_amdgcn_mfma_f32_32x32x16_bf16(SBA_P(pw2), SBA_VFR(6), o1, 0, 0, 0);
    o0 = __builtin_amdgcn_mfma_f32_32x32x16_bf16(SBA_P(pw3), SBA_VFR(3), o0, 0, 0, 0);
    o1 = __builtin_amdgcn_mfma_f32_32x32x16_bf16(SBA_P(pw3), SBA_VFR(7), o1, 0, 0, 0);
#undef SBA_VFR
}

__device__ __forceinline__ void wave_unit(int b, int h, int qi, const bf16* QKVY, bf16* CAT, char* shm_wave, int lane) {
    const int r32 = lane & 31, hi = lane >> 5;
    const long rowbase = (long)b * S; const int r0 = qi * 32;
    const bf16* Qw = QKVY + (rowbase + r0) * QW + 512 + h * 64;
    const bf16* Kl = QKVY + (rowbase + r32) * QW + 1024 + h * 64 + 8 * hi;
    const bf16* Vl = QKVY + (rowbase + (lane >> 2)) * QW + 1536 + h * 64 + (lane & 3) * 8;
    const unsigned lds0 = (unsigned)(uintptr_t)shm_wave;
    const lds_cptr vp0 = (lds_cptr)shm_wave + ((lane >> 4) & 1) * 32 + (lane & 3) * 8 + (4 * hi + ((lane & 15) >> 2)) * 64;
#define SBA_LOAD_V(t) do { _Pragma("unroll") for (int p_ = 0; p_ < 8; ++p_) vreg[p_] = *reinterpret_cast<const u32x4*>(Vl + ((long)(t) * KVB + 16 * (p_ & 3)) * QW + (p_ >> 2) * 32); } while (0)
#define SBA_STORE_V(slot) do { _Pragma("unroll") for (int p_ = 0; p_ < 8; ++p_) *(__attribute__((address_space(3))) u32x4*)((lds_cptr)shm_wave + (slot) * SLOTB + p_ * 1024 + lane * 16) = vreg[p_]; } while (0)
#define SBA_LOAD_K(t) do { _Pragma("unroll") for (int d0_ = 0; d0_ < 4; ++d0_) { kf[2 * d0_] = *reinterpret_cast<const bf16x8*>(Kl + (long)(t) * KVB * QW + 16 * d0_); kf[2 * d0_ + 1] = *reinterpret_cast<const bf16x8*>(Kl + ((long)(t) * KVB + 32) * QW + 16 * d0_); } } while (0)
    const int td = (r0 + 31) >> 6;
    bf16x8 kf[8], qr[4]; u32x4 vreg[8];
    SBA_LOAD_V(td); SBA_STORE_V(0);
    SBA_LOAD_K(td);
#pragma unroll
    for (int d0 = 0; d0 < 4; ++d0) qr[d0] = *reinterpret_cast<const bf16x8*>(&Qw[(long)r32 * QW + d0 * 16 + hi * 8]);
    h8 T0, T1, ONES;
#pragma unroll
    for (int jj = 0; jj < 8; ++jj) { const int kap = 8 * (jj >> 2) + 4 * hi + (jj & 3); T0[jj] = (kap >= r32) ? (_Float16)-1.0f : (_Float16)0.0f; T1[jj] = (16 + kap >= r32) ? (_Float16)-1.0f : (_Float16)0.0f; ONES[jj] = (_Float16)-1.0f; }
    f32x16 o0 = {}, o1 = {};
    float C = 0.f;
    for (int it = 0;; ++it) {
        const int t = td - it, slot = it & 1;
        f32x16 p0 = {}, p1 = {};
#pragma unroll
        for (int d0 = 0; d0 < 4; ++d0) { p0 = __builtin_amdgcn_mfma_f32_32x32x16_bf16(kf[2 * d0], qr[d0], p0, 0, 0, 0); p1 = __builtin_amdgcn_mfma_f32_32x32x16_bf16(kf[2 * d0 + 1], qr[d0], p1, 0, 0, 0); }
        if (t > 0) { SBA_LOAD_K(t - 1); SBA_LOAD_V(t - 1); }
        const lds_cptr vp = vp0 + slot * SLOTB;
        if (it == 0) tile<true>(p0, p1, o0, o1, C, T0, T1, ONES, KVB * t + 4 * hi - (r0 + r32), hi, vp);
        else tile<false>(p0, p1, o0, o1, C, T0, T1, ONES, 0, hi, vp);
        if (t == 0 || __all(C >= THR)) break;
        SBA_STORE_V(slot ^ 1);
    }
    bf16* Ow = CAT + (rowbase + r0) * D + 512 + h * 64;
#pragma unroll
    for (int r = 0; r < 16; ++r) { const int orow = (r & 3) + 8 * (r >> 2) + 4 * hi;
        Ow[(long)orow * D + r32] = (bf16)(cvtpk_bf(o0[r], 0.f) & 0xffffu); Ow[(long)orow * D + 32 + r32] = (bf16)(cvtpk_bf(o1[r], 0.f) & 0xffffu); }
#undef SBA_LOAD_V
#undef SBA_STORE_V
#undef SBA_LOAD_K
}
#undef SBA_H
#undef SBA_P
__device__ __forceinline__ void phase(const bf16* QKVY, bf16* CAT, char* lds, int vcu, int G, int wid, int lane) {
    for (int wu = vcu * 8 + wid; wu < NB * 8 * (S / 32); wu += G * 8) {
        const int bh = wu >> 7, qi = wu & 127;
        wave_unit(bh >> 3, bh & 7, qi, QKVY, CAT, lds + wid * 2 * SLOTB, lane);
    }
}
}


namespace gla {
typedef short bf16x8 __attribute__((ext_vector_type(8)));
typedef short s16x4 __attribute__((ext_vector_type(4)));
typedef short v4i16_t __attribute__((ext_vector_type(4)));
typedef float f32x16 __attribute__((ext_vector_type(16)));
typedef __attribute__((address_space(3))) const char* lds_cptr;
constexpr int NCH = NB * 4 * 64;
constexpr int L_VP = 0, L_KP = 16384, L_TOT = 24576, L_DL = 26624, L_PS = 16384, QSTR = 27136;
__device__ __forceinline__ void glds16(const void* gsrc, unsigned lds_dst) { unsigned keep;
    asm volatile("s_mov_b32 %0, m0\n\ts_mov_b32 m0, %2\n\ts_nop 0\n\tglobal_load_lds_dwordx4 %1, off\n\ts_mov_b32 m0, %0" : "=&s"(keep) : "v"(gsrc), "s"(lds_dst) : "memory"); }
__device__ __forceinline__ s16x4 vtr(lds_cptr p) { return __builtin_bit_cast(s16x4, __builtin_amdgcn_ds_read_tr16_b64_v4i16((__attribute__((address_space(3))) v4i16_t*)p)); }
#define GLA_WAIT_BAR() asm volatile("s_waitcnt vmcnt(0) lgkmcnt(0)\n\ts_barrier" ::: "memory")
__device__ __forceinline__ void dma_v(const bf16* QKVY, long t0, int h, unsigned lds0, int wid, int lane) {
#pragma unroll
    for (int i = 0; i < 2; ++i) { const int p = wid * 2 + i, ctile = p >> 2, tg = p & 3;
        glds16(QKVY + (t0 + 16 * tg + (lane >> 2)) * QW + 512 + h * 128 + 32 * ctile + (lane & 3) * 8, (unsigned)__builtin_amdgcn_readfirstlane(lds0 + L_VP + p * 1024)); }
}
__device__ __forceinline__ bf16x8 trfrag(lds_cptr base, int piece, int lane) {
    const int hi = lane >> 5; const lds_cptr p = base + piece * 1024 + ((lane >> 4) & 1) * 32 + (lane & 3) * 8 + (4 * hi + ((lane & 15) >> 2)) * 64;
    const s16x4 lo = vtr(p), hh = vtr(p + 512); return (bf16x8){lo[0], lo[1], lo[2], lo[3], hh[0], hh[1], hh[2], hh[3]};
}
__device__ __forceinline__ void pass_a(KA args, const bf16* QKVY, const float* ALOW, bf16* QIN, bf16* KIN, float* KVT, float* DEC, char* shm, int vcu, int G, int wid, int lane) {
    const unsigned lds0 = (unsigned)(uintptr_t)shm; const lds_cptr shm3 = (lds_cptr)shm;
    const float* gw = INP(14); const float* gb = INP(15);
    for (int base = 4 * vcu; base < NCH; base += 4 * G) {
        const int bh = base >> 6, b = bh >> 2, h = bh & 3;
        float gwv[16];
#pragma unroll
        for (int r = 0; r < 16; ++r) gwv[r] = gw[r * 256 + h * 64 + lane];
        const float gbv = gb[h * 64 + lane];
        float bl[4][8], qv[4][8], kv[4][8];
#pragma unroll
        for (int q = 0; q < 4; ++q) { const long t0 = (long)b * S + ((base + q) & 63) * 64;
            dma_v(QKVY, t0, h, lds0 + q * QSTR, wid, lane);
#pragma unroll
            for (int tt = 0; tt < 8; ++tt) { const long t = t0 + 8 * wid + tt; const f32x4* al = (const f32x4*)(ALOW + t * 16); float x = gbv;
#pragma unroll
                for (int r4 = 0; r4 < 4; ++r4) { const f32x4 a4 = al[r4]; x += a4.x * gwv[4 * r4] + a4.y * gwv[4 * r4 + 1] + a4.z * gwv[4 * r4 + 2] + a4.w * gwv[4 * r4 + 3]; }
                const float la = -softplusf_(-x) * (1.f / 16.f);
                bl[q][tt] = (tt ? bl[q][tt - 1] : 0.f) + la;
                qv[q][tt] = bf2f(QKVY[t * QW + h * 64 + lane]); kv[q][tt] = bf2f(QKVY[t * QW + 256 + h * 64 + lane]); }
            ((__attribute__((address_space(3))) float*)(shm3 + q * QSTR + L_TOT))[wid * 64 + lane] = bl[q][7]; }
        asm volatile("s_waitcnt lgkmcnt(0)\n\ts_barrier" ::: "memory");
#pragma unroll
        for (int q = 0; q < 4; ++q) { const int ch = base + q; const long t0 = (long)b * S + (ch & 63) * 64;
            __attribute__((address_space(3))) float* tot = (__attribute__((address_space(3))) float*)(shm3 + q * QSTR + L_TOT);
            __attribute__((address_space(3))) bf16* kp = (__attribute__((address_space(3))) bf16*)(shm3 + q * QSTR + L_KP);
            float off = 0.f, blast = 0.f;
#pragma unroll
            for (int w = 0; w < 8; ++w) { const float v = tot[w * 64 + lane]; if (w < wid) off += v; blast += v; }
#pragma unroll
            for (int tt = 0; tt < 8; ++tt) { const long t = t0 + 8 * wid + tt; const float bb = bl[q][tt] + off; const int tk = 8 * wid + tt;
                const float qi = qv[q][tt] * __expf(bb), ki = kv[q][tt] * __expf(-bb);
                QIN[t * 256 + h * 64 + lane] = (bf16)f2bf(qi); const bf16 kb = (bf16)f2bf(ki); KIN[t * 256 + h * 64 + lane] = kb;
                kp[((lane >> 5) * 4 + (tk >> 4)) * 512 + (tk & 15) * 32 + (lane & 31)] = kb; }
            if (wid == 0) { const float dd = __expf(blast); ((__attribute__((address_space(3))) float*)(shm3 + q * QSTR + L_DL))[lane] = dd; DEC[ch * 64 + lane] = dd; } }
        GLA_WAIT_BAR();
        const int dvt = wid & 3, dt = wid >> 2;
#pragma unroll
        for (int q = 0; q < 4; ++q) { const int ch = base + q;
            f32x16 acc = {};
#pragma unroll
            for (int ks = 0; ks < 4; ++ks) acc = __builtin_amdgcn_mfma_f32_32x32x16_bf16(trfrag(shm3 + q * QSTR + L_VP, dvt * 4 + ks, lane), trfrag(shm3 + q * QSTR + L_KP, dt * 4 + ks, lane), acc, 0, 0, 0);
            const int dcol = 32 * dt + (lane & 31); const float dsc = ((__attribute__((address_space(3))) float*)(shm3 + q * QSTR + L_DL))[dcol];
            float* kvo = KVT + ((size_t)ch * 128 + 32 * dvt) * 64 + dcol;
#pragma unroll
            for (int r = 0; r < 16; ++r) kvo[(size_t)((r & 3) + 8 * (r >> 2) + 4 * (lane >> 5)) * 64] = acc[r] * dsc; }
        GLA_WAIT_BAR();
    }
}
__device__ __forceinline__ void pass_b(const float* KVT, const float* DEC, bf16* SINT, int vcu, int G, int tid) {
    for (int e = vcu * 512 + tid; e < NB * 4 * 128 * 64; e += G * 512) {
        const int bh = e >> 13, rem = e & 8191, d = e & 63;
        float st = 0.f;
        for (int n0 = 0; n0 < 64; n0 += 8) {
            float kvv[8], dc[8];
#pragma unroll
            for (int i = 0; i < 8; ++i) { const size_t ch = (size_t)bh * 64 + n0 + i; kvv[i] = KVT[ch * 8192 + rem]; dc[i] = DEC[ch * 64 + d]; }
#pragma unroll
            for (int i = 0; i < 8; ++i) { const size_t ch = (size_t)bh * 64 + n0 + i; SINT[ch * 8192 + rem] = (bf16)f2bf(st); st = dc[i] * st + kvv[i]; }
        }
    }
}
__device__ __forceinline__ void pass_c(KA args, const bf16* QKVY, const bf16* QIN, const bf16* KIN, const bf16* SINT, bf16* CAT, char* shm, int vcu, int G, int wid, int lane) {
    const unsigned lds0 = (unsigned)(uintptr_t)shm; const lds_cptr shm3 = (lds_cptr)shm;
    const int r32 = lane & 31, hi = lane >> 5, it = wid >> 2, ct = wid & 3;
    const float* gng = INP(16);
    for (int base = 4 * vcu; base < NCH; base += 4 * G) {
        const int bh = base >> 6, b = bh >> 2, h = bh & 3;
        f32x16 o[4]; unsigned pw[4][2][8];
#pragma unroll
        for (int q = 0; q < 4; ++q) { const int ch = base + q; const long t0 = (long)b * S + (ch & 63) * 64;
            dma_v(QKVY, t0, h, lds0 + q * QSTR, wid, lane);
            bf16x8 qf[4];
#pragma unroll
            for (int d0 = 0; d0 < 4; ++d0) qf[d0] = *(const bf16x8*)(QIN + (t0 + 32 * it + r32) * 256 + h * 64 + 16 * d0 + 8 * hi);
            f32x16 oo = {};
#pragma unroll
            for (int ks = 0; ks < 4; ++ks) { const bf16x8 sf = *(const bf16x8*)(SINT + ((size_t)ch * 128 + 32 * ct + r32) * 64 + 16 * ks + 8 * hi);
                oo = __builtin_amdgcn_mfma_f32_32x32x16_bf16(qf[ks], sf, oo, 0, 0, 0); }
            o[q] = oo;
            f32x16 pt0 = {}, pt1 = {};
#pragma unroll
            for (int d0 = 0; d0 < 4; ++d0) { const bf16x8 kf = *(const bf16x8*)(KIN + (t0 + r32) * 256 + h * 64 + 16 * d0 + 8 * hi);
                pt0 = __builtin_amdgcn_mfma_f32_32x32x16_bf16(kf, qf[d0], pt0, 0, 0, 0); }
            if (it == 1) {
#pragma unroll
                for (int d0 = 0; d0 < 4; ++d0) { const bf16x8 kf = *(const bf16x8*)(KIN + (t0 + 32 + r32) * 256 + h * 64 + 16 * d0 + 8 * hi);
                    pt1 = __builtin_amdgcn_mfma_f32_32x32x16_bf16(kf, qf[d0], pt1, 0, 0, 0); }
            }
#pragma unroll
            for (int r = 0; r < 16; r += 2) { const int j0 = (r & 3) + 8 * (r >> 2) + 4 * hi;
                float a0 = pt0[r], a1 = pt0[r + 1], c0 = pt1[r], c1 = pt1[r + 1];
                if (it == 0) { if (j0 > r32) a0 = 0.f; if (j0 + 1 > r32) a1 = 0.f; } else { if (j0 > r32) c0 = 0.f; if (j0 + 1 > r32) c1 = 0.f; }
                pw[q][0][r >> 1] = pk2(a0, a1); pw[q][1][r >> 1] = pk2(c0, c1); } }
        GLA_WAIT_BAR();
#pragma unroll
        for (int q = 0; q < 4; ++q) { f32x16 oo = o[q];
#pragma unroll
            for (int ks2 = 0; ks2 < 2; ++ks2) { const v4u a = {pw[q][0][4 * ks2], pw[q][0][4 * ks2 + 1], pw[q][0][4 * ks2 + 2], pw[q][0][4 * ks2 + 3]};
                oo = __builtin_amdgcn_mfma_f32_32x32x16_bf16(__builtin_bit_cast(bf16x8, a), trfrag(shm3 + q * QSTR + L_VP, ct * 4 + ks2, lane), oo, 0, 0, 0); }
            if (it == 1) {
#pragma unroll
                for (int ks2 = 0; ks2 < 2; ++ks2) { const v4u a = {pw[q][1][4 * ks2], pw[q][1][4 * ks2 + 1], pw[q][1][4 * ks2 + 2], pw[q][1][4 * ks2 + 3]};
                    oo = __builtin_amdgcn_mfma_f32_32x32x16_bf16(__builtin_bit_cast(bf16x8, a), trfrag(shm3 + q * QSTR + L_VP, ct * 4 + 2 + ks2, lane), oo, 0, 0, 0); }
            }
            o[q] = oo;
            __attribute__((address_space(3))) float* ps = (__attribute__((address_space(3))) float*)(shm3 + q * QSTR + L_PS);
#pragma unroll
            for (int r = 0; r < 16; ++r) { float v = xor16_add(row_sum16(oo[r] * oo[r]));
                if ((lane & 31) == 0) ps[(32 * it + (r & 3) + 8 * (r >> 2) + 4 * hi) * 4 + ct] = v; } }
        asm volatile("s_waitcnt lgkmcnt(0)\n\ts_barrier" ::: "memory");
        const float gv = gng[h * 128 + 32 * ct + r32];
#pragma unroll
        for (int q = 0; q < 4; ++q) { const int ch = base + q; const long t0 = (long)b * S + (ch & 63) * 64;
            const __attribute__((address_space(3))) float* ps = (const __attribute__((address_space(3))) float*)(shm3 + q * QSTR + L_PS);
#pragma unroll
            for (int r = 0; r < 16; ++r) { const int row = 32 * it + (r & 3) + 8 * (r >> 2) + 4 * hi; const long t = t0 + row;
                const f32x4 p4 = *(const __attribute__((address_space(3))) f32x4*)(ps + row * 4);
                const float rr = rsqrtf(((p4.x + p4.y) + (p4.z + p4.w)) * (1.f / 128.f) + 1e-6f);
                const float rg = bf2f(QKVY[t * QW + 1024 + h * 128 + 32 * ct + r32]);
                CAT[t * D + h * 128 + 32 * ct + r32] = (bf16)f2bf(o[q][r] * rr * gv * siluf_(rg)); } }
        asm volatile("s_waitcnt lgkmcnt(0)\n\ts_barrier" ::: "memory");
    }
}
typedef unsigned u32x4 __attribute__((ext_vector_type(4)));
constexpr int W_VP = 0, W_KP = 16384, W_AL = 24576, W_DL = 28672, WSTR = 29696;
__device__ __forceinline__ void stage_v_wave(const bf16* QKVY, long t0, int h, lds_cptr blk, int lane) {
#pragma unroll
    for (int half = 0; half < 2; ++half) { u32x4 r[8];
#pragma unroll
        for (int i = 0; i < 8; ++i) { const int p = half * 8 + i; r[i] = *(const u32x4*)(QKVY + (t0 + 16 * (p & 3) + (lane >> 2)) * QW + 512 + h * 128 + 32 * (p >> 2) + (lane & 3) * 8); }
#pragma unroll
        for (int i = 0; i < 8; ++i) { const int p = half * 8 + i; *(__attribute__((address_space(3))) u32x4*)(blk + W_VP + p * 1024 + lane * 16) = r[i]; } }
}
__device__ __forceinline__ void pass_a_w(KA args, const bf16* QKVY, const float* ALOW, bf16* QIN, bf16* KIN, float* KVT, float* DEC, char* shm, int vcu, int G, int wid, int lane) {
    if (wid >= 4) return;
    const lds_cptr blk = (lds_cptr)shm + wid * WSTR;
    __attribute__((address_space(3))) float* al = (__attribute__((address_space(3))) float*)(blk + W_AL);
    __attribute__((address_space(3))) float* dl = (__attribute__((address_space(3))) float*)(blk + W_DL);
    __attribute__((address_space(3))) bf16* kp = (__attribute__((address_space(3))) bf16*)(blk + W_KP);
    const float* gw = INP(14); const float* gb = INP(15);
    for (int ch = 4 * vcu + wid; ch < NCH; ch += 4 * G) {
        const int bh = ch >> 6, n = ch & 63, b = bh >> 2, h = bh & 3; const long t0 = (long)b * S + n * 64;
        stage_v_wave(QKVY, t0, h, blk, lane);
#pragma unroll
        for (int j = 0; j < 4; ++j) *(__attribute__((address_space(3))) f32x4*)(al + 4 * (lane + 64 * j)) = *(const f32x4*)(ALOW + t0 * 16 + 4 * (lane + 64 * j));
        float gwv[16];
#pragma unroll
        for (int r = 0; r < 16; ++r) gwv[r] = gw[r * 256 + h * 64 + lane];
        const float gbv = gb[h * 64 + lane];
        float bcum = 0.f, qn[8], kn[8];
#pragma unroll
        for (int tt = 0; tt < 8; ++tt) { qn[tt] = bf2f(QKVY[(t0 + tt) * QW + h * 64 + lane]); kn[tt] = bf2f(QKVY[(t0 + tt) * QW + 256 + h * 64 + lane]); }
        asm volatile("s_waitcnt lgkmcnt(0)" ::: "memory");
        for (int t8 = 0; t8 < 64; t8 += 8) {
            float qv[8], kv[8];
#pragma unroll
            for (int tt = 0; tt < 8; ++tt) { qv[tt] = qn[tt]; kv[tt] = kn[tt]; }
            if (t8 < 56) {
#pragma unroll
                for (int tt = 0; tt < 8; ++tt) { qn[tt] = bf2f(QKVY[(t0 + t8 + 8 + tt) * QW + h * 64 + lane]); kn[tt] = bf2f(QKVY[(t0 + t8 + 8 + tt) * QW + 256 + h * 64 + lane]); } }
#pragma unroll
            for (int tt = 0; tt < 8; ++tt) { const int tk = t8 + tt; const long t = t0 + tk; float x = gbv;
#pragma unroll
                for (int r4 = 0; r4 < 4; ++r4) { const f32x4 a4 = *(const __attribute__((address_space(3))) f32x4*)(al + tk * 16 + 4 * r4); x += a4.x * gwv[4 * r4] + a4.y * gwv[4 * r4 + 1] + a4.z * gwv[4 * r4 + 2] + a4.w * gwv[4 * r4 + 3]; }
                bcum += -softplusf_(-x) * (1.f / 16.f);
                const float qi = qv[tt] * __expf(bcum), ki = kv[tt] * __expf(-bcum);
                QIN[t * 256 + h * 64 + lane] = (bf16)f2bf(qi); const bf16 kb = (bf16)f2bf(ki); KIN[t * 256 + h * 64 + lane] = kb;
                kp[((lane >> 5) * 4 + (tk >> 4)) * 512 + (tk & 15) * 32 + (lane & 31)] = kb; }
        }
        { const float dd = __expf(bcum); dl[lane] = dd; DEC[ch * 64 + lane] = dd; }
        asm volatile("s_waitcnt lgkmcnt(0)" ::: "memory");
#pragma unroll
        for (int dt = 0; dt < 2; ++dt) { bf16x8 kf[4];
#pragma unroll
            for (int ks = 0; ks < 4; ++ks) kf[ks] = trfrag(blk + W_KP, dt * 4 + ks, lane);
            const int dcol = 32 * dt + (lane & 31); const float dsc = dl[dcol];
#pragma unroll
            for (int dvt = 0; dvt < 4; ++dvt) { f32x16 acc = {};
#pragma unroll
                for (int ks = 0; ks < 4; ++ks) acc = __builtin_amdgcn_mfma_f32_32x32x16_bf16(trfrag(blk + W_VP, dvt * 4 + ks, lane), kf[ks], acc, 0, 0, 0);
                float* kvo = KVT + ((size_t)ch * 128 + 32 * dvt) * 64 + dcol;
#pragma unroll
                for (int r = 0; r < 16; ++r) kvo[(size_t)((r & 3) + 8 * (r >> 2) + 4 * (lane >> 5)) * 64] = acc[r] * dsc; } }
        asm volatile("s_waitcnt lgkmcnt(0)" ::: "memory");
    }
}
__device__ __forceinline__ void pass_c_w(KA args, const bf16* QKVY, const bf16* QIN, const bf16* KIN, const bf16* SINT, bf16* CAT, char* shm, int vcu, int G, int wid, int lane) {
    const lds_cptr blk = (lds_cptr)shm + wid * 16384;
    const int r32 = lane & 31, hi = lane >> 5, it = wid >> 2;
    const float* gng = INP(16);
    for (int ch = 4 * vcu + (wid & 3); ch < NCH; ch += 4 * G) {
        const int bh = ch >> 6, n = ch & 63, b = bh >> 2, h = bh & 3; const long t0 = (long)b * S + n * 64;
        stage_v_wave(QKVY, t0, h, blk, lane);
        bf16x8 qf[4];
#pragma unroll
        for (int d0 = 0; d0 < 4; ++d0) qf[d0] = *(const bf16x8*)(QIN + (t0 + 32 * it + r32) * 256 + h * 64 + 16 * d0 + 8 * hi);
        f32x16 pt0 = {}, pt1 = {};
#pragma unroll
        for (int d0 = 0; d0 < 4; ++d0) { const bf16x8 kf = *(const bf16x8*)(KIN + (t0 + r32) * 256 + h * 64 + 16 * d0 + 8 * hi);
            pt0 = __builtin_amdgcn_mfma_f32_32x32x16_bf16(kf, qf[d0], pt0, 0, 0, 0); }
        if (it == 1) {
#pragma unroll
            for (int d0 = 0; d0 < 4; ++d0) { const bf16x8 kf = *(const bf16x8*)(KIN + (t0 + 32 + r32) * 256 + h * 64 + 16 * d0 + 8 * hi);
                pt1 = __builtin_amdgcn_mfma_f32_32x32x16_bf16(kf, qf[d0], pt1, 0, 0, 0); } }
        unsigned pw[2][8];
#pragma unroll
        for (int r = 0; r < 16; r += 2) { const int j0 = (r & 3) + 8 * (r >> 2) + 4 * hi;
            float a0 = pt0[r], a1 = pt0[r + 1], c0 = pt1[r], c1 = pt1[r + 1];
            if (it == 0) { if (j0 > r32) a0 = 0.f; if (j0 + 1 > r32) a1 = 0.f; } else { if (j0 > r32) c0 = 0.f; if (j0 + 1 > r32) c1 = 0.f; }
            pw[0][r >> 1] = pk2(a0, a1); pw[1][r >> 1] = pk2(c0, c1); }
        asm volatile("s_waitcnt lgkmcnt(0)" ::: "memory");
        f32x16 o[4]; float ss[16];
#pragma unroll
        for (int r = 0; r < 16; ++r) ss[r] = 0.f;
#pragma unroll
        for (int ct = 0; ct < 4; ++ct) { f32x16 oo = {};
#pragma unroll
            for (int ks = 0; ks < 4; ++ks) { const bf16x8 sf = *(const bf16x8*)(SINT + ((size_t)ch * 128 + 32 * ct + r32) * 64 + 16 * ks + 8 * hi);
                oo = __builtin_amdgcn_mfma_f32_32x32x16_bf16(qf[ks], sf, oo, 0, 0, 0); }
#pragma unroll
            for (int ks2 = 0; ks2 < 2; ++ks2) { const v4u a = {pw[0][4 * ks2], pw[0][4 * ks2 + 1], pw[0][4 * ks2 + 2], pw[0][4 * ks2 + 3]};
                oo = __builtin_amdgcn_mfma_f32_32x32x16_bf16(__builtin_bit_cast(bf16x8, a), trfrag(blk + W_VP, ct * 4 + ks2, lane), oo, 0, 0, 0); }
            if (it == 1) {
#pragma unroll
                for (int ks2 = 0; ks2 < 2; ++ks2) { const v4u a = {pw[1][4 * ks2], pw[1][4 * ks2 + 1], pw[1][4 * ks2 + 2], pw[1][4 * ks2 + 3]};
                    oo = __builtin_amdgcn_mfma_f32_32x32x16_bf16(__builtin_bit_cast(bf16x8, a), trfrag(blk + W_VP, ct * 4 + 2 + ks2, lane), oo, 0, 0, 0); } }
            o[ct] = oo;
#pragma unroll
            for (int r = 0; r < 16; ++r) ss[r] += oo[r] * oo[r]; }
#pragma unroll
        for (int r = 0; r < 16; ++r) ss[r] = rsqrtf(xor16_add(row_sum16(ss[r])) * (1.f / 128.f) + 1e-6f);
#pragma unroll
        for (int ct = 0; ct < 4; ++ct) { const float gv = gng[h * 128 + 32 * ct + r32];
#pragma unroll
            for (int r = 0; r < 16; ++r) { const long t = t0 + 32 * it + (r & 3) + 8 * (r >> 2) + 4 * hi;
                const float rg = bf2f(QKVY[t * QW + 1024 + h * 128 + 32 * ct + r32]);
                CAT[t * D + h * 128 + 32 * ct + r32] = (bf16)f2bf(o[ct][r] * ss[r] * gv * siluf_(rg)); } }
        asm volatile("s_waitcnt lgkmcnt(0)" ::: "memory");
    }
}
#undef GLA_WAIT_BAR
}

__device__ __forceinline__ void dot16x2(const f32x4 (&v0)[4], const f32x4 (&v1)[4], const LAS float* tabw, int lane, float (&c0)[4], float (&c1)[4]) {
    float a[16], b[16];
#pragma unroll
    for (int e = 0; e < 16; ++e) { a[e] = 0.f; b[e] = 0.f; }
#pragma unroll
    for (int j = 0; j < 4; ++j)
#pragma unroll
        for (int q = 0; q < 4; ++q) { const float h0 = v0[j][q], h1 = v1[j][q]; const LAS float* p = tabw + ((j * 4 + q) * 64 + lane) * W16_PITCH;
#pragma unroll
            for (int k = 0; k < 4; ++k) { const f32x4 w = *(const LAS f32x4*)(p + 4 * k);
                a[4 * k] += h0 * w.x; a[4 * k + 1] += h0 * w.y; a[4 * k + 2] += h0 * w.z; a[4 * k + 3] += h0 * w.w;
                b[4 * k] += h1 * w.x; b[4 * k + 1] += h1 * w.y; b[4 * k + 2] += h1 * w.z; b[4 * k + 3] += h1 * w.w; } }
    float t8[8];
#pragma unroll
    for (int i = 0; i < 8; ++i) { auto rr = __builtin_amdgcn_permlane32_swap(__float_as_uint(a[i]), __float_as_uint(a[i + 8]), false, false); t8[i] = __uint_as_float(rr[0]) + __uint_as_float(rr[1]); }
#pragma unroll
    for (int i = 0; i < 4; ++i) { auto rr = __builtin_amdgcn_permlane16_swap(__float_as_uint(t8[i]), __float_as_uint(t8[i + 4]), false, false); c0[i] = row_sum16(__uint_as_float(rr[0]) + __uint_as_float(rr[1])); }
#pragma unroll
    for (int i = 0; i < 8; ++i) { auto rr = __builtin_amdgcn_permlane32_swap(__float_as_uint(b[i]), __float_as_uint(b[i + 8]), false, false); t8[i] = __uint_as_float(rr[0]) + __uint_as_float(rr[1]); }
#pragma unroll
    for (int i = 0; i < 4; ++i) { auto rr = __builtin_amdgcn_permlane16_swap(__float_as_uint(t8[i]), __float_as_uint(t8[i + 4]), false, false); c1[i] = row_sum16(__uint_as_float(rr[0]) + __uint_as_float(rr[1])); }
}
__device__ __forceinline__ void router_pass(KA args, Frame& F, int l, const bf16* X1, bf16* XN, int* eidx, float* ew, int* cntw, int* loc, unsigned* pcnt, unsigned pneed) {
    const float* mod = (const float*)(F.ws + WS_MOD) + (size_t)l * 4 * 6144;
    const float* rb = INP(21); const float* g = INP(5) + l * D;
    LAS float* tabw = (LAS float*)F.lds;
    LAS float* lg = (LAS float*)(F.lds + 1024 * W16_PITCH * 4);
    __syncthreads();
    stage_w16(tabw, INP(20), F.tid);
    for (int chunk = F.vcu; chunk < T / 64; chunk += F.G) {
        if (F.wave == 0) { unsigned sp = 0;
            while ((unsigned)__builtin_amdgcn_readfirstlane(__hip_atomic_load(pcnt + 64 * (chunk >> 2), __ATOMIC_RELAXED, __HIP_MEMORY_SCOPE_AGENT)) < pneed) { __builtin_amdgcn_s_sleep(2); if (++sp > (1u << 20)) break; }
            __builtin_amdgcn_fence(__ATOMIC_ACQUIRE, "agent"); asm volatile("s_waitcnt vmcnt(0)" ::: "memory"); }
        __syncthreads();
        const int tb = chunk * 64 + F.wave * 8, b = tb / S;
        const float* sc = mod + b * 6144 + 4096; const float* sh = mod + b * 6144 + 3072;
        f32x4 n0[4], n1[4];
        load_row_bf16(X1 + (size_t)tb * D, F.lane, n0); load_row_bf16(X1 + (size_t)(tb + 1) * D, F.lane, n1);
        for (int i = 0; i < 4; ++i) { const int t = tb + 2 * i;
            f32x4 v0[4], v1[4];
#pragma unroll
            for (int j = 0; j < 4; ++j) { v0[j] = n0[j]; v1[j] = n1[j]; }
            if (i < 3) { load_row_bf16(X1 + (size_t)(t + 2) * D, F.lane, n0); load_row_bf16(X1 + (size_t)(t + 3) * D, F.lane, n1); }
            norm_row(v0, F.lane, g, sc, sh); norm_row(v1, F.lane, g, sc, sh);
            store_row_bf16(v0, F.lane, XN + (size_t)t * D); store_row_bf16(v1, F.lane, XN + (size_t)(t + 1) * D);
            float c0[4], c1[4];
            dot16x2(v0, v1, tabw, F.lane, c0, c1);
            if ((F.lane & 15) == 0) { const int r = F.lane >> 4, tl = F.wave * 8 + 2 * i;
                *(LAS f32x4*)(lg + tl * W16_PITCH + 4 * r) = (f32x4){c0[0], c0[1], c0[2], c0[3]}; *(LAS f32x4*)(lg + (tl + 1) * W16_PITCH + 4 * r) = (f32x4){c1[0], c1[1], c1[2], c1[3]}; }
        }
        __syncthreads();
        if (F.wave == 0) {
            const int t = chunk * 64 + F.lane;
            float acc[16], rbv[16];
#pragma unroll
            for (int k = 0; k < 4; ++k) { const f32x4 w = *(const LAS f32x4*)(lg + F.lane * W16_PITCH + 4 * k); acc[4 * k] = w.x; acc[4 * k + 1] = w.y; acc[4 * k + 2] = w.z; acc[4 * k + 3] = w.w; }
#pragma unroll
            for (int e = 0; e < 16; ++e) rbv[e] = rb[e];
            float m = acc[0];
#pragma unroll
            for (int e = 1; e < 16; ++e) m = fmaxf(m, acc[e]);
            float sc16[16], ssum = 0.f;
#pragma unroll
            for (int e = 0; e < 16; ++e) { sc16[e] = expf(acc[e] - m); ssum += sc16[e]; }
            float sel[16];
#pragma unroll
            for (int e = 0; e < 16; ++e) { sc16[e] = sc16[e] / ssum; sel[e] = sc16[e] + rbv[e]; }
            int gi = 0; float gbest = -1e30f; int l0s[4], l1s[4];
#pragma unroll
            for (int gg = 0; gg < 4; ++gg) {
                int i0 = 0; float v0 = sel[4 * gg];
#pragma unroll
                for (int k = 1; k < 4; ++k) if (sel[4 * gg + k] > v0) { v0 = sel[4 * gg + k]; i0 = k; }
                int i1 = -1; float v1 = -1e30f;
#pragma unroll
                for (int k = 0; k < 4; ++k) if (k != i0 && sel[4 * gg + k] > v1) { v1 = sel[4 * gg + k]; i1 = k; }
                l0s[gg] = i0; l1s[gg] = i1;
                const float gs = v0 + v1; if (gs > gbest) { gbest = gs; gi = gg; }
            }
            int e0 = 0, e1 = 0;
#pragma unroll
            for (int gg = 0; gg < 4; ++gg) if (gg == gi) { e0 = 4 * gg + l0s[gg]; e1 = 4 * gg + l1s[gg]; }
            float w0 = 0.f, w1 = 0.f;
#pragma unroll
            for (int e = 0; e < 16; ++e) { if (e == e0) w0 = sc16[e]; if (e == e1) w1 = sc16[e]; }
            const float wsum = w0 + w1;
            *(int2*)(eidx + 2 * t) = make_int2(e0, e1); *(float2*)(ew + 2 * t) = make_float2(w0 / wsum, w1 / wsum);
            const unsigned long long below = (1ull << F.lane) - 1ull;
            for (int e = 0; e < 16; ++e) { const unsigned long long m0 = __ballot(e0 == e), m1 = __ballot(e1 == e); const int cc = __popcll(m0);
                if (e0 == e) loc[(chunk * 16 + e) * 64 + __popcll(m0 & below)] = 2 * t;
                if (e1 == e) loc[(chunk * 16 + e) * 64 + cc + __popcll(m1 & below)] = 2 * t + 1;
                if (F.lane == 0) cntw[chunk * 16 + e] = cc + __popcll(m1); }
        }
    }
}
__device__ __forceinline__ void chunk_publish(Frame& F, unsigned* cnt, int panel) {
    asm volatile("s_waitcnt vmcnt(0)" ::: "memory");
    __syncthreads();
    if (F.tid == 0) { __builtin_amdgcn_fence(__ATOMIC_RELEASE, "agent"); asm volatile("s_waitcnt vmcnt(0)" ::: "memory");
        __hip_atomic_fetch_add(cnt + 64 * panel, 1u, __ATOMIC_RELAXED, __HIP_MEMORY_SCOPE_AGENT); }
}
__device__ __forceinline__ void xn0_pass(KA args, Frame& F, bf16* XN, unsigned* cnt) {
    const float* mod = (const float*)(F.ws + WS_MOD);
    for (int chunk = F.vcu; chunk < T / 64; chunk += F.G) {
        for (int i = 0; i < 8; ++i) { const int t = chunk * 64 + F.wave * 8 + i, b = t / S; f32x4 v[4]; const f32x4* xr = (const f32x4*)(INP(0) + (size_t)t * D) + F.lane;
#pragma unroll
            for (int j = 0; j < 4; ++j) v[j] = xr[64 * j];
            norm_row(v, F.lane, INP(4), mod + b * 6144 + 1024, mod + b * 6144);
            store_row_bf16(v, F.lane, XN + (size_t)t * D); }
        chunk_publish(F, cnt, chunk >> 2);
    }
}
__device__ __forceinline__ void combine_pass(KA args, Frame& F, int l, bf16* X1, const bf16* YS, bf16* XN, float* ALOW, float* out, unsigned* cnt) {
    const float* mod = (const float*)(F.ws + WS_MOD) + (size_t)l * 4 * 6144;
    const float* modn = (const float*)(F.ws + WS_MOD) + (size_t)(l + 1) * 4 * 6144;
    LAS float* tabw = (LAS float*)F.lds;
    __syncthreads();
    if (l == 0) stage_w16(tabw, (const float*)(F.ws + WS_ALOWW), F.tid);
    __syncthreads();
    for (int chunk = F.vcu; chunk < T / 64; chunk += F.G) {
      for (int i = 0; i < 8; ++i) { const int t = chunk * 64 + F.wave * 8 + i, b = t / S;
        f32x4 v[4], xr[4]; load_row_bf16(X1 + (size_t)t * D, F.lane, xr);
        const v2u* y0 = (const v2u*)(YS + (size_t)(2 * t) * D) + F.lane; const v2u* y1 = (const v2u*)(YS + (size_t)(2 * t + 1) * D) + F.lane;
#pragma unroll
        for (int j = 0; j < 4; ++j) { const f32x4 g2 = *(const f32x4*)(mod + b * 6144 + 5120 + 4 * F.lane + 256 * j); const v2u a = y0[64 * j], c = y1[64 * j];
            const f32x4 ys = {bflo(a.x) + bflo(c.x), bfhi(a.x) + bfhi(c.x), bflo(a.y) + bflo(c.y), bfhi(a.y) + bfhi(c.y)};
            v[j] = xr[j] + g2 * ys; }
        if (l == 0) {
            store_row_bf16(v, F.lane, X1 + (size_t)t * D);
            norm_row(v, F.lane, INP(4) + D, modn + b * 6144 + 1024, modn + b * 6144);
            store_row_bf16(v, F.lane, XN + (size_t)t * D);
            float acc[16];
            dot16(v, tabw, F.lane, acc);
            if (F.lane == 0) {
#pragma unroll
                for (int k = 0; k < 4; ++k) *(f32x4*)(ALOW + (size_t)t * 16 + 4 * k) = (f32x4){acc[4 * k], acc[4 * k + 1], acc[4 * k + 2], acc[4 * k + 3]}; }
        } else {
            norm_row(v, F.lane, INP(25), nullptr, nullptr);
            f32x4* o = (f32x4*)(out + (size_t)t * D) + F.lane;
#pragma unroll
            for (int j = 0; j < 4; ++j) __builtin_nontemporal_store(v[j], o + 64 * j);
        }
      }
      if (cnt) chunk_publish(F, cnt, chunk >> 2);
    }
}

__global__ void __launch_bounds__(512, 2) mega_fwd(Args args_) {
    KA args = kargs();
    extern __shared__ __attribute__((aligned(16))) unsigned char lds[];
    Frame F;
    F.lds = (LAS unsigned char*)lds; F.ws = args->ws;
    F.wave = __builtin_amdgcn_readfirstlane((int)threadIdx.x >> 6); F.lane = lane_id(); F.tid = F.wave * 64 + F.lane;
    { int g_ = (int)gridDim.x, b_ = (int)blockIdx.x; asm volatile("" : "+s"(g_), "+s"(b_)); F.G = g_; F.bx = b_; F.vcu = (g_ % 8 == 0) ? (b_ % 8) * (g_ / 8) + b_ / 8 : b_; }
    unsigned char* ws = args->ws;
    for (int u = F.tid; u < (LDS_BYTES - LDSCTL_OFF) / 4; u += 512) ((LAS unsigned*)(F.lds + LDSCTL_OFF))[u] = 0u;
    __syncthreads();
    (void)xcd_barrier_post((unsigned*)(ws + WS_CTL) + CW_BAR, (volatile LAS unsigned*)(F.lds + L_MISC) + 8, F.wave);
#define MKBAR() XcdBarrier{(unsigned*)(ws + WS_CTL) + CW_BAR, xb_xcc_id(), (volatile LAS unsigned*)(F.lds + L_MISC) + 8, F.wave}
#ifndef PHMASK
#define PHMASK 0xFFFFFFFFu
#endif
#ifndef PROBE_MASK
#define PROBE_MASK 0u
#endif
#define NREP(k) ((((PROBE_MASK) >> (k)) & 1u) ? 4 : 1)
#define IN(k) ((((PHMASK) >> ((k) >= 9 ? (k) - 7 : (k))) & 1u) != 0u)
#define MIDBAR() do { xcd_barrier(MKBAR()); F.lane = lane_id(); F.tid = F.wave * 64 + F.lane; args = kargs(); ws = args->ws; F.ws = ws; { int g_ = (int)gridDim.x, b_ = (int)blockIdx.x; asm volatile("" : "+s"(g_), "+s"(b_)); F.G = g_; F.bx = b_; F.vcu = (g_ % 8 == 0) ? (b_ % 8) * (g_ / 8) + b_ / 8 : b_; } } while (0)
#define SEAM(k) do { if (IN(k) && IN((k) + 1)) xcd_barrier(MKBAR()); F.lane = lane_id(); F.tid = F.wave * 64 + F.lane; args = kargs(); ws = args->ws; F.ws = ws; { int g_ = (int)gridDim.x, b_ = (int)blockIdx.x; asm volatile("" : "+s"(g_), "+s"(b_)); F.G = g_; F.bx = b_; F.vcu = (g_ % 8 == 0) ? (b_ % 8) * (g_ / 8) + b_ / 8 : b_; } } while (0)

#define mod ((float*)(ws + WS_MOD))
#define XN ((bf16*)(ws + WS_XN))
#define QKVY ((bf16*)(ws + WS_QKVY))
#define YS ((bf16*)(ws + WS_QKVY))
#define CAT ((bf16*)(ws + WS_CAT))
#define ACT ((bf16*)(ws + WS_CAT))
#define X1 ((bf16*)(ws + WS_X1))
#define ALOW ((float*)(ws + WS_ALOW))
#define cntw ((int*)(ws + WS_CNTW))
#define eidx ((int*)(ws + WS_EIDX))
#define ew ((float*)(ws + WS_EW))
#define loc ((int*)(ws + WS_LOC))
    LAS int* tab = (LAS int*)(F.lds + L_NE); LAS int* rowtab = (LAS int*)(F.lds + L_ROWTAB);

    if (IN(0)) for (int rep_ = 0; rep_ < NREP(0); ++rep_) { if (rep_) MIDBAR(); p0_prologue(args, F); } SEAM(0);
#pragma unroll
    for (int l = 0; l < 2; ++l) {
        const int pb = 2 + 7 * l;
        const float* modl = mod + (size_t)l * 4 * 6144;
        if (IN(pb)) for (int rep_ = 0; rep_ < NREP(pb); ++rep_) { if (rep_) MIDBAR();
            unsigned* acnt = (unsigned*)(ws + WS_CTL) + CW_APANEL + l * 8192;
            if (l == 0) xn0_pass(args, F, XN, acnt); else combine_pass(args, F, 0, X1, YS, XN, ALOW, args->out, acnt);
            pg8::DenseSched Sd; Sd.acnt = acnt; Sd.aneed = 4u * (unsigned)(rep_ + 1);
            if (l == 0) { Sd.init(XN, (const bf16*)(ws + WS_WIN0), T, NIN0, D, F.G, F.bx); EpiIn0 E{QKVY}; pg8::gemm_phase<EpiIn0, pg8::DenseSched, true>(F.lds, D, Sd, E, F.wave);
                int nwg_ = (T / 256) * (NIN0 / 256), bx_ = F.bx; asm volatile("" : "+s"(nwg_), "+s"(bx_));
                const int nidle = F.G - (nwg_ - 2 * F.G), cid = bx_ - (nwg_ - 2 * F.G);
                if (nwg_ > 2 * F.G && nwg_ <= 3 * F.G) { if (cid >= 0) { __syncthreads(); p0_items(args, F, P0_NITEMS - P0_NFILL, P0_NITEMS, cid * 8 + F.wave, nidle * 8); } }
                else { __syncthreads(); p0_items(args, F, P0_NITEMS - P0_NFILL, P0_NITEMS, F.vcu * 8 + F.wave, F.G * 8); } }
            else { Sd.init(XN, (const bf16*)(ws + WS_WIN1), T, NIN1, D, F.G, F.bx); EpiIn1 E{QKVY}; pg8::gemm_phase<EpiIn1, pg8::DenseSched, true>(F.lds, D, Sd, E, F.wave); }
        } SEAM(pb);
        if (IN(pb + 1)) for (int rep_ = 0; rep_ < NREP(pb + 1); ++rep_) { if (rep_) MIDBAR();
            if (l == 0) {
#if defined(PROBE_CONV)
                for (int r3 = 0; r3 < 3; ++r3) { conv_phase(args, F, QKVY, CAT); __syncthreads(); }
#endif
#if defined(PROBE_SBA)
                for (int r3 = 0; r3 < 3; ++r3) { sba::phase(QKVY, CAT, (char*)lds, F.vcu, F.G, F.wave, F.lane); __syncthreads(); }
#endif
                conv_phase(args, F, QKVY, CAT); __syncthreads(); sba::phase(QKVY, CAT, (char*)lds, F.vcu, F.G, F.wave, F.lane); }
            else {
                float* KVT = (float*)(ws + WS_XN); bf16* SINT = (bf16*)(ws + WS_WGU); bf16* QIN = SINT + (size_t)gla::NCH * 8192; bf16* KIN = QIN + (size_t)T * 256; float* DEC = (float*)(ws + WS_WD);
#ifndef PROBE_M1SUB
#define PROBE_M1SUB 0
#endif
                for (int r3 = 0; r3 < (PROBE_M1SUB == 1 ? 4 : 1); ++r3) { pool_phase(args, F, QKVY, (const bf16*)(ws + WS_WPT), CAT); __syncthreads(); }
                for (int r3 = 0; r3 < (PROBE_M1SUB == 2 ? 4 : 1); ++r3) { gla::pass_a_w(args, QKVY, ALOW, QIN, KIN, KVT, DEC, (char*)lds, F.vcu, F.G, F.wave, F.lane); __syncthreads(); }
                MIDBAR();
                for (int r3 = 0; r3 < (PROBE_M1SUB == 3 ? 4 : 1); ++r3) { gla::pass_b(KVT, DEC, SINT, F.vcu, F.G, F.tid); __syncthreads(); }
                MIDBAR();
                for (int r3 = 0; r3 < (PROBE_M1SUB == 4 ? 4 : 1); ++r3) { gla::pass_c_w(args, QKVY, QIN, KIN, SINT, CAT, (char*)lds, F.vcu, F.G, F.wave, F.lane); __syncthreads(); } }
        } SEAM(pb + 1);
        if (IN(pb + 2)) for (int rep_ = 0; rep_ < NREP(pb + 2); ++rep_) { if (rep_) MIDBAR();
            unsigned* pcnt = (unsigned*)(ws + WS_CTL) + CW_PANEL + l * 8192;
            pg8::DenseSched Sd; Sd.init(CAT, (const bf16*)(ws + (l == 0 ? WS_WOUT0 : WS_WOUT1)), T, D, D, F.G, F.bx); Sd.pcnt = pcnt;
            if (l == 0) { EpiOut<true> E{INP(0), X1, modl + 2048}; pg8::gemm_phase<EpiOut<true>, pg8::DenseSched, false>(F.lds, D, Sd, E, F.wave); }
            else { EpiOut<false> E{X1, X1, modl + 2048}; pg8::gemm_phase<EpiOut<false>, pg8::DenseSched, false>(F.lds, D, Sd, E, F.wave); }
            router_pass(args, F, l, X1, XN, eidx, ew, cntw, loc, pcnt, 32u * (unsigned)(rep_ + 1));
        } SEAM(pb + 2);
        if (IN(pb + 4)) for (int rep_ = 0; rep_ < NREP(pb + 4); ++rep_) { if (rep_) MIDBAR();
            moe_plan(F, cntw, loc, F.vcu);
            unsigned* mcnt = (unsigned*)(ws + WS_CTL) + CW_MOECNT + l * 16384;
            { MoeSched<1> Sm{XN, (const bf16*)(ws + WS_WGU) + (size_t)l * NE * 1024 * D, D, (size_t)1024 * D * 2, tab, rowtab, mcnt, F.G, F.vcu};
              EpiM1 E{ACT, ew, rowtab};
              pg8::gemm_phase<EpiM1, MoeSched<1>, true>(F.lds, D, Sm, E, F.wave); }
            { MoeSched<2> Sm{ACT, (const bf16*)(ws + WS_WD) + (size_t)l * NE * D * DE, DE, (size_t)D * DE * 2, tab, rowtab, mcnt, F.G, F.vcu};
              EpiM2 E{YS, rowtab};
              pg8::gemm_phase<EpiM2, MoeSched<2>, true>(F.lds, DE, Sm, E, F.wave); }
        } SEAM(pb + 4);
        if (l == 1) { if (IN(pb + 6)) { combine_pass(args, F, 1, X1, YS, XN, ALOW, args->out, nullptr); } }
    }
#undef IN
#undef SEAM
}

extern "C" void kernel_launch(void* const* d_in, const int* in_sizes, int n_in, void* d_out, int out_size, void* d_ws, size_t ws_size, hipStream_t stream) {
    static int grid = 0;
    if (grid == 0) {
        if (n_in != 26 || out_size != T * D || ws_size < WS_END) { fprintf(stderr, "kernel_launch: unexpected shapes / workspace (%zu < %zu)\n", ws_size, (size_t)WS_END); grid = -1; return; }
        int dev = 0, cus = 0;
        if (hipGetDevice(&dev) != hipSuccess || hipDeviceGetAttribute(&cus, hipDeviceAttributeMultiprocessorCount, dev) != hipSuccess) { grid = -1; return; }
        if (hipFuncSetAttribute((const void*)mega_fwd, hipFuncAttributeMaxDynamicSharedMemorySize, LDS_BYTES) != hipSuccess) { fprintf(stderr, "kernel_launch: hipFuncSetAttribute failed\n"); grid = -1; return; }
        grid = cus;
    }
    if (grid < 0) return;
    (void)hipMemsetAsync((char*)d_ws + WS_CTL, 0, CTL_ZERO_BYTES, stream);
    Args a{};
    for (int i = 0; i < 26; ++i) a.in[i] = (const float*)d_in[i];
    a.out = (float*)d_out; a.ws = (unsigned char*)d_ws;
    hipLaunchKernelGGL(mega_fwd, dim3(grid), dim3(512), LDS_BYTES, stream, a);
}
```

```cpp
#include <hip/hip_runtime.h>
#include <cstdint>
#include <cstdio>

constexpr int D = 1024, NB = 4, S = 4096, T = NB * S, NE = 16, DE = 512;
constexpr int NIN0 = 2560, NIN1 = 2048, QW = 2048;
constexpr float QSCALE0 = 0.125f * 1.4426950408889634f;

#define GAS __attribute__((address_space(1)))
#define LAS __attribute__((address_space(3)))
typedef unsigned short bf16;
typedef unsigned v4u __attribute__((ext_vector_type(4)));
typedef unsigned v2u __attribute__((ext_vector_type(2)));
typedef float f32x4 __attribute__((ext_vector_type(4)));
typedef short bf16x8 __attribute__((ext_vector_type(8)));
typedef GAS unsigned gu32;
#define RLX_AGENT __ATOMIC_RELAXED, __HIP_MEMORY_SCOPE_AGENT
#define LDS_WAIT() asm volatile("s_waitcnt lgkmcnt(0)" ::: "memory")
#define VM_WAIT() asm volatile("s_waitcnt vmcnt(0)" ::: "memory")

__device__ __forceinline__ unsigned f2bf(float f) { unsigned u = __builtin_bit_cast(unsigned, f); return (u + 0x7fffu + ((u >> 16) & 1u)) >> 16; }
__device__ __forceinline__ unsigned pk2(float lo, float hi) { unsigned r; asm volatile("v_cvt_pk_bf16_f32 %0, %1, %2" : "=v"(r) : "v"(lo), "v"(hi)); return r; }
__device__ __forceinline__ float bflo(unsigned u) { return __uint_as_float(u << 16); }
__device__ __forceinline__ float bfhi(unsigned u) { return __uint_as_float(u & 0xffff0000u); }
__device__ __forceinline__ float bf2f(bf16 h) { return __uint_as_float((unsigned)h << 16); }
__device__ __forceinline__ int lane_id() { int l; asm volatile("v_mbcnt_lo_u32_b32 %0, -1, 0\n\tv_mbcnt_hi_u32_b32 %0, -1, %0" : "=v"(l)); return l; }
template <int CTRL> __device__ __forceinline__ float dpp_add(float v) { return v + __int_as_float(__builtin_amdgcn_update_dpp(0, __float_as_int(v), CTRL, 0xF, 0xF, false)); }
__device__ __forceinline__ float row_sum16(float v) {
    v = dpp_add<0xB1>(v); v = dpp_add<0x4E>(v); v = dpp_add<0x141>(v); v = dpp_add<0x140>(v); return v; }
__device__ __forceinline__ float rdlane(float v, int l) { return __int_as_float(__builtin_amdgcn_readlane(__float_as_int(v), l)); }
__device__ __forceinline__ float wave_sum(float v) { v = row_sum16(v); return (rdlane(v, 0) + rdlane(v, 16)) + (rdlane(v, 32) + rdlane(v, 48)); }
__device__ __forceinline__ float xor16_add(float v) { auto rr = __builtin_amdgcn_permlane16_swap(__float_as_uint(v), __float_as_uint(v), false, false); return __uint_as_float(rr[0]) + __uint_as_float(rr[1]); }
__device__ __forceinline__ int wave_sum_i(int v) { return (int)wave_sum((float)v); }
__device__ __forceinline__ int wave_scan_i(int v) { const int l = lane_id();
#pragma unroll
    for (int d = 1; d < 64; d <<= 1) { const int n = __builtin_amdgcn_ds_bpermute((l - d) << 2, v); if (l >= d) v += n; }
    return v; }
__device__ __forceinline__ float sigmoidf_(float x) { return __builtin_amdgcn_rcpf(1.f + __builtin_amdgcn_exp2f(-1.4426950408889634f * x)); }
__device__ __forceinline__ float siluf_(float x) { return x * __builtin_amdgcn_rcpf(1.f + __builtin_amdgcn_exp2f(-1.4426950408889634f * x)); }
__device__ __forceinline__ float softplusf_(float z) { return fmaxf(z, 0.f) + 0.6931471805599453f * __builtin_amdgcn_logf(1.f + __builtin_amdgcn_exp2f(-1.4426950408889634f * fabsf(z))); }

namespace pg8 {
#define PG8_LAS __attribute__((address_space(3)))
typedef unsigned short bf16_t;
typedef short bf16x8 __attribute__((ext_vector_type(8)));
typedef float f32x4 __attribute__((ext_vector_type(4)));
typedef unsigned u32x4 __attribute__((ext_vector_type(4)));
constexpr int BM = 256, BK = 64, HALF = 128, HTB = HALF * BK * 2, STAGE_BYTES = 8 * HTB, NXCD = 8, WGM = 8;

__host__ __device__ __forceinline__ int lds_byte(int r, int c) { const int st = (r >> 4) * 2 + (c >> 5), rr = r & 15, cc = c & 31, ob = rr * 64 + cc * 2; return st * 1024 + (ob ^ (((ob >> 9) & 1) << 5)); }
__host__ __device__ __forceinline__ void stage_rc(int b, int& R, int& C) { const int st = b / 1024, sb = b % 1024, swz = sb ^ (((sb >> 9) & 1) << 5); R = (st >> 1) * 16 + swz / 64; C = (st & 1) * 32 + (swz % 64) / 2; }
__host__ __device__ __forceinline__ int perm32(int rho) { const int n = rho >> 4, i = rho & 15; return 8 * (i >> 2) + 4 * n + (i & 3); }

struct Unit { int pm, pn, e, li, nr, r0; };

struct DenseSched {
    const bf16_t* A; const bf16_t* Bt; int K; int nM, nN, nwg, G, c; unsigned* pcnt = nullptr; unsigned* acnt = nullptr; unsigned aneed = 0;
    __device__ void init(const bf16_t* A_, const bf16_t* Bt_, int M, int N, int K_, int G_, int c_) { A = A_; Bt = Bt_; K = K_; nM = M / BM; nN = N / BM; nwg = nM * nN; G = G_; c = c_; }
    __device__ __forceinline__ bool next(int i, Unit& u) const {
        const long L = (long)i * G + c; if (L >= nwg) return false;
        int wgid = (int)L; { const int q = nwg / NXCD, r = nwg % NXCD, xcd = wgid % NXCD, off = wgid / NXCD; wgid = (xcd < r ? xcd * (q + 1) : r * (q + 1) + (xcd - r) * q) + off; }
        const int nig = WGM * nN, gid = wgid / nig, fm = gid * WGM, gsz = (nM - fm) < WGM ? (nM - fm) : WGM;
        u.pm = fm + ((wgid % nig) % gsz); u.pn = (wgid % nig) / gsz; u.e = 0; u.li = i; u.nr = 256; u.r0 = u.pm * BM; return true;
    }
    __device__ __forceinline__ const char* a_base(const Unit& u) const { return (const char*)A + (size_t)u.pm * BM * K * 2; }
    __device__ __forceinline__ const char* b_base(const Unit& u) const { return (const char*)Bt + (size_t)u.pn * BM * K * 2; }
    static constexpr bool GATHER = false;
    __device__ __forceinline__ void a_ready(const Unit& u, int wid, int lane) const {
        if (acnt) {
            if (wid == 0) { unsigned sp = 0;
                while ((unsigned)__builtin_amdgcn_readfirstlane(__hip_atomic_load(acnt + 64 * u.pm, __ATOMIC_RELAXED, __HIP_MEMORY_SCOPE_AGENT)) < aneed) { __builtin_amdgcn_s_sleep(2); if (++sp > (1u << 20)) break; }
                __builtin_amdgcn_fence(__ATOMIC_ACQUIRE, "agent");
                asm volatile("s_waitcnt vmcnt(0)" ::: "memory"); }
            asm volatile("" ::: "memory"); __builtin_amdgcn_s_barrier(); asm volatile("" ::: "memory");
        }
    }
    __device__ __forceinline__ void publish(int pm, int lane) const { if (pcnt && lane == 0) __hip_atomic_fetch_add(pcnt + 64 * pm, 1u, __ATOMIC_RELAXED, __HIP_MEMORY_SCOPE_AGENT); }
    __device__ __forceinline__ void a_off(const Unit&, int tid, unsigned (&v)[4]) const {
#pragma unroll
        for (int i = 0; i < 2; ++i) { int R, C; stage_rc(tid * 16 + i * 8192, R, C);
#pragma unroll
            for (int h = 0; h < 2; ++h) v[2 * h + i] = (unsigned)((h * HALF + R) * K + C) * 2u; }
    }
};

template <class Epi, class Sched, bool ALIGN_EPI>
__device__ __forceinline__ void gemm_phase(PG8_LAS unsigned char* lds, const int K, const Sched& S, const Epi& E, const int wave_id) {
    int wid_ = wave_id; asm volatile("" : "+s"(wid_));
    const int wid = wid_, lane = lane_id(), tid = wid * 64 + lane,
        wr = wid >> 2, wc = wid & 3, fr = lane & 15, fq = lane >> 4;
    const int nt = K / BK;
    unsigned voffB[2];
#pragma unroll
    for (int i = 0; i < 2; ++i) { int R, C; stage_rc(tid * 16 + i * 8192, R, C); const int Rb = Epi::PERM ? ((R & ~31) + perm32(R & 31)) : R; voffB[i] = (unsigned)(Rb * K + C) * 2u; }
    const size_t kstep = (size_t)(BK * 2);
    const size_t hstep = (size_t)HALF * K * 2;
    const unsigned ldsw = (unsigned)wid * 1024u;
    const int aoff = lds_byte(wr * 64 + fr, fq * 8), boff = lds_byte(wc * 32 + fr, fq * 8);
#define PG8_SA(b, h) (((b) * 2 + (h)) * HTB)
#define PG8_SB(b, h) ((4 + (b) * 2 + (h)) * HTB)
#define PG8_STAGE2(bufoff, gbase, o0, o1) do { \
        __builtin_amdgcn_global_load_lds((const unsigned*)((const char*)(gbase) + (o0)), (PG8_LAS unsigned*)(lds + (bufoff) + ldsw), 16, 0, 0); \
        __builtin_amdgcn_global_load_lds((const unsigned*)((const char*)(gbase) + (o1)), (PG8_LAS unsigned*)(lds + (bufoff) + ldsw + 8192), 16, 0, 0); } while (0)
#define PG8_STAGEB(bufoff, gbase) PG8_STAGE2(bufoff, gbase, voffB[0], voffB[1])
#define PG8_LDA(dst, b, h) do { _Pragma("unroll") for (int m = 0; m < 4; ++m) _Pragma("unroll") for (int k = 0; k < 2; ++k) dst[m][k] = *(const PG8_LAS bf16x8*)(lds + PG8_SA(b, h) + aoff + m * 2048 + k * 1024); } while (0)
#define PG8_LDB(dst, b, h) do { _Pragma("unroll") for (int n = 0; n < 2; ++n) _Pragma("unroll") for (int k = 0; k < 2; ++k) dst[n][k] = *(const PG8_LAS bf16x8*)(lds + PG8_SB(b, h) + boff + n * 2048 + k * 1024); } while (0)
#define PG8_MMA(ai, bj, At, Bt) do { __builtin_amdgcn_s_setprio(1); _Pragma("unroll") for (int m = 0; m < 4; ++m) _Pragma("unroll") for (int n = 0; n < 2; ++n) _Pragma("unroll") for (int k = 0; k < 2; ++k) \
        acc[ai][bj][m][n] = __builtin_amdgcn_mfma_f32_16x16x32_bf16(Bt[n][k], At[m][k], acc[ai][bj][m][n], 0, 0, 0); __builtin_amdgcn_s_setprio(0); } while (0)
#define PG8_WAIT_V(n) asm volatile("s_waitcnt vmcnt(" #n ")" ::: "memory")
#define PG8_WAIT_L(n) asm volatile("s_waitcnt lgkmcnt(" #n ")" ::: "memory")
#define PG8_BAR __builtin_amdgcn_s_barrier()
#define PG8_SCHED __builtin_amdgcn_sched_barrier(0)
    Unit cur, nxt; int ui = 0;
    if (!S.next(0, cur)) return;
    f32x4 acc[2][2][4][2];
#pragma unroll
    for (int a = 0; a < 2; ++a)
#pragma unroll
        for (int b = 0; b < 2; ++b)
#pragma unroll
            for (int m = 0; m < 4; ++m)
#pragma unroll
                for (int n = 0; n < 2; ++n) acc[a][b][m][n] = (f32x4){0.f, 0.f, 0.f, 0.f};
    bf16x8 At[4][2], B0[2][2], B1[2][2];
    unsigned vc[4];
    S.a_ready(cur, wid, lane);
    S.a_off(cur, tid, vc);
    const char* cA = S.a_base(cur); const char* cB = S.b_base(cur);
    PG8_STAGEB(PG8_SB(0, 0), cB); PG8_STAGEB(PG8_SB(0, 1), cB + hstep); PG8_STAGE2(PG8_SA(0, 0), cA, vc[0], vc[1]); PG8_STAGE2(PG8_SA(0, 1), cA, vc[2], vc[3]);
    if (wr == 1) PG8_BAR;
    PG8_WAIT_V(2); PG8_BAR;
    PG8_STAGEB(PG8_SB(1, 0), cB + kstep); PG8_STAGE2(PG8_SA(1, 0), cA + kstep, vc[0], vc[1]); PG8_STAGEB(PG8_SB(1, 1), cB + hstep + kstep);
    PG8_WAIT_V(6); PG8_BAR;
    int pend = -1;
    for (;;) {
        const bool has_next = S.next(ui + 1, nxt);
        const char* nA = cA; const char* nB = cB;
        if (has_next) { nA = S.a_base(nxt); nB = S.b_base(nxt); }
        for (int t = 0; t < nt; t += 2) {
            const bool last = (t == nt - 2);
            if (last && has_next) S.a_ready(nxt, wid, lane);
            const char* a1 = cA + (size_t)(t + 1) * kstep;
            const char* a2 = last ? nA : cA + (size_t)(t + 2) * kstep; const char* b2 = last ? nB : cB + (size_t)(t + 2) * kstep;
            const char* a3 = a2 + kstep; const char* b3 = b2 + kstep;
            PG8_LDB(B0, 0, 0); PG8_LDB(B1, 0, 1); PG8_SCHED; PG8_LDA(At, 0, 0); PG8_STAGE2(PG8_SA(1, 1), a1, vc[2], vc[3]);
            if constexpr (Sched::GATHER) { if (last && has_next) S.a_off(nxt, tid, vc); }
            PG8_WAIT_V(8); PG8_WAIT_L(0); PG8_BAR; PG8_MMA(0, 0, At, B0); PG8_MMA(0, 1, At, B1); PG8_BAR; PG8_SCHED;
            PG8_LDA(At, 0, 1); PG8_STAGEB(PG8_SB(0, 0), b2); PG8_STAGEB(PG8_SB(0, 1), b2 + hstep); PG8_STAGE2(PG8_SA(0, 0), a2, vc[0], vc[1]);
            PG8_WAIT_V(8);
            if (pend >= 0) { S.publish(pend, lane); pend = -1; }
            PG8_WAIT_L(0); PG8_BAR; PG8_MMA(1, 0, At, B0); PG8_MMA(1, 1, At, B1); PG8_BAR; PG8_SCHED;
            PG8_LDB(B0, 1, 0); PG8_LDB(B1, 1, 1); PG8_SCHED; PG8_LDA(At, 1, 0); PG8_STAGE2(PG8_SA(0, 1), a2, vc[2], vc[3]);
            PG8_WAIT_V(8); PG8_WAIT_L(0); PG8_BAR; PG8_MMA(0, 0, At, B0); PG8_MMA(0, 1, At, B1); PG8_BAR; PG8_SCHED;
            PG8_LDA(At, 1, 1); PG8_STAGEB(PG8_SB(1, 0), b3); PG8_STAGEB(PG8_SB(1, 1), b3 + hstep); PG8_STAGE2(PG8_SA(1, 0), a3, vc[0], vc[1]);
            PG8_WAIT_V(8); PG8_WAIT_L(0); PG8_BAR; PG8_MMA(1, 0, At, B0); PG8_MMA(1, 1, At, B1); PG8_BAR; PG8_SCHED;
        }
        if constexpr (ALIGN_EPI) { if (wr == 0) PG8_BAR; }
        E(acc, cur, wr, wc, fr, fq);
        pend = cur.pm;
        if (!has_next) break;
#pragma unroll
        for (int a = 0; a < 2; ++a)
#pragma unroll
            for (int b = 0; b < 2; ++b)
#pragma unroll
                for (int m = 0; m < 4; ++m)
#pragma unroll
                    for (int n = 0; n < 2; ++n) acc[a][b][m][n] = (f32x4){0.f, 0.f, 0.f, 0.f};
        cur = nxt; cA = nA; cB = nB; ++ui;
        if constexpr (ALIGN_EPI) { if (wr == 1) PG8_BAR; }
    }
    PG8_WAIT_V(0);
    if (pend >= 0) S.publish(pend, lane);
    if constexpr (!ALIGN_EPI) { if (wr == 0) PG8_BAR; }
    PG8_BAR;
#undef PG8_SA
#undef PG8_SB
#undef PG8_STAGE2
#undef PG8_STAGEB
#undef PG8_LDA
#undef PG8_LDB
#undef PG8_MMA
#undef PG8_WAIT_V
#undef PG8_WAIT_L
#undef PG8_BAR
#undef PG8_SCHED
}
}

constexpr size_t MiB = 1u << 20;
constexpr size_t WS_CTL = 0, CTL_ZERO_BYTES = 1 * MiB;
constexpr size_t WS_MOD = 1 * MiB;
constexpr size_t WS_ALOWW = WS_MOD + 256 * 1024;
constexpr size_t WS_CNTW = WS_ALOWW + 64 * 1024;
constexpr size_t WS_EIDX = WS_CNTW + 16 * 1024;
constexpr size_t WS_EW = WS_EIDX + (size_t)2 * T * 4;
constexpr size_t WS_LOC = WS_EW + (size_t)2 * T * 4;
constexpr size_t WS_ALOW = WS_LOC + 1 * MiB;
constexpr size_t WS_WPT = WS_ALOW + 1 * MiB;
constexpr size_t WS_WIN0 = 5 * MiB;
constexpr size_t WS_WOUT0 = WS_WIN0 + (size_t)NIN0 * D * 2;
constexpr size_t WS_WIN1 = WS_WOUT0 + (size_t)D * D * 2;
constexpr size_t WS_WOUT1 = WS_WIN1 + (size_t)NIN1 * D * 2;
constexpr size_t WS_WGU = WS_WOUT1 + (size_t)D * D * 2;
constexpr size_t WS_WD = WS_WGU + (size_t)2 * NE * 1024 * D * 2;
constexpr size_t WS_X1 = WS_WD + (size_t)2 * NE * D * DE * 2;
constexpr size_t WS_XN = WS_X1 + (size_t)T * D * 2;
constexpr size_t WS_QKVY = WS_XN + (size_t)T * D * 2;
constexpr size_t WS_CAT = WS_QKVY + (size_t)T * QW * 2;
constexpr size_t WS_END = WS_CAT + (size_t)(2 * T + 256) * DE * 2;
static_assert(WS_WPT + 128 * 1024 <= WS_WIN0, "small tables fit below the weights");
static_assert(WS_END <= 346000000, "workspace budget");
constexpr int CW_BAR = 4096;
constexpr int CW_APANEL = 98304;
constexpr int CW_PANEL = 65536;

constexpr int RING_BYTES = 131072;
constexpr int LDSCTL_OFF = RING_BYTES;
constexpr int L_MISC = LDSCTL_OFF;
constexpr int L_NE = L_MISC + 256;
constexpr int L_ROWTAB = L_NE + 512;
constexpr int LDS_BYTES = 147456;
static_assert(L_ROWTAB + 8192 <= LDS_BYTES, "LDS map");

#define XB_TMO      128
#define XB_XCNT(j)  (256  + 64 * (j))
#define XB_XSUB(j)  (1280 + 64 * (j))
#define XB_XGEN(j)  (2304 + 64 * (j))
#define XB_TOP      3328
#define XB_TOPGEN   3392
#define XCD_BAR_WORDS 3456
#define XB_SPIN_CAP (1u << 18)
__device__ __forceinline__ unsigned xb_ld(unsigned* p)              { return __hip_atomic_load(p, __ATOMIC_RELAXED, __HIP_MEMORY_SCOPE_AGENT); }
__device__ __forceinline__ unsigned xb_add(unsigned* p, unsigned v) { return __hip_atomic_fetch_add(p, v, __ATOMIC_RELAXED, __HIP_MEMORY_SCOPE_AGENT); }
__device__ __forceinline__ unsigned xb_xcc_id() { return (unsigned)__builtin_amdgcn_s_getreg((3 << 11) | 20) & 0xFu; }
#define XB_SPIN(cond, bar) do { unsigned _sp = 0; while (cond) { __builtin_amdgcn_s_sleep(1); \
    if ((++_sp & 255u) == 0u) { if (xb_ld(&(bar)[XB_TMO])) break; if (_sp > XB_SPIN_CAP) { atomicAdd(&(bar)[XB_TMO], 1u); break; } } } } while (0)
struct XcdBarrier { unsigned* bar; unsigned x; volatile LAS unsigned* st; int wave; };
__device__ __forceinline__ XcdBarrier xcd_barrier_post(unsigned* bar, volatile LAS unsigned* st, int wave) {
    XcdBarrier b; b.bar = bar; b.x = xb_xcc_id(); b.st = st; b.wave = wave;
    if (wave == 0 && lane_id() == 0) (void)xb_add(&bar[XB_XCNT(b.x)], 1u);
    return b;
}
__device__ __forceinline__ void xcd_barrier_complete(unsigned* bar, unsigned x, unsigned& nloc, unsigned& nx) {
    const unsigned G = gridDim.x * gridDim.y * gridDim.z;
    unsigned sum, cnt, mine, sp = 0u;
    for (;;) {
        sum = 0u; cnt = 0u; mine = 0u;
#pragma unroll
        for (unsigned j = 0; j < 16; ++j) { const unsigned c = xb_ld(&bar[XB_XCNT(j)]); sum += c; cnt += (c > 0u) ? 1u : 0u; mine = (j == x) ? c : mine; }
        if (sum == G) break;
        __builtin_amdgcn_s_sleep(1);
        if ((++sp & 255u) == 0u) { if (xb_ld(&bar[XB_TMO])) break; if (sp > XB_SPIN_CAP) { atomicAdd(&bar[XB_TMO], 1u); break; } }
    }
    nloc = mine > 0u ? mine : 1u; nx = cnt > 0u ? cnt : 1u;
}
__device__ __forceinline__ void xcd_barrier(const XcdBarrier& b) {
    asm volatile("s_waitcnt vmcnt(0)" ::: "memory");
    __syncthreads();
    if (b.wave == 0 && lane_id() == 0) {
        unsigned* bar = b.bar;
        __builtin_amdgcn_s_waitcnt(0);
        unsigned nloc = b.st[0], nx = b.st[1];
        if (nloc == 0u) { xcd_barrier_complete(bar, b.x, nloc, nx); b.st[0] = nloc; b.st[1] = nx; }
        const unsigned old = xb_add(&bar[XB_XSUB(b.x)], 1u);
        const unsigned gen = old / nloc;
        if (old + 1u == (gen + 1u) * nloc) {
            __builtin_amdgcn_fence(__ATOMIC_RELEASE, "agent");
            asm volatile("s_waitcnt vmcnt(0)" ::: "memory");
            const unsigned og = xb_add(&bar[XB_TOP], 1u);
            const unsigned tg = og / nx;
            if (og + 1u == (tg + 1u) * nx) xb_add(&bar[XB_TOPGEN], 1u);
            else XB_SPIN(xb_ld(&bar[XB_TOPGEN]) == tg, bar);
            __builtin_amdgcn_fence(__ATOMIC_ACQUIRE, "agent");
            xb_add(&bar[XB_XGEN(b.x)], 1u);
            asm volatile("s_waitcnt vmcnt(0)" ::: "memory");
        } else {
            XB_SPIN(xb_ld(&bar[XB_XGEN(b.x)]) == gen, bar);
            __builtin_amdgcn_fence(__ATOMIC_ACQUIRE, "agent");
            asm volatile("s_waitcnt vmcnt(0)" ::: "memory");
        }
    }
    __syncthreads();
}

struct Args { const float* in[26]; float* out; unsigned char* ws; };
struct Frame {
    LAS unsigned char* lds; unsigned char* ws;
    int tid, lane, wave, vcu, G, bx;
};
typedef const __attribute__((address_space(4))) Args* KA;
__device__ __forceinline__ KA kargs() { auto p = __builtin_amdgcn_kernarg_segment_ptr(); asm volatile("" : "+s"(p)); return (KA)p; }
#define INP(k) (args->in[k])

struct P0Item { const float* s; bf16* d; int ldw, Kd; };
__device__ __forceinline__ void p0_load(const P0Item& it, float (&r)[32], int lane) {
#pragma unroll
    for (int i = 0; i < 32; ++i) r[i] = __builtin_nontemporal_load(it.s + (size_t)(2 * i + (lane >> 5)) * it.ldw + (lane & 31));
}
__device__ __forceinline__ void p0_store(const P0Item& it, const float (&r)[32], LAS float* scr, int lane) {
#pragma unroll
    for (int i = 0; i < 32; ++i) scr[(2 * i + (lane >> 5)) * 33 + (lane & 31)] = r[i];
    LDS_WAIT(); asm volatile("" ::: "memory");
    const int c = lane & 7;
#pragma unroll
    for (int j = 0; j < 4; ++j) { const int n = (lane >> 3) + 8 * j; const LAS float* sp = scr + (8 * c) * 33 + n;
        v4u o; o.x = pk2(sp[0 * 33], sp[1 * 33]); o.y = pk2(sp[2 * 33], sp[3 * 33]); o.z = pk2(sp[4 * 33], sp[5 * 33]); o.w = pk2(sp[6 * 33], sp[7 * 33]);
        __builtin_nontemporal_store(o, (GAS v4u*)(it.d + (size_t)n * it.Kd + 8 * c)); }
    LDS_WAIT(); asm volatile("" ::: "memory");
}
template <class DMap>
__device__ __forceinline__ P0Item p0_matrix(const float* W, int ldw, int K, int scol0, int ncols, bf16* WT, const DMap& dmap, int it) {
    const int nblk = ncols / 32, kb = it / nblk, nb = it % nblk, n0 = 32 * nb;
    return P0Item{W + (size_t)(64 * kb) * ldw + scol0 + n0, WT + (size_t)(dmap(n0 >> 7) + (n0 & 127)) * K + 64 * kb, ldw, K};
}
struct MapId { int base; __device__ int operator()(int g) const { return base + 128 * g; } };
struct MapGlu { int second; __device__ int operator()(int g) const { return 256 * g + second; } };

constexpr int P0_I_IN0A = 16 * 16, P0_I_IN0Q = 16 * 48, P0_I_OUT = 16 * 32, P0_I_IN1A = 16 * 48, P0_I_IN1P = 16 * 16, P0_I_G = 16 * 16, P0_I_D = 8 * 32;
constexpr int P0_I_MOE = 2 * P0_I_G + P0_I_D;
constexpr int P0_I_PW = 4 * 8;
constexpr int P0_NITEMS = 2 * P0_I_IN0A + P0_I_IN0Q + 2 * P0_I_OUT + P0_I_IN1A + P0_I_IN1P + P0_I_PW + 32 * P0_I_MOE;
constexpr int P0_NFILL = 8 * P0_I_MOE;
__device__ __forceinline__ void p0_items(KA args, Frame& F, int first, int last, int widx, int nw) {
    LAS float* scr = (LAS float*)(F.lds + F.wave * 16384);
    auto decode = [&](int it) -> P0Item {
        KA args = kargs();
        unsigned char* ws = args->ws;
        bf16* win0 = (bf16*)(ws + WS_WIN0); bf16* wout0 = (bf16*)(ws + WS_WOUT0); bf16* win1 = (bf16*)(ws + WS_WIN1); bf16* wout1 = (bf16*)(ws + WS_WOUT1);
        int r = it;
        if (r < P0_I_IN0A) return p0_matrix(INP(6), NIN0, D, 0, 512, win0, MapGlu{0}, r); r -= P0_I_IN0A;
        if (r < P0_I_IN0A) return p0_matrix(INP(6), NIN0, D, 512, 512, win0, MapGlu{128}, r); r -= P0_I_IN0A;
        if (r < P0_I_IN0Q) return p0_matrix(INP(6), NIN0, D, 1024, 1536, win0, MapId{1024}, r); r -= P0_I_IN0Q;
        if (r < P0_I_OUT) return p0_matrix(INP(7), D, D, 0, 1024, wout0, MapId{0}, r); r -= P0_I_OUT;
        if (r < P0_I_IN1A) return p0_matrix(INP(12), 2064, D, 0, 1536, win1, MapId{0}, r); r -= P0_I_IN1A;
        if (r < P0_I_IN1P) return p0_matrix(INP(12), 2064, D, 1552, 512, win1, MapId{1536}, r); r -= P0_I_IN1P;
        if (r < P0_I_OUT) return p0_matrix(INP(13), D, D, 0, 1024, wout1, MapId{0}, r); r -= P0_I_OUT;
        if (r < P0_I_PW) { const int g = r >> 3; return p0_matrix(INP(17) + (size_t)g * 128 * 128, 128, 128, 0, 128, (bf16*)(ws + WS_WPT) + (size_t)g * 128 * 128, MapId{0}, r & 7); } r -= P0_I_PW;
        const int le = r / P0_I_MOE; r -= le * P0_I_MOE;
        bf16* wgu = (bf16*)(ws + WS_WGU) + (size_t)le * 1024 * D; bf16* wd = (bf16*)(ws + WS_WD) + (size_t)le * D * DE;
        if (r < P0_I_G) return p0_matrix(INP(22) + (size_t)le * D * DE, DE, D, 0, 512, wgu, MapGlu{0}, r); r -= P0_I_G;
        if (r < P0_I_G) return p0_matrix(INP(23) + (size_t)le * D * DE, DE, D, 0, 512, wgu, MapGlu{128}, r); r -= P0_I_G;
        return p0_matrix(INP(24) + (size_t)le * DE * D, D, DE, 0, 1024, wd, MapId{0}, r);
    };
    const int i0 = first + widx;
    if (i0 < last) {
        P0Item cur = decode(i0); float rc[32]; p0_load(cur, rc, F.lane);
        for (int it = i0; it < last; it += nw) {
            P0Item nx = cur; float rn[32];
            if (it + nw < last) { nx = decode(it + nw); p0_load(nx, rn, F.lane); }
            p0_store(cur, rc, scr, F.lane);
            if (it + nw < last) { cur = nx;
#pragma unroll
                for (int i = 0; i < 32; ++i) rc[i] = rn[i]; }
        }
    }
}
__device__ __forceinline__ void p0_prologue(KA args, Frame& F) {
    unsigned char* ws = F.ws;
    if (F.vcu < 192) {
        LAS float* cs = (LAS float*)F.lds;
        LAS float* part = (LAS float*)(F.lds + 16384);
        const float* c = INP(1);
        for (int i = F.tid; i < 4096; i += 512) cs[i] = siluf_(c[i]);
        __syncthreads();
        const int l = F.vcu / 96, cg = F.vcu % 96;
        const float* wp = INP(2) + (size_t)l * 1024 * 6144 + 64 * cg + F.lane;
        float a0 = 0.f, a1 = 0.f, a2 = 0.f, a3 = 0.f;
#pragma unroll 16
        for (int kk = 0; kk < 128; ++kk) { const int k = 128 * F.wave + kk; const float wv = __builtin_nontemporal_load(wp + (size_t)k * 6144);
            a0 += cs[k] * wv; a1 += cs[1024 + k] * wv; a2 += cs[2048 + k] * wv; a3 += cs[3072 + k] * wv; }
        part[(F.wave * 4 + 0) * 64 + F.lane] = a0; part[(F.wave * 4 + 1) * 64 + F.lane] = a1; part[(F.wave * 4 + 2) * 64 + F.lane] = a2; part[(F.wave * 4 + 3) * 64 + F.lane] = a3;
        __syncthreads();
        float* mod = (float*)(ws + WS_MOD);
        if (F.tid < 256) { const int b = F.tid >> 6, col = F.tid & 63; float sm = INP(3)[l * 6144 + 64 * cg + col];
#pragma unroll
            for (int w = 0; w < 8; ++w) sm += part[(w * 4 + b) * 64 + col];
            mod[(l * 4 + b) * 6144 + 64 * cg + col] = sm; }
        __syncthreads();
    }
    { float* aw = (float*)(ws + WS_ALOWW); const float* w1 = INP(12);
      for (int i = F.vcu * 512 + F.tid; i < 1024 * 16; i += F.G * 512) aw[i] = w1[(size_t)(i >> 4) * 2064 + 1536 + (i & 15)]; }
    p0_items(args, F, 0, P0_NITEMS - P0_NFILL, F.vcu * 8 + F.wave, F.G * 8);
}

__device__ __forceinline__ void norm_row(f32x4 (&v)[4], int lane, const float* g, const float* sc, const float* sh) {
    float s = 0.f;
#pragma unroll
    for (int j = 0; j < 4; ++j) s += (v[j].x * v[j].x + v[j].y * v[j].y) + (v[j].z * v[j].z + v[j].w * v[j].w);
    const float r = rsqrtf(wave_sum(s) * (1.f / D) + 1e-6f);
#pragma unroll
    for (int j = 0; j < 4; ++j) { const int c = 4 * lane + 256 * j; const f32x4 gg = *(const f32x4*)(g + c);
        v[j] = v[j] * r * gg;
        if (sc) { const f32x4 s1 = *(const f32x4*)(sc + c), s0 = *(const f32x4*)(sh + c); v[j] = v[j] * (1.f + s1) + s0; } }
}
__device__ __forceinline__ void store_row_bf16(const f32x4 (&v)[4], int lane, bf16* orow) {
    GAS v2u* o = (GAS v2u*)orow + lane;
#pragma unroll
    for (int j = 0; j < 4; ++j) { v2u w; w.x = pk2(v[j].x, v[j].y); w.y = pk2(v[j].z, v[j].w); o[64 * j] = w; }
}


__device__ __forceinline__ void load_row_bf16(const bf16* row, int lane, f32x4 (&v)[4]) {
    const GAS v2u* p = (const GAS v2u*)row + lane;
#pragma unroll
    for (int j = 0; j < 4; ++j) { const v2u w = p[64 * j]; v[j] = (f32x4){bflo(w.x), bfhi(w.x), bflo(w.y), bfhi(w.y)}; }
}
constexpr int W16_PITCH = 20;
__device__ __forceinline__ void stage_w16(LAS float* tabw, const float* w, int tid) {
    for (int i = tid; i < 1024 * 4; i += 512) { const int c = i >> 2, k4 = i & 3; const f32x4 v = *(const f32x4*)(w + c * 16 + 4 * k4);
        const int sidx = ((c >> 8) * 4 + (c & 3)) * 64 + ((c >> 2) & 63); *(LAS f32x4*)(tabw + sidx * W16_PITCH + 4 * k4) = v; }
}
__device__ __forceinline__ void dot16(const f32x4 (&v)[4], const LAS float* tabw, int lane, float (&lg)[16]) {
    float a[16];
#pragma unroll
    for (int e = 0; e < 16; ++e) a[e] = 0.f;
#pragma unroll
    for (int j = 0; j < 4; ++j)
#pragma unroll
        for (int q = 0; q < 4; ++q) { const float hv = v[j][q]; const LAS float* p = tabw + ((j * 4 + q) * 64 + lane) * W16_PITCH;
#pragma unroll
            for (int k = 0; k < 4; ++k) { const f32x4 w = *(const LAS f32x4*)(p + 4 * k); a[4 * k] += hv * w.x; a[4 * k + 1] += hv * w.y; a[4 * k + 2] += hv * w.z; a[4 * k + 3] += hv * w.w; } }
    float b[8], c[4];
#pragma unroll
    for (int i = 0; i < 8; ++i) { auto rr = __builtin_amdgcn_permlane32_swap(__float_as_uint(a[i]), __float_as_uint(a[i + 8]), false, false); b[i] = __uint_as_float(rr[0]) + __uint_as_float(rr[1]); }
#pragma unroll
    for (int i = 0; i < 4; ++i) { auto rr = __builtin_amdgcn_permlane16_swap(__float_as_uint(b[i]), __float_as_uint(b[i + 4]), false, false); c[i] = row_sum16(__uint_as_float(rr[0]) + __uint_as_float(rr[1])); }
#pragma unroll
    for (int e = 0; e < 16; ++e) lg[e] = rdlane(c[e & 3], 16 * (e >> 2));
}

__device__ __forceinline__ void store16_wt(void* p, v4u v) { asm volatile("global_store_dwordx4 %0, %1, off sc1\n\ts_nop 1" :: "v"(p), "v"(v) : "memory"); }

struct EpiIn0 {
    static constexpr bool PERM = true;
    bf16* O;
    __device__ __forceinline__ void operator()(const f32x4 (&acc)[2][2][4][2], const pg8::Unit& u, int wr, int wc, int fr, int fq) const {
        const int row0 = u.pm * 256 + wr * 64 + fr;
        if (u.pn < 4) {
            const int col0 = u.pn * 128 + wc * 32 + 8 * fq;
#pragma unroll
            for (int ai = 0; ai < 2; ++ai)
#pragma unroll
                for (int m = 0; m < 4; ++m) { bf16* rowp = O + (size_t)(row0 + ai * 128 + m * 16) * QW + col0;
                    const f32x4 a0 = acc[ai][0][m][0], a1 = acc[ai][0][m][1], g0 = acc[ai][1][m][0], g1 = acc[ai][1][m][1];
                    v4u w; w.x = pk2(a0[0] * sigmoidf_(g0[0]), a0[1] * sigmoidf_(g0[1])); w.y = pk2(a0[2] * sigmoidf_(g0[2]), a0[3] * sigmoidf_(g0[3]));
                    w.z = pk2(a1[0] * sigmoidf_(g1[0]), a1[1] * sigmoidf_(g1[1])); w.w = pk2(a1[2] * sigmoidf_(g1[2]), a1[3] * sigmoidf_(g1[3]));
                    *(v4u*)rowp = w; }
        } else {
            const float sc = (u.pn < 6) ? QSCALE0 : 1.f;
            const int col0 = 512 + (u.pn - 4) * 256 + wc * 32 + 8 * fq;
#pragma unroll
            for (int ai = 0; ai < 2; ++ai)
#pragma unroll
                for (int m = 0; m < 4; ++m) { bf16* rowp = O + (size_t)(row0 + ai * 128 + m * 16) * QW + col0;
#pragma unroll
                    for (int bj = 0; bj < 2; ++bj) { const f32x4 v0 = acc[ai][bj][m][0] * sc, v1 = acc[ai][bj][m][1] * sc;
                        v4u w; w.x = pk2(v0[0], v0[1]); w.y = pk2(v0[2], v0[3]); w.z = pk2(v1[0], v1[1]); w.w = pk2(v1[2], v1[3]);
                        *(v4u*)(rowp + bj * 128) = w; } }
        }
    }
};
struct EpiIn1 {
    static constexpr bool PERM = true;
    bf16* O;
    __device__ __forceinline__ void operator()(const f32x4 (&acc)[2][2][4][2], const pg8::Unit& u, int wr, int wc, int fr, int fq) const {
        const int row0 = u.pm * 256 + wr * 64 + fr;
        const float sc = (u.pn == 0) ? 0.125f : 1.f;
        const int col0 = u.pn * 256 + wc * 32 + 8 * fq;
#pragma unroll
        for (int ai = 0; ai < 2; ++ai)
#pragma unroll
            for (int m = 0; m < 4; ++m) { bf16* rowp = O + (size_t)(row0 + ai * 128 + m * 16) * QW + col0;
#pragma unroll
                for (int bj = 0; bj < 2; ++bj) { const f32x4 v0 = acc[ai][bj][m][0] * sc, v1 = acc[ai][bj][m][1] * sc;
                    v4u w; w.x = pk2(v0[0], v0[1]); w.y = pk2(v0[2], v0[3]); w.z = pk2(v1[0], v1[1]); w.w = pk2(v1[2], v1[3]);
                    *(v4u*)(rowp + bj * 128) = w; } }
    }
};
template <bool XIN_F32> struct EpiOut {
    static constexpr bool PERM = true;
    const void* xin; bf16* xout; const float* gate;
    __device__ __forceinline__ void operator()(const f32x4 (&acc)[2][2][4][2], const pg8::Unit& u, int wr, int wc, int fr, int fq) const {
        const int row0 = u.pm * 256 + wr * 64 + fr, col0 = u.pn * 256 + wc * 32 + 8 * fq;
        const float* gb = gate + ((u.pm * 256) / S) * 6144 + col0;
        f32x4 gv[2][2];
#pragma unroll
        for (int bj = 0; bj < 2; ++bj)
#pragma unroll
            for (int n = 0; n < 2; ++n) gv[bj][n] = *(const f32x4*)(gb + bj * 128 + 4 * n);
#pragma unroll
        for (int ai = 0; ai < 2; ++ai)
#pragma unroll
            for (int m = 0; m < 4; ++m) { const size_t off = (size_t)(row0 + ai * 128 + m * 16) * D + col0;
#pragma unroll
                for (int bj = 0; bj < 2; ++bj) { f32x4 x0, x1;
                    if (XIN_F32) { const float* xp = (const float*)xin + off + bj * 128; x0 = *(const f32x4*)xp; x1 = *(const f32x4*)(xp + 4); }
                    else { const v4u w = *(const v4u*)((const bf16*)xin + off + bj * 128); x0 = (f32x4){bflo(w.x), bfhi(w.x), bflo(w.y), bfhi(w.y)}; x1 = (f32x4){bflo(w.z), bfhi(w.z), bflo(w.w), bfhi(w.w)}; }
                    x0 += gv[bj][0] * acc[ai][bj][m][0]; x1 += gv[bj][1] * acc[ai][bj][m][1];
                    v4u o; o.x = pk2(x0[0], x0[1]); o.y = pk2(x0[2], x0[3]); o.z = pk2(x1[0], x1[1]); o.w = pk2(x1[2], x1[3]);
                    store16_wt(xout + off + bj * 128, o); } }
    }
};

constexpr int CW_MOECNT = 32768;
__device__ __forceinline__ int moe_unit_index(int mode, int i, int c, int G, int U, int nlow, int nfull) {
    if (i >= 4) return -1;
    int X;
    if (mode == 1) X = i * G + c;
    else if (c >= nfull) { const int j = c - nfull; X = (i == 0) ? j : (i == 1) ? j + nlow : 2 * nlow + c + (i - 2) * G; }
    else X = 2 * nlow + c + i * G;
    return X < U ? X : -1;
}
template <int MODE> struct MoeSched {
    const bf16* A; const bf16* Bt; int K; size_t bstride;
    LAS int* tab; LAS int* rowtab;
    unsigned* cnt; int G, c;
    static constexpr bool GATHER = (MODE == 1);
    __device__ __forceinline__ bool next(int i, pg8::Unit& u) const {
        const int U = __builtin_amdgcn_readfirstlane(tab[49]);
        const int X = moe_unit_index(MODE, i, c, G, U, __builtin_amdgcn_readfirstlane(tab[61]), __builtin_amdgcn_readfirstlane(tab[62]));
        if (X < 0) return false;
        int e = 0;
#pragma unroll
        for (int j = 1; j < 16; ++j) if (X >= __builtin_amdgcn_readfirstlane(tab[33 + j])) e = j;
        const int r = X - __builtin_amdgcn_readfirstlane(tab[33 + e]); const int rt = r >> 2, ct = r & 3;
        u.pm = X >> 2; u.pn = ct; u.e = e; u.li = (MODE == 1 ? 0 : 4) + i; u.r0 = __builtin_amdgcn_readfirstlane(tab[16 + e]) + 256 * rt; u.nr = min(256, __builtin_amdgcn_readfirstlane(tab[e]) - 256 * rt); return true;
    }
    __device__ __forceinline__ const char* a_base(const pg8::Unit& u) const { return GATHER ? (const char*)A : (const char*)A + (size_t)u.r0 * K * 2; }
    __device__ __forceinline__ const char* b_base(const pg8::Unit& u) const { return (const char*)Bt + (size_t)u.e * bstride + (size_t)u.pn * 256 * K * 2; }
    __device__ __forceinline__ void a_off(const pg8::Unit& u, int tid, unsigned (&v)[4]) const {
#pragma unroll
        for (int i = 0; i < 2; ++i) { int R, C; pg8::stage_rc(tid * 16 + i * 8192, R, C);
#pragma unroll
            for (int h = 0; h < 2; ++h) {
                if (GATHER) v[2 * h + i] = (unsigned)(rowtab[u.li * 256 + h * 128 + R] >> 1) * (unsigned)(K * 2) + (unsigned)C * 2u;
                else v[2 * h + i] = (unsigned)((h * 128 + R) * K + C) * 2u;
            } }
    }
    __device__ __forceinline__ void a_ready(const pg8::Unit& u, int wid, int lane) const {
        if (MODE == 2) {
            if (wid == 0) { unsigned sp = 0;
                while ((unsigned)__builtin_amdgcn_readfirstlane(__hip_atomic_load(cnt + 64 * u.pm, __ATOMIC_RELAXED, __HIP_MEMORY_SCOPE_AGENT)) < 32u) { __builtin_amdgcn_s_sleep(2); if (++sp > (1u << 20)) break; }
                __builtin_amdgcn_fence(__ATOMIC_ACQUIRE, "agent");
                asm volatile("s_waitcnt vmcnt(0)" ::: "memory"); }
            asm volatile("" ::: "memory"); __builtin_amdgcn_s_barrier(); asm volatile("" ::: "memory");
        }
    }
    __device__ __forceinline__ void publish(int rtg, int lane) const {
        if (MODE == 1) { if (lane == 0) __hip_atomic_fetch_add(cnt + 64 * rtg, 1u, __ATOMIC_RELAXED, __HIP_MEMORY_SCOPE_AGENT); }
    }
};
__device__ __forceinline__ void moe_plan(Frame& F, const int* cntw, const int* loc, int c) {
    LAS int* tab = (LAS int*)(F.lds + L_NE); LAS int* rowtab = (LAS int*)(F.lds + L_ROWTAB);
    __syncthreads();
    for (int ee = 0; ee < 2; ++ee) { const int e = 2 * F.wave + ee; int s = 0;
#pragma unroll
        for (int i = 0; i < 4; ++i) s += cntw[(F.lane + 64 * i) * 16 + e];
        s = wave_sum_i(s); if (F.lane == 0) tab[e] = s; }
    for (int i = F.tid; i < 2048; i += 512) rowtab[i] = 0;
    __syncthreads();
    if (F.tid == 0) { int a = 0, ub = 0; for (int e = 0; e < 16; ++e) { tab[16 + e] = a; tab[33 + e] = ub; a += tab[e]; ub += 4 * ((tab[e] + 255) >> 8); } tab[32] = a; tab[49] = ub;
        const int R = 1 + (ub > F.G) + (ub > 2 * F.G) + (ub > 3 * F.G), nfull = ub - (R - 1) * F.G;
        tab[60] = R; tab[61] = F.G - nfull; tab[62] = nfull; }
    __syncthreads();
    const int li = F.wave;
    const int X = moe_unit_index(li < 4 ? 1 : 2, li & 3, c, F.G, tab[49], tab[61], tab[62]);
    if (X >= 0) {
        int e = 0;
        for (int j = 1; j < 16; ++j) if (X >= tab[33 + j]) e = j;
        const int rt = (X - tab[33 + e]) >> 2;
        int cw[4], tot = 0;
#pragma unroll
        for (int i = 0; i < 4; ++i) { cw[i] = cntw[(4 * F.lane + i) * 16 + e]; tot += cw[i]; }
        const int incl = wave_scan_i(tot);
        int start = incl - tot - 256 * rt;
#pragma unroll
        for (int i = 0; i < 4; ++i) { if (start < 256 && start + cw[i] > 0) { for (int j = 0; j < cw[i]; ++j) { const int rank = start + j; if (rank >= 0 && rank < 256) rowtab[li * 256 + rank] = loc[((4 * F.lane + i) * 16 + e) * 64 + j]; } } start += cw[i]; }
    }
    __syncthreads();
}
struct EpiM1 {
    static constexpr bool PERM = true;
    bf16* ACT; const float* ew; LAS int* rowtab;
    __device__ __forceinline__ void operator()(const f32x4 (&acc)[2][2][4][2], const pg8::Unit& u, int wr, int wc, int fr, int fq) const {
        const int col0 = u.pn * 128 + wc * 32 + 8 * fq;
#pragma unroll
        for (int ai = 0; ai < 2; ++ai)
#pragma unroll
            for (int m = 0; m < 4; ++m) { const int r = ai * 128 + wr * 64 + m * 16 + fr;
                if (r < u.nr) { const float w8 = ew[rowtab[u.li * 256 + r]];
                    const f32x4 g0 = acc[ai][0][m][0], g1 = acc[ai][0][m][1], u0 = acc[ai][1][m][0], u1 = acc[ai][1][m][1];
                    v4u w; w.x = pk2(siluf_(g0[0]) * u0[0] * w8, siluf_(g0[1]) * u0[1] * w8); w.y = pk2(siluf_(g0[2]) * u0[2] * w8, siluf_(g0[3]) * u0[3] * w8);
                    w.z = pk2(siluf_(g1[0]) * u1[0] * w8, siluf_(g1[1]) * u1[1] * w8); w.w = pk2(siluf_(g1[2]) * u1[2] * w8, siluf_(g1[3]) * u1[3] * w8);
                    store16_wt(ACT + (size_t)(u.r0 + r) * DE + col0, w); } }
    }
};
struct EpiM2 {
    static constexpr bool PERM = true;
    bf16* YS; LAS int* rowtab;
    __device__ __forceinline__ void operator()(const f32x4 (&acc)[2][2][4][2], const pg8::Unit& u, int wr, int wc, int fr, int fq) const {
        const int col0 = u.pn * 256 + wc * 32 + 8 * fq;
#pragma unroll
        for (int ai = 0; ai < 2; ++ai)
#pragma unroll
            for (int m = 0; m < 4; ++m) { const int r = ai * 128 + wr * 64 + m * 16 + fr;
                if (r < u.nr) { bf16* rowp = YS + (size_t)rowtab[u.li * 256 + r] * D + col0;
#pragma unroll
                    for (int bj = 0; bj < 2; ++bj) { const f32x4 v0 = acc[ai][bj][m][0], v1 = acc[ai][bj][m][1];
                        v4u w; w.x = pk2(v0[0], v0[1]); w.y = pk2(v0[2], v0[3]); w.z = pk2(v1[0], v1[1]); w.w = pk2(v1[2], v1[3]);
                        *(v4u*)(rowp + bj * 128) = w; } } }
    }
};

constexpr int MX_PITCH = 520;
__device__ __forceinline__ void stage_rows(LAS bf16* dst, const bf16* QKVY, int col0, int t0, int halo, int tid) {
    const int tt0 = t0 % S, nrow = 64 + halo;
    for (int p = tid; p < nrow * 64; p += 512) { const int row = p >> 6, c8 = (p & 63) * 8; v4u v = {0u, 0u, 0u, 0u};
        if (tt0 - halo + row >= 0) v = *(const v4u*)(QKVY + (size_t)(t0 - halo + row) * QW + col0 + c8);
        *(LAS v4u*)(dst + row * MX_PITCH + c8) = v; }
}
__device__ __forceinline__ void conv_phase(KA args, Frame& F, const bf16* QKVY, bf16* CAT) {
    typedef float f2 __attribute__((ext_vector_type(2)));
    LAS bf16* ys = (LAS bf16*)F.lds;
    const int half = F.tid >> 8, cp = (F.tid & 255) * 2;
    const float* cw = INP(8);
    f2 w[31];
#pragma unroll
    for (int j = 0; j < 31; ++j) w[j] = *(const f2*)(cw + j * 512 + cp);
    const f2 bb = *(const f2*)(INP(9) + cp), gg = *(const f2*)(INP(10) + cp), nn = *(const f2*)(INP(11) + cp);
    for (int chunk = F.vcu; chunk < T / 64; chunk += F.G) {
        const int t0 = chunk * 64;
        __syncthreads();
        stage_rows(ys, QKVY, 0, t0, 30, F.tid);
        __syncthreads();
        for (int blk = 0; blk < 4; ++blk) { const int tok0 = half * 32 + blk * 8;
            f2 y[38];
#pragma unroll
            for (int r = 0; r < 38; ++r) { const unsigned u = *(const LAS unsigned*)(ys + (tok0 + r) * MX_PITCH + cp); y[r] = (f2){bflo(u), bfhi(u)}; }
#pragma unroll
            for (int i = 0; i < 8; ++i) { f2 a = bb;
#pragma unroll
                for (int j = 0; j < 31; ++j) a = y[i + j] * w[j] + a;
                float s = xor16_add(row_sum16(a.x + a.y));
                const float mean = s * (1.f / 64.f); const f2 d = a - mean;
                float q = xor16_add(row_sum16(d.x * d.x + d.y * d.y));
                const float rs = rsqrtf(q * (1.f / 64.f) + 1e-5f);
                const f2 yn = d * rs * gg + nn;
                *(unsigned*)(CAT + (size_t)(t0 + tok0 + i) * D + cp) = pk2(siluf_(yn.x), siluf_(yn.y)); }
        }
    }
}
__device__ __forceinline__ void pool_phase(KA args, Frame& F, const bf16* QKVY, const bf16* WPT, bf16* CAT) {
    typedef float f32x16 __attribute__((ext_vector_type(16)));
    LAS bf16* us = (LAS bf16*)F.lds;
    const int g = (F.wave < 4) ? 3 - (F.wave >> 1) : ((F.wave - 4) >> 1), tt = F.wave & 1, r32 = F.lane & 31, hi = F.lane >> 5, win = 2 << g;
    const float* pb = INP(18); const float* ps = INP(19);
    for (int chunk = F.vcu; chunk < T / 64; chunk += F.G) {
        const int t0 = chunk * 64, tt0 = t0 % S;
        __syncthreads();
        stage_rows(us, QKVY, 1536, t0, 15, F.tid);
        __syncthreads();
        const int tok = tt * 32 + r32;
        const float inv = 1.f / (float)min(tt0 + tok + 1, win);
        f32x16 acc[4];
#pragma unroll
        for (int ct = 0; ct < 4; ++ct) acc[ct] = (f32x16){};
        for (int ks = 0; ks < 8; ++ks) {
            const LAS bf16* col = us + (tok + 15) * MX_PITCH + g * 128 + 16 * ks + 8 * hi;
            float sm[8];
#pragma unroll
            for (int e = 0; e < 8; ++e) sm[e] = 0.f;
            for (int j = 0; j < win; ++j) { const v4u u = *(const LAS v4u*)(col - j * MX_PITCH);
                sm[0] += bflo(u.x); sm[1] += bfhi(u.x); sm[2] += bflo(u.y); sm[3] += bfhi(u.y); sm[4] += bflo(u.z); sm[5] += bfhi(u.z); sm[6] += bflo(u.w); sm[7] += bfhi(u.w); }
            const v4u c = *(const LAS v4u*)col;
            v4u pa; pa.x = pk2(sm[0] * inv - bflo(c.x), sm[1] * inv - bfhi(c.x)); pa.y = pk2(sm[2] * inv - bflo(c.y), sm[3] * inv - bfhi(c.y));
            pa.z = pk2(sm[4] * inv - bflo(c.z), sm[5] * inv - bfhi(c.z)); pa.w = pk2(sm[6] * inv - bflo(c.w), sm[7] * inv - bfhi(c.w));
            const bf16x8 af = __builtin_bit_cast(bf16x8, pa);
#pragma unroll
            for (int ct = 0; ct < 4; ++ct) { const bf16x8 bfr = *(const bf16x8*)(WPT + (size_t)(g * 128 + 32 * ct + r32) * 128 + 16 * ks + 8 * hi);
                acc[ct] = __builtin_amdgcn_mfma_f32_32x32x16_bf16(af, bfr, acc[ct], 0, 0, 0); }
        }
#pragma unroll
        for (int ct = 0; ct < 4; ++ct) { const int n = g * 128 + 32 * ct + r32; const float bb = pb[n], sc = ps[n];
#pragma unroll
            for (int r = 0; r < 16; ++r) { const int row = tt * 32 + (r & 3) + 8 * (r >> 2) + 4 * hi;
                CAT[(size_t)(t0 + row) * D + 512 + n] = (bf16)(pk2((acc[ct][r] + bb) * sc, 0.f) & 0xffffu); } }
    }
}

namespace sba {
typedef short bf16x8 __attribute__((ext_vector_type(8)));
typedef short s16x4 __attribute__((ext_vector_type(4)));
typedef short v4i16_t __attribute__((ext_vector_type(4)));
typedef _Float16 h8 __attribute__((ext_vector_type(8)));
typedef _Float16 h2 __attribute__((ext_vector_type(2)));
typedef float f2 __attribute__((ext_vector_type(2)));
typedef float f32x16 __attribute__((ext_vector_type(16)));
typedef unsigned u32x4 __attribute__((ext_vector_type(4)));
typedef __bf16 bf16x2_t __attribute__((ext_vector_type(2)));
constexpr int KVB = 64, SLOTB = 8192;
constexpr float THR = 160.f;
__device__ __forceinline__ void glds16(const void* gsrc, unsigned lds_dst) { unsigned keep;
    asm volatile("s_mov_b32 %0, m0\n\ts_mov_b32 m0, %2\n\ts_nop 0\n\tglobal_load_lds_dwordx4 %1, off\n\ts_mov_b32 m0, %0" : "=&s"(keep) : "v"(gsrc), "s"(lds_dst) : "memory"); }
__device__ __forceinline__ unsigned cvtpk_bf(float lo, float hi) { f2 v = {lo, hi}; bf16x2_t b = __builtin_convertvector(v, bf16x2_t); return __builtin_bit_cast(unsigned, b); }
__device__ __forceinline__ unsigned cvtpk_h(float lo, float hi) { f2 v = {lo, hi}; h2 b = __builtin_convertvector(v, h2); return __builtin_bit_cast(unsigned, b); }
__device__ __forceinline__ float min30(float a) { float r; asm("v_min_f32_e32 %0, 0x41f00000, %1" : "=v"(r) : "v"(a)); return r; }
__device__ __forceinline__ float maxf_(float a, float b) { float r; asm("v_max_f32_e32 %0, %1, %2" : "=v"(r) : "v"(a), "v"(b)); return r; }
typedef __attribute__((address_space(3))) const char* lds_cptr;
__device__ __forceinline__ s16x4 vtr(lds_cptr p) { return __builtin_bit_cast(s16x4, __builtin_amdgcn_ds_read_tr16_b64_v4i16((__attribute__((address_space(3))) v4i16_t*)p)); }
#define SBA_H(x) __builtin_bit_cast(h8, x)
#define SBA_P(x) __builtin_bit_cast(bf16x8, x)

template <bool DIAG> __device__ __forceinline__ void tile(f32x16& p0, f32x16& p1, f32x16& o0, f32x16& o1, float& C, const h8& T0, const h8& T1, const h8& ONES, int kvb, int hi, lds_cptr vp) {
    const float z0 = p0[0];
    u32x4 lf0, lf1, lf2, lf3;
    {
        float l[16];
#pragma unroll
        for (int r = 0; r < 16; ++r) { const float z = p0[r]; float v = maxf_(__builtin_amdgcn_logf(1.f + __builtin_amdgcn_exp2f(min30(z))), z);
            if (DIAG) { if (kvb + (r & 3) + 8 * (r >> 2) >= 0) v = 0.f; } l[r] = v; }
        lf0 = (u32x4){cvtpk_h(l[0], l[1]), cvtpk_h(l[2], l[3]), cvtpk_h(l[4], l[5]), cvtpk_h(l[6], l[7])};
        lf1 = (u32x4){cvtpk_h(l[8], l[9]), cvtpk_h(l[10], l[11]), cvtpk_h(l[12], l[13]), cvtpk_h(l[14], l[15])};
#pragma unroll
        for (int r = 0; r < 16; ++r) { const float z = p1[r]; float v = maxf_(__builtin_amdgcn_logf(1.f + __builtin_amdgcn_exp2f(min30(z))), z);
            if (DIAG) { if (kvb + 32 + (r & 3) + 8 * (r >> 2) >= 0) v = 0.f; } l[r] = v; }
        if (!DIAG) l[15] += hi ? C : 0.f;
        lf2 = (u32x4){cvtpk_h(l[0], l[1]), cvtpk_h(l[2], l[3]), cvtpk_h(l[4], l[5]), cvtpk_h(l[6], l[7])};
        lf3 = (u32x4){cvtpk_h(l[8], l[9]), cvtpk_h(l[10], l[11]), cvtpk_h(l[12], l[13]), cvtpk_h(l[14], l[15])};
    }
    p0 = __builtin_amdgcn_mfma_f32_32x32x16_f16(T0, SBA_H(lf0), p0, 0, 0, 0);
    p0 = __builtin_amdgcn_mfma_f32_32x32x16_f16(T1, SBA_H(lf1), p0, 0, 0, 0);
    p0 = __builtin_amdgcn_mfma_f32_32x32x16_f16(ONES, SBA_H(lf2), p0, 0, 0, 0);
    p0 = __builtin_amdgcn_mfma_f32_32x32x16_f16(ONES, SBA_H(lf3), p0, 0, 0, 0);
    p1 = __builtin_amdgcn_mfma_f32_32x32x16_f16(T0, SBA_H(lf2), p1, 0, 0, 0);
    p1 = __builtin_amdgcn_mfma_f32_32x32x16_f16(T1, SBA_H(lf3), p1, 0, 0, 0);
    float cn = z0 - p0[0];
    { auto rr = __builtin_amdgcn_permlane32_swap(__float_as_uint(cn), __float_as_uint(cn), false, false); cn = __uint_as_float(rr[0]); }
    C = cn;
    u32x4 pw0, pw1, pw2, pw3;
    {
        float a[16];
#pragma unroll
        for (int r = 0; r < 16; ++r) { float v = __builtin_amdgcn_exp2f(p0[r]); if (DIAG) { if (kvb + (r & 3) + 8 * (r >> 2) >= 0) v = 0.f; } a[r] = v; }
        pw0 = (u32x4){cvtpk_bf(a[0], a[1]), cvtpk_bf(a[2], a[3]), cvtpk_bf(a[4], a[5]), cvtpk_bf(a[6], a[7])};
        pw1 = (u32x4){cvtpk_bf(a[8], a[9]), cvtpk_bf(a[10], a[11]), cvtpk_bf(a[12], a[13]), cvtpk_bf(a[14], a[15])};
#pragma unroll
        for (int r = 0; r < 16; ++r) { float v = __builtin_amdgcn_exp2f(p1[r]); if (DIAG) { if (kvb + 32 + (r & 3) + 8 * (r >> 2) >= 0) v = 0.f; } a[r] = v; }
        pw2 = (u32x4){cvtpk_bf(a[0], a[1]), cvtpk_bf(a[2], a[3]), cvtpk_bf(a[4], a[5]), cvtpk_bf(a[6], a[7])};
        pw3 = (u32x4){cvtpk_bf(a[8], a[9]), cvtpk_bf(a[10], a[11]), cvtpk_bf(a[12], a[13]), cvtpk_bf(a[14], a[15])};
    }
#define SBA_VFR(i) ({ const s16x4 lo_ = vtr(vp + (((i) >> 2) * 4096 + ((i) & 3) * 1024)); const s16x4 hi_ = vtr(vp + (((i) >> 2) * 4096 + ((i) & 3) * 1024 + 512)); (bf16x8){lo_[0], lo_[1], lo_[2], lo_[3], hi_[0], hi_[1], hi_[2], hi_[3]}; })
    o0 = __builtin_amdgcn_mfma_f32_32x32x16_bf16(SBA_P(pw0), SBA_VFR(0), o0, 0, 0, 0);
    o1 = __builtin_amdgcn_mfma_f32_32x32x16_bf16(SBA_P(pw0), SBA_VFR(4), o1, 0, 0, 0);
    o0 = __builtin_amdgcn_mfma_f32_32x32x16_bf16(SBA_P(pw1), SBA_VFR(1), o0, 0, 0, 0);
    o1 = __builtin_amdgcn_mfma_f32_32x32x16_bf16(SBA_P(pw1), SBA_VFR(5), o1, 0, 0, 0);
    o0 = __builtin_amdgcn_mfma_f32_32x32x16_bf16(SBA_P(pw2), SBA_VFR(2), o0, 0, 0, 0);
    o1 = __builtin_amdgcn_mfma_f32_32x32x16_bf16(SBA_P(pw2), SBA_VFR(6), o1, 0, 0, 0);
    o0 = __builtin_amdgcn_mfma_f32_32x32x16_bf16(SBA_P(pw3), SBA_VFR(3), o0, 0, 0, 0);
    o1 = __builtin_amdgcn_mfma_f32_32x32x16_bf16(SBA_P(pw3), SBA_VFR(7), o1, 0, 0, 0);
#undef SBA_VFR
}

__device__ __forceinline__ void wave_unit(int b, int h, int qi, const bf16* QKVY, bf16* CAT, char* shm_wave, int lane) {
    const int r32 = lane & 31, hi = lane >> 5;
    const long rowbase = (long)b * S; const int r0 = qi * 32;
    const bf16* Qw = QKVY + (rowbase + r0) * QW + 512 + h * 64;
    const bf16* Kl = QKVY + (rowbase + r32) * QW + 1024 + h * 64 + 8 * hi;
    const bf16* Vl = QKVY + (rowbase + (lane >> 2)) * QW + 1536 + h * 64 + (lane & 3) * 8;
    const unsigned lds0 = (unsigned)(uintptr_t)shm_wave;
    const lds_cptr vp0 = (lds_cptr)shm_wave + ((lane >> 4) & 1) * 32 + (lane & 3) * 8 + (4 * hi + ((lane & 15) >> 2)) * 64;
#define SBA_LOAD_V(t) do { _Pragma("unroll") for (int p_ = 0; p_ < 8; ++p_) vreg[p_] = *reinterpret_cast<const u32x4*>(Vl + ((long)(t) * KVB + 16 * (p_ & 3)) * QW + (p_ >> 2) * 32); } while (0)
#define SBA_STORE_V(slot) do { _Pragma("unroll") for (int p_ = 0; p_ < 8; ++p_) *(__attribute__((address_space(3))) u32x4*)((lds_cptr)shm_wave + (slot) * SLOTB + p_ * 1024 + lane * 16) = vreg[p_]; } while (0)
#define SBA_LOAD_K(t) do { _Pragma("unroll") for (int d0_ = 0; d0_ < 4; ++d0_) { kf[2 * d0_] = *reinterpret_cast<const bf16x8*>(Kl + (long)(t) * KVB * QW + 16 * d0_); kf[2 * d0_ + 1] = *reinterpret_cast<const bf16x8*>(Kl + ((long)(t) * KVB + 32) * QW + 16 * d0_); } } while (0)
    const int td = (r0 + 31) >> 6;
    bf16x8 kf[8], qr[4]; u32x4 vreg[8];
    SBA_LOAD_V(td); SBA_STORE_V(0);
    SBA_LOAD_K(td);
#pragma unroll
    for (int d0 = 0; d0 < 4; ++d0) qr[d0] = *reinterpret_cast<const bf16x8*>(&Qw[(long)r32 * QW + d0 * 16 + hi * 8]);
    h8 T0, T1, ONES;
#pragma unroll
    for (int jj = 0; jj < 8; ++jj) { const int kap = 8 * (jj >> 2) + 4 * hi + (jj & 3); T0[jj] = (kap >= r32) ? (_Float16)-1.0f : (_Float16)0.0f; T1[jj] = (16 + kap >= r32) ? (_Float16)-1.0f : (_Float16)0.0f; ONES[jj] = (_Float16)-1.0f; }
    f32x16 o0 = {}, o1 = {};
    float C = 0.f;
    for (int it = 0;; ++it) {
        const int t = td - it, slot = it & 1;
        f32x16 p0 = {}, p1 = {};
#pragma unroll
        for (int d0 = 0; d0 < 4; ++d0) { p0 = __builtin_amdgcn_mfma_f32_32x32x16_bf16(kf[2 * d0], qr[d0], p0, 0, 0, 0); p1 = __builtin_amdgcn_mfma_f32_32x32x16_bf16(kf[2 * d0 + 1], qr[d0], p1, 0, 0, 0); }
        if (t > 0) { SBA_LOAD_K(t - 1); SBA_LOAD_V(t - 1); }
        const lds_cptr vp = vp0 + slot * SLOTB;
        if (it == 0) tile<true>(p0, p1, o0, o1, C, T0, T1, ONES, KVB * t + 4 * hi - (r0 + r32), hi, vp);
        else tile<false>(p0, p1, o0, o1, C, T0, T1, ONES, 0, hi, vp);
        if (t == 0 || __all(C >= THR)) break;
        SBA_STORE_V(slot ^ 1);
    }
    bf16* Ow = CAT + (rowbase + r0) * D + 512 + h * 64;
#pragma unroll
    for (int r = 0; r < 16; ++r) { const int orow = (r & 3) + 8 * (r >> 2) + 4 * hi;
        Ow[(long)orow * D + r32] = (bf16)(cvtpk_bf(o0[r], 0.f) & 0xffffu); Ow[(long)orow * D + 32 + r32] = (bf16)(cvtpk_bf(o1[r], 0.f) & 0xffffu); }
#undef SBA_LOAD_V
#undef SBA_STORE_V
#undef SBA_LOAD_K
}
#undef SBA_H
#undef SBA_P
__device__ __forceinline__ void phase(const bf16* QKVY, bf16* CAT, char* lds, int vcu, int G, int wid, int lane) {
    for (int wu = vcu * 8 + wid; wu < NB * 8 * (S / 32); wu += G * 8) {
        const int bh = wu >> 7, qi = wu & 127;
        wave_unit(bh >> 3, bh & 7, qi, QKVY, CAT, lds + wid * 2 * SLOTB, lane);
    }
}
}


namespace gla {
typedef short bf16x8 __attribute__((ext_vector_type(8)));
typedef short s16x4 __attribute__((ext_vector_type(4)));
typedef short v4i16_t __attribute__((ext_vector_type(4)));
typedef float f32x16 __attribute__((ext_vector_type(16)));
typedef __attribute__((address_space(3))) const char* lds_cptr;
constexpr int NCH = NB * 4 * 64;
constexpr int L_VP = 0, L_KP = 16384, L_TOT = 24576, L_DL = 26624, L_PS = 16384, QSTR = 27136;
__device__ __forceinline__ void glds16(const void* gsrc, unsigned lds_dst) { unsigned keep;
    asm volatile("s_mov_b32 %0, m0\n\ts_mov_b32 m0, %2\n\ts_nop 0\n\tglobal_load_lds_dwordx4 %1, off\n\ts_mov_b32 m0, %0" : "=&s"(keep) : "v"(gsrc), "s"(lds_dst) : "memory"); }
__device__ __forceinline__ s16x4 vtr(lds_cptr p) { return __builtin_bit_cast(s16x4, __builtin_amdgcn_ds_read_tr16_b64_v4i16((__attribute__((address_space(3))) v4i16_t*)p)); }
#define GLA_WAIT_BAR() asm volatile("s_waitcnt vmcnt(0) lgkmcnt(0)\n\ts_barrier" ::: "memory")
__device__ __forceinline__ void dma_v(const bf16* QKVY, long t0, int h, unsigned lds0, int wid, int lane) {
#pragma unroll
    for (int i = 0; i < 2; ++i) { const int p = wid * 2 + i, ctile = p >> 2, tg = p & 3;
        glds16(QKVY + (t0 + 16 * tg + (lane >> 2)) * QW + 512 + h * 128 + 32 * ctile + (lane & 3) * 8, (unsigned)__builtin_amdgcn_readfirstlane(lds0 + L_VP + p * 1024)); }
}
__device__ __forceinline__ bf16x8 trfrag(lds_cptr base, int piece, int lane) {
    const int hi = lane >> 5; const lds_cptr p = base + piece * 1024 + ((lane >> 4) & 1) * 32 + (lane & 3) * 8 + (4 * hi + ((lane & 15) >> 2)) * 64;
    const s16x4 lo = vtr(p), hh = vtr(p + 512); return (bf16x8){lo[0], lo[1], lo[2], lo[3], hh[0], hh[1], hh[2], hh[3]};
}
__device__ __forceinline__ void pass_a(KA args, const bf16* QKVY, const float* ALOW, bf16* QIN, bf16* KIN, float* KVT, float* DEC, char* shm, int vcu, int G, int wid, int lane) {
    const unsigned lds0 = (unsigned)(uintptr_t)shm; const lds_cptr shm3 = (lds_cptr)shm;
    const float* gw = INP(14); const float* gb = INP(15);
    for (int base = 4 * vcu; base < NCH; base += 4 * G) {
        const int bh = base >> 6, b = bh >> 2, h = bh & 3;
        float gwv[16];
#pragma unroll
        for (int r = 0; r < 16; ++r) gwv[r] = gw[r * 256 + h * 64 + lane];
        const float gbv = gb[h * 64 + lane];
        float bl[4][8], qv[4][8], kv[4][8];
#pragma unroll
        for (int q = 0; q < 4; ++q) { const long t0 = (long)b * S + ((base + q) & 63) * 64;
            dma_v(QKVY, t0, h, lds0 + q * QSTR, wid, lane);
#pragma unroll
            for (int tt = 0; tt < 8; ++tt) { const long t = t0 + 8 * wid + tt; const f32x4* al = (const f32x4*)(ALOW + t * 16); float x = gbv;
#pragma unroll
                for (int r4 = 0; r4 < 4; ++r4) { const f32x4 a4 = al[r4]; x += a4.x * gwv[4 * r4] + a4.y * gwv[4 * r4 + 1] + a4.z * gwv[4 * r4 + 2] + a4.w * gwv[4 * r4 + 3]; }
                const float la = -softplusf_(-x) * (1.f / 16.f);
                bl[q][tt] = (tt ? bl[q][tt - 1] : 0.f) + la;
                qv[q][tt] = bf2f(QKVY[t * QW + h * 64 + lane]); kv[q][tt] = bf2f(QKVY[t * QW + 256 + h * 64 + lane]); }
            ((__attribute__((address_space(3))) float*)(shm3 + q * QSTR + L_TOT))[wid * 64 + lane] = bl[q][7]; }
        asm volatile("s_waitcnt lgkmcnt(0)\n\ts_barrier" ::: "memory");
#pragma unroll
        for (int q = 0; q < 4; ++q) { const int ch = base + q; const long t0 = (long)b * S + (ch & 63) * 64;
            __attribute__((address_space(3))) float* tot = (__attribute__((address_space(3))) float*)(shm3 + q * QSTR + L_TOT);
            __attribute__((address_space(3))) bf16* kp = (__attribute__((address_space(3))) bf16*)(shm3 + q * QSTR + L_KP);
            float off = 0.f, blast = 0.f;
#pragma unroll
            for (int w = 0; w < 8; ++w) { const float v = tot[w * 64 + lane]; if (w < wid) off += v; blast += v; }
#pragma unroll
            for (int tt = 0; tt < 8; ++tt) { const long t = t0 + 8 * wid + tt; const float bb = bl[q][tt] + off; const int tk = 8 * wid + tt;
                const float qi = qv[q][tt] * __expf(bb), ki = kv[q][tt] * __expf(-bb);
                QIN[t * 256 + h * 64 + lane] = (bf16)f2bf(qi); const bf16 kb = (bf16)f2bf(ki); KIN[t * 256 + h * 64 + lane] = kb;
                kp[((lane >> 5) * 4 + (tk >> 4)) * 512 + (tk & 15) * 32 + (lane & 31)] = kb; }
            if (wid == 0) { const float dd = __expf(blast); ((__attribute__((address_space(3))) float*)(shm3 + q * QSTR + L_DL))[lane] = dd; DEC[ch * 64 + lane] = dd; } }
        GLA_WAIT_BAR();
        const int dvt = wid & 3, dt = wid >> 2;
#pragma unroll
        for (int q = 0; q < 4; ++q) { const int ch = base + q;
            f32x16 acc = {};
#pragma unroll
            for (int ks = 0; ks < 4; ++ks) acc = __builtin_amdgcn_mfma_f32_32x32x16_bf16(trfrag(shm3 + q * QSTR + L_VP, dvt * 4 + ks, lane), trfrag(shm3 + q * QSTR + L_KP, dt * 4 + ks, lane), acc, 0, 0, 0);
            const int dcol = 32 * dt + (lane & 31); const float dsc = ((__attribute__((address_space(3))) float*)(shm3 + q * QSTR + L_DL))[dcol];
            float* kvo = KVT + ((size_t)ch * 128 + 32 * dvt) * 64 + dcol;
#pragma unroll
            for (int r = 0; r < 16; ++r) kvo[(size_t)((r & 3) + 8 * (r >> 2) + 4 * (lane >> 5)) * 64] = acc[r] * dsc; }
        GLA_WAIT_BAR();
    }
}
__device__ __forceinline__ void pass_b(const float* KVT, const float* DEC, bf16* SINT, int vcu, int G, int tid) {
    for (int e = vcu * 512 + tid; e < NB * 4 * 128 * 64; e += G * 512) {
        const int bh = e >> 13, rem = e & 8191, d = e & 63;
        float st = 0.f;
        for (int n0 = 0; n0 < 64; n0 += 8) {
            float kvv[8], dc[8];
#pragma unroll
            for (int i = 0; i < 8; ++i) { const size_t ch = (size_t)bh * 64 + n0 + i; kvv[i] = KVT[ch * 8192 + rem]; dc[i] = DEC[ch * 64 + d]; }
#pragma unroll
            for (int i = 0; i < 8; ++i) { const size_t ch = (size_t)bh * 64 + n0 + i; SINT[ch * 8192 + rem] = (bf16)f2bf(st); st = dc[i] * st + kvv[i]; }
        }
    }
}
__device__ __forceinline__ void pass_c(KA args, const bf16* QKVY, const bf16* QIN, const bf16* KIN, const bf16* SINT, bf16* CAT, char* shm, int vcu, int G, int wid, int lane) {
    const unsigned lds0 = (unsigned)(uintptr_t)shm; const lds_cptr shm3 = (lds_cptr)shm;
    const int r32 = lane & 31, hi = lane >> 5, it = wid >> 2, ct = wid & 3;
    const float* gng = INP(16);
    for (int base = 4 * vcu; base < NCH; base += 4 * G) {
        const int bh = base >> 6, b = bh >> 2, h = bh & 3;
        f32x16 o[4]; unsigned pw[4][2][8];
#pragma unroll
        for (int q = 0; q < 4; ++q) { const int ch = base + q; const long t0 = (long)b * S + (ch & 63) * 64;
            dma_v(QKVY, t0, h, lds0 + q * QSTR, wid, lane);
            bf16x8 qf[4];
#pragma unroll
            for (int d0 = 0; d0 < 4; ++d0) qf[d0] = *(const bf16x8*)(QIN + (t0 + 32 * it + r32) * 256 + h * 64 + 16 * d0 + 8 * hi);
            f32x16 oo = {};
#pragma unroll
            for (int ks = 0; ks < 4; ++ks) { const bf16x8 sf = *(const bf16x8*)(SINT + ((size_t)ch * 128 + 32 * ct + r32) * 64 + 16 * ks + 8 * hi);
                oo = __builtin_amdgcn_mfma_f32_32x32x16_bf16(qf[ks], sf, oo, 0, 0, 0); }
            o[q] = oo;
            f32x16 pt0 = {}, pt1 = {};
#pragma unroll
            for (int d0 = 0; d0 < 4; ++d0) { const bf16x8 kf = *(const bf16x8*)(KIN + (t0 + r32) * 256 + h * 64 + 16 * d0 + 8 * hi);
                pt0 = __builtin_amdgcn_mfma_f32_32x32x16_bf16(kf, qf[d0], pt0, 0, 0, 0); }
            if (it == 1) {
#pragma unroll
                for (int d0 = 0; d0 < 4; ++d0) { const bf16x8 kf = *(const bf16x8*)(KIN + (t0 + 32 + r32) * 256 + h * 64 + 16 * d0 + 8 * hi);
                    pt1 = __builtin_amdgcn_mfma_f32_32x32x16_bf16(kf, qf[d0], pt1, 0, 0, 0); }
            }
#pragma unroll
            for (int r = 0; r < 16; r += 2) { const int j0 = (r & 3) + 8 * (r >> 2) + 4 * hi;
                float a0 = pt0[r], a1 = pt0[r + 1], c0 = pt1[r], c1 = pt1[r + 1];
                if (it == 0) { if (j0 > r32) a0 = 0.f; if (j0 + 1 > r32) a1 = 0.f; } else { if (j0 > r32) c0 = 0.f; if (j0 + 1 > r32) c1 = 0.f; }
                pw[q][0][r >> 1] = pk2(a0, a1); pw[q][1][r >> 1] = pk2(c0, c1); } }
        GLA_WAIT_BAR();
#pragma unroll
        for (int q = 0; q < 4; ++q) { f32x16 oo = o[q];
#pragma unroll
            for (int ks2 = 0; ks2 < 2; ++ks2) { const v4u a = {pw[q][0][4 * ks2], pw[q][0][4 * ks2 + 1], pw[q][0][4 * ks2 + 2], pw[q][0][4 * ks2 + 3]};
                oo = __builtin_amdgcn_mfma_f32_32x32x16_bf16(__builtin_bit_cast(bf16x8, a), trfrag(shm3 + q * QSTR + L_VP, ct * 4 + ks2, lane), oo, 0, 0, 0); }
            if (it == 1) {
#pragma unroll
                for (int ks2 = 0; ks2 < 2; ++ks2) { const v4u a = {pw[q][1][4 * ks2], pw[q][1][4 * ks2 + 1], pw[q][1][4 * ks2 + 2], pw[q][1][4 * ks2 + 3]};
                    oo = __builtin_amdgcn_mfma_f32_32x32x16_bf16(__builtin_bit_cast(bf16x8, a), trfrag(shm3 + q * QSTR + L_VP, ct * 4 + 2 + ks2, lane), oo, 0, 0, 0); }
            }
            o[q] = oo;
            __attribute__((address_space(3))) float* ps = (__attribute__((address_space(3))) float*)(shm3 + q * QSTR + L_PS);
#pragma unroll
            for (int r = 0; r < 16; ++r) { float v = xor16_add(row_sum16(oo[r] * oo[r]));
                if ((lane & 31) == 0) ps[(32 * it + (r & 3) + 8 * (r >> 2) + 4 * hi) * 4 + ct] = v; } }
        asm volatile("s_waitcnt lgkmcnt(0)\n\ts_barrier" ::: "memory");
        const float gv = gng[h * 128 + 32 * ct + r32];
#pragma unroll
        for (int q = 0; q < 4; ++q) { const int ch = base + q; const long t0 = (long)b * S + (ch & 63) * 64;
            const __attribute__((address_space(3))) float* ps = (const __attribute__((address_space(3))) float*)(shm3 + q * QSTR + L_PS);
#pragma unroll
            for (int r = 0; r < 16; ++r) { const int row = 32 * it + (r & 3) + 8 * (r >> 2) + 4 * hi; const long t = t0 + row;
                const f32x4 p4 = *(const __attribute__((address_space(3))) f32x4*)(ps + row * 4);
                const float rr = rsqrtf(((p4.x + p4.y) + (p4.z + p4.w)) * (1.f / 128.f) + 1e-6f);
                const float rg = bf2f(QKVY[t * QW + 1024 + h * 128 + 32 * ct + r32]);
                CAT[t * D + h * 128 + 32 * ct + r32] = (bf16)f2bf(o[q][r] * rr * gv * siluf_(rg)); } }
        asm volatile("s_waitcnt lgkmcnt(0)\n\ts_barrier" ::: "memory");
    }
}
typedef unsigned u32x4 __attribute__((ext_vector_type(4)));
constexpr int W_VP = 0, W_KP = 16384, W_AL = 24576, W_DL = 28672, WSTR = 29696;
__device__ __forceinline__ void stage_v_wave(const bf16* QKVY, long t0, int h, lds_cptr blk, int lane) {
#pragma unroll
    for (int half = 0; half < 2; ++half) { u32x4 r[8];
#pragma unroll
        for (int i = 0; i < 8; ++i) { const int p = half * 8 + i; r[i] = *(const u32x4*)(QKVY + (t0 + 16 * (p & 3) + (lane >> 2)) * QW + 512 + h * 128 + 32 * (p >> 2) + (lane & 3) * 8); }
#pragma unroll
        for (int i = 0; i < 8; ++i) { const int p = half * 8 + i; *(__attribute__((address_space(3))) u32x4*)(blk + W_VP + p * 1024 + lane * 16) = r[i]; } }
}
__device__ __forceinline__ void pass_a_w(KA args, const bf16* QKVY, const float* ALOW, bf16* QIN, bf16* KIN, float* KVT, float* DEC, char* shm, int vcu, int G, int wid, int lane) {
    const int role = wid >> 2;
    const lds_cptr blk = (lds_cptr)shm + (wid & 3) * WSTR;
    __attribute__((address_space(3))) float* al = (__attribute__((address_space(3))) float*)(blk + W_AL);
    __attribute__((address_space(3))) float* dl = (__attribute__((address_space(3))) float*)(blk + W_DL);
    __attribute__((address_space(3))) float* totA = dl + 64;
    volatile __attribute__((address_space(3))) unsigned* flg = (volatile __attribute__((address_space(3))) unsigned*)(dl + 128);
    __attribute__((address_space(3))) bf16* kp = (__attribute__((address_space(3))) bf16*)(blk + W_KP);
    __attribute__((address_space(3))) float* blbuf = (__attribute__((address_space(3))) float*)(blk + W_VP + 8192);
    const float* gw = INP(14); const float* gb = INP(15);
    if (lane < 4 && role == 0) flg[lane] = 0u;
    __syncthreads();
    unsigned epoch = 0;
    for (int ch = 4 * vcu + (wid & 3); ch < NCH; ch += 4 * G) {
        ++epoch;
        const int bh = ch >> 6, n = ch & 63, b = bh >> 2, h = bh & 3; const long t0 = (long)b * S + n * 64;
        const int tk0 = 32 * role;
        u32x4 vr[8];
#pragma unroll
        for (int i = 0; i < 8; ++i) { const int p = 8 * role + i; vr[i] = *(const u32x4*)(QKVY + (t0 + 16 * (p & 3) + (lane >> 2)) * QW + 512 + h * 128 + 32 * (p >> 2) + (lane & 3) * 8); }
        if (role == 0) {
#pragma unroll
            for (int i = 0; i < 8; ++i) *(__attribute__((address_space(3))) u32x4*)(blk + W_VP + i * 1024 + lane * 16) = vr[i]; }
#pragma unroll
        for (int j = 0; j < 2; ++j) *(__attribute__((address_space(3))) f32x4*)(al + tk0 * 16 + 4 * (lane + 64 * j)) = *(const f32x4*)(ALOW + (t0 + tk0) * 16 + 4 * (lane + 64 * j));
        float gwv[16];
#pragma unroll
        for (int r = 0; r < 16; ++r) gwv[r] = gw[r * 256 + h * 64 + lane];
        const float gbv = gb[h * 64 + lane];
        asm volatile("s_waitcnt lgkmcnt(0)" ::: "memory");
        float bcum = 0.f, off = 0.f;
        if (role == 1) {
            for (int tt = 0; tt < 32; ++tt) { float x = gbv;
#pragma unroll
                for (int r4 = 0; r4 < 4; ++r4) { const f32x4 a4 = *(const __attribute__((address_space(3))) f32x4*)(al + (tk0 + tt) * 16 + 4 * r4); x += a4.x * gwv[4 * r4] + a4.y * gwv[4 * r4 + 1] + a4.z * gwv[4 * r4 + 2] + a4.w * gwv[4 * r4 + 3]; }
                bcum += -softplusf_(-x) * (1.f / 16.f); blbuf[tt * 64 + lane] = bcum; }
            while (flg[0] != epoch) __builtin_amdgcn_s_sleep(1);
            asm volatile("" ::: "memory"); off = totA[lane];
        }
        for (int t8 = 0; t8 < 32; t8 += 8) {
            float qv[8], kv[8];
#pragma unroll
            for (int tt = 0; tt < 8; ++tt) { qv[tt] = bf2f(QKVY[(t0 + tk0 + t8 + tt) * QW + h * 64 + lane]); kv[tt] = bf2f(QKVY[(t0 + tk0 + t8 + tt) * QW + 256 + h * 64 + lane]); }
#pragma unroll
            for (int tt = 0; tt < 8; ++tt) { const int tk = tk0 + t8 + tt; const long t = t0 + tk; float bb;
                if (role == 0) { float x = gbv;
#pragma unroll
                    for (int r4 = 0; r4 < 4; ++r4) { const f32x4 a4 = *(const __attribute__((address_space(3))) f32x4*)(al + tk * 16 + 4 * r4); x += a4.x * gwv[4 * r4] + a4.y * gwv[4 * r4 + 1] + a4.z * gwv[4 * r4 + 2] + a4.w * gwv[4 * r4 + 3]; }
                    bcum += -softplusf_(-x) * (1.f / 16.f); bb = bcum; }
                else bb = blbuf[(t8 + tt) * 64 + lane] + off;
                const float qi = qv[tt] * __expf(bb), ki = kv[tt] * __expf(-bb);
                QIN[t * 256 + h * 64 + lane] = (bf16)f2bf(qi); const bf16 kb = (bf16)f2bf(ki); KIN[t * 256 + h * 64 + lane] = kb;
                kp[((lane >> 5) * 4 + (tk >> 4)) * 512 + (tk & 15) * 32 + (lane & 31)] = kb; }
        }
        if (role == 0) { totA[lane] = bcum; asm volatile("s_waitcnt lgkmcnt(0)" ::: "memory"); if (lane == 0) flg[0] = epoch; }
        else { const float dd = __expf(bcum + off); dl[lane] = dd; DEC[ch * 64 + lane] = dd;
            asm volatile("s_waitcnt lgkmcnt(0)" ::: "memory");
#pragma unroll
            for (int i = 0; i < 8; ++i) *(__attribute__((address_space(3))) u32x4*)(blk + W_VP + (8 + i) * 1024 + lane * 16) = vr[i]; }
        asm volatile("s_waitcnt lgkmcnt(0)" ::: "memory");
        if (role == 1) { if (lane == 0) flg[1] = epoch; } else { while (flg[1] != epoch) __builtin_amdgcn_s_sleep(1); }
        asm volatile("" ::: "memory");
        { const int dt = role; bf16x8 kf[4];
#pragma unroll
          for (int ks = 0; ks < 4; ++ks) kf[ks] = trfrag(blk + W_KP, dt * 4 + ks, lane);
          const int dcol = 32 * dt + (lane & 31); const float dsc = dl[dcol];
#pragma unroll
          for (int dvt = 0; dvt < 4; ++dvt) { f32x16 acc = {};
#pragma unroll
              for (int ks = 0; ks < 4; ++ks) acc = __builtin_amdgcn_mfma_f32_32x32x16_bf16(trfrag(blk + W_VP, dvt * 4 + ks, lane), kf[ks], acc, 0, 0, 0);
              float* kvo = KVT + ((size_t)ch * 128 + 32 * dvt) * 64 + dcol;
#pragma unroll
              for (int r = 0; r < 16; ++r) kvo[(size_t)((r & 3) + 8 * (r >> 2) + 4 * (lane >> 5)) * 64] = acc[r] * dsc; } }
        asm volatile("s_waitcnt lgkmcnt(0)" ::: "memory");
        if (lane == 0) flg[2 + role] = epoch;
        while (flg[3 - role] != epoch) __builtin_amdgcn_s_sleep(1);
        asm volatile("" ::: "memory");
    }
}
__device__ __forceinline__ void pass_c_w(KA args, const bf16* QKVY, const bf16* QIN, const bf16* KIN, const bf16* SINT, bf16* CAT, char* shm, int vcu, int G, int wid, int lane) {
    const lds_cptr blk = (lds_cptr)shm + wid * 16384;
    const int r32 = lane & 31, hi = lane >> 5, it = wid >> 2;
    const float* gng = INP(16);
    for (int ch = 4 * vcu + (wid & 3); ch < NCH; ch += 4 * G) {
        const int bh = ch >> 6, n = ch & 63, b = bh >> 2, h = bh & 3; const long t0 = (long)b * S + n * 64;
        stage_v_wave(QKVY, t0, h, blk, lane);
        bf16x8 qf[4];
#pragma unroll
        for (int d0 = 0; d0 < 4; ++d0) qf[d0] = *(const bf16x8*)(QIN + (t0 + 32 * it + r32) * 256 + h * 64 + 16 * d0 + 8 * hi);
        f32x16 pt0 = {}, pt1 = {};
#pragma unroll
        for (int d0 = 0; d0 < 4; ++d0) { const bf16x8 kf = *(const bf16x8*)(KIN + (t0 + r32) * 256 + h * 64 + 16 * d0 + 8 * hi);
            pt0 = __builtin_amdgcn_mfma_f32_32x32x16_bf16(kf, qf[d0], pt0, 0, 0, 0); }
        if (it == 1) {
#pragma unroll
            for (int d0 = 0; d0 < 4; ++d0) { const bf16x8 kf = *(const bf16x8*)(KIN + (t0 + 32 + r32) * 256 + h * 64 + 16 * d0 + 8 * hi);
                pt1 = __builtin_amdgcn_mfma_f32_32x32x16_bf16(kf, qf[d0], pt1, 0, 0, 0); } }
        unsigned pw[2][8];
#pragma unroll
        for (int r = 0; r < 16; r += 2) { const int j0 = (r & 3) + 8 * (r >> 2) + 4 * hi;
            float a0 = pt0[r], a1 = pt0[r + 1], c0 = pt1[r], c1 = pt1[r + 1];
            if (it == 0) { if (j0 > r32) a0 = 0.f; if (j0 + 1 > r32) a1 = 0.f; } else { if (j0 > r32) c0 = 0.f; if (j0 + 1 > r32) c1 = 0.f; }
            pw[0][r >> 1] = pk2(a0, a1); pw[1][r >> 1] = pk2(c0, c1); }
        asm volatile("s_waitcnt lgkmcnt(0)" ::: "memory");
        f32x16 o[4]; float ss[16];
#pragma unroll
        for (int r = 0; r < 16; ++r) ss[r] = 0.f;
#pragma unroll
        for (int ct = 0; ct < 4; ++ct) { f32x16 oo = {};
#pragma unroll
            for (int ks = 0; ks < 4; ++ks) { const bf16x8 sf = *(const bf16x8*)(SINT + ((size_t)ch * 128 + 32 * ct + r32) * 64 + 16 * ks + 8 * hi);
                oo = __builtin_amdgcn_mfma_f32_32x32x16_bf16(qf[ks], sf, oo, 0, 0, 0); }
#pragma unroll
            for (int ks2 = 0; ks2 < 2; ++ks2) { const v4u a = {pw[0][4 * ks2], pw[0][4 * ks2 + 1], pw[0][4 * ks2 + 2], pw[0][4 * ks2 + 3]};
                oo = __builtin_amdgcn_mfma_f32_32x32x16_bf16(__builtin_bit_cast(bf16x8, a), trfrag(blk + W_VP, ct * 4 + ks2, lane), oo, 0, 0, 0); }
            if (it == 1) {
#pragma unroll
                for (int ks2 = 0; ks2 < 2; ++ks2) { const v4u a = {pw[1][4 * ks2], pw[1][4 * ks2 + 1], pw[1][4 * ks2 + 2], pw[1][4 * ks2 + 3]};
                    oo = __builtin_amdgcn_mfma_f32_32x32x16_bf16(__builtin_bit_cast(bf16x8, a), trfrag(blk + W_VP, ct * 4 + 2 + ks2, lane), oo, 0, 0, 0); } }
            o[ct] = oo;
#pragma unroll
            for (int r = 0; r < 16; ++r) ss[r] += oo[r] * oo[r]; }
#pragma unroll
        for (int r = 0; r < 16; ++r) ss[r] = rsqrtf(xor16_add(row_sum16(ss[r])) * (1.f / 128.f) + 1e-6f);
#pragma unroll
        for (int ct = 0; ct < 4; ++ct) { const float gv = gng[h * 128 + 32 * ct + r32];
#pragma unroll
            for (int r = 0; r < 16; ++r) { const long t = t0 + 32 * it + (r & 3) + 8 * (r >> 2) + 4 * hi;
                const float rg = bf2f(QKVY[t * QW + 1024 + h * 128 + 32 * ct + r32]);
                CAT[t * D + h * 128 + 32 * ct + r32] = (bf16)f2bf(o[ct][r] * ss[r] * gv * siluf_(rg)); } }
        asm volatile("s_waitcnt lgkmcnt(0)" ::: "memory");
    }
}
#undef GLA_WAIT_BAR
}

__device__ __forceinline__ void dot16x2(const f32x4 (&v0)[4], const f32x4 (&v1)[4], const LAS float* tabw, int lane, float (&c0)[4], float (&c1)[4]) {
    float a[16], b[16];
#pragma unroll
    for (int e = 0; e < 16; ++e) { a[e] = 0.f; b[e] = 0.f; }
#pragma unroll
    for (int j = 0; j < 4; ++j)
#pragma unroll
        for (int q = 0; q < 4; ++q) { const float h0 = v0[j][q], h1 = v1[j][q]; const LAS float* p = tabw + ((j * 4 + q) * 64 + lane) * W16_PITCH;
#pragma unroll
            for (int k = 0; k < 4; ++k) { const f32x4 w = *(const LAS f32x4*)(p + 4 * k);
                a[4 * k] += h0 * w.x; a[4 * k + 1] += h0 * w.y; a[4 * k + 2] += h0 * w.z; a[4 * k + 3] += h0 * w.w;
                b[4 * k] += h1 * w.x; b[4 * k + 1] += h1 * w.y; b[4 * k + 2] += h1 * w.z; b[4 * k + 3] += h1 * w.w; } }
    float t8[8];
#pragma unroll
    for (int i = 0; i < 8; ++i) { auto rr = __builtin_amdgcn_permlane32_swap(__float_as_uint(a[i]), __float_as_uint(a[i + 8]), false, false); t8[i] = __uint_as_float(rr[0]) + __uint_as_float(rr[1]); }
#pragma unroll
    for (int i = 0; i < 4; ++i) { auto rr = __builtin_amdgcn_permlane16_swap(__float_as_uint(t8[i]), __float_as_uint(t8[i + 4]), false, false); c0[i] = row_sum16(__uint_as_float(rr[0]) + __uint_as_float(rr[1])); }
#pragma unroll
    for (int i = 0; i < 8; ++i) { auto rr = __builtin_amdgcn_permlane32_swap(__float_as_uint(b[i]), __float_as_uint(b[i + 8]), false, false); t8[i] = __uint_as_float(rr[0]) + __uint_as_float(rr[1]); }
#pragma unroll
    for (int i = 0; i < 4; ++i) { auto rr = __builtin_amdgcn_permlane16_swap(__float_as_uint(t8[i]), __float_as_uint(t8[i + 4]), false, false); c1[i] = row_sum16(__uint_as_float(rr[0]) + __uint_as_float(rr[1])); }
}
__device__ __forceinline__ void router_pass(KA args, Frame& F, int l, const bf16* X1, bf16* XN, int* eidx, float* ew, int* cntw, int* loc, unsigned* pcnt, unsigned pneed) {
    const float* mod = (const float*)(F.ws + WS_MOD) + (size_t)l * 4 * 6144;
    const float* rb = INP(21); const float* g = INP(5) + l * D;
    LAS float* tabw = (LAS float*)F.lds;
    LAS float* lg = (LAS float*)(F.lds + 1024 * W16_PITCH * 4);
    __syncthreads();
    stage_w16(tabw, INP(20), F.tid);
    for (int chunk = F.vcu; chunk < T / 64; chunk += F.G) {
        if (F.wave == 0) { unsigned sp = 0;
            while ((unsigned)__builtin_amdgcn_readfirstlane(__hip_atomic_load(pcnt + 64 * (chunk >> 2), __ATOMIC_RELAXED, __HIP_MEMORY_SCOPE_AGENT)) < pneed) { __builtin_amdgcn_s_sleep(2); if (++sp > (1u << 20)) break; }
            __builtin_amdgcn_fence(__ATOMIC_ACQUIRE, "agent"); asm volatile("s_waitcnt vmcnt(0)" ::: "memory"); }
        __syncthreads();
        const int tb = chunk * 64 + F.wave * 8, b = tb / S;
        const float* sc = mod + b * 6144 + 4096; const float* sh = mod + b * 6144 + 3072;
        f32x4 n0[4], n1[4];
        load_row_bf16(X1 + (size_t)tb * D, F.lane, n0); load_row_bf16(X1 + (size_t)(tb + 1) * D, F.lane, n1);
        for (int i = 0; i < 4; ++i) { const int t = tb + 2 * i;
            f32x4 v0[4], v1[4];
#pragma unroll
            for (int j = 0; j < 4; ++j) { v0[j] = n0[j]; v1[j] = n1[j]; }
            if (i < 3) { load_row_bf16(X1 + (size_t)(t + 2) * D, F.lane, n0); load_row_bf16(X1 + (size_t)(t + 3) * D, F.lane, n1); }
            norm_row(v0, F.lane, g, sc, sh); norm_row(v1, F.lane, g, sc, sh);
            store_row_bf16(v0, F.lane, XN + (size_t)t * D); store_row_bf16(v1, F.lane, XN + (size_t)(t + 1) * D);
            float c0[4], c1[4];
            dot16x2(v0, v1, tabw, F.lane, c0, c1);
            if ((F.lane & 15) == 0) { const int r = F.lane >> 4, tl = F.wave * 8 + 2 * i;
                *(LAS f32x4*)(lg + tl * W16_PITCH + 4 * r) = (f32x4){c0[0], c0[1], c0[2], c0[3]}; *(LAS f32x4*)(lg + (tl + 1) * W16_PITCH + 4 * r) = (f32x4){c1[0], c1[1], c1[2], c1[3]}; }
        }
        __syncthreads();
        if (F.wave == 0) {
            const int t = chunk * 64 + F.lane;
            float acc[16], rbv[16];
#pragma unroll
            for (int k = 0; k < 4; ++k) { const f32x4 w = *(const LAS f32x4*)(lg + F.lane * W16_PITCH + 4 * k); acc[4 * k] = w.x; acc[4 * k + 1] = w.y; acc[4 * k + 2] = w.z; acc[4 * k + 3] = w.w; }
#pragma unroll
            for (int e = 0; e < 16; ++e) rbv[e] = rb[e];
            float m = acc[0];
#pragma unroll
            for (int e = 1; e < 16; ++e) m = fmaxf(m, acc[e]);
            float sc16[16], ssum = 0.f;
#pragma unroll
            for (int e = 0; e < 16; ++e) { sc16[e] = expf(acc[e] - m); ssum += sc16[e]; }
            float sel[16];
#pragma unroll
            for (int e = 0; e < 16; ++e) { sc16[e] = sc16[e] / ssum; sel[e] = sc16[e] + rbv[e]; }
            int gi = 0; float gbest = -1e30f; int l0s[4], l1s[4];
#pragma unroll
            for (int gg = 0; gg < 4; ++gg) {
                int i0 = 0; float v0 = sel[4 * gg];
#pragma unroll
                for (int k = 1; k < 4; ++k) if (sel[4 * gg + k] > v0) { v0 = sel[4 * gg + k]; i0 = k; }
                int i1 = -1; float v1 = -1e30f;
#pragma unroll
                for (int k = 0; k < 4; ++k) if (k != i0 && sel[4 * gg + k] > v1) { v1 = sel[4 * gg + k]; i1 = k; }
                l0s[gg] = i0; l1s[gg] = i1;
                const float gs = v0 + v1; if (gs > gbest) { gbest = gs; gi = gg; }
            }
            int e0 = 0, e1 = 0;
#pragma unroll
            for (int gg = 0; gg < 4; ++gg) if (gg == gi) { e0 = 4 * gg + l0s[gg]; e1 = 4 * gg + l1s[gg]; }
            float w0 = 0.f, w1 = 0.f;
#pragma unroll
            for (int e = 0; e < 16; ++e) { if (e == e0) w0 = sc16[e]; if (e == e1) w1 = sc16[e]; }
            const float wsum = w0 + w1;
            *(int2*)(eidx + 2 * t) = make_int2(e0, e1); *(float2*)(ew + 2 * t) = make_float2(w0 / wsum, w1 / wsum);
            const unsigned long long below = (1ull << F.lane) - 1ull;
            for (int e = 0; e < 16; ++e) { const unsigned long long m0 = __ballot(e0 == e), m1 = __ballot(e1 == e); const int cc = __popcll(m0);
                if (e0 == e) loc[(chunk * 16 + e) * 64 + __popcll(m0 & below)] = 2 * t;
                if (e1 == e) loc[(chunk * 16 + e) * 64 + cc + __popcll(m1 & below)] = 2 * t + 1;
                if (F.lane == 0) cntw[chunk * 16 + e] = cc + __popcll(m1); }
        }
    }
}
__device__ __forceinline__ void chunk_publish(Frame& F, unsigned* cnt, int panel) {
    asm volatile("s_waitcnt vmcnt(0)" ::: "memory");
    __syncthreads();
    if (F.tid == 0) { __builtin_amdgcn_fence(__ATOMIC_RELEASE, "agent"); asm volatile("s_waitcnt vmcnt(0)" ::: "memory");
        __hip_atomic_fetch_add(cnt + 64 * panel, 1u, __ATOMIC_RELAXED, __HIP_MEMORY_SCOPE_AGENT); }
}
__device__ __forceinline__ void xn0_pass(KA args, Frame& F, bf16* XN, unsigned* cnt) {
    const float* mod = (const float*)(F.ws + WS_MOD);
    for (int chunk = F.vcu; chunk < T / 64; chunk += F.G) {
        for (int i = 0; i < 8; ++i) { const int t = chunk * 64 + F.wave * 8 + i, b = t / S; f32x4 v[4]; const f32x4* xr = (const f32x4*)(INP(0) + (size_t)t * D) + F.lane;
#pragma unroll
            for (int j = 0; j < 4; ++j) v[j] = xr[64 * j];
            norm_row(v, F.lane, INP(4), mod + b * 6144 + 1024, mod + b * 6144);
            store_row_bf16(v, F.lane, XN + (size_t)t * D); }
        chunk_publish(F, cnt, chunk >> 2);
    }
}
__device__ __forceinline__ void combine_pass(KA args, Frame& F, int l, bf16* X1, const bf16* YS, bf16* XN, float* ALOW, float* out, unsigned* cnt) {
    const float* mod = (const float*)(F.ws + WS_MOD) + (size_t)l * 4 * 6144;
    const float* modn = (const float*)(F.ws + WS_MOD) + (size_t)(l + 1) * 4 * 6144;
    LAS float* tabw = (LAS float*)F.lds;
    __syncthreads();
    if (l == 0) stage_w16(tabw, (const float*)(F.ws + WS_ALOWW), F.tid);
    __syncthreads();
    for (int chunk = F.vcu; chunk < T / 64; chunk += F.G) {
      for (int i = 0; i < 8; ++i) { const int t = chunk * 64 + F.wave * 8 + i, b = t / S;
        f32x4 v[4], xr[4]; load_row_bf16(X1 + (size_t)t * D, F.lane, xr);
        const v2u* y0 = (const v2u*)(YS + (size_t)(2 * t) * D) + F.lane; const v2u* y1 = (const v2u*)(YS + (size_t)(2 * t + 1) * D) + F.lane;
#pragma unroll
        for (int j = 0; j < 4; ++j) { const f32x4 g2 = *(const f32x4*)(mod + b * 6144 + 5120 + 4 * F.lane + 256 * j); const v2u a = y0[64 * j], c = y1[64 * j];
            const f32x4 ys = {bflo(a.x) + bflo(c.x), bfhi(a.x) + bfhi(c.x), bflo(a.y) + bflo(c.y), bfhi(a.y) + bfhi(c.y)};
            v[j] = xr[j] + g2 * ys; }
        if (l == 0) {
            store_row_bf16(v, F.lane, X1 + (size_t)t * D);
            norm_row(v, F.lane, INP(4) + D, modn + b * 6144 + 1024, modn + b * 6144);
            store_row_bf16(v, F.lane, XN + (size_t)t * D);
            float acc[16];
            dot16(v, tabw, F.lane, acc);
            if (F.lane == 0) {
#pragma unroll
                for (int k = 0; k < 4; ++k) *(f32x4*)(ALOW + (size_t)t * 16 + 4 * k) = (f32x4){acc[4 * k], acc[4 * k + 1], acc[4 * k + 2], acc[4 * k + 3]}; }
        } else {
            norm_row(v, F.lane, INP(25), nullptr, nullptr);
            f32x4* o = (f32x4*)(out + (size_t)t * D) + F.lane;
#pragma unroll
            for (int j = 0; j < 4; ++j) __builtin_nontemporal_store(v[j], o + 64 * j);
        }
      }
      if (cnt) chunk_publish(F, cnt, chunk >> 2);
    }
}

__global__ void __launch_bounds__(512, 2) mega_fwd(Args args_) {
    KA args = kargs();
    extern __shared__ __attribute__((aligned(16))) unsigned char lds[];
    Frame F;
    F.lds = (LAS unsigned char*)lds; F.ws = args->ws;
    F.wave = __builtin_amdgcn_readfirstlane((int)threadIdx.x >> 6); F.lane = lane_id(); F.tid = F.wave * 64 + F.lane;
    { int g_ = (int)gridDim.x, b_ = (int)blockIdx.x; asm volatile("" : "+s"(g_), "+s"(b_)); F.G = g_; F.bx = b_; F.vcu = (g_ % 8 == 0) ? (b_ % 8) * (g_ / 8) + b_ / 8 : b_; }
    unsigned char* ws = args->ws;
    for (int u = F.tid; u < (LDS_BYTES - LDSCTL_OFF) / 4; u += 512) ((LAS unsigned*)(F.lds + LDSCTL_OFF))[u] = 0u;
    __syncthreads();
    (void)xcd_barrier_post((unsigned*)(ws + WS_CTL) + CW_BAR, (volatile LAS unsigned*)(F.lds + L_MISC) + 8, F.wave);
#define MKBAR() XcdBarrier{(unsigned*)(ws + WS_CTL) + CW_BAR, xb_xcc_id(), (volatile LAS unsigned*)(F.lds + L_MISC) + 8, F.wave}
#ifndef PHMASK
#define PHMASK 0xFFFFFFFFu
#endif
#ifndef PROBE_MASK
#define PROBE_MASK 0u
#endif
#define NREP(k) ((((PROBE_MASK) >> (k)) & 1u) ? 4 : 1)
#define IN(k) ((((PHMASK) >> ((k) >= 9 ? (k) - 7 : (k))) & 1u) != 0u)
#define MIDBAR() do { xcd_barrier(MKBAR()); F.lane = lane_id(); F.tid = F.wave * 64 + F.lane; args = kargs(); ws = args->ws; F.ws = ws; { int g_ = (int)gridDim.x, b_ = (int)blockIdx.x; asm volatile("" : "+s"(g_), "+s"(b_)); F.G = g_; F.bx = b_; F.vcu = (g_ % 8 == 0) ? (b_ % 8) * (g_ / 8) + b_ / 8 : b_; } } while (0)
#define SEAM(k) do { if (IN(k) && IN((k) + 1)) xcd_barrier(MKBAR()); F.lane = lane_id(); F.tid = F.wave * 64 + F.lane; args = kargs(); ws = args->ws; F.ws = ws; { int g_ = (int)gridDim.x, b_ = (int)blockIdx.x; asm volatile("" : "+s"(g_), "+s"(b_)); F.G = g_; F.bx = b_; F.vcu = (g_ % 8 == 0) ? (b_ % 8) * (g_ / 8) + b_ / 8 : b_; } } while (0)

#define mod ((float*)(ws + WS_MOD))
#define XN ((bf16*)(ws + WS_XN))
#define QKVY ((bf16*)(ws + WS_QKVY))
#define YS ((bf16*)(ws + WS_QKVY))
#define CAT ((bf16*)(ws + WS_CAT))
#define ACT ((bf16*)(ws + WS_CAT))
#define X1 ((bf16*)(ws + WS_X1))
#define ALOW ((float*)(ws + WS_ALOW))
#define cntw ((int*)(ws + WS_CNTW))
#define eidx ((int*)(ws + WS_EIDX))
#define ew ((float*)(ws + WS_EW))
#define loc ((int*)(ws + WS_LOC))
    LAS int* tab = (LAS int*)(F.lds + L_NE); LAS int* rowtab = (LAS int*)(F.lds + L_ROWTAB);

    if (IN(0)) for (int rep_ = 0; rep_ < NREP(0); ++rep_) { if (rep_) MIDBAR(); p0_prologue(args, F); } SEAM(0);
#pragma unroll
    for (int l = 0; l < 2; ++l) {
        const int pb = 2 + 7 * l;
        const float* modl = mod + (size_t)l * 4 * 6144;
        if (IN(pb)) for (int rep_ = 0; rep_ < NREP(pb); ++rep_) { if (rep_) MIDBAR();
            unsigned* acnt = (unsigned*)(ws + WS_CTL) + CW_APANEL + l * 8192;
            if (l == 0) xn0_pass(args, F, XN, acnt); else combine_pass(args, F, 0, X1, YS, XN, ALOW, args->out, acnt);
            pg8::DenseSched Sd; Sd.acnt = acnt; Sd.aneed = 4u * (unsigned)(rep_ + 1);
            if (l == 0) { Sd.init(XN, (const bf16*)(ws + WS_WIN0), T, NIN0, D, F.G, F.bx); EpiIn0 E{QKVY}; pg8::gemm_phase<EpiIn0, pg8::DenseSched, true>(F.lds, D, Sd, E, F.wave);
                int nwg_ = (T / 256) * (NIN0 / 256), bx_ = F.bx; asm volatile("" : "+s"(nwg_), "+s"(bx_));
                const int nidle = F.G - (nwg_ - 2 * F.G), cid = bx_ - (nwg_ - 2 * F.G);
                if (nwg_ > 2 * F.G && nwg_ <= 3 * F.G) { if (cid >= 0) { __syncthreads(); p0_items(args, F, P0_NITEMS - P0_NFILL, P0_NITEMS, cid * 8 + F.wave, nidle * 8); } }
                else { __syncthreads(); p0_items(args, F, P0_NITEMS - P0_NFILL, P0_NITEMS, F.vcu * 8 + F.wave, F.G * 8); } }
            else { Sd.init(XN, (const bf16*)(ws + WS_WIN1), T, NIN1, D, F.G, F.bx); EpiIn1 E{QKVY}; pg8::gemm_phase<EpiIn1, pg8::DenseSched, true>(F.lds, D, Sd, E, F.wave); }
        } SEAM(pb);
        if (IN(pb + 1)) for (int rep_ = 0; rep_ < NREP(pb + 1); ++rep_) { if (rep_) MIDBAR();
            if (l == 0) {
#if defined(PROBE_CONV)
                for (int r3 = 0; r3 < 3; ++r3) { conv_phase(args, F, QKVY, CAT); __syncthreads(); }
#endif
#if defined(PROBE_SBA)
                for (int r3 = 0; r3 < 3; ++r3) { sba::phase(QKVY, CAT, (char*)lds, F.vcu, F.G, F.wave, F.lane); __syncthreads(); }
#endif
                conv_phase(args, F, QKVY, CAT); __syncthreads(); sba::phase(QKVY, CAT, (char*)lds, F.vcu, F.G, F.wave, F.lane); }
            else {
                float* KVT = (float*)(ws + WS_XN); bf16* SINT = (bf16*)(ws + WS_WGU); bf16* QIN = SINT + (size_t)gla::NCH * 8192; bf16* KIN = QIN + (size_t)T * 256; float* DEC = (float*)(ws + WS_WD);
#ifndef PROBE_M1SUB
#define PROBE_M1SUB 0
#endif
                for (int r3 = 0; r3 < (PROBE_M1SUB == 1 ? 4 : 1); ++r3) { pool_phase(args, F, QKVY, (const bf16*)(ws + WS_WPT), CAT); __syncthreads(); }
                for (int r3 = 0; r3 < (PROBE_M1SUB == 2 ? 4 : 1); ++r3) { gla::pass_a_w(args, QKVY, ALOW, QIN, KIN, KVT, DEC, (char*)lds, F.vcu, F.G, F.wave, F.lane); __syncthreads(); }
                MIDBAR();
                for (int r3 = 0; r3 < (PROBE_M1SUB == 3 ? 4 : 1); ++r3) { gla::pass_b(KVT, DEC, SINT, F.vcu, F.G, F.tid); __syncthreads(); }
                MIDBAR();
                for (int r3 = 0; r3 < (PROBE_M1SUB == 4 ? 4 : 1); ++r3) { gla::pass_c_w(args, QKVY, QIN, KIN, SINT, CAT, (char*)lds, F.vcu, F.G, F.wave, F.lane); __syncthreads(); } }
        } SEAM(pb + 1);
        if (IN(pb + 2)) for (int rep_ = 0; rep_ < NREP(pb + 2); ++rep_) { if (rep_) MIDBAR();
            unsigned* pcnt = (unsigned*)(ws + WS_CTL) + CW_PANEL + l * 8192;
            pg8::DenseSched Sd; Sd.init(CAT, (const bf16*)(ws + (l == 0 ? WS_WOUT0 : WS_WOUT1)), T, D, D, F.G, F.bx); Sd.pcnt = pcnt;
            if (l == 0) { EpiOut<true> E{INP(0), X1, modl + 2048}; pg8::gemm_phase<EpiOut<true>, pg8::DenseSched, false>(F.lds, D, Sd, E, F.wave); }
            else { EpiOut<false> E{X1, X1, modl + 2048}; pg8::gemm_phase<EpiOut<false>, pg8::DenseSched, false>(F.lds, D, Sd, E, F.wave); }
            router_pass(args, F, l, X1, XN, eidx, ew, cntw, loc, pcnt, 32u * (unsigned)(rep_ + 1));
        } SEAM(pb + 2);
        if (IN(pb + 4)) for (int rep_ = 0; rep_ < NREP(pb + 4); ++rep_) { if (rep_) MIDBAR();
            moe_plan(F, cntw, loc, F.vcu);
            unsigned* mcnt = (unsigned*)(ws + WS_CTL) + CW_MOECNT + l * 16384;
            { MoeSched<1> Sm{XN, (const bf16*)(ws + WS_WGU) + (size_t)l * NE * 1024 * D, D, (size_t)1024 * D * 2, tab, rowtab, mcnt, F.G, F.vcu};
              EpiM1 E{ACT, ew, rowtab};
              pg8::gemm_phase<EpiM1, MoeSched<1>, true>(F.lds, D, Sm, E, F.wave); }
            { MoeSched<2> Sm{ACT, (const bf16*)(ws + WS_WD) + (size_t)l * NE * D * DE, DE, (size_t)D * DE * 2, tab, rowtab, mcnt, F.G, F.vcu};
              EpiM2 E{YS, rowtab};
              pg8::gemm_phase<EpiM2, MoeSched<2>, true>(F.lds, DE, Sm, E, F.wave); }
        } SEAM(pb + 4);
        if (l == 1) { if (IN(pb + 6)) { combine_pass(args, F, 1, X1, YS, XN, ALOW, args->out, nullptr); } }
    }
#undef IN
#undef SEAM
}

extern "C" void kernel_launch(void* const* d_in, const int* in_sizes, int n_in, void* d_out, int out_size, void* d_ws, size_t ws_size, hipStream_t stream) {
    static int grid = 0;
    if (grid == 0) {
        if (n_in != 26 || out_size != T * D || ws_size < WS_END) { fprintf(stderr, "kernel_launch: unexpected shapes / workspace (%zu < %zu)\n", ws_size, (size_t)WS_END); grid = -1; return; }
        int dev = 0, cus = 0;
        if (hipGetDevice(&dev) != hipSuccess || hipDeviceGetAttribute(&cus, hipDeviceAttributeMultiprocessorCount, dev) != hipSuccess) { grid = -1; return; }
        if (hipFuncSetAttribute((const void*)mega_fwd, hipFuncAttributeMaxDynamicSharedMemorySize, LDS_BYTES) != hipSuccess) { fprintf(stderr, "kernel_launch: hipFuncSetAttribute failed\n"); grid = -1; return; }
        grid = cus;
    }
    if (grid < 0) return;
    (void)hipMemsetAsync((char*)d_ws + WS_CTL, 0, CTL_ZERO_BYTES, stream);
    Args a{};
    for (int i = 0; i < 26; ++i) a.in[i] = (const float*)d_in[i];
    a.out = (float*)d_out; a.ws = (unsigned char*)d_ws;
    hipLaunchKernelGGL(mega_fwd, dim3(grid), dim3(512), LDS_BYTES, stream, a);
}
```

```cpp
#include <hip/hip_runtime.h>
#include <cstdint>
#include <cstdio>

constexpr int D = 1024, NB = 4, S = 4096, T = NB * S, NE = 16, DE = 512;
constexpr int NIN0 = 2560, NIN1 = 2048, QW = 2048;
constexpr float QSCALE0 = 0.125f * 1.4426950408889634f;

#define GAS __attribute__((address_space(1)))
#define LAS __attribute__((address_space(3)))
typedef unsigned short bf16;
typedef unsigned v4u __attribute__((ext_vector_type(4)));
typedef unsigned v2u __attribute__((ext_vector_type(2)));
typedef float f32x4 __attribute__((ext_vector_type(4)));
typedef short bf16x8 __attribute__((ext_vector_type(8)));
typedef GAS unsigned gu32;
#define RLX_AGENT __ATOMIC_RELAXED, __HIP_MEMORY_SCOPE_AGENT
#define LDS_WAIT() asm volatile("s_waitcnt lgkmcnt(0)" ::: "memory")
#define VM_WAIT() asm volatile("s_waitcnt vmcnt(0)" ::: "memory")

__device__ __forceinline__ unsigned f2bf(float f) { unsigned u = __builtin_bit_cast(unsigned, f); return (u + 0x7fffu + ((u >> 16) & 1u)) >> 16; }
__device__ __forceinline__ unsigned pk2(float lo, float hi) { unsigned r; asm volatile("v_cvt_pk_bf16_f32 %0, %1, %2" : "=v"(r) : "v"(lo), "v"(hi)); return r; }
__device__ __forceinline__ float bflo(unsigned u) { return __uint_as_float(u << 16); }
__device__ __forceinline__ float bfhi(unsigned u) { return __uint_as_float(u & 0xffff0000u); }
__device__ __forceinline__ float bf2f(bf16 h) { return __uint_as_float((unsigned)h << 16); }
__device__ __forceinline__ int lane_id() { int l; asm volatile("v_mbcnt_lo_u32_b32 %0, -1, 0\n\tv_mbcnt_hi_u32_b32 %0, -1, %0" : "=v"(l)); return l; }
template <int CTRL> __device__ __forceinline__ float dpp_add(float v) { return v + __int_as_float(__builtin_amdgcn_update_dpp(0, __float_as_int(v), CTRL, 0xF, 0xF, false)); }
__device__ __forceinline__ float row_sum16(float v) {
    v = dpp_add<0xB1>(v); v = dpp_add<0x4E>(v); v = dpp_add<0x141>(v); v = dpp_add<0x140>(v); return v; }
__device__ __forceinline__ float rdlane(float v, int l) { return __int_as_float(__builtin_amdgcn_readlane(__float_as_int(v), l)); }
__device__ __forceinline__ float wave_sum(float v) { v = row_sum16(v); return (rdlane(v, 0) + rdlane(v, 16)) + (rdlane(v, 32) + rdlane(v, 48)); }
__device__ __forceinline__ float xor16_add(float v) { auto rr = __builtin_amdgcn_permlane16_swap(__float_as_uint(v), __float_as_uint(v), false, false); return __uint_as_float(rr[0]) + __uint_as_float(rr[1]); }
__device__ __forceinline__ int wave_sum_i(int v) { return (int)wave_sum((float)v); }
__device__ __forceinline__ int wave_scan_i(int v) { const int l = lane_id();
#pragma unroll
    for (int d = 1; d < 64; d <<= 1) { const int n = __builtin_amdgcn_ds_bpermute((l - d) << 2, v); if (l >= d) v += n; }
    return v; }
__device__ __forceinline__ float sigmoidf_(float x) { return __builtin_amdgcn_rcpf(1.f + __builtin_amdgcn_exp2f(-1.4426950408889634f * x)); }
__device__ __forceinline__ float siluf_(float x) { return x * __builtin_amdgcn_rcpf(1.f + __builtin_amdgcn_exp2f(-1.4426950408889634f * x)); }
__device__ __forceinline__ float softplusf_(float z) { return fmaxf(z, 0.f) + 0.6931471805599453f * __builtin_amdgcn_logf(1.f + __builtin_amdgcn_exp2f(-1.4426950408889634f * fabsf(z))); }

namespace pg8 {
#define PG8_LAS __attribute__((address_space(3)))
typedef unsigned short bf16_t;
typedef short bf16x8 __attribute__((ext_vector_type(8)));
typedef float f32x4 __attribute__((ext_vector_type(4)));
typedef unsigned u32x4 __attribute__((ext_vector_type(4)));
constexpr int BM = 256, BK = 64, HALF = 128, HTB = HALF * BK * 2, STAGE_BYTES = 8 * HTB, NXCD = 8, WGM = 8;

__host__ __device__ __forceinline__ int lds_byte(int r, int c) { const int st = (r >> 4) * 2 + (c >> 5), rr = r & 15, cc = c & 31, ob = rr * 64 + cc * 2; return st * 1024 + (ob ^ (((ob >> 9) & 1) << 5)); }
__host__ __device__ __forceinline__ void stage_rc(int b, int& R, int& C) { const int st = b / 1024, sb = b % 1024, swz = sb ^ (((sb >> 9) & 1) << 5); R = (st >> 1) * 16 + swz / 64; C = (st & 1) * 32 + (swz % 64) / 2; }
__host__ __device__ __forceinline__ int perm32(int rho) { const int n = rho >> 4, i = rho & 15; return 8 * (i >> 2) + 4 * n + (i & 3); }

struct Unit { int pm, pn, e, li, nr, r0; };

struct DenseSched {
    const bf16_t* A; const bf16_t* Bt; int K; int nM, nN, nwg, G, c; unsigned* pcnt = nullptr; unsigned* acnt = nullptr; unsigned aneed = 0;
    __device__ void init(const bf16_t* A_, const bf16_t* Bt_, int M, int N, int K_, int G_, int c_) { A = A_; Bt = Bt_; K = K_; nM = M / BM; nN = N / BM; nwg = nM * nN; G = G_; c = c_; }
    __device__ __forceinline__ bool next(int i, Unit& u) const {
        const long L = (long)i * G + c; if (L >= nwg) return false;
        int wgid = (int)L; { const int q = nwg / NXCD, r = nwg % NXCD, xcd = wgid % NXCD, off = wgid / NXCD; wgid = (xcd < r ? xcd * (q + 1) : r * (q + 1) + (xcd - r) * q) + off; }
        const int nig = WGM * nN, gid = wgid / nig, fm = gid * WGM, gsz = (nM - fm) < WGM ? (nM - fm) : WGM;
        u.pm = fm + ((wgid % nig) % gsz); u.pn = (wgid % nig) / gsz; u.e = 0; u.li = i; u.nr = 256; u.r0 = u.pm * BM; return true;
    }
    __device__ __forceinline__ const char* a_base(const Unit& u) const { return (const char*)A + (size_t)u.pm * BM * K * 2; }
    __device__ __forceinline__ const char* b_base(const Unit& u) const { return (const char*)Bt + (size_t)u.pn * BM * K * 2; }
    static constexpr bool GATHER = false;
    __device__ __forceinline__ void a_ready(const Unit& u, int wid, int lane) const {
        if (acnt) {
            if (wid == 0) { unsigned sp = 0;
                while ((unsigned)__builtin_amdgcn_readfirstlane(__hip_atomic_load(acnt + 64 * u.pm, __ATOMIC_RELAXED, __HIP_MEMORY_SCOPE_AGENT)) < aneed) { __builtin_amdgcn_s_sleep(2); if (++sp > (1u << 20)) break; }
                __builtin_amdgcn_fence(__ATOMIC_ACQUIRE, "agent");
                asm volatile("s_waitcnt vmcnt(0)" ::: "memory"); }
            asm volatile("" ::: "memory"); __builtin_amdgcn_s_barrier(); asm volatile("" ::: "memory");
        }
    }
    __device__ __forceinline__ void publish(int pm, int lane) const { if (pcnt && lane == 0) __hip_atomic_fetch_add(pcnt + 64 * pm, 1u, __ATOMIC_RELAXED, __HIP_MEMORY_SCOPE_AGENT); }
    __device__ __forceinline__ void a_off(const Unit&, int tid, unsigned (&v)[4]) const {
#pragma unroll
        for (int i = 0; i < 2; ++i) { int R, C; stage_rc(tid * 16 + i * 8192, R, C);
#pragma unroll
            for (int h = 0; h < 2; ++h) v[2 * h + i] = (unsigned)((h * HALF + R) * K + C) * 2u; }
    }
};

template <class Epi, class Sched, bool ALIGN_EPI>
__device__ __forceinline__ void gemm_phase(PG8_LAS unsigned char* lds, const int K, const Sched& S, const Epi& E, const int wave_id) {
    int wid_ = wave_id; asm volatile("" : "+s"(wid_));
    const int wid = wid_, lane = lane_id(), tid = wid * 64 + lane,
        wr = wid >> 2, wc = wid & 3, fr = lane & 15, fq = lane >> 4;
    const int nt = K / BK;
    unsigned voffB[2];
#pragma unroll
    for (int i = 0; i < 2; ++i) { int R, C; stage_rc(tid * 16 + i * 8192, R, C); const int Rb = Epi::PERM ? ((R & ~31) + perm32(R & 31)) : R; voffB[i] = (unsigned)(Rb * K + C) * 2u; }
    const size_t kstep = (size_t)(BK * 2);
    const size_t hstep = (size_t)HALF * K * 2;
    const unsigned ldsw = (unsigned)wid * 1024u;
    const int aoff = lds_byte(wr * 64 + fr, fq * 8), boff = lds_byte(wc * 32 + fr, fq * 8);
#define PG8_SA(b, h) (((b) * 2 + (h)) * HTB)
#define PG8_SB(b, h) ((4 + (b) * 2 + (h)) * HTB)
#define PG8_STAGE2(bufoff, gbase, o0, o1) do { \
        __builtin_amdgcn_global_load_lds((const unsigned*)((const char*)(gbase) + (o0)), (PG8_LAS unsigned*)(lds + (bufoff) + ldsw), 16, 0, 0); \
        __builtin_amdgcn_global_load_lds((const unsigned*)((const char*)(gbase) + (o1)), (PG8_LAS unsigned*)(lds + (bufoff) + ldsw + 8192), 16, 0, 0); } while (0)
#define PG8_STAGEB(bufoff, gbase) PG8_STAGE2(bufoff, gbase, voffB[0], voffB[1])
#define PG8_LDA(dst, b, h) do { _Pragma("unroll") for (int m = 0; m < 4; ++m) _Pragma("unroll") for (int k = 0; k < 2; ++k) dst[m][k] = *(const PG8_LAS bf16x8*)(lds + PG8_SA(b, h) + aoff + m * 2048 + k * 1024); } while (0)
#define PG8_LDB(dst, b, h) do { _Pragma("unroll") for (int n = 0; n < 2; ++n) _Pragma("unroll") for (int k = 0; k < 2; ++k) dst[n][k] = *(const PG8_LAS bf16x8*)(lds + PG8_SB(b, h) + boff + n * 2048 + k * 1024); } while (0)
#define PG8_MMA(ai, bj, At, Bt) do { __builtin_amdgcn_s_setprio(1); _Pragma("unroll") for (int m = 0; m < 4; ++m) _Pragma("unroll") for (int n = 0; n < 2; ++n) _Pragma("unroll") for (int k = 0; k < 2; ++k) \
        acc[ai][bj][m][n] = __builtin_amdgcn_mfma_f32_16x16x32_bf16(Bt[n][k], At[m][k], acc[ai][bj][m][n], 0, 0, 0); __builtin_amdgcn_s_setprio(0); } while (0)
#define PG8_WAIT_V(n) asm volatile("s_waitcnt vmcnt(" #n ")" ::: "memory")
#define PG8_WAIT_V8_UNLESS(p) do { int pp_ = __builtin_amdgcn_readfirstlane(p); asm volatile("s_cmp_lt_i32 %0, 0\n\ts_cbranch_scc0 .Lpg8skip_%=\n\ts_waitcnt vmcnt(8)\n.Lpg8skip_%=:" : "+s"(pp_) :: "memory", "scc"); } while (0)
#define PG8_WAIT_L(n) asm volatile("s_waitcnt lgkmcnt(" #n ")" ::: "memory")
#define PG8_BAR __builtin_amdgcn_s_barrier()
#define PG8_SCHED __builtin_amdgcn_sched_barrier(0)
    Unit cur, nxt; int ui = 0;
    if (!S.next(0, cur)) return;
    f32x4 acc[2][2][4][2];
#pragma unroll
    for (int a = 0; a < 2; ++a)
#pragma unroll
        for (int b = 0; b < 2; ++b)
#pragma unroll
            for (int m = 0; m < 4; ++m)
#pragma unroll
                for (int n = 0; n < 2; ++n) acc[a][b][m][n] = (f32x4){0.f, 0.f, 0.f, 0.f};
    bf16x8 At[4][2], B0[2][2], B1[2][2];
    unsigned vc[4];
    S.a_ready(cur, wid, lane);
    S.a_off(cur, tid, vc);
    const char* cA = S.a_base(cur); const char* cB = S.b_base(cur);
    E.prefetch(cur, tid, (PG8_LAS unsigned*)(lds + STAGE_BYTES + 1024 + wid * 256));
    PG8_STAGEB(PG8_SB(0, 0), cB); PG8_STAGEB(PG8_SB(0, 1), cB + hstep); PG8_STAGE2(PG8_SA(0, 0), cA, vc[0], vc[1]); PG8_STAGE2(PG8_SA(0, 1), cA, vc[2], vc[3]);
    if (wr == 1) PG8_BAR;
    PG8_WAIT_V(2); PG8_BAR;
    PG8_STAGEB(PG8_SB(1, 0), cB + kstep); PG8_STAGE2(PG8_SA(1, 0), cA + kstep, vc[0], vc[1]); PG8_STAGEB(PG8_SB(1, 1), cB + hstep + kstep);
    PG8_WAIT_V(6); PG8_BAR;
    int pend = -1;
    for (;;) {
        const bool has_next = S.next(ui + 1, nxt);
        const char* nA = cA; const char* nB = cB;
        if (has_next) { nA = S.a_base(nxt); nB = S.b_base(nxt); }
        for (int t = 0; t < nt; t += 2) {
            const bool last = (t == nt - 2);
            if (last && has_next) S.a_ready(nxt, wid, lane);
            const char* a1 = cA + (size_t)(t + 1) * kstep;
            const char* a2 = last ? nA : cA + (size_t)(t + 2) * kstep; const char* b2 = last ? nB : cB + (size_t)(t + 2) * kstep;
            const char* a3 = a2 + kstep; const char* b3 = b2 + kstep;
            PG8_LDB(B0, 0, 0); PG8_LDB(B1, 0, 1); PG8_SCHED; PG8_LDA(At, 0, 0); PG8_STAGE2(PG8_SA(1, 1), a1, vc[2], vc[3]);
            if constexpr (Sched::GATHER) { if (last && has_next) S.a_off(nxt, tid, vc); }
            PG8_WAIT_V8_UNLESS(pend);
            PG8_WAIT_L(0); PG8_BAR; PG8_MMA(0, 0, At, B0); PG8_MMA(0, 1, At, B1); PG8_BAR; PG8_SCHED;
            PG8_LDA(At, 0, 1); PG8_STAGEB(PG8_SB(0, 0), b2); PG8_STAGEB(PG8_SB(0, 1), b2 + hstep); PG8_STAGE2(PG8_SA(0, 0), a2, vc[0], vc[1]);
            PG8_WAIT_V8_UNLESS(pend);
            PG8_WAIT_L(0); PG8_BAR; PG8_MMA(1, 0, At, B0); PG8_MMA(1, 1, At, B1); PG8_BAR; PG8_SCHED;
            PG8_LDB(B0, 1, 0); PG8_LDB(B1, 1, 1); PG8_SCHED; PG8_LDA(At, 1, 0); PG8_STAGE2(PG8_SA(0, 1), a2, vc[2], vc[3]);
            PG8_WAIT_V8_UNLESS(pend);
            PG8_WAIT_L(0); PG8_BAR; PG8_MMA(0, 0, At, B0); PG8_MMA(0, 1, At, B1); PG8_BAR; PG8_SCHED;
            PG8_LDA(At, 1, 1); PG8_STAGEB(PG8_SB(1, 0), b3); PG8_STAGEB(PG8_SB(1, 1), b3 + hstep); PG8_STAGE2(PG8_SA(1, 0), a3, vc[0], vc[1]);
            PG8_WAIT_V(8);
            if (pend >= 0) { S.publish(pend, lane); pend = -1; }
            PG8_WAIT_L(0); PG8_BAR; PG8_MMA(1, 0, At, B0); PG8_MMA(1, 1, At, B1); PG8_BAR; PG8_SCHED;
        }
        PG8_WAIT_V(0);
        if constexpr (ALIGN_EPI) { if (wr == 0) PG8_BAR; }
        E(acc, cur, wr, wc, fr, fq);
        pend = __builtin_amdgcn_readfirstlane(cur.pm);
        if (!has_next) break;
#pragma unroll
        for (int a = 0; a < 2; ++a)
#pragma unroll
            for (int b = 0; b < 2; ++b)
#pragma unroll
                for (int m = 0; m < 4; ++m)
#pragma unroll
                    for (int n = 0; n < 2; ++n) acc[a][b][m][n] = (f32x4){0.f, 0.f, 0.f, 0.f};
        cur = nxt; cA = nA; cB = nB; ++ui;
        if constexpr (ALIGN_EPI) { if (wr == 1) PG8_BAR; }
    }
    PG8_WAIT_V(0);
    if (pend >= 0) S.publish(pend, lane);
    if constexpr (!ALIGN_EPI) { if (wr == 0) PG8_BAR; }
    PG8_BAR;
#undef PG8_SA
#undef PG8_SB
#undef PG8_STAGE2
#undef PG8_STAGEB
#undef PG8_LDA
#undef PG8_LDB
#undef PG8_MMA
#undef PG8_WAIT_V
#undef PG8_WAIT_L
#undef PG8_WAIT_V8_UNLESS
#undef PG8_BAR
#undef PG8_SCHED
}
}

constexpr size_t MiB = 1u << 20;
constexpr size_t WS_CTL = 0, CTL_ZERO_BYTES = 1 * MiB;
constexpr size_t WS_MOD = 1 * MiB;
constexpr size_t WS_ALOWW = WS_MOD + 256 * 1024;
constexpr size_t WS_CNTW = WS_ALOWW + 64 * 1024;
constexpr size_t WS_EIDX = WS_CNTW + 16 * 1024;
constexpr size_t WS_EW = WS_EIDX + (size_t)2 * T * 4;
constexpr size_t WS_LOC = WS_EW + (size_t)2 * T * 4;
constexpr size_t WS_ALOW = WS_LOC + 1 * MiB;
constexpr size_t WS_WPT = WS_ALOW + 1 * MiB;
constexpr size_t WS_WIN0 = 5 * MiB;
constexpr size_t WS_WOUT0 = WS_WIN0 + (size_t)NIN0 * D * 2;
constexpr size_t WS_WIN1 = WS_WOUT0 + (size_t)D * D * 2;
constexpr size_t WS_WOUT1 = WS_WIN1 + (size_t)NIN1 * D * 2;
constexpr size_t WS_WGU = WS_WOUT1 + (size_t)D * D * 2;
constexpr size_t WS_WD = WS_WGU + (size_t)2 * NE * 1024 * D * 2;
constexpr size_t WS_X1 = WS_WD + (size_t)2 * NE * D * DE * 2;
constexpr size_t WS_XN = WS_X1 + (size_t)T * D * 2;
constexpr size_t WS_QKVY = WS_XN + (size_t)T * D * 2;
constexpr size_t WS_CAT = WS_QKVY + (size_t)T * QW * 2;
constexpr size_t WS_END = WS_CAT + (size_t)(2 * T + 256) * DE * 2;
static_assert(WS_WPT + 128 * 1024 <= WS_WIN0, "small tables fit below the weights");
static_assert(WS_END <= 346000000, "workspace budget");
constexpr int CW_BAR = 4096;
constexpr int CW_APANEL = 98304;
constexpr int CW_PANEL = 65536;

constexpr int RING_BYTES = 131072;
constexpr int LDSCTL_OFF = RING_BYTES;
constexpr int L_MISC = LDSCTL_OFF;
constexpr int L_NE = L_MISC + 256;
constexpr int L_ROWTAB = L_NE + 512;
constexpr int LDS_BYTES = 147456;
static_assert(L_ROWTAB + 8192 <= LDS_BYTES, "LDS map");

#define XB_TMO      128
#define XB_XCNT(j)  (256  + 64 * (j))
#define XB_XSUB(j)  (1280 + 64 * (j))
#define XB_XGEN(j)  (2304 + 64 * (j))
#define XB_TOP      3328
#define XB_TOPGEN   3392
#define XCD_BAR_WORDS 3456
#define XB_SPIN_CAP (1u << 18)
__device__ __forceinline__ unsigned xb_ld(unsigned* p)              { return __hip_atomic_load(p, __ATOMIC_RELAXED, __HIP_MEMORY_SCOPE_AGENT); }
__device__ __forceinline__ unsigned xb_add(unsigned* p, unsigned v) { return __hip_atomic_fetch_add(p, v, __ATOMIC_RELAXED, __HIP_MEMORY_SCOPE_AGENT); }
__device__ __forceinline__ unsigned xb_xcc_id() { return (unsigned)__builtin_amdgcn_s_getreg((3 << 11) | 20) & 0xFu; }
#define XB_SPIN(cond, bar) do { unsigned _sp = 0; while (cond) { __builtin_amdgcn_s_sleep(1); \
    if ((++_sp & 255u) == 0u) { if (xb_ld(&(bar)[XB_TMO])) break; if (_sp > XB_SPIN_CAP) { atomicAdd(&(bar)[XB_TMO], 1u); break; } } } } while (0)
struct XcdBarrier { unsigned* bar; unsigned x; volatile LAS unsigned* st; int wave; };
__device__ __forceinline__ XcdBarrier xcd_barrier_post(unsigned* bar, volatile LAS unsigned* st, int wave) {
    XcdBarrier b; b.bar = bar; b.x = xb_xcc_id(); b.st = st; b.wave = wave;
    if (wave == 0 && lane_id() == 0) (void)xb_add(&bar[XB_XCNT(b.x)], 1u);
    return b;
}
__device__ __forceinline__ void xcd_barrier_complete(unsigned* bar, unsigned x, unsigned& nloc, unsigned& nx) {
    const unsigned G = gridDim.x * gridDim.y * gridDim.z;
    unsigned sum, cnt, mine, sp = 0u;
    for (;;) {
        sum = 0u; cnt = 0u; mine = 0u;
#pragma unroll
        for (unsigned j = 0; j < 16; ++j) { const unsigned c = xb_ld(&bar[XB_XCNT(j)]); sum += c; cnt += (c > 0u) ? 1u : 0u; mine = (j == x) ? c : mine; }
        if (sum == G) break;
        __builtin_amdgcn_s_sleep(1);
        if ((++sp & 255u) == 0u) { if (xb_ld(&bar[XB_TMO])) break; if (sp > XB_SPIN_CAP) { atomicAdd(&bar[XB_TMO], 1u); break; } }
    }
    nloc = mine > 0u ? mine : 1u; nx = cnt > 0u ? cnt : 1u;
}
__device__ __forceinline__ void xcd_barrier(const XcdBarrier& b) {
    asm volatile("s_waitcnt vmcnt(0)" ::: "memory");
    __syncthreads();
    if (b.wave == 0 && lane_id() == 0) {
        unsigned* bar = b.bar;
        __builtin_amdgcn_s_waitcnt(0);
        unsigned nloc = b.st[0], nx = b.st[1];
        if (nloc == 0u) { xcd_barrier_complete(bar, b.x, nloc, nx); b.st[0] = nloc; b.st[1] = nx; }
        const unsigned old = xb_add(&bar[XB_XSUB(b.x)], 1u);
        const unsigned gen = old / nloc;
        if (old + 1u == (gen + 1u) * nloc) {
            __builtin_amdgcn_fence(__ATOMIC_RELEASE, "agent");
            asm volatile("s_waitcnt vmcnt(0)" ::: "memory");
            const unsigned og = xb_add(&bar[XB_TOP], 1u);
            const unsigned tg = og / nx;
            if (og + 1u == (tg + 1u) * nx) xb_add(&bar[XB_TOPGEN], 1u);
            else XB_SPIN(xb_ld(&bar[XB_TOPGEN]) == tg, bar);
            __builtin_amdgcn_fence(__ATOMIC_ACQUIRE, "agent");
            xb_add(&bar[XB_XGEN(b.x)], 1u);
            asm volatile("s_waitcnt vmcnt(0)" ::: "memory");
        } else {
            XB_SPIN(xb_ld(&bar[XB_XGEN(b.x)]) == gen, bar);
            __builtin_amdgcn_fence(__ATOMIC_ACQUIRE, "agent");
            asm volatile("s_waitcnt vmcnt(0)" ::: "memory");
        }
    }
    __syncthreads();
}

struct Args { const float* in[26]; float* out; unsigned char* ws; };
struct Frame {
    LAS unsigned char* lds; unsigned char* ws;
    int tid, lane, wave, vcu, G, bx;
};
typedef const __attribute__((address_space(4))) Args* KA;
__device__ __forceinline__ KA kargs() { auto p = __builtin_amdgcn_kernarg_segment_ptr(); asm volatile("" : "+s"(p)); return (KA)p; }
#define INP(k) (args->in[k])

struct P0Item { const float* s; bf16* d; int ldw, Kd; };
__device__ __forceinline__ void p0_load(const P0Item& it, float (&r)[32], int lane) {
#pragma unroll
    for (int i = 0; i < 32; ++i) r[i] = __builtin_nontemporal_load(it.s + (size_t)(2 * i + (lane >> 5)) * it.ldw + (lane & 31));
}
__device__ __forceinline__ void p0_store(const P0Item& it, const float (&r)[32], LAS float* scr, int lane) {
#pragma unroll
    for (int i = 0; i < 32; ++i) scr[(2 * i + (lane >> 5)) * 33 + (lane & 31)] = r[i];
    LDS_WAIT(); asm volatile("" ::: "memory");
    const int c = lane & 7;
#pragma unroll
    for (int j = 0; j < 4; ++j) { const int n = (lane >> 3) + 8 * j; const LAS float* sp = scr + (8 * c) * 33 + n;
        v4u o; o.x = pk2(sp[0 * 33], sp[1 * 33]); o.y = pk2(sp[2 * 33], sp[3 * 33]); o.z = pk2(sp[4 * 33], sp[5 * 33]); o.w = pk2(sp[6 * 33], sp[7 * 33]);
        __builtin_nontemporal_store(o, (GAS v4u*)(it.d + (size_t)n * it.Kd + 8 * c)); }
    LDS_WAIT(); asm volatile("" ::: "memory");
}
template <class DMap>
__device__ __forceinline__ P0Item p0_matrix(const float* W, int ldw, int K, int scol0, int ncols, bf16* WT, const DMap& dmap, int it) {
    const int nblk = ncols / 32, kb = it / nblk, nb = it % nblk, n0 = 32 * nb;
    return P0Item{W + (size_t)(64 * kb) * ldw + scol0 + n0, WT + (size_t)(dmap(n0 >> 7) + (n0 & 127)) * K + 64 * kb, ldw, K};
}
struct MapId { int base; __device__ int operator()(int g) const { return base + 128 * g; } };
struct MapGlu { int second; __device__ int operator()(int g) const { return 256 * g + second; } };

constexpr int P0_I_IN0A = 16 * 16, P0_I_IN0Q = 16 * 48, P0_I_OUT = 16 * 32, P0_I_IN1A = 16 * 48, P0_I_IN1P = 16 * 16, P0_I_G = 16 * 16, P0_I_D = 8 * 32;
constexpr int P0_I_MOE = 2 * P0_I_G + P0_I_D;
constexpr int P0_I_PW = 4 * 8;
constexpr int P0_NITEMS = 2 * P0_I_IN0A + P0_I_IN0Q + 2 * P0_I_OUT + P0_I_IN1A + P0_I_IN1P + P0_I_PW + 32 * P0_I_MOE;
constexpr int P0_NFILL = 8 * P0_I_MOE;
__device__ __forceinline__ void p0_items(KA args, Frame& F, int first, int last, int widx, int nw) {
    LAS float* scr = (LAS float*)(F.lds + F.wave * 16384);
    auto decode = [&](int it) -> P0Item {
        KA args = kargs();
        unsigned char* ws = args->ws;
        bf16* win0 = (bf16*)(ws + WS_WIN0); bf16* wout0 = (bf16*)(ws + WS_WOUT0); bf16* win1 = (bf16*)(ws + WS_WIN1); bf16* wout1 = (bf16*)(ws + WS_WOUT1);
        int r = it;
        if (r < P0_I_IN0A) return p0_matrix(INP(6), NIN0, D, 0, 512, win0, MapGlu{0}, r); r -= P0_I_IN0A;
        if (r < P0_I_IN0A) return p0_matrix(INP(6), NIN0, D, 512, 512, win0, MapGlu{128}, r); r -= P0_I_IN0A;
        if (r < P0_I_IN0Q) return p0_matrix(INP(6), NIN0, D, 1024, 1536, win0, MapId{1024}, r); r -= P0_I_IN0Q;
        if (r < P0_I_OUT) return p0_matrix(INP(7), D, D, 0, 1024, wout0, MapId{0}, r); r -= P0_I_OUT;
        if (r < P0_I_IN1A) return p0_matrix(INP(12), 2064, D, 0, 1536, win1, MapId{0}, r); r -= P0_I_IN1A;
        if (r < P0_I_IN1P) return p0_matrix(INP(12), 2064, D, 1552, 512, win1, MapId{1536}, r); r -= P0_I_IN1P;
        if (r < P0_I_OUT) return p0_matrix(INP(13), D, D, 0, 1024, wout1, MapId{0}, r); r -= P0_I_OUT;
        if (r < P0_I_PW) { const int g = r >> 3; return p0_matrix(INP(17) + (size_t)g * 128 * 128, 128, 128, 0, 128, (bf16*)(ws + WS_WPT) + (size_t)g * 128 * 128, MapId{0}, r & 7); } r -= P0_I_PW;
        const int le = r / P0_I_MOE; r -= le * P0_I_MOE;
        bf16* wgu = (bf16*)(ws + WS_WGU) + (size_t)le * 1024 * D; bf16* wd = (bf16*)(ws + WS_WD) + (size_t)le * D * DE;
        if (r < P0_I_G) return p0_matrix(INP(22) + (size_t)le * D * DE, DE, D, 0, 512, wgu, MapGlu{0}, r); r -= P0_I_G;
        if (r < P0_I_G) return p0_matrix(INP(23) + (size_t)le * D * DE, DE, D, 0, 512, wgu, MapGlu{128}, r); r -= P0_I_G;
        return p0_matrix(INP(24) + (size_t)le * DE * D, D, DE, 0, 1024, wd, MapId{0}, r);
    };
    const int i0 = first + widx;
    if (i0 < last) {
        P0Item cur = decode(i0); float rc[32]; p0_load(cur, rc, F.lane);
        for (int it = i0; it < last; it += nw) {
            P0Item nx = cur; float rn[32];
            if (it + nw < last) { nx = decode(it + nw); p0_load(nx, rn, F.lane); }
            p0_store(cur, rc, scr, F.lane);
            if (it + nw < last) { cur = nx;
#pragma unroll
                for (int i = 0; i < 32; ++i) rc[i] = rn[i]; }
        }
    }
}
__device__ __forceinline__ void p0_prologue(KA args, Frame& F) {
    unsigned char* ws = F.ws;
    if (F.vcu < 192) {
        LAS float* cs = (LAS float*)F.lds;
        LAS float* part = (LAS float*)(F.lds + 16384);
        const float* c = INP(1);
        for (int i = F.tid; i < 4096; i += 512) cs[i] = siluf_(c[i]);
        __syncthreads();
        const int l = F.vcu / 96, cg = F.vcu % 96;
        const float* wp = INP(2) + (size_t)l * 1024 * 6144 + 64 * cg + F.lane;
        float a0 = 0.f, a1 = 0.f, a2 = 0.f, a3 = 0.f;
#pragma unroll 16
        for (int kk = 0; kk < 128; ++kk) { const int k = 128 * F.wave + kk; const float wv = __builtin_nontemporal_load(wp + (size_t)k * 6144);
            a0 += cs[k] * wv; a1 += cs[1024 + k] * wv; a2 += cs[2048 + k] * wv; a3 += cs[3072 + k] * wv; }
        part[(F.wave * 4 + 0) * 64 + F.lane] = a0; part[(F.wave * 4 + 1) * 64 + F.lane] = a1; part[(F.wave * 4 + 2) * 64 + F.lane] = a2; part[(F.wave * 4 + 3) * 64 + F.lane] = a3;
        __syncthreads();
        float* mod = (float*)(ws + WS_MOD);
        if (F.tid < 256) { const int b = F.tid >> 6, col = F.tid & 63; float sm = INP(3)[l * 6144 + 64 * cg + col];
#pragma unroll
            for (int w = 0; w < 8; ++w) sm += part[(w * 4 + b) * 64 + col];
            mod[(l * 4 + b) * 6144 + 64 * cg + col] = sm; }
        __syncthreads();
    }
    { float* aw = (float*)(ws + WS_ALOWW); const float* w1 = INP(12);
      for (int i = F.vcu * 512 + F.tid; i < 1024 * 16; i += F.G * 512) aw[i] = w1[(size_t)(i >> 4) * 2064 + 1536 + (i & 15)]; }
    p0_items(args, F, 0, P0_NITEMS - P0_NFILL, F.vcu * 8 + F.wave, F.G * 8);
}

#ifdef PROBE_TS
#ifndef PROBE_LO
#define PROBE_LO 0
#define PROBE_HI 256
#endif
#define TSBUF ((unsigned long long*)(ws + WS_CTL + 524288))
#define TS_PUT(slot) do { if (F.tid == 0) TSBUF[(slot) * 256 + F.bx] = __builtin_amdgcn_s_memrealtime(); } while (0)
#define TS_PRE(idx) do { __syncthreads(); TS_PUT(1 + 2 * (idx)); } while (0)
#define TS_MARK(m) do { if (l == 0) { unsigned char* ws = F.ws; TS_PUT(26 + (m)); } } while (0)
#define TS_MARK1(m) do { if (l == 1) { unsigned char* ws = F.ws; TS_PUT(26 + (m)); } } while (0)
#define TS_POST(idx) TS_PUT(2 + 2 * (idx))
#define SEAM_IDX(k) ((k) == 0 ? 0 : (k) <= 4 ? (k) - 1 : (k) == 6 ? 4 : (k) == 9 ? 5 : (k) == 10 ? 8 : (k) == 11 ? 9 : 10)
#else
#define TS_PUT(slot) do {} while (0)
#define TS_MARK(m) do {} while (0)
#define TS_MARK1(m) do {} while (0)
#define TS_PRE(idx) do {} while (0)
#define TS_POST(idx) do {} while (0)
#define SEAM_IDX(k) 0
#endif
__device__ __forceinline__ void norm_row(f32x4 (&v)[4], int lane, const float* g, const float* sc, const float* sh) {
    float s = 0.f;
#pragma unroll
    for (int j = 0; j < 4; ++j) s += (v[j].x * v[j].x + v[j].y * v[j].y) + (v[j].z * v[j].z + v[j].w * v[j].w);
    const float r = rsqrtf(wave_sum(s) * (1.f / D) + 1e-6f);
#pragma unroll
    for (int j = 0; j < 4; ++j) { const int c = 4 * lane + 256 * j; const f32x4 gg = *(const f32x4*)(g + c);
        v[j] = v[j] * r * gg;
        if (sc) { const f32x4 s1 = *(const f32x4*)(sc + c), s0 = *(const f32x4*)(sh + c); v[j] = v[j] * (1.f + s1) + s0; } }
}
template <bool SHIFT> __device__ __forceinline__ void norm_row_pre(f32x4 (&v)[4], const f32x4 (&A)[4], const f32x4 (&Bv)[4]) {
    float s = 0.f;
#pragma unroll
    for (int j = 0; j < 4; ++j) s += (v[j].x * v[j].x + v[j].y * v[j].y) + (v[j].z * v[j].z + v[j].w * v[j].w);
    const float r = rsqrtf(wave_sum(s) * (1.f / D) + 1e-6f);
#pragma unroll
    for (int j = 0; j < 4; ++j) { v[j] = v[j] * r * A[j]; if (SHIFT) v[j] = v[j] + Bv[j]; }
}
__device__ __forceinline__ void load_colvec(f32x4 (&A)[4], f32x4 (&Bv)[4], int lane, const float* g, const float* sc, const float* sh) {
#pragma unroll
    for (int j = 0; j < 4; ++j) { const int c = 4 * lane + 256 * j; const f32x4 gg = *(const f32x4*)(g + c);
        if (sc) { const f32x4 s1 = *(const f32x4*)(sc + c); A[j] = gg * (1.f + s1); Bv[j] = *(const f32x4*)(sh + c); } else { A[j] = gg; Bv[j] = (f32x4){0.f, 0.f, 0.f, 0.f}; } }
}
__device__ __forceinline__ void store_row_bf16(const f32x4 (&v)[4], int lane, bf16* orow) {
    GAS v2u* o = (GAS v2u*)orow + lane;
#pragma unroll
    for (int j = 0; j < 4; ++j) { v2u w; w.x = pk2(v[j].x, v[j].y); w.y = pk2(v[j].z, v[j].w); o[64 * j] = w; }
}


__device__ __forceinline__ void load_row_bf16(const bf16* row, int lane, f32x4 (&v)[4]) {
    const GAS v2u* p = (const GAS v2u*)row + lane;
#pragma unroll
    for (int j = 0; j < 4; ++j) { const v2u w = p[64 * j]; v[j] = (f32x4){bflo(w.x), bfhi(w.x), bflo(w.y), bfhi(w.y)}; }
}
constexpr int W16_PITCH = 20;
__device__ __forceinline__ void stage_w16(LAS float* tabw, const float* w, int tid) {
    for (int i = tid; i < 1024 * 4; i += 512) { const int c = i >> 2, k4 = i & 3; const f32x4 v = *(const f32x4*)(w + c * 16 + 4 * k4);
        const int sidx = ((c >> 8) * 4 + (c & 3)) * 64 + ((c >> 2) & 63); *(LAS f32x4*)(tabw + sidx * W16_PITCH + 4 * k4) = v; }
}
__device__ __forceinline__ void dot16(const f32x4 (&v)[4], const LAS float* tabw, int lane, float (&lg)[16]) {
    float a[16];
#pragma unroll
    for (int e = 0; e < 16; ++e) a[e] = 0.f;
#pragma unroll
    for (int j = 0; j < 4; ++j)
#pragma unroll
        for (int q = 0; q < 4; ++q) { const float hv = v[j][q]; const LAS float* p = tabw + ((j * 4 + q) * 64 + lane) * W16_PITCH;
#pragma unroll
            for (int k = 0; k < 4; ++k) { const f32x4 w = *(const LAS f32x4*)(p + 4 * k); a[4 * k] += hv * w.x; a[4 * k + 1] += hv * w.y; a[4 * k + 2] += hv * w.z; a[4 * k + 3] += hv * w.w; } }
    float b[8], c[4];
#pragma unroll
    for (int i = 0; i < 8; ++i) { auto rr = __builtin_amdgcn_permlane32_swap(__float_as_uint(a[i]), __float_as_uint(a[i + 8]), false, false); b[i] = __uint_as_float(rr[0]) + __uint_as_float(rr[1]); }
#pragma unroll
    for (int i = 0; i < 4; ++i) { auto rr = __builtin_amdgcn_permlane16_swap(__float_as_uint(b[i]), __float_as_uint(b[i + 4]), false, false); c[i] = row_sum16(__uint_as_float(rr[0]) + __uint_as_float(rr[1])); }
#pragma unroll
    for (int e = 0; e < 16; ++e) lg[e] = rdlane(c[e & 3], 16 * (e >> 2));
}

__device__ __forceinline__ void store16_wt(void* p, v4u v) { asm volatile("global_store_dwordx4 %0, %1, off sc1\n\ts_nop 1" :: "v"(p), "v"(v) : "memory"); }

struct EpiIn0 {
    static constexpr bool PERM = true;
    __device__ __forceinline__ void prefetch(const pg8::Unit&, int, LAS unsigned*) const {}
    bf16* O;
    __device__ __forceinline__ void operator()(const f32x4 (&acc)[2][2][4][2], const pg8::Unit& u, int wr, int wc, int fr, int fq) const {
        const int row0 = u.pm * 256 + wr * 64 + fr;
        if (u.pn < 4) {
            const int col0 = u.pn * 128 + wc * 32 + 8 * fq;
#pragma unroll
            for (int ai = 0; ai < 2; ++ai)
#pragma unroll
                for (int m = 0; m < 4; ++m) { bf16* rowp = O + (size_t)(row0 + ai * 128 + m * 16) * QW + col0;
                    const f32x4 a0 = acc[ai][0][m][0], a1 = acc[ai][0][m][1], g0 = acc[ai][1][m][0], g1 = acc[ai][1][m][1];
                    v4u w; w.x = pk2(a0[0] * sigmoidf_(g0[0]), a0[1] * sigmoidf_(g0[1])); w.y = pk2(a0[2] * sigmoidf_(g0[2]), a0[3] * sigmoidf_(g0[3]));
                    w.z = pk2(a1[0] * sigmoidf_(g1[0]), a1[1] * sigmoidf_(g1[1])); w.w = pk2(a1[2] * sigmoidf_(g1[2]), a1[3] * sigmoidf_(g1[3]));
                    *(v4u*)rowp = w; }
        } else {
            const float sc = (u.pn < 6) ? QSCALE0 : 1.f;
            const int col0 = 512 + (u.pn - 4) * 256 + wc * 32 + 8 * fq;
#pragma unroll
            for (int ai = 0; ai < 2; ++ai)
#pragma unroll
                for (int m = 0; m < 4; ++m) { bf16* rowp = O + (size_t)(row0 + ai * 128 + m * 16) * QW + col0;
#pragma unroll
                    for (int bj = 0; bj < 2; ++bj) { const f32x4 v0 = acc[ai][bj][m][0] * sc, v1 = acc[ai][bj][m][1] * sc;
                        v4u w; w.x = pk2(v0[0], v0[1]); w.y = pk2(v0[2], v0[3]); w.z = pk2(v1[0], v1[1]); w.w = pk2(v1[2], v1[3]);
                        *(v4u*)(rowp + bj * 128) = w; } }
        }
    }
};
struct EpiIn1 {
    static constexpr bool PERM = true;
    __device__ __forceinline__ void prefetch(const pg8::Unit&, int, LAS unsigned*) const {}
    bf16* O;
    __device__ __forceinline__ void operator()(const f32x4 (&acc)[2][2][4][2], const pg8::Unit& u, int wr, int wc, int fr, int fq) const {
        const int row0 = u.pm * 256 + wr * 64 + fr;
        const float sc = (u.pn == 0) ? 0.125f : 1.f;
        const int col0 = u.pn * 256 + wc * 32 + 8 * fq;
#pragma unroll
        for (int ai = 0; ai < 2; ++ai)
#pragma unroll
            for (int m = 0; m < 4; ++m) { bf16* rowp = O + (size_t)(row0 + ai * 128 + m * 16) * QW + col0;
#pragma unroll
                for (int bj = 0; bj < 2; ++bj) { const f32x4 v0 = acc[ai][bj][m][0] * sc, v1 = acc[ai][bj][m][1] * sc;
                    v4u w; w.x = pk2(v0[0], v0[1]); w.y = pk2(v0[2], v0[3]); w.z = pk2(v1[0], v1[1]); w.w = pk2(v1[2], v1[3]);
                    *(v4u*)(rowp + bj * 128) = w; } }
    }
};
template <bool XIN_F32> struct EpiOut {
    static constexpr bool PERM = true;
    __device__ __forceinline__ void prefetch(const pg8::Unit&, int, LAS unsigned*) const {}
    const void* xin; bf16* xout; const float* gate;
#ifdef PROBE_TS
    void* tsb;
#endif
    __device__ __forceinline__ void operator()(const f32x4 (&acc)[2][2][4][2], const pg8::Unit& u, int wr, int wc, int fr, int fq) const {
#ifdef PROBE_TS
        if (XIN_F32 && threadIdx.x == 0) ((unsigned long long*)tsb)[(26 + 3) * 256 + blockIdx.x] = __builtin_amdgcn_s_memrealtime();
#endif
        const int row0 = u.pm * 256 + wr * 64 + fr, col0 = u.pn * 256 + wc * 32 + 8 * fq;
        const float* gb = gate + ((u.pm * 256) / S) * 6144 + col0;
        f32x4 gv[2][2];
#pragma unroll
        for (int bj = 0; bj < 2; ++bj)
#pragma unroll
            for (int n = 0; n < 2; ++n) gv[bj][n] = *(const f32x4*)(gb + bj * 128 + 4 * n);
#pragma unroll
        for (int ai = 0; ai < 2; ++ai) {
            f32x4 xf[4][2][2]; v4u xb[4][2];
#pragma unroll
            for (int m = 0; m < 4; ++m) { const size_t off = (size_t)(row0 + ai * 128 + m * 16) * D + col0;
#pragma unroll
                for (int bj = 0; bj < 2; ++bj) {
                    if (XIN_F32) { const float* xp = (const float*)xin + off + bj * 128; xf[m][bj][0] = *(const f32x4*)xp; xf[m][bj][1] = *(const f32x4*)(xp + 4); }
                    else xb[m][bj] = *(const v4u*)((const bf16*)xin + off + bj * 128); } }
            __builtin_amdgcn_sched_barrier(0);
#pragma unroll
            for (int m = 0; m < 4; ++m) { const size_t off = (size_t)(row0 + ai * 128 + m * 16) * D + col0;
#pragma unroll
                for (int bj = 0; bj < 2; ++bj) { f32x4 x0, x1;
                    if (XIN_F32) { x0 = xf[m][bj][0]; x1 = xf[m][bj][1]; }
                    else { const v4u w = xb[m][bj]; x0 = (f32x4){bflo(w.x), bfhi(w.x), bflo(w.y), bfhi(w.y)}; x1 = (f32x4){bflo(w.z), bfhi(w.z), bflo(w.w), bfhi(w.w)}; }
                    x0 += gv[bj][0] * acc[ai][bj][m][0]; x1 += gv[bj][1] * acc[ai][bj][m][1];
                    v4u o; o.x = pk2(x0[0], x0[1]); o.y = pk2(x0[2], x0[3]); o.z = pk2(x1[0], x1[1]); o.w = pk2(x1[2], x1[3]);
                    store16_wt(xout + off + bj * 128, o); } }
            __builtin_amdgcn_sched_barrier(0);
        }
    }
};

constexpr int CW_MOECNT = 32768;
__device__ __forceinline__ int moe_unit_index(int mode, int i, int c, int G, int U, int nlow, int nfull) {
    if (i >= 4) return -1;
    int X;
    if (mode == 1) X = i * G + c;
    else if (c >= nfull) { const int j = c - nfull; X = (i == 0) ? j : (i == 1) ? j + nlow : 2 * nlow + c + (i - 2) * G; }
    else X = 2 * nlow + c + i * G;
    return X < U ? X : -1;
}
template <int MODE> struct MoeSched {
    const bf16* A; const bf16* Bt; int K; size_t bstride;
    LAS int* tab; LAS int* rowtab;
    unsigned* cnt; int G, c;
    static constexpr bool GATHER = (MODE == 1);
    __device__ __forceinline__ bool next(int i, pg8::Unit& u) const {
        const int U = __builtin_amdgcn_readfirstlane(tab[49]);
        const int X = moe_unit_index(MODE, i, c, G, U, __builtin_amdgcn_readfirstlane(tab[61]), __builtin_amdgcn_readfirstlane(tab[62]));
        if (X < 0) return false;
        int e = 0;
#pragma unroll
        for (int j = 1; j < 16; ++j) if (X >= __builtin_amdgcn_readfirstlane(tab[33 + j])) e = j;
        const int r = X - __builtin_amdgcn_readfirstlane(tab[33 + e]); const int rt = r >> 2, ct = r & 3;
        u.pm = X >> 2; u.pn = ct; u.e = e; u.li = (MODE == 1 ? 0 : 4) + i; u.r0 = __builtin_amdgcn_readfirstlane(tab[16 + e]) + 256 * rt; u.nr = min(256, __builtin_amdgcn_readfirstlane(tab[e]) - 256 * rt); return true;
    }
    __device__ __forceinline__ const char* a_base(const pg8::Unit& u) const { return GATHER ? (const char*)A : (const char*)A + (size_t)u.r0 * K * 2; }
    __device__ __forceinline__ const char* b_base(const pg8::Unit& u) const { return (const char*)Bt + (size_t)u.e * bstride + (size_t)u.pn * 256 * K * 2; }
    __device__ __forceinline__ void a_off(const pg8::Unit& u, int tid, unsigned (&v)[4]) const {
#pragma unroll
        for (int i = 0; i < 2; ++i) { int R, C; pg8::stage_rc(tid * 16 + i * 8192, R, C);
#pragma unroll
            for (int h = 0; h < 2; ++h) {
                if (GATHER) v[2 * h + i] = (unsigned)(rowtab[u.li * 256 + h * 128 + R] >> 1) * (unsigned)(K * 2) + (unsigned)C * 2u;
                else v[2 * h + i] = (unsigned)((h * 128 + R) * K + C) * 2u;
            } }
    }
    __device__ __forceinline__ void a_ready(const pg8::Unit& u, int wid, int lane) const {
        if (MODE == 2) {
            if (wid == 0) { unsigned sp = 0;
                while ((unsigned)__builtin_amdgcn_readfirstlane(__hip_atomic_load(cnt + 64 * u.pm, __ATOMIC_RELAXED, __HIP_MEMORY_SCOPE_AGENT)) < 32u) { __builtin_amdgcn_s_sleep(2); if (++sp > (1u << 20)) break; }
                __builtin_amdgcn_fence(__ATOMIC_ACQUIRE, "agent");
                asm volatile("s_waitcnt vmcnt(0)" ::: "memory"); }
            asm volatile("" ::: "memory"); __builtin_amdgcn_s_barrier(); asm volatile("" ::: "memory");
        }
    }
    __device__ __forceinline__ void publish(int rtg, int lane) const {
        if (MODE == 1) { if (lane == 0) __hip_atomic_fetch_add(cnt + 64 * rtg, 1u, __ATOMIC_RELAXED, __HIP_MEMORY_SCOPE_AGENT); }
    }
};
__device__ __forceinline__ void moe_plan(Frame& F, const int* cntw, const int* loc, int c) {
    LAS int* tab = (LAS int*)(F.lds + L_NE); LAS int* rowtab = (LAS int*)(F.lds + L_ROWTAB);
    LAS int* pre = (LAS int*)F.lds + F.wave * 320;
    __syncthreads();
    { int v[8];
#pragma unroll
      for (int i = 0; i < 4; ++i) { v[i] = cntw[(F.lane + 64 * i) * 16 + 2 * F.wave]; v[4 + i] = cntw[(F.lane + 64 * i) * 16 + 2 * F.wave + 1]; }
      const int s0 = wave_sum_i((v[0] + v[1]) + (v[2] + v[3])), s1 = wave_sum_i((v[4] + v[5]) + (v[6] + v[7]));
      if (F.lane == 0) { tab[2 * F.wave] = s0; tab[2 * F.wave + 1] = s1; } }
    for (int i = F.tid; i < 2048; i += 512) rowtab[i] = 0;
    __syncthreads();
    if (F.tid == 0) { int a = 0, ub = 0; for (int e = 0; e < 16; ++e) { tab[16 + e] = a; tab[33 + e] = ub; a += tab[e]; ub += 4 * ((tab[e] + 255) >> 8); } tab[32] = a; tab[49] = ub;
        const int R = 1 + (ub > F.G) + (ub > 2 * F.G) + (ub > 3 * F.G), nfull = ub - (R - 1) * F.G;
        tab[60] = R; tab[61] = F.G - nfull; tab[62] = nfull; }
    __syncthreads();
    const int li = F.wave;
    const int X = moe_unit_index(li < 4 ? 1 : 2, li & 3, c, F.G, tab[49], tab[61], tab[62]);
    if (X >= 0) {
        int e = 0;
        for (int j = 1; j < 16; ++j) if (X >= tab[33 + j]) e = j;
        const int rt = (X - tab[33 + e]) >> 2, ne = tab[e];
        int cw[4], tot = 0;
#pragma unroll
        for (int i = 0; i < 4; ++i) { cw[i] = cntw[(4 * F.lane + i) * 16 + e]; tot += cw[i]; }
        int start = wave_scan_i(tot) - tot;
#pragma unroll
        for (int i = 0; i < 4; ++i) { pre[4 * F.lane + i] = start; start += cw[i]; }
        asm volatile("s_waitcnt lgkmcnt(0)" ::: "memory");
        int cidx[4], gidx[4];
#pragma unroll
        for (int k = 0; k < 4; ++k) { const int g = 256 * rt + 64 * k + F.lane; int lo = 0;
#pragma unroll
            for (int st = 128; st >= 1; st >>= 1) { if (pre[lo + st] <= g) lo += st; }
            cidx[k] = lo; gidx[k] = g; }
        int val[4];
#pragma unroll
        for (int k = 0; k < 4; ++k) { val[k] = 0; if (gidx[k] < ne) val[k] = loc[(cidx[k] * 16 + e) * 64 + (gidx[k] - pre[cidx[k]])]; }
#pragma unroll
        for (int k = 0; k < 4; ++k) if (gidx[k] < ne) rowtab[li * 256 + 64 * k + F.lane] = val[k];
    }
    __syncthreads();
}
struct EpiM1 {
    static constexpr bool PERM = true;
    __device__ __forceinline__ void prefetch(const pg8::Unit&, int, LAS unsigned*) const {}
    bf16* ACT; const float* ew; LAS int* rowtab;
    __device__ __forceinline__ void operator()(const f32x4 (&acc)[2][2][4][2], const pg8::Unit& u, int wr, int wc, int fr, int fq) const {
        const int col0 = u.pn * 128 + wc * 32 + 8 * fq;
#pragma unroll
        for (int ai = 0; ai < 2; ++ai)
#pragma unroll
            for (int m = 0; m < 4; ++m) { const int r = ai * 128 + wr * 64 + m * 16 + fr;
                if (r < u.nr) { const float w8 = ew[rowtab[u.li * 256 + r]];
                    const f32x4 g0 = acc[ai][0][m][0], g1 = acc[ai][0][m][1], u0 = acc[ai][1][m][0], u1 = acc[ai][1][m][1];
                    v4u w; w.x = pk2(siluf_(g0[0]) * u0[0] * w8, siluf_(g0[1]) * u0[1] * w8); w.y = pk2(siluf_(g0[2]) * u0[2] * w8, siluf_(g0[3]) * u0[3] * w8);
                    w.z = pk2(siluf_(g1[0]) * u1[0] * w8, siluf_(g1[1]) * u1[1] * w8); w.w = pk2(siluf_(g1[2]) * u1[2] * w8, siluf_(g1[3]) * u1[3] * w8);
                    store16_wt(ACT + (size_t)(u.r0 + r) * DE + col0, w); } }
    }
};
struct EpiM2 {
    static constexpr bool PERM = true;
    __device__ __forceinline__ void prefetch(const pg8::Unit&, int, LAS unsigned*) const {}
    bf16* YS; LAS int* rowtab;
    __device__ __forceinline__ void operator()(const f32x4 (&acc)[2][2][4][2], const pg8::Unit& u, int wr, int wc, int fr, int fq) const {
        const int col0 = u.pn * 256 + wc * 32 + 8 * fq;
#pragma unroll
        for (int ai = 0; ai < 2; ++ai)
#pragma unroll
            for (int m = 0; m < 4; ++m) { const int r = ai * 128 + wr * 64 + m * 16 + fr;
                if (r < u.nr) { bf16* rowp = YS + (size_t)rowtab[u.li * 256 + r] * D + col0;
#pragma unroll
                    for (int bj = 0; bj < 2; ++bj) { const f32x4 v0 = acc[ai][bj][m][0], v1 = acc[ai][bj][m][1];
                        v4u w; w.x = pk2(v0[0], v0[1]); w.y = pk2(v0[2], v0[3]); w.z = pk2(v1[0], v1[1]); w.w = pk2(v1[2], v1[3]);
                        *(v4u*)(rowp + bj * 128) = w; } } }
    }
};

constexpr int MX_PITCH = 520;
template <int HALO> __device__ __forceinline__ void stage_rows(LAS bf16* dst, const bf16* QKVY, int col0, int t0, int tid) {
    constexpr int NROW = 64 + HALO, NP = (NROW * 64 + 511) / 512;
    const int tt0 = t0 % S;
    v4u v[NP];
#pragma unroll
    for (int i = 0; i < NP; ++i) { const int p = tid + 512 * i, row = p >> 6, c8 = (p & 63) * 8; v[i] = (v4u){0u, 0u, 0u, 0u};
        if (p < NROW * 64 && tt0 - HALO + row >= 0) v[i] = *(const v4u*)(QKVY + (size_t)(t0 - HALO + row) * QW + col0 + c8); }
#pragma unroll
    for (int i = 0; i < NP; ++i) { const int p = tid + 512 * i, row = p >> 6, c8 = (p & 63) * 8;
        if (p < NROW * 64) *(LAS v4u*)(dst + row * MX_PITCH + c8) = v[i]; }
}
__device__ __forceinline__ void conv_phase(KA args, Frame& F, const bf16* QKVY, bf16* CAT) {
    typedef float f2 __attribute__((ext_vector_type(2)));
    LAS bf16* ys = (LAS bf16*)F.lds;
    const int half = F.tid >> 8, cp = (F.tid & 255) * 2;
    const float* cw = INP(8);
    f2 w[31];
#pragma unroll
    for (int j = 0; j < 31; ++j) w[j] = *(const f2*)(cw + j * 512 + cp);
    const f2 bb = *(const f2*)(INP(9) + cp), gg = *(const f2*)(INP(10) + cp), nn = *(const f2*)(INP(11) + cp);
    for (int chunk = F.vcu; chunk < T / 64; chunk += F.G) {
        const int t0 = chunk * 64;
        __syncthreads();
        stage_rows<30>(ys, QKVY, 0, t0, F.tid);
        __syncthreads();
        for (int blk = 0; blk < 4; ++blk) { const int tok0 = half * 32 + blk * 8;
            f2 y[38];
#pragma unroll
            for (int r = 0; r < 38; ++r) { const unsigned u = *(const LAS unsigned*)(ys + (tok0 + r) * MX_PITCH + cp); y[r] = (f2){bflo(u), bfhi(u)}; }
#pragma unroll
            for (int i = 0; i < 8; ++i) { f2 a = bb;
#pragma unroll
                for (int j = 0; j < 31; ++j) a = y[i + j] * w[j] + a;
                float s = xor16_add(row_sum16(a.x + a.y));
                const float mean = s * (1.f / 64.f); const f2 d = a - mean;
                float q = xor16_add(row_sum16(d.x * d.x + d.y * d.y));
                const float rs = rsqrtf(q * (1.f / 64.f) + 1e-5f);
                const f2 yn = d * rs * gg + nn;
                *(unsigned*)(CAT + (size_t)(t0 + tok0 + i) * D + cp) = pk2(siluf_(yn.x), siluf_(yn.y)); }
        }
    }
}
__device__ __forceinline__ void pool_phase(KA args, Frame& F, const bf16* QKVY, const bf16* WPT, bf16* CAT) {
    typedef float f32x16 __attribute__((ext_vector_type(16)));
    LAS bf16* us = (LAS bf16*)F.lds;
    const int g = (F.wave < 4) ? 3 - (F.wave >> 1) : ((F.wave - 4) >> 1), tt = F.wave & 1, r32 = F.lane & 31, hi = F.lane >> 5, win = 2 << g;
    const float* pb = INP(18); const float* ps = INP(19);
    for (int chunk = F.vcu; chunk < T / 64; chunk += F.G) {
        const int t0 = chunk * 64, tt0 = t0 % S;
        __syncthreads();
        stage_rows<15>(us, QKVY, 1536, t0, F.tid);
        __syncthreads();
        const int tok = tt * 32 + r32;
        const float inv = 1.f / (float)min(tt0 + tok + 1, win);
        f32x16 acc[4];
#pragma unroll
        for (int ct = 0; ct < 4; ++ct) acc[ct] = (f32x16){};
        bf16x8 bnx[4];
#pragma unroll
        for (int ct = 0; ct < 4; ++ct) bnx[ct] = *(const bf16x8*)(WPT + (size_t)(g * 128 + 32 * ct + r32) * 128 + 8 * hi);
#pragma unroll
        for (int ks = 0; ks < 8; ++ks) {
            bf16x8 bcur[4];
#pragma unroll
            for (int ct = 0; ct < 4; ++ct) bcur[ct] = bnx[ct];
            if (ks < 7) {
#pragma unroll
                for (int ct = 0; ct < 4; ++ct) bnx[ct] = *(const bf16x8*)(WPT + (size_t)(g * 128 + 32 * ct + r32) * 128 + 16 * (ks + 1) + 8 * hi); }
            const LAS bf16* col = us + (tok + 15) * MX_PITCH + g * 128 + 16 * ks + 8 * hi;
            float sm[8];
#pragma unroll
            for (int e = 0; e < 8; ++e) sm[e] = 0.f;
            for (int j = 0; j < win; ++j) { const v4u u = *(const LAS v4u*)(col - j * MX_PITCH);
                sm[0] += bflo(u.x); sm[1] += bfhi(u.x); sm[2] += bflo(u.y); sm[3] += bfhi(u.y); sm[4] += bflo(u.z); sm[5] += bfhi(u.z); sm[6] += bflo(u.w); sm[7] += bfhi(u.w); }
            const v4u c = *(const LAS v4u*)col;
            v4u pa; pa.x = pk2(sm[0] * inv - bflo(c.x), sm[1] * inv - bfhi(c.x)); pa.y = pk2(sm[2] * inv - bflo(c.y), sm[3] * inv - bfhi(c.y));
            pa.z = pk2(sm[4] * inv - bflo(c.z), sm[5] * inv - bfhi(c.z)); pa.w = pk2(sm[6] * inv - bflo(c.w), sm[7] * inv - bfhi(c.w));
            const bf16x8 af = __builtin_bit_cast(bf16x8, pa);
#pragma unroll
            for (int ct = 0; ct < 4; ++ct) acc[ct] = __builtin_amdgcn_mfma_f32_32x32x16_bf16(af, bcur[ct], acc[ct], 0, 0, 0);
        }
#pragma unroll
        for (int ct = 0; ct < 4; ++ct) { const int n = g * 128 + 32 * ct + r32; const float bb = pb[n], sc = ps[n];
#pragma unroll
            for (int r = 0; r < 16; ++r) { const int row = tt * 32 + (r & 3) + 8 * (r >> 2) + 4 * hi;
                CAT[(size_t)(t0 + row) * D + 512 + n] = (bf16)(pk2((acc[ct][r] + bb) * sc, 0.f) & 0xffffu); } }
    }
}

namespace sba {
typedef short bf16x8 __attribute__((ext_vector_type(8)));
typedef short s16x4 __attribute__((ext_vector_type(4)));
typedef short v4i16_t __attribute__((ext_vector_type(4)));
typedef _Float16 h8 __attribute__((ext_vector_type(8)));
typedef _Float16 h2 __attribute__((ext_vector_type(2)));
typedef float f2 __attribute__((ext_vector_type(2)));
typedef float f32x16 __attribute__((ext_vector_type(16)));
typedef unsigned u32x4 __attribute__((ext_vector_type(4)));
typedef __bf16 bf16x2_t __attribute__((ext_vector_type(2)));
constexpr int KVB = 64, SLOTB = 8192;
constexpr float THR = 160.f;
__device__ __forceinline__ void glds16(const void* gsrc, unsigned lds_dst) { unsigned keep;
    asm volatile("s_mov_b32 %0, m0\n\ts_mov_b32 m0, %2\n\ts_nop 0\n\tglobal_load_lds_dwordx4 %1, off\n\ts_mov_b32 m0, %0" : "=&s"(keep) : "v"(gsrc), "s"(lds_dst) : "memory"); }
__device__ __forceinline__ unsigned cvtpk_bf(float lo, float hi) { f2 v = {lo, hi}; bf16x2_t b = __builtin_convertvector(v, bf16x2_t); return __builtin_bit_cast(unsigned, b); }
__device__ __forceinline__ unsigned cvtpk_h(float lo, float hi) { f2 v = {lo, hi}; h2 b = __builtin_convertvector(v, h2); return __builtin_bit_cast(unsigned, b); }
__device__ __forceinline__ float min30(float a) { float r; asm("v_min_f32_e32 %0, 0x41f00000, %1" : "=v"(r) : "v"(a)); return r; }
__device__ __forceinline__ float maxf_(float a, float b) { float r; asm("v_max_f32_e32 %0, %1, %2" : "=v"(r) : "v"(a), "v"(b)); return r; }
typedef __attribute__((address_space(3))) const char* lds_cptr;
__device__ __forceinline__ s16x4 vtr(lds_cptr p) { return __builtin_bit_cast(s16x4, __builtin_amdgcn_ds_read_tr16_b64_v4i16((__attribute__((address_space(3))) v4i16_t*)p)); }
#define SBA_H(x) __builtin_bit_cast(h8, x)
#define SBA_P(x) __builtin_bit_cast(bf16x8, x)

template <bool DIAG> __device__ __forceinline__ void tile(f32x16& p0, f32x16& p1, f32x16& o0, f32x16& o1, float& C, const h8& T0, const h8& T1, const h8& ONES, int kvb, int hi, lds_cptr vp) {
    const float z0 = p0[0];
    u32x4 lf0, lf1, lf2, lf3;
    {
        float l[16];
#pragma unroll
        for (int r = 0; r < 16; ++r) { const float z = p0[r]; float v = maxf_(__builtin_amdgcn_logf(1.f + __builtin_amdgcn_exp2f(min30(z))), z);
            if (DIAG) { if (kvb + (r & 3) + 8 * (r >> 2) >= 0) v = 0.f; } l[r] = v; }
        lf0 = (u32x4){cvtpk_h(l[0], l[1]), cvtpk_h(l[2], l[3]), cvtpk_h(l[4], l[5]), cvtpk_h(l[6], l[7])};
        lf1 = (u32x4){cvtpk_h(l[8], l[9]), cvtpk_h(l[10], l[11]), cvtpk_h(l[12], l[13]), cvtpk_h(l[14], l[15])};
#pragma unroll
        for (int r = 0; r < 16; ++r) { const float z = p1[r]; float v = maxf_(__builtin_amdgcn_logf(1.f + __builtin_amdgcn_exp2f(min30(z))), z);
            if (DIAG) { if (kvb + 32 + (r & 3) + 8 * (r >> 2) >= 0) v = 0.f; } l[r] = v; }
        if (!DIAG) l[15] += hi ? C : 0.f;
        lf2 = (u32x4){cvtpk_h(l[0], l[1]), cvtpk_h(l[2], l[3]), cvtpk_h(l[4], l[5]), cvtpk_h(l[6], l[7])};
        lf3 = (u32x4){cvtpk_h(l[8], l[9]), cvtpk_h(l[10], l[11]), cvtpk_h(l[12], l[13]), cvtpk_h(l[14], l[15])};
    }
    p0 = __builtin_amdgcn_mfma_f32_32x32x16_f16(T0, SBA_H(lf0), p0, 0, 0, 0);
    p0 = __builtin_amdgcn_mfma_f32_32x32x16_f16(T1, SBA_H(lf1), p0, 0, 0, 0);
    p0 = __builtin_amdgcn_mfma_f32_32x32x16_f16(ONES, SBA_H(lf2), p0, 0, 0, 0);
    p0 = __builtin_amdgcn_mfma_f32_32x32x16_f16(ONES, SBA_H(lf3), p0, 0, 0, 0);
    p1 = __builtin_amdgcn_mfma_f32_32x32x16_f16(T0, SBA_H(lf2), p1, 0, 0, 0);
    p1 = __builtin_amdgcn_mfma_f32_32x32x16_f16(T1, SBA_H(lf3), p1, 0, 0, 0);
    float cn = z0 - p0[0];
    { auto rr = __builtin_amdgcn_permlane32_swap(__float_as_uint(cn), __float_as_uint(cn), false, false); cn = __uint_as_float(rr[0]); }
    C = cn;
    u32x4 pw0, pw1, pw2, pw3;
    {
        float a[16];
#pragma unroll
        for (int r = 0; r < 16; ++r) { float v = __builtin_amdgcn_exp2f(p0[r]); if (DIAG) { if (kvb + (r & 3) + 8 * (r >> 2) >= 0) v = 0.f; } a[r] = v; }
        pw0 = (u32x4){cvtpk_bf(a[0], a[1]), cvtpk_bf(a[2], a[3]), cvtpk_bf(a[4], a[5]), cvtpk_bf(a[6], a[7])};
        pw1 = (u32x4){cvtpk_bf(a[8], a[9]), cvtpk_bf(a[10], a[11]), cvtpk_bf(a[12], a[13]), cvtpk_bf(a[14], a[15])};
#pragma unroll
        for (int r = 0; r < 16; ++r) { float v = __builtin_amdgcn_exp2f(p1[r]); if (DIAG) { if (kvb + 32 + (r & 3) + 8 * (r >> 2) >= 0) v = 0.f; } a[r] = v; }
        pw2 = (u32x4){cvtpk_bf(a[0], a[1]), cvtpk_bf(a[2], a[3]), cvtpk_bf(a[4], a[5]), cvtpk_bf(a[6], a[7])};
        pw3 = (u32x4){cvtpk_bf(a[8], a[9]), cvtpk_bf(a[10], a[11]), cvtpk_bf(a[12], a[13]), cvtpk_bf(a[14], a[15])};
    }
#define SBA_VFR(i) ({ const s16x4 lo_ = vtr(vp + (((i) >> 2) * 4096 + ((i) & 3) * 1024)); const s16x4 hi_ = vtr(vp + (((i) >> 2) * 4096 + ((i) & 3) * 1024 + 512)); (bf16x8){lo_[0], lo_[1], lo_[2], lo_[3], hi_[0], hi_[1], hi_[2], hi_[3]}; })
    o0 = __builtin_amdgcn_mfma_f32_32x32x16_bf16(SBA_P(pw0), SBA_VFR(0), o0, 0, 0, 0);
    o1 = __builtin_amdgcn_mfma_f32_32x32x16_bf16(SBA_P(pw0), SBA_VFR(4), o1, 0, 0, 0);
    o0 = __builtin_amdgcn_mfma_f32_32x32x16_bf16(SBA_P(pw1), SBA_VFR(1), o0, 0, 0, 0);
    o1 = __builtin_amdgcn_mfma_f32_32x32x16_bf16(SBA_P(pw1), SBA_VFR(5), o1, 0, 0, 0);
    o0 = __builtin_amdgcn_mfma_f32_32x32x16_bf16(SBA_P(pw2), SBA_VFR(2), o0, 0, 0, 0);
    o1 = __builtin_amdgcn_mfma_f32_32x32x16_bf16(SBA_P(pw2), SBA_VFR(6), o1, 0, 0, 0);
    o0 = __builtin_amdgcn_mfma_f32_32x32x16_bf16(SBA_P(pw3), SBA_VFR(3), o0, 0, 0, 0);
    o1 = __builtin_amdgcn_mfma_f32_32x32x16_bf16(SBA_P(pw3), SBA_VFR(7), o1, 0, 0, 0);
#undef SBA_VFR
}

__device__ __forceinline__ void wave_unit(int b, int h, int qi, const bf16* QKVY, bf16* CAT, char* shm_wave, int lane) {
    const int r32 = lane & 31, hi = lane >> 5;
    const long rowbase = (long)b * S; const int r0 = qi * 32;
    const bf16* Qw = QKVY + (rowbase + r0) * QW + 512 + h * 64;
    const bf16* Kl = QKVY + (rowbase + r32) * QW + 1024 + h * 64 + 8 * hi;
    const bf16* Vl = QKVY + (rowbase + (lane >> 2)) * QW + 1536 + h * 64 + (lane & 3) * 8;
    const unsigned lds0 = (unsigned)(uintptr_t)shm_wave;
    const lds_cptr vp0 = (lds_cptr)shm_wave + ((lane >> 4) & 1) * 32 + (lane & 3) * 8 + (4 * hi + ((lane & 15) >> 2)) * 64;
#define SBA_LOAD_V(t) do { _Pragma("unroll") for (int p_ = 0; p_ < 8; ++p_) vreg[p_] = *reinterpret_cast<const u32x4*>(Vl + ((long)(t) * KVB + 16 * (p_ & 3)) * QW + (p_ >> 2) * 32); } while (0)
#define SBA_STORE_V(slot) do { _Pragma("unroll") for (int p_ = 0; p_ < 8; ++p_) *(__attribute__((address_space(3))) u32x4*)((lds_cptr)shm_wave + (slot) * SLOTB + p_ * 1024 + lane * 16) = vreg[p_]; } while (0)
#define SBA_LOAD_K(t) do { _Pragma("unroll") for (int d0_ = 0; d0_ < 4; ++d0_) { kf[2 * d0_] = *reinterpret_cast<const bf16x8*>(Kl + (long)(t) * KVB * QW + 16 * d0_); kf[2 * d0_ + 1] = *reinterpret_cast<const bf16x8*>(Kl + ((long)(t) * KVB + 32) * QW + 16 * d0_); } } while (0)
    const int td = (r0 + 31) >> 6;
    bf16x8 kf[8], qr[4]; u32x4 vreg[8];
    SBA_LOAD_V(td); SBA_STORE_V(0);
    SBA_LOAD_K(td);
#pragma unroll
    for (int d0 = 0; d0 < 4; ++d0) qr[d0] = *reinterpret_cast<const bf16x8*>(&Qw[(long)r32 * QW + d0 * 16 + hi * 8]);
    h8 T0, T1, ONES;
#pragma unroll
    for (int jj = 0; jj < 8; ++jj) { const int kap = 8 * (jj >> 2) + 4 * hi + (jj & 3); T0[jj] = (kap >= r32) ? (_Float16)-1.0f : (_Float16)0.0f; T1[jj] = (16 + kap >= r32) ? (_Float16)-1.0f : (_Float16)0.0f; ONES[jj] = (_Float16)-1.0f; }
    f32x16 o0 = {}, o1 = {};
    float C = 0.f;
    for (int it = 0;; ++it) {
        const int t = td - it, slot = it & 1;
        f32x16 p0 = {}, p1 = {};
#pragma unroll
        for (int d0 = 0; d0 < 4; ++d0) { p0 = __builtin_amdgcn_mfma_f32_32x32x16_bf16(kf[2 * d0], qr[d0], p0, 0, 0, 0); p1 = __builtin_amdgcn_mfma_f32_32x32x16_bf16(kf[2 * d0 + 1], qr[d0], p1, 0, 0, 0); }
        if (t > 0) { SBA_LOAD_K(t - 1); SBA_LOAD_V(t - 1); }
        const lds_cptr vp = vp0 + slot * SLOTB;
        if (it == 0) tile<true>(p0, p1, o0, o1, C, T0, T1, ONES, KVB * t + 4 * hi - (r0 + r32), hi, vp);
        else tile<false>(p0, p1, o0, o1, C, T0, T1, ONES, 0, hi, vp);
        if (t == 0 || __all(C >= THR)) break;
        SBA_STORE_V(slot ^ 1);
    }
    bf16* Ow = CAT + (rowbase + r0) * D + 512 + h * 64;
#pragma unroll
    for (int r = 0; r < 16; ++r) { const int orow = (r & 3) + 8 * (r >> 2) + 4 * hi;
        Ow[(long)orow * D + r32] = (bf16)(cvtpk_bf(o0[r], 0.f) & 0xffffu); Ow[(long)orow * D + 32 + r32] = (bf16)(cvtpk_bf(o1[r], 0.f) & 0xffffu); }
#undef SBA_LOAD_V
#undef SBA_STORE_V
#undef SBA_LOAD_K
}
#undef SBA_H
#undef SBA_P
__device__ __forceinline__ void phase(const bf16* QKVY, bf16* CAT, char* lds, int vcu, int G, int wid, int lane) {
    for (int wu = vcu * 8 + wid; wu < NB * 8 * (S / 32); wu += G * 8) {
        const int bh = wu >> 7, qi = wu & 127;
        wave_unit(bh >> 3, bh & 7, qi, QKVY, CAT, lds + wid * 2 * SLOTB, lane);
    }
}
}


namespace gla {
typedef short bf16x8 __attribute__((ext_vector_type(8)));
typedef short s16x4 __attribute__((ext_vector_type(4)));
typedef short v4i16_t __attribute__((ext_vector_type(4)));
typedef float f32x16 __attribute__((ext_vector_type(16)));
typedef __attribute__((address_space(3))) const char* lds_cptr;
constexpr int NCH = NB * 4 * 64;
constexpr int L_VP = 0, L_KP = 16384, L_TOT = 24576, L_DL = 26624, L_PS = 16384, QSTR = 27136;
__device__ __forceinline__ void glds16(const void* gsrc, unsigned lds_dst) { unsigned keep;
    asm volatile("s_mov_b32 %0, m0\n\ts_mov_b32 m0, %2\n\ts_nop 0\n\tglobal_load_lds_dwordx4 %1, off\n\ts_mov_b32 m0, %0" : "=&s"(keep) : "v"(gsrc), "s"(lds_dst) : "memory"); }
__device__ __forceinline__ s16x4 vtr(lds_cptr p) { return __builtin_bit_cast(s16x4, __builtin_amdgcn_ds_read_tr16_b64_v4i16((__attribute__((address_space(3))) v4i16_t*)p)); }
#define GLA_WAIT_BAR() asm volatile("s_waitcnt vmcnt(0) lgkmcnt(0)\n\ts_barrier" ::: "memory")
__device__ __forceinline__ void dma_v(const bf16* QKVY, long t0, int h, unsigned lds0, int wid, int lane) {
#pragma unroll
    for (int i = 0; i < 2; ++i) { const int p = wid * 2 + i, ctile = p >> 2, tg = p & 3;
        glds16(QKVY + (t0 + 16 * tg + (lane >> 2)) * QW + 512 + h * 128 + 32 * ctile + (lane & 3) * 8, (unsigned)__builtin_amdgcn_readfirstlane(lds0 + L_VP + p * 1024)); }
}
__device__ __forceinline__ bf16x8 trfrag(lds_cptr base, int piece, int lane) {
    const int hi = lane >> 5; const lds_cptr p = base + piece * 1024 + ((lane >> 4) & 1) * 32 + (lane & 3) * 8 + (4 * hi + ((lane & 15) >> 2)) * 64;
    const s16x4 lo = vtr(p), hh = vtr(p + 512); return (bf16x8){lo[0], lo[1], lo[2], lo[3], hh[0], hh[1], hh[2], hh[3]};
}
__device__ __forceinline__ void pass_a(KA args, const bf16* QKVY, const float* ALOW, bf16* QIN, bf16* KIN, float* KVT, float* DEC, char* shm, int vcu, int G, int wid, int lane) {
    const unsigned lds0 = (unsigned)(uintptr_t)shm; const lds_cptr shm3 = (lds_cptr)shm;
    const float* gw = INP(14); const float* gb = INP(15);
    for (int base = 4 * vcu; base < NCH; base += 4 * G) {
        const int bh = base >> 6, b = bh >> 2, h = bh & 3;
        float gwv[16];
#pragma unroll
        for (int r = 0; r < 16; ++r) gwv[r] = gw[r * 256 + h * 64 + lane];
        const float gbv = gb[h * 64 + lane];
        float bl[4][8], qv[4][8], kv[4][8];
#pragma unroll
        for (int q = 0; q < 4; ++q) { const long t0 = (long)b * S + ((base + q) & 63) * 64;
            dma_v(QKVY, t0, h, lds0 + q * QSTR, wid, lane);
#pragma unroll
            for (int tt = 0; tt < 8; ++tt) { const long t = t0 + 8 * wid + tt; const f32x4* al = (const f32x4*)(ALOW + t * 16); float x = gbv;
#pragma unroll
                for (int r4 = 0; r4 < 4; ++r4) { const f32x4 a4 = al[r4]; x += a4.x * gwv[4 * r4] + a4.y * gwv[4 * r4 + 1] + a4.z * gwv[4 * r4 + 2] + a4.w * gwv[4 * r4 + 3]; }
                const float la = -softplusf_(-x) * (1.f / 16.f);
                bl[q][tt] = (tt ? bl[q][tt - 1] : 0.f) + la;
                qv[q][tt] = bf2f(QKVY[t * QW + h * 64 + lane]); kv[q][tt] = bf2f(QKVY[t * QW + 256 + h * 64 + lane]); }
            ((__attribute__((address_space(3))) float*)(shm3 + q * QSTR + L_TOT))[wid * 64 + lane] = bl[q][7]; }
        asm volatile("s_waitcnt lgkmcnt(0)\n\ts_barrier" ::: "memory");
#pragma unroll
        for (int q = 0; q < 4; ++q) { const int ch = base + q; const long t0 = (long)b * S + (ch & 63) * 64;
            __attribute__((address_space(3))) float* tot = (__attribute__((address_space(3))) float*)(shm3 + q * QSTR + L_TOT);
            __attribute__((address_space(3))) bf16* kp = (__attribute__((address_space(3))) bf16*)(shm3 + q * QSTR + L_KP);
            float off = 0.f, blast = 0.f;
#pragma unroll
            for (int w = 0; w < 8; ++w) { const float v = tot[w * 64 + lane]; if (w < wid) off += v; blast += v; }
#pragma unroll
            for (int tt = 0; tt < 8; ++tt) { const long t = t0 + 8 * wid + tt; const float bb = bl[q][tt] + off; const int tk = 8 * wid + tt;
                const float qi = qv[q][tt] * __expf(bb), ki = kv[q][tt] * __expf(-bb);
                QIN[t * 256 + h * 64 + lane] = (bf16)f2bf(qi); const bf16 kb = (bf16)f2bf(ki); KIN[t * 256 + h * 64 + lane] = kb;
                kp[((lane >> 5) * 4 + (tk >> 4)) * 512 + (tk & 15) * 32 + (lane & 31)] = kb; }
            if (wid == 0) { const float dd = __expf(blast); ((__attribute__((address_space(3))) float*)(shm3 + q * QSTR + L_DL))[lane] = dd; DEC[ch * 64 + lane] = dd; } }
        GLA_WAIT_BAR();
        const int dvt = wid & 3, dt = wid >> 2;
#pragma unroll
        for (int q = 0; q < 4; ++q) { const int ch = base + q;
            f32x16 acc = {};
#pragma unroll
            for (int ks = 0; ks < 4; ++ks) acc = __builtin_amdgcn_mfma_f32_32x32x16_bf16(trfrag(shm3 + q * QSTR + L_VP, dvt * 4 + ks, lane), trfrag(shm3 + q * QSTR + L_KP, dt * 4 + ks, lane), acc, 0, 0, 0);
            const int dcol = 32 * dt + (lane & 31); const float dsc = ((__attribute__((address_space(3))) float*)(shm3 + q * QSTR + L_DL))[dcol];
            float* kvo = KVT + ((size_t)ch * 128 + 32 * dvt) * 64 + dcol;
#pragma unroll
            for (int r = 0; r < 16; ++r) kvo[(size_t)((r & 3) + 8 * (r >> 2) + 4 * (lane >> 5)) * 64] = acc[r] * dsc; }
        GLA_WAIT_BAR();
    }
}
__device__ __forceinline__ void pass_b(const float* KVT, const float* DEC, bf16* SINT, int vcu, int G, int tid) {
    for (int e = vcu * 512 + tid; e < NB * 4 * 128 * 64; e += G * 512) {
        const int bh = e >> 13, rem = e & 8191, d = e & 63;
        float st = 0.f;
        for (int n0 = 0; n0 < 64; n0 += 8) {
            float kvv[8], dc[8];
#pragma unroll
            for (int i = 0; i < 8; ++i) { const size_t ch = (size_t)bh * 64 + n0 + i; kvv[i] = KVT[ch * 8192 + rem]; dc[i] = DEC[ch * 64 + d]; }
#pragma unroll
            for (int i = 0; i < 8; ++i) { const size_t ch = (size_t)bh * 64 + n0 + i; SINT[ch * 8192 + rem] = (bf16)f2bf(st); st = dc[i] * st + kvv[i]; }
        }
    }
}
__device__ __forceinline__ void pass_c(KA args, const bf16* QKVY, const bf16* QIN, const bf16* KIN, const bf16* SINT, bf16* CAT, char* shm, int vcu, int G, int wid, int lane) {
    const unsigned lds0 = (unsigned)(uintptr_t)shm; const lds_cptr shm3 = (lds_cptr)shm;
    const int r32 = lane & 31, hi = lane >> 5, it = wid >> 2, ct = wid & 3;
    const float* gng = INP(16);
    for (int base = 4 * vcu; base < NCH; base += 4 * G) {
        const int bh = base >> 6, b = bh >> 2, h = bh & 3;
        f32x16 o[4]; unsigned pw[4][2][8];
#pragma unroll
        for (int q = 0; q < 4; ++q) { const int ch = base + q; const long t0 = (long)b * S + (ch & 63) * 64;
            dma_v(QKVY, t0, h, lds0 + q * QSTR, wid, lane);
            bf16x8 qf[4];
#pragma unroll
            for (int d0 = 0; d0 < 4; ++d0) qf[d0] = *(const bf16x8*)(QIN + (t0 + 32 * it + r32) * 256 + h * 64 + 16 * d0 + 8 * hi);
            f32x16 oo = {};
#pragma unroll
            for (int ks = 0; ks < 4; ++ks) { const bf16x8 sf = *(const bf16x8*)(SINT + ((size_t)ch * 128 + 32 * ct + r32) * 64 + 16 * ks + 8 * hi);
                oo = __builtin_amdgcn_mfma_f32_32x32x16_bf16(qf[ks], sf, oo, 0, 0, 0); }
            o[q] = oo;
            f32x16 pt0 = {}, pt1 = {};
#pragma unroll
            for (int d0 = 0; d0 < 4; ++d0) { const bf16x8 kf = *(const bf16x8*)(KIN + (t0 + r32) * 256 + h * 64 + 16 * d0 + 8 * hi);
                pt0 = __builtin_amdgcn_mfma_f32_32x32x16_bf16(kf, qf[d0], pt0, 0, 0, 0); }
            if (it == 1) {
#pragma unroll
                for (int d0 = 0; d0 < 4; ++d0) { const bf16x8 kf = *(const bf16x8*)(KIN + (t0 + 32 + r32) * 256 + h * 64 + 16 * d0 + 8 * hi);
                    pt1 = __builtin_amdgcn_mfma_f32_32x32x16_bf16(kf, qf[d0], pt1, 0, 0, 0); }
            }
#pragma unroll
            for (int r = 0; r < 16; r += 2) { const int j0 = (r & 3) + 8 * (r >> 2) + 4 * hi;
                float a0 = pt0[r], a1 = pt0[r + 1], c0 = pt1[r], c1 = pt1[r + 1];
                if (it == 0) { if (j0 > r32) a0 = 0.f; if (j0 + 1 > r32) a1 = 0.f; } else { if (j0 > r32) c0 = 0.f; if (j0 + 1 > r32) c1 = 0.f; }
                pw[q][0][r >> 1] = pk2(a0, a1); pw[q][1][r >> 1] = pk2(c0, c1); } }
        GLA_WAIT_BAR();
#pragma unroll
        for (int q = 0; q < 4; ++q) { f32x16 oo = o[q];
#pragma unroll
            for (int ks2 = 0; ks2 < 2; ++ks2) { const v4u a = {pw[q][0][4 * ks2], pw[q][0][4 * ks2 + 1], pw[q][0][4 * ks2 + 2], pw[q][0][4 * ks2 + 3]};
                oo = __builtin_amdgcn_mfma_f32_32x32x16_bf16(__builtin_bit_cast(bf16x8, a), trfrag(shm3 + q * QSTR + L_VP, ct * 4 + ks2, lane), oo, 0, 0, 0); }
            if (it == 1) {
#pragma unroll
                for (int ks2 = 0; ks2 < 2; ++ks2) { const v4u a = {pw[q][1][4 * ks2], pw[q][1][4 * ks2 + 1], pw[q][1][4 * ks2 + 2], pw[q][1][4 * ks2 + 3]};
                    oo = __builtin_amdgcn_mfma_f32_32x32x16_bf16(__builtin_bit_cast(bf16x8, a), trfrag(shm3 + q * QSTR + L_VP, ct * 4 + 2 + ks2, lane), oo, 0, 0, 0); }
            }
            o[q] = oo;
            __attribute__((address_space(3))) float* ps = (__attribute__((address_space(3))) float*)(shm3 + q * QSTR + L_PS);
#pragma unroll
            for (int r = 0; r < 16; ++r) { float v = xor16_add(row_sum16(oo[r] * oo[r]));
                if ((lane & 31) == 0) ps[(32 * it + (r & 3) + 8 * (r >> 2) + 4 * hi) * 4 + ct] = v; } }
        asm volatile("s_waitcnt lgkmcnt(0)\n\ts_barrier" ::: "memory");
        const float gv = gng[h * 128 + 32 * ct + r32];
#pragma unroll
        for (int q = 0; q < 4; ++q) { const int ch = base + q; const long t0 = (long)b * S + (ch & 63) * 64;
            const __attribute__((address_space(3))) float* ps = (const __attribute__((address_space(3))) float*)(shm3 + q * QSTR + L_PS);
#pragma unroll
            for (int r = 0; r < 16; ++r) { const int row = 32 * it + (r & 3) + 8 * (r >> 2) + 4 * hi; const long t = t0 + row;
                const f32x4 p4 = *(const __attribute__((address_space(3))) f32x4*)(ps + row * 4);
                const float rr = rsqrtf(((p4.x + p4.y) + (p4.z + p4.w)) * (1.f / 128.f) + 1e-6f);
                const float rg = bf2f(QKVY[t * QW + 1024 + h * 128 + 32 * ct + r32]);
                CAT[t * D + h * 128 + 32 * ct + r32] = (bf16)f2bf(o[q][r] * rr * gv * siluf_(rg)); } }
        asm volatile("s_waitcnt lgkmcnt(0)\n\ts_barrier" ::: "memory");
    }
}
typedef unsigned u32x4 __attribute__((ext_vector_type(4)));
constexpr int W_VP = 0, W_KP = 16384, W_AL = 24576, W_DL = 28672, WSTR = 29696;
__device__ __forceinline__ void stage_v_wave(const bf16* QKVY, long t0, int h, lds_cptr blk, int lane) {
#pragma unroll
    for (int half = 0; half < 2; ++half) { u32x4 r[8];
#pragma unroll
        for (int i = 0; i < 8; ++i) { const int p = half * 8 + i; r[i] = *(const u32x4*)(QKVY + (t0 + 16 * (p & 3) + (lane >> 2)) * QW + 512 + h * 128 + 32 * (p >> 2) + (lane & 3) * 8); }
#pragma unroll
        for (int i = 0; i < 8; ++i) { const int p = half * 8 + i; *(__attribute__((address_space(3))) u32x4*)(blk + W_VP + p * 1024 + lane * 16) = r[i]; } }
}
__device__ __forceinline__ void pass_a_w(KA args, const bf16* QKVY, const float* ALOW, bf16* QIN, bf16* KIN, float* KVT, float* DEC, char* shm, int vcu, int G, int wid, int lane) {
    if (wid >= 4) return;
    const lds_cptr blk = (lds_cptr)shm + wid * WSTR;
    __attribute__((address_space(3))) float* al = (__attribute__((address_space(3))) float*)(blk + W_AL);
    __attribute__((address_space(3))) float* dl = (__attribute__((address_space(3))) float*)(blk + W_DL);
    __attribute__((address_space(3))) bf16* kp = (__attribute__((address_space(3))) bf16*)(blk + W_KP);
    const float* gw = INP(14); const float* gb = INP(15);
    for (int ch = 4 * vcu + wid; ch < NCH; ch += 4 * G) {
        const int bh = ch >> 6, n = ch & 63, b = bh >> 2, h = bh & 3; const long t0 = (long)b * S + n * 64;
        stage_v_wave(QKVY, t0, h, blk, lane);
#pragma unroll
        for (int j = 0; j < 4; ++j) *(__attribute__((address_space(3))) f32x4*)(al + 4 * (lane + 64 * j)) = *(const f32x4*)(ALOW + t0 * 16 + 4 * (lane + 64 * j));
        float gwv[16];
#pragma unroll
        for (int r = 0; r < 16; ++r) gwv[r] = gw[r * 256 + h * 64 + lane];
        const float gbv = gb[h * 64 + lane];
        float bcum = 0.f, qn[8], kn[8];
#pragma unroll
        for (int tt = 0; tt < 8; ++tt) { qn[tt] = bf2f(QKVY[(t0 + tt) * QW + h * 64 + lane]); kn[tt] = bf2f(QKVY[(t0 + tt) * QW + 256 + h * 64 + lane]); }
        asm volatile("s_waitcnt lgkmcnt(0)" ::: "memory");
        for (int t8 = 0; t8 < 64; t8 += 8) {
            float qv[8], kv[8];
#pragma unroll
            for (int tt = 0; tt < 8; ++tt) { qv[tt] = qn[tt]; kv[tt] = kn[tt]; }
            if (t8 < 56) {
#pragma unroll
                for (int tt = 0; tt < 8; ++tt) { qn[tt] = bf2f(QKVY[(t0 + t8 + 8 + tt) * QW + h * 64 + lane]); kn[tt] = bf2f(QKVY[(t0 + t8 + 8 + tt) * QW + 256 + h * 64 + lane]); } }
#pragma unroll
            for (int tt = 0; tt < 8; ++tt) { const int tk = t8 + tt; const long t = t0 + tk; float x = gbv;
#pragma unroll
                for (int r4 = 0; r4 < 4; ++r4) { const f32x4 a4 = *(const __attribute__((address_space(3))) f32x4*)(al + tk * 16 + 4 * r4); x += a4.x * gwv[4 * r4] + a4.y * gwv[4 * r4 + 1] + a4.z * gwv[4 * r4 + 2] + a4.w * gwv[4 * r4 + 3]; }
                bcum += -softplusf_(-x) * (1.f / 16.f);
                const float qi = qv[tt] * __expf(bcum), ki = kv[tt] * __expf(-bcum);
                QIN[t * 256 + h * 64 + lane] = (bf16)f2bf(qi); const bf16 kb = (bf16)f2bf(ki); KIN[t * 256 + h * 64 + lane] = kb;
                kp[((lane >> 5) * 4 + (tk >> 4)) * 512 + (tk & 15) * 32 + (lane & 31)] = kb; }
        }
        { const float dd = __expf(bcum); dl[lane] = dd; DEC[ch * 64 + lane] = dd; }
        asm volatile("s_waitcnt lgkmcnt(0)" ::: "memory");
#pragma unroll
        for (int dt = 0; dt < 2; ++dt) { bf16x8 kf[4];
#pragma unroll
            for (int ks = 0; ks < 4; ++ks) kf[ks] = trfrag(blk + W_KP, dt * 4 + ks, lane);
            const int dcol = 32 * dt + (lane & 31); const float dsc = dl[dcol];
#pragma unroll
            for (int dvt = 0; dvt < 4; ++dvt) { f32x16 acc = {};
#pragma unroll
                for (int ks = 0; ks < 4; ++ks) acc = __builtin_amdgcn_mfma_f32_32x32x16_bf16(trfrag(blk + W_VP, dvt * 4 + ks, lane), kf[ks], acc, 0, 0, 0);
                float* kvo = KVT + ((size_t)ch * 128 + 32 * dvt) * 64 + dcol;
#pragma unroll
                for (int r = 0; r < 16; ++r) kvo[(size_t)((r & 3) + 8 * (r >> 2) + 4 * (lane >> 5)) * 64] = acc[r] * dsc; } }
        asm volatile("s_waitcnt lgkmcnt(0)" ::: "memory");
    }
}
__device__ __forceinline__ void pass_c_w(KA args, const bf16* QKVY, const bf16* QIN, const bf16* KIN, const bf16* SINT, bf16* CAT, char* shm, int vcu, int G, int wid, int lane) {
    const lds_cptr blk = (lds_cptr)shm + wid * 16384;
    const int r32 = lane & 31, hi = lane >> 5, it = wid >> 2;
    const float* gng = INP(16);
    for (int ch = 4 * vcu + (wid & 3); ch < NCH; ch += 4 * G) {
        const int bh = ch >> 6, n = ch & 63, b = bh >> 2, h = bh & 3; const long t0 = (long)b * S + n * 64;
        stage_v_wave(QKVY, t0, h, blk, lane);
        bf16x8 qf[4];
#pragma unroll
        for (int d0 = 0; d0 < 4; ++d0) qf[d0] = *(const bf16x8*)(QIN + (t0 + 32 * it + r32) * 256 + h * 64 + 16 * d0 + 8 * hi);
        unsigned short rgv[4][16];
#pragma unroll
        for (int ct = 0; ct < 4; ++ct)
#pragma unroll
            for (int r = 0; r < 16; ++r) rgv[ct][r] = QKVY[(t0 + 32 * it + (r & 3) + 8 * (r >> 2) + 4 * hi) * QW + 1024 + h * 128 + 32 * ct + r32];
        f32x16 pt0 = {}, pt1 = {};
#pragma unroll
        for (int d0 = 0; d0 < 4; ++d0) { const bf16x8 kf = *(const bf16x8*)(KIN + (t0 + r32) * 256 + h * 64 + 16 * d0 + 8 * hi);
            pt0 = __builtin_amdgcn_mfma_f32_32x32x16_bf16(kf, qf[d0], pt0, 0, 0, 0); }
        if (it == 1) {
#pragma unroll
            for (int d0 = 0; d0 < 4; ++d0) { const bf16x8 kf = *(const bf16x8*)(KIN + (t0 + 32 + r32) * 256 + h * 64 + 16 * d0 + 8 * hi);
                pt1 = __builtin_amdgcn_mfma_f32_32x32x16_bf16(kf, qf[d0], pt1, 0, 0, 0); } }
        unsigned pw[2][8];
#pragma unroll
        for (int r = 0; r < 16; r += 2) { const int j0 = (r & 3) + 8 * (r >> 2) + 4 * hi;
            float a0 = pt0[r], a1 = pt0[r + 1], c0 = pt1[r], c1 = pt1[r + 1];
            if (it == 0) { if (j0 > r32) a0 = 0.f; if (j0 + 1 > r32) a1 = 0.f; } else { if (j0 > r32) c0 = 0.f; if (j0 + 1 > r32) c1 = 0.f; }
            pw[0][r >> 1] = pk2(a0, a1); pw[1][r >> 1] = pk2(c0, c1); }
        asm volatile("s_waitcnt lgkmcnt(0)" ::: "memory");
        f32x16 o[4]; float ss[16];
#pragma unroll
        for (int r = 0; r < 16; ++r) ss[r] = 0.f;
#pragma unroll
        for (int ct = 0; ct < 4; ++ct) { f32x16 oo = {};
#pragma unroll
            for (int ks = 0; ks < 4; ++ks) { const bf16x8 sf = *(const bf16x8*)(SINT + ((size_t)ch * 128 + 32 * ct + r32) * 64 + 16 * ks + 8 * hi);
                oo = __builtin_amdgcn_mfma_f32_32x32x16_bf16(qf[ks], sf, oo, 0, 0, 0); }
#pragma unroll
            for (int ks2 = 0; ks2 < 2; ++ks2) { const v4u a = {pw[0][4 * ks2], pw[0][4 * ks2 + 1], pw[0][4 * ks2 + 2], pw[0][4 * ks2 + 3]};
                oo = __builtin_amdgcn_mfma_f32_32x32x16_bf16(__builtin_bit_cast(bf16x8, a), trfrag(blk + W_VP, ct * 4 + ks2, lane), oo, 0, 0, 0); }
            if (it == 1) {
#pragma unroll
                for (int ks2 = 0; ks2 < 2; ++ks2) { const v4u a = {pw[1][4 * ks2], pw[1][4 * ks2 + 1], pw[1][4 * ks2 + 2], pw[1][4 * ks2 + 3]};
                    oo = __builtin_amdgcn_mfma_f32_32x32x16_bf16(__builtin_bit_cast(bf16x8, a), trfrag(blk + W_VP, ct * 4 + 2 + ks2, lane), oo, 0, 0, 0); } }
            o[ct] = oo;
#pragma unroll
            for (int r = 0; r < 16; ++r) ss[r] += oo[r] * oo[r]; }
#pragma unroll
        for (int r = 0; r < 16; ++r) ss[r] = rsqrtf(xor16_add(row_sum16(ss[r])) * (1.f / 128.f) + 1e-6f);
#pragma unroll
        for (int ct = 0; ct < 4; ++ct) { const float gv = gng[h * 128 + 32 * ct + r32];
#pragma unroll
            for (int r = 0; r < 16; ++r) { const long t = t0 + 32 * it + (r & 3) + 8 * (r >> 2) + 4 * hi;
                const float rg = bf2f(rgv[ct][r]);
                CAT[t * D + h * 128 + 32 * ct + r32] = (bf16)f2bf(o[ct][r] * ss[r] * gv * siluf_(rg)); } }
        asm volatile("s_waitcnt lgkmcnt(0)" ::: "memory");
    }
}
#undef GLA_WAIT_BAR
}

__device__ __forceinline__ void dot16x2(const f32x4 (&v0)[4], const f32x4 (&v1)[4], const LAS float* tabw, int lane, float (&c0)[4], float (&c1)[4]) {
    float a[16], b[16];
#pragma unroll
    for (int e = 0; e < 16; ++e) { a[e] = 0.f; b[e] = 0.f; }
#pragma unroll
    for (int j = 0; j < 4; ++j)
#pragma unroll
        for (int q = 0; q < 4; ++q) { const float h0 = v0[j][q], h1 = v1[j][q]; const LAS float* p = tabw + ((j * 4 + q) * 64 + lane) * W16_PITCH;
#pragma unroll
            for (int k = 0; k < 4; ++k) { const f32x4 w = *(const LAS f32x4*)(p + 4 * k);
                a[4 * k] += h0 * w.x; a[4 * k + 1] += h0 * w.y; a[4 * k + 2] += h0 * w.z; a[4 * k + 3] += h0 * w.w;
                b[4 * k] += h1 * w.x; b[4 * k + 1] += h1 * w.y; b[4 * k + 2] += h1 * w.z; b[4 * k + 3] += h1 * w.w; } }
    float t8[8];
#pragma unroll
    for (int i = 0; i < 8; ++i) { auto rr = __builtin_amdgcn_permlane32_swap(__float_as_uint(a[i]), __float_as_uint(a[i + 8]), false, false); t8[i] = __uint_as_float(rr[0]) + __uint_as_float(rr[1]); }
#pragma unroll
    for (int i = 0; i < 4; ++i) { auto rr = __builtin_amdgcn_permlane16_swap(__float_as_uint(t8[i]), __float_as_uint(t8[i + 4]), false, false); c0[i] = row_sum16(__uint_as_float(rr[0]) + __uint_as_float(rr[1])); }
#pragma unroll
    for (int i = 0; i < 8; ++i) { auto rr = __builtin_amdgcn_permlane32_swap(__float_as_uint(b[i]), __float_as_uint(b[i + 8]), false, false); t8[i] = __uint_as_float(rr[0]) + __uint_as_float(rr[1]); }
#pragma unroll
    for (int i = 0; i < 4; ++i) { auto rr = __builtin_amdgcn_permlane16_swap(__float_as_uint(t8[i]), __float_as_uint(t8[i + 4]), false, false); c1[i] = row_sum16(__uint_as_float(rr[0]) + __uint_as_float(rr[1])); }
}
__device__ __forceinline__ void router_pass(KA args, Frame& F, int l, const bf16* X1, bf16* XN, int* eidx, float* ew, int* cntw, int* loc, unsigned* pcnt, unsigned pneed) {
    const float* mod = (const float*)(F.ws + WS_MOD) + (size_t)l * 4 * 6144;
    const float* rb = INP(21); const float* g = INP(5) + l * D;
    LAS float* tabw = (LAS float*)F.lds;
    LAS float* lg = (LAS float*)(F.lds + 1024 * W16_PITCH * 4);
    __syncthreads();
    TS_MARK(0);
    stage_w16(tabw, INP(20), F.tid);
    for (int chunk = F.vcu; chunk < T / 64; chunk += F.G) {
        if (F.wave == 0) { unsigned sp = 0;
            while ((unsigned)__builtin_amdgcn_readfirstlane(__hip_atomic_load(pcnt + 64 * (chunk >> 2), __ATOMIC_RELAXED, __HIP_MEMORY_SCOPE_AGENT)) < pneed) { __builtin_amdgcn_s_sleep(2); if (++sp > (1u << 20)) break; }
            __builtin_amdgcn_fence(__ATOMIC_ACQUIRE, "agent"); asm volatile("s_waitcnt vmcnt(0)" ::: "memory"); }
        __syncthreads();
        TS_MARK(1);
        const int tb = chunk * 64 + F.wave * 8, b = tb / S;
        f32x4 cA[4], cB[4];
        v2u rw[2][2][4];
#pragma unroll
        for (int p = 0; p < 2; ++p)
#pragma unroll
            for (int q = 0; q < 2; ++q) { const v2u* xp = (const v2u*)(X1 + (size_t)(tb + 2 * p + q) * D) + F.lane;
#pragma unroll
                for (int j = 0; j < 4; ++j) rw[p][q][j] = xp[64 * j]; }
        load_colvec(cA, cB, F.lane, g, mod + b * 6144 + 4096, mod + b * 6144 + 3072);
#pragma unroll
        for (int i = 0; i < 4; ++i) { const int t = tb + 2 * i;
            f32x4 v0[4], v1[4];
#pragma unroll
            for (int j = 0; j < 4; ++j) { const v2u a = rw[i & 1][0][j], c = rw[i & 1][1][j]; v0[j] = (f32x4){bflo(a.x), bfhi(a.x), bflo(a.y), bfhi(a.y)}; v1[j] = (f32x4){bflo(c.x), bfhi(c.x), bflo(c.y), bfhi(c.y)}; }
            if (i < 2) {
#pragma unroll
                for (int q = 0; q < 2; ++q) { const v2u* xp = (const v2u*)(X1 + (size_t)(t + 4 + q) * D) + F.lane;
#pragma unroll
                    for (int j = 0; j < 4; ++j) rw[i & 1][q][j] = xp[64 * j]; } }
            norm_row_pre<true>(v0, cA, cB); norm_row_pre<true>(v1, cA, cB);
            store_row_bf16(v0, F.lane, XN + (size_t)t * D); store_row_bf16(v1, F.lane, XN + (size_t)(t + 1) * D);
            float c0[4], c1[4];
            dot16x2(v0, v1, tabw, F.lane, c0, c1);
            if ((F.lane & 15) == 0) { const int r = F.lane >> 4, tl = F.wave * 8 + 2 * i;
                *(LAS f32x4*)(lg + tl * W16_PITCH + 4 * r) = (f32x4){c0[0], c0[1], c0[2], c0[3]}; *(LAS f32x4*)(lg + (tl + 1) * W16_PITCH + 4 * r) = (f32x4){c1[0], c1[1], c1[2], c1[3]}; }
        }
        __syncthreads();
        TS_MARK(2);
        if (F.wave == 0) {
            const int t = chunk * 64 + F.lane;
            float acc[16], rbv[16];
#pragma unroll
            for (int k = 0; k < 4; ++k) { const f32x4 w = *(const LAS f32x4*)(lg + F.lane * W16_PITCH + 4 * k); acc[4 * k] = w.x; acc[4 * k + 1] = w.y; acc[4 * k + 2] = w.z; acc[4 * k + 3] = w.w; }
#pragma unroll
            for (int e = 0; e < 16; ++e) rbv[e] = rb[e];
            float m = acc[0];
#pragma unroll
            for (int e = 1; e < 16; ++e) m = fmaxf(m, acc[e]);
            float sc16[16], ssum = 0.f;
#pragma unroll
            for (int e = 0; e < 16; ++e) { sc16[e] = expf(acc[e] - m); ssum += sc16[e]; }
            float sel[16];
#pragma unroll
            for (int e = 0; e < 16; ++e) { sc16[e] = sc16[e] / ssum; sel[e] = sc16[e] + rbv[e]; }
            int gi = 0; float gbest = -1e30f; int l0s[4], l1s[4];
#pragma unroll
            for (int gg = 0; gg < 4; ++gg) {
                int i0 = 0; float v0 = sel[4 * gg];
#pragma unroll
                for (int k = 1; k < 4; ++k) if (sel[4 * gg + k] > v0) { v0 = sel[4 * gg + k]; i0 = k; }
                int i1 = -1; float v1 = -1e30f;
#pragma unroll
                for (int k = 0; k < 4; ++k) if (k != i0 && sel[4 * gg + k] > v1) { v1 = sel[4 * gg + k]; i1 = k; }
                l0s[gg] = i0; l1s[gg] = i1;
                const float gs = v0 + v1; if (gs > gbest) { gbest = gs; gi = gg; }
            }
            int e0 = 0, e1 = 0;
#pragma unroll
            for (int gg = 0; gg < 4; ++gg) if (gg == gi) { e0 = 4 * gg + l0s[gg]; e1 = 4 * gg + l1s[gg]; }
            float w0 = 0.f, w1 = 0.f;
#pragma unroll
            for (int e = 0; e < 16; ++e) { if (e == e0) w0 = sc16[e]; if (e == e1) w1 = sc16[e]; }
            const float wsum = w0 + w1;
            *(int2*)(eidx + 2 * t) = make_int2(e0, e1); *(float2*)(ew + 2 * t) = make_float2(w0 / wsum, w1 / wsum);
            const unsigned long long below = (1ull << F.lane) - 1ull;
            for (int e = 0; e < 16; ++e) { const unsigned long long m0 = __ballot(e0 == e), m1 = __ballot(e1 == e); const int cc = __popcll(m0);
                if (e0 == e) loc[(chunk * 16 + e) * 64 + __popcll(m0 & below)] = 2 * t;
                if (e1 == e) loc[(chunk * 16 + e) * 64 + cc + __popcll(m1 & below)] = 2 * t + 1;
                if (F.lane == 0) cntw[chunk * 16 + e] = cc + __popcll(m1); }
        }
    }
}
__device__ __forceinline__ void chunk_publish(Frame& F, unsigned* cnt, int panel) {
    asm volatile("s_waitcnt vmcnt(0)" ::: "memory");
    __syncthreads();
    if (F.tid == 0) { __builtin_amdgcn_fence(__ATOMIC_RELEASE, "agent"); asm volatile("s_waitcnt vmcnt(0)" ::: "memory");
        __hip_atomic_fetch_add(cnt + 64 * panel, 1u, __ATOMIC_RELAXED, __HIP_MEMORY_SCOPE_AGENT); }
}
__device__ __forceinline__ void xn0_pass(KA args, Frame& F, bf16* XN, unsigned* cnt) {
    const float* mod = (const float*)(F.ws + WS_MOD);
    for (int chunk = F.vcu; chunk < T / 64; chunk += F.G) {
        const int tb = chunk * 64 + F.wave * 8, b = tb / S;
        f32x4 raw[3][4], cA[4], cB[4];
#pragma unroll
        for (int p = 0; p < 3; ++p) { const f32x4* xr = (const f32x4*)(INP(0) + (size_t)(tb + p) * D) + F.lane;
#pragma unroll
            for (int j = 0; j < 4; ++j) raw[p][j] = xr[64 * j]; }
        load_colvec(cA, cB, F.lane, INP(4), mod + b * 6144 + 1024, mod + b * 6144);
#pragma unroll
        for (int i = 0; i < 8; ++i) { const int t = tb + i; f32x4 v[4];
#pragma unroll
            for (int j = 0; j < 4; ++j) v[j] = raw[i % 3][j];
            if (i + 3 < 8) { const f32x4* xr = (const f32x4*)(INP(0) + (size_t)(t + 3) * D) + F.lane;
#pragma unroll
                for (int j = 0; j < 4; ++j) raw[i % 3][j] = xr[64 * j]; }
            norm_row_pre<true>(v, cA, cB);
            store_row_bf16(v, F.lane, XN + (size_t)t * D); }
        chunk_publish(F, cnt, chunk >> 2);
    }
}
__device__ __forceinline__ void combine_pass(KA args, Frame& F, int l, bf16* X1, const bf16* YS, bf16* XN, float* ALOW, float* out, unsigned* cnt) {
    const float* mod = (const float*)(F.ws + WS_MOD) + (size_t)l * 4 * 6144;
    const float* modn = (const float*)(F.ws + WS_MOD) + (size_t)(l + 1) * 4 * 6144;
    LAS float* tabw = (LAS float*)F.lds;
    __syncthreads();
    if (l == 0) stage_w16(tabw, (const float*)(F.ws + WS_ALOWW), F.tid);
    __syncthreads();
    for (int chunk = F.vcu; chunk < T / 64; chunk += F.G) {
      const int tb = chunk * 64 + F.wave * 8, b = tb / S;
      v2u rw[3][3][4];
#pragma unroll
      for (int p = 0; p < 3; ++p) { const v2u* x0 = (const v2u*)(X1 + (size_t)(tb + p) * D) + F.lane; const v2u* y0 = (const v2u*)(YS + (size_t)(2 * (tb + p)) * D) + F.lane;
#pragma unroll
          for (int j = 0; j < 4; ++j) { rw[p][0][j] = x0[64 * j]; rw[p][1][j] = y0[64 * j]; rw[p][2][j] = y0[64 * j + 256]; } }
      f32x4 g2v[4], cA[4], cB[4];
#pragma unroll
      for (int j = 0; j < 4; ++j) g2v[j] = *(const f32x4*)(mod + b * 6144 + 5120 + 4 * F.lane + 256 * j);
      if (l == 0) load_colvec(cA, cB, F.lane, INP(4) + D, modn + b * 6144 + 1024, modn + b * 6144); else load_colvec(cA, cB, F.lane, INP(25), nullptr, nullptr);
#pragma unroll
      for (int i = 0; i < 8; ++i) { const int t = tb + i;
        f32x4 v[4];
#pragma unroll
        for (int j = 0; j < 4; ++j) { const f32x4 g2 = g2v[j]; const v2u x = rw[i % 3][0][j], a = rw[i % 3][1][j], c = rw[i % 3][2][j];
            const f32x4 ys = {bflo(a.x) + bflo(c.x), bfhi(a.x) + bfhi(c.x), bflo(a.y) + bflo(c.y), bfhi(a.y) + bfhi(c.y)};
            v[j] = (f32x4){bflo(x.x), bfhi(x.x), bflo(x.y), bfhi(x.y)} + g2 * ys; }
        if (i + 3 < 8) { const v2u* x0 = (const v2u*)(X1 + (size_t)(t + 3) * D) + F.lane; const v2u* y0 = (const v2u*)(YS + (size_t)(2 * (t + 3)) * D) + F.lane;
#pragma unroll
            for (int j = 0; j < 4; ++j) { rw[i % 3][0][j] = x0[64 * j]; rw[i % 3][1][j] = y0[64 * j]; rw[i % 3][2][j] = y0[64 * j + 256]; } }
        if (l == 0) {
            store_row_bf16(v, F.lane, X1 + (size_t)t * D);
            norm_row_pre<true>(v, cA, cB);
            store_row_bf16(v, F.lane, XN + (size_t)t * D);
            float acc[16];
            dot16(v, tabw, F.lane, acc);
            if (F.lane == 0) {
#pragma unroll
                for (int k = 0; k < 4; ++k) *(f32x4*)(ALOW + (size_t)t * 16 + 4 * k) = (f32x4){acc[4 * k], acc[4 * k + 1], acc[4 * k + 2], acc[4 * k + 3]}; }
        } else {
            norm_row_pre<false>(v, cA, cB);
            f32x4* o = (f32x4*)(out + (size_t)t * D) + F.lane;
#pragma unroll
            for (int j = 0; j < 4; ++j) __builtin_nontemporal_store(v[j], o + 64 * j);
        }
      }
      if (cnt) chunk_publish(F, cnt, chunk >> 2);
    }
}

__global__ void __launch_bounds__(512, 2) mega_fwd(Args args_) {
    KA args = kargs();
    extern __shared__ __attribute__((aligned(16))) unsigned char lds[];
    Frame F;
    F.lds = (LAS unsigned char*)lds; F.ws = args->ws;
    F.wave = __builtin_amdgcn_readfirstlane((int)threadIdx.x >> 6); F.lane = lane_id(); F.tid = F.wave * 64 + F.lane;
    { int g_ = (int)gridDim.x, b_ = (int)blockIdx.x; asm volatile("" : "+s"(g_), "+s"(b_)); F.G = g_; F.bx = b_; F.vcu = (g_ % 8 == 0) ? (b_ % 8) * (g_ / 8) + b_ / 8 : b_; }
    unsigned char* ws = args->ws;
    for (int u = F.tid; u < (LDS_BYTES - LDSCTL_OFF) / 4; u += 512) ((LAS unsigned*)(F.lds + LDSCTL_OFF))[u] = 0u;
    __syncthreads();
    (void)xcd_barrier_post((unsigned*)(ws + WS_CTL) + CW_BAR, (volatile LAS unsigned*)(F.lds + L_MISC) + 8, F.wave);
#define MKBAR() XcdBarrier{(unsigned*)(ws + WS_CTL) + CW_BAR, xb_xcc_id(), (volatile LAS unsigned*)(F.lds + L_MISC) + 8, F.wave}
#ifndef PHMASK
#define PHMASK 0xFFFFFFFFu
#endif
#ifndef PROBE_MASK
#define PROBE_MASK 0u
#endif
#define NREP(k) ((((PROBE_MASK) >> (k)) & 1u) ? 4 : 1)
#define IN(k) ((((PHMASK) >> ((k) >= 9 ? (k) - 7 : (k))) & 1u) != 0u)
#define MIDBAR() do { xcd_barrier(MKBAR()); F.lane = lane_id(); F.tid = F.wave * 64 + F.lane; args = kargs(); ws = args->ws; F.ws = ws; { int g_ = (int)gridDim.x, b_ = (int)blockIdx.x; asm volatile("" : "+s"(g_), "+s"(b_)); F.G = g_; F.bx = b_; F.vcu = (g_ % 8 == 0) ? (b_ % 8) * (g_ / 8) + b_ / 8 : b_; } } while (0)
#define SEAM(k) do { if (IN(k) && IN((k) + 1)) { TS_PRE(SEAM_IDX(k)); xcd_barrier(MKBAR()); } F.lane = lane_id(); F.tid = F.wave * 64 + F.lane; args = kargs(); ws = args->ws; F.ws = ws; { int g_ = (int)gridDim.x, b_ = (int)blockIdx.x; asm volatile("" : "+s"(g_), "+s"(b_)); F.G = g_; F.bx = b_; F.vcu = (g_ % 8 == 0) ? (b_ % 8) * (g_ / 8) + b_ / 8 : b_; } TS_POST(SEAM_IDX(k)); } while (0)

    TS_PUT(0);
#define mod ((float*)(ws + WS_MOD))
#define XN ((bf16*)(ws + WS_XN))
#define QKVY ((bf16*)(ws + WS_QKVY))
#define YS ((bf16*)(ws + WS_QKVY))
#define CAT ((bf16*)(ws + WS_CAT))
#define ACT ((bf16*)(ws + WS_CAT))
#define X1 ((bf16*)(ws + WS_X1))
#define ALOW ((float*)(ws + WS_ALOW))
#define cntw ((int*)(ws + WS_CNTW))
#define eidx ((int*)(ws + WS_EIDX))
#define ew ((float*)(ws + WS_EW))
#define loc ((int*)(ws + WS_LOC))
    LAS int* tab = (LAS int*)(F.lds + L_NE); LAS int* rowtab = (LAS int*)(F.lds + L_ROWTAB);

    if (IN(0)) for (int rep_ = 0; rep_ < NREP(0); ++rep_) { if (rep_) MIDBAR(); p0_prologue(args, F); } SEAM(0);
#pragma unroll
    for (int l = 0; l < 2; ++l) {
        const int pb = 2 + 7 * l;
        const float* modl = mod + (size_t)l * 4 * 6144;
        if (IN(pb)) for (int rep_ = 0; rep_ < NREP(pb); ++rep_) { if (rep_) MIDBAR();
            unsigned* acnt = (unsigned*)(ws + WS_CTL) + CW_APANEL + l * 8192;
            if (l == 0) xn0_pass(args, F, XN, acnt); else combine_pass(args, F, 0, X1, YS, XN, ALOW, args->out, acnt);
            TS_MARK(8); TS_MARK1(12);
            pg8::DenseSched Sd; Sd.acnt = acnt; Sd.aneed = 4u * (unsigned)(rep_ + 1);
            if (l == 0) { Sd.init(XN, (const bf16*)(ws + WS_WIN0), T, NIN0, D, F.G, F.bx); EpiIn0 E{QKVY}; pg8::gemm_phase<EpiIn0, pg8::DenseSched, true>(F.lds, D, Sd, E, F.wave); TS_MARK(9);
                int nwg_ = (T / 256) * (NIN0 / 256), bx_ = F.bx; asm volatile("" : "+s"(nwg_), "+s"(bx_));
                const int nidle = F.G - (nwg_ - 2 * F.G), cid = bx_ - (nwg_ - 2 * F.G);
                if (nwg_ > 2 * F.G && nwg_ <= 3 * F.G) { if (cid >= 0) { __syncthreads(); p0_items(args, F, P0_NITEMS - P0_NFILL, P0_NITEMS, cid * 8 + F.wave, nidle * 8); } }
                else { __syncthreads(); p0_items(args, F, P0_NITEMS - P0_NFILL, P0_NITEMS, F.vcu * 8 + F.wave, F.G * 8); } }
            else { Sd.init(XN, (const bf16*)(ws + WS_WIN1), T, NIN1, D, F.G, F.bx); EpiIn1 E{QKVY}; pg8::gemm_phase<EpiIn1, pg8::DenseSched, true>(F.lds, D, Sd, E, F.wave); TS_MARK1(13); }
        } SEAM(pb);
        if (IN(pb + 1)) for (int rep_ = 0; rep_ < NREP(pb + 1); ++rep_) { if (rep_) MIDBAR();
            if (l == 0) {
#if defined(PROBE_CONV)
                for (int r3 = 0; r3 < 3; ++r3) { conv_phase(args, F, QKVY, CAT); __syncthreads(); }
#endif
#if defined(PROBE_SBA)
                for (int r3 = 0; r3 < 3; ++r3) { sba::phase(QKVY, CAT, (char*)lds, F.vcu, F.G, F.wave, F.lane); __syncthreads(); }
#endif
                conv_phase(args, F, QKVY, CAT); __syncthreads(); TS_MARK(10); sba::phase(QKVY, CAT, (char*)lds, F.vcu, F.G, F.wave, F.lane); }
            else {
                float* KVT = (float*)(ws + WS_XN); bf16* SINT = (bf16*)(ws + WS_WGU); bf16* QIN = SINT + (size_t)gla::NCH * 8192; bf16* KIN = QIN + (size_t)T * 256; float* DEC = (float*)(ws + WS_WD);
#ifndef PROBE_M1SUB
#define PROBE_M1SUB 0
#endif
                for (int r3 = 0; r3 < (PROBE_M1SUB == 1 ? 4 : 1); ++r3) { pool_phase(args, F, QKVY, (const bf16*)(ws + WS_WPT), CAT); __syncthreads(); }
                for (int r3 = 0; r3 < (PROBE_M1SUB == 2 ? 4 : 1); ++r3) { gla::pass_a_w(args, QKVY, ALOW, QIN, KIN, KVT, DEC, (char*)lds, F.vcu, F.G, F.wave, F.lane); __syncthreads(); }
                TS_PRE(6); MIDBAR(); TS_POST(6);
                for (int r3 = 0; r3 < (PROBE_M1SUB == 3 ? 4 : 1); ++r3) { gla::pass_b(KVT, DEC, SINT, F.vcu, F.G, F.tid); __syncthreads(); }
                TS_PRE(7); MIDBAR(); TS_POST(7);
                for (int r3 = 0; r3 < (PROBE_M1SUB == 4 ? 4 : 1); ++r3) { gla::pass_c_w(args, QKVY, QIN, KIN, SINT, CAT, (char*)lds, F.vcu, F.G, F.wave, F.lane); __syncthreads(); } }
        } SEAM(pb + 1);
        if (IN(pb + 2)) for (int rep_ = 0; rep_ < NREP(pb + 2); ++rep_) { if (rep_) MIDBAR();
            unsigned* pcnt = (unsigned*)(ws + WS_CTL) + CW_PANEL + l * 8192;
            pg8::DenseSched Sd; Sd.init(CAT, (const bf16*)(ws + (l == 0 ? WS_WOUT0 : WS_WOUT1)), T, D, D, F.G, F.bx); Sd.pcnt = pcnt;
#ifdef PROBE_TS
            if (l == 0) { EpiOut<true> E{INP(0), X1, modl + 2048, (void*)TSBUF}; pg8::gemm_phase<EpiOut<true>, pg8::DenseSched, false>(F.lds, D, Sd, E, F.wave); }
            else { EpiOut<false> E{X1, X1, modl + 2048, nullptr}; pg8::gemm_phase<EpiOut<false>, pg8::DenseSched, false>(F.lds, D, Sd, E, F.wave); }
#else
            if (l == 0) { EpiOut<true> E{INP(0), X1, modl + 2048}; pg8::gemm_phase<EpiOut<true>, pg8::DenseSched, false>(F.lds, D, Sd, E, F.wave); }
            else { EpiOut<false> E{X1, X1, modl + 2048}; pg8::gemm_phase<EpiOut<false>, pg8::DenseSched, false>(F.lds, D, Sd, E, F.wave); }
#endif
            router_pass(args, F, l, X1, XN, eidx, ew, cntw, loc, pcnt, 32u * (unsigned)(rep_ + 1));
        } SEAM(pb + 2);
        if (IN(pb + 4)) for (int rep_ = 0; rep_ < NREP(pb + 4); ++rep_) { if (rep_) MIDBAR();
            TS_MARK(4); moe_plan(F, cntw, loc, F.vcu); TS_MARK(5);
            unsigned* mcnt = (unsigned*)(ws + WS_CTL) + CW_MOECNT + l * 16384;
            { MoeSched<1> Sm{XN, (const bf16*)(ws + WS_WGU) + (size_t)l * NE * 1024 * D, D, (size_t)1024 * D * 2, tab, rowtab, mcnt, F.G, F.vcu};
              EpiM1 E{ACT, ew, rowtab};
              pg8::gemm_phase<EpiM1, MoeSched<1>, true>(F.lds, D, Sm, E, F.wave); TS_MARK(6); }
            { MoeSched<2> Sm{ACT, (const bf16*)(ws + WS_WD) + (size_t)l * NE * D * DE, DE, (size_t)D * DE * 2, tab, rowtab, mcnt, F.G, F.vcu};
              EpiM2 E{YS, rowtab};
              pg8::gemm_phase<EpiM2, MoeSched<2>, true>(F.lds, DE, Sm, E, F.wave); }
        } SEAM(pb + 4);
        if (l == 1) { if (IN(pb + 6)) { combine_pass(args, F, 1, X1, YS, XN, ALOW, args->out, nullptr); } }
    }
#ifdef PROBE_TS
    { TS_PRE(11); MIDBAR();
      if (F.bx == 0 && F.wave == 0) {
          const unsigned long long rlast = __builtin_amdgcn_s_memrealtime();
          int qq[2];
#pragma unroll
          for (int j = 0; j < 2; ++j) { const int id = j == 0 ? (PROBE_Q1) : (PROBE_Q2); int q;
              if (id == 31) q = 10;
              else { const int k = id & 15; const unsigned long long prev = (k == 0) ? TSBUF[0] : TSBUF[(2 + 2 * (k - 1)) * 256];
                  float dt;
                  if (id < 16) { const unsigned long long cur = (k == 11) ? rlast : TSBUF[(2 + 2 * k) * 256]; dt = (float)(long long)(cur - prev); }
                  else if (id >= 64) {
                      float mx = 0.f; const int mx_ = id - 80; const unsigned long long p0_ = (id >= 80) ? TSBUF[(2 + 2 * (mx_ >= 12 ? 4 : mx_ >= 10 ? 1 : mx_ >= 8 ? 0 : mx_ >= 4 ? 3 : 2)) * 256] : prev; const int slot = (id >= 80) ? 26 + (id - 80) : 1 + 2 * k;
                      for (int w = F.lane; w < F.G; w += 64) mx = fmaxf(mx, (float)(long long)(TSBUF[slot * 256 + w] - p0_));
                      for (int o = 1; o < 64; o <<= 1) mx = fmaxf(mx, __int_as_float(__builtin_amdgcn_ds_bpermute(((F.lane ^ o) & 63) << 2, __float_as_int(mx))));
                      dt = mx; }
                  else if (id >= 48) { float sacc = 0.f; const int mm_ = id - 48; const unsigned long long p2 = TSBUF[(2 + 2 * (mm_ >= 12 ? 4 : mm_ >= 10 ? 1 : mm_ >= 8 ? 0 : mm_ >= 4 ? 3 : 2)) * 256]; for (int w = F.lane; w < F.G; w += 64) sacc += (float)(long long)(TSBUF[(26 + (id - 48)) * 256 + w] - p2); dt = wave_sum(sacc) / (float)F.G; }
                  else if (id < 32) { float sacc = 0.f; for (int w = F.lane; w < F.G; w += 64) sacc += (float)(long long)(TSBUF[(1 + 2 * k) * 256 + w] - prev); dt = wave_sum(sacc) / (float)F.G; }
                  else { float sacc = 0.f, nacc = 0.f;
                      for (int w = F.lane; w < F.G; w += 64) { const int vc = (w % 8) * (F.G / 8) + w / 8; if (vc >= (PROBE_LO) && vc < (PROBE_HI)) { sacc += (float)(long long)(TSBUF[(1 + 2 * k) * 256 + w] - prev); nacc += 1.f; } }
                      dt = wave_sum(sacc) / fmaxf(wave_sum(nacc), 1.f); }
                  q = (int)(dt * (1.f / 250.f) + 0.5f); q = q < 0 ? 0 : q > 63 ? 63 : q; }
              qq[j] = __builtin_amdgcn_readfirstlane(q); }
          const unsigned long long tend = __builtin_amdgcn_s_memrealtime() + (unsigned long long)(qq[0] + 64 * qq[1]) * 1600ull;
          while (__builtin_amdgcn_s_memrealtime() < tend) __builtin_amdgcn_s_sleep(8);
      } }
#endif
#undef IN
#undef SEAM
}

extern "C" void kernel_launch(void* const* d_in, const int* in_sizes, int n_in, void* d_out, int out_size, void* d_ws, size_t ws_size, hipStream_t stream) {
    static int grid = 0;
    if (grid == 0) {
        if (n_in != 26 || out_size != T * D || ws_size < WS_END) { fprintf(stderr, "kernel_launch: unexpected shapes / workspace (%zu < %zu)\n", ws_size, (size_t)WS_END); grid = -1; return; }
        int dev = 0, cus = 0;
        if (hipGetDevice(&dev) != hipSuccess || hipDeviceGetAttribute(&cus, hipDeviceAttributeMultiprocessorCount, dev) != hipSuccess) { grid = -1; return; }
        if (hipFuncSetAttribute((const void*)mega_fwd, hipFuncAttributeMaxDynamicSharedMemorySize, LDS_BYTES) != hipSuccess) { fprintf(stderr, "kernel_launch: hipFuncSetAttribute failed\n"); grid = -1; return; }
        grid = cus;
    }
    if (grid < 0) return;
    (void)hipMemsetAsync((char*)d_ws + WS_CTL, 0, CTL_ZERO_BYTES, stream);
    Args a{};
    for (int i = 0; i < 26; ++i) a.in[i] = (const float*)d_in[i];
    a.out = (float*)d_out; a.ws = (unsigned char*)d_ws;
    hipLaunchKernelGGL(mega_fwd, dim3(grid), dim3(512), LDS_BYTES, stream, a);
}
```

```cpp
#include <hip/hip_runtime.h>
#include <cstdint>
#include <cstdio>

constexpr int D = 1024, NB = 4, S = 4096, T = NB * S, NE = 16, DE = 512;
constexpr int NIN0 = 2560, NIN1 = 2048, QW = 2048;
constexpr float QSCALE0 = 0.125f * 1.4426950408889634f;

#define GAS __attribute__((address_space(1)))
#define LAS __attribute__((address_space(3)))
typedef unsigned short bf16;
typedef unsigned v4u __attribute__((ext_vector_type(4)));
typedef unsigned v2u __attribute__((ext_vector_type(2)));
typedef float f32x4 __attribute__((ext_vector_type(4)));
typedef short bf16x8 __attribute__((ext_vector_type(8)));
typedef GAS unsigned gu32;
#define RLX_AGENT __ATOMIC_RELAXED, __HIP_MEMORY_SCOPE_AGENT
#define LDS_WAIT() asm volatile("s_waitcnt lgkmcnt(0)" ::: "memory")
#define VM_WAIT() asm volatile("s_waitcnt vmcnt(0)" ::: "memory")

__device__ __forceinline__ unsigned f2bf(float f) { unsigned u = __builtin_bit_cast(unsigned, f); return (u + 0x7fffu + ((u >> 16) & 1u)) >> 16; }
__device__ __forceinline__ unsigned pk2(float lo, float hi) { unsigned r; asm volatile("v_cvt_pk_bf16_f32 %0, %1, %2" : "=v"(r) : "v"(lo), "v"(hi)); return r; }
__device__ __forceinline__ float bflo(unsigned u) { return __uint_as_float(u << 16); }
__device__ __forceinline__ float bfhi(unsigned u) { return __uint_as_float(u & 0xffff0000u); }
__device__ __forceinline__ float bf2f(bf16 h) { return __uint_as_float((unsigned)h << 16); }
__device__ __forceinline__ int lane_id() { int l; asm volatile("v_mbcnt_lo_u32_b32 %0, -1, 0\n\tv_mbcnt_hi_u32_b32 %0, -1, %0" : "=v"(l)); return l; }
template <int CTRL> __device__ __forceinline__ float dpp_add(float v) { return v + __int_as_float(__builtin_amdgcn_update_dpp(0, __float_as_int(v), CTRL, 0xF, 0xF, false)); }
__device__ __forceinline__ float row_sum16(float v) {
    v = dpp_add<0xB1>(v); v = dpp_add<0x4E>(v); v = dpp_add<0x141>(v); v = dpp_add<0x140>(v); return v; }
__device__ __forceinline__ float rdlane(float v, int l) { return __int_as_float(__builtin_amdgcn_readlane(__float_as_int(v), l)); }
__device__ __forceinline__ float wave_sum(float v) { v = row_sum16(v); return (rdlane(v, 0) + rdlane(v, 16)) + (rdlane(v, 32) + rdlane(v, 48)); }
__device__ __forceinline__ float xor16_add(float v) { auto rr = __builtin_amdgcn_permlane16_swap(__float_as_uint(v), __float_as_uint(v), false, false); return __uint_as_float(rr[0]) + __uint_as_float(rr[1]); }
__device__ __forceinline__ int wave_sum_i(int v) { return (int)wave_sum((float)v); }
__device__ __forceinline__ int wave_scan_i(int v) { const int l = lane_id();
#pragma unroll
    for (int d = 1; d < 64; d <<= 1) { const int n = __builtin_amdgcn_ds_bpermute((l - d) << 2, v); if (l >= d) v += n; }
    return v; }
__device__ __forceinline__ float sigmoidf_(float x) { return __builtin_amdgcn_rcpf(1.f + __builtin_amdgcn_exp2f(-1.4426950408889634f * x)); }
__device__ __forceinline__ float siluf_(float x) { return x * __builtin_amdgcn_rcpf(1.f + __builtin_amdgcn_exp2f(-1.4426950408889634f * x)); }
__device__ __forceinline__ float softplusf_(float z) { return fmaxf(z, 0.f) + 0.6931471805599453f * __builtin_amdgcn_logf(1.f + __builtin_amdgcn_exp2f(-1.4426950408889634f * fabsf(z))); }

namespace pg8 {
#define PG8_LAS __attribute__((address_space(3)))
typedef unsigned short bf16_t;
typedef short bf16x8 __attribute__((ext_vector_type(8)));
typedef float f32x4 __attribute__((ext_vector_type(4)));
typedef unsigned u32x4 __attribute__((ext_vector_type(4)));
constexpr int BM = 256, BK = 64, HALF = 128, HTB = HALF * BK * 2, STAGE_BYTES = 8 * HTB, NXCD = 8, WGM = 8;

__host__ __device__ __forceinline__ int lds_byte(int r, int c) { const int st = (r >> 4) * 2 + (c >> 5), rr = r & 15, cc = c & 31, ob = rr * 64 + cc * 2; return st * 1024 + (ob ^ (((ob >> 9) & 1) << 5)); }
__host__ __device__ __forceinline__ void stage_rc(int b, int& R, int& C) { const int st = b / 1024, sb = b % 1024, swz = sb ^ (((sb >> 9) & 1) << 5); R = (st >> 1) * 16 + swz / 64; C = (st & 1) * 32 + (swz % 64) / 2; }
__host__ __device__ __forceinline__ int perm32(int rho) { const int n = rho >> 4, i = rho & 15; return 8 * (i >> 2) + 4 * n + (i & 3); }

struct Unit { int pm, pn, e, li, nr, r0; };

struct DenseSched {
    const bf16_t* A; const bf16_t* Bt; int K; int nM, nN, nwg, G, c; unsigned* pcnt = nullptr; unsigned* acnt = nullptr; unsigned aneed = 0;
    __device__ void init(const bf16_t* A_, const bf16_t* Bt_, int M, int N, int K_, int G_, int c_) { A = A_; Bt = Bt_; K = K_; nM = M / BM; nN = N / BM; nwg = nM * nN; G = G_; c = c_; }
    __device__ __forceinline__ bool next(int i, Unit& u) const {
        const long L = (long)i * G + c; if (L >= nwg) return false;
        int wgid = (int)L; { const int q = nwg / NXCD, r = nwg % NXCD, xcd = wgid % NXCD, off = wgid / NXCD; wgid = (xcd < r ? xcd * (q + 1) : r * (q + 1) + (xcd - r) * q) + off; }
        const int nig = WGM * nN, gid = wgid / nig, fm = gid * WGM, gsz = (nM - fm) < WGM ? (nM - fm) : WGM;
        u.pm = fm + ((wgid % nig) % gsz); u.pn = (wgid % nig) / gsz; u.e = 0; u.li = i; u.nr = 256; u.r0 = u.pm * BM; return true;
    }
    __device__ __forceinline__ const char* a_base(const Unit& u) const { return (const char*)A + (size_t)u.pm * BM * K * 2; }
    __device__ __forceinline__ const char* b_base(const Unit& u) const { return (const char*)Bt + (size_t)u.pn * BM * K * 2; }
    static constexpr bool GATHER = false;
    __device__ __forceinline__ void a_ready(const Unit& u, int wid, int lane) const {
        if (acnt) {
            if (wid == 0) { unsigned sp = 0;
                while ((unsigned)__builtin_amdgcn_readfirstlane(__hip_atomic_load(acnt + 64 * u.pm, __ATOMIC_RELAXED, __HIP_MEMORY_SCOPE_AGENT)) < aneed) { __builtin_amdgcn_s_sleep(2); if (++sp > (1u << 20)) break; }
                __builtin_amdgcn_fence(__ATOMIC_ACQUIRE, "agent");
                asm volatile("s_waitcnt vmcnt(0)" ::: "memory"); }
            asm volatile("" ::: "memory"); __builtin_amdgcn_s_barrier(); asm volatile("" ::: "memory");
        }
    }
    __device__ __forceinline__ void publish(int pm, int lane) const { if (pcnt && lane == 0) __hip_atomic_fetch_add(pcnt + 64 * pm, 1u, __ATOMIC_RELAXED, __HIP_MEMORY_SCOPE_AGENT); }
    __device__ __forceinline__ void a_off(const Unit&, int tid, unsigned (&v)[4]) const {
#pragma unroll
        for (int i = 0; i < 2; ++i) { int R, C; stage_rc(tid * 16 + i * 8192, R, C);
#pragma unroll
            for (int h = 0; h < 2; ++h) v[2 * h + i] = (unsigned)((h * HALF + R) * K + C) * 2u; }
    }
};

template <class Epi, class Sched, bool ALIGN_EPI>
__device__ __forceinline__ void gemm_phase(PG8_LAS unsigned char* lds, const int K, const Sched& S, const Epi& E, const int wave_id) {
    int wid_ = wave_id; asm volatile("" : "+s"(wid_));
    const int wid = wid_, lane = lane_id(), tid = wid * 64 + lane,
        wr = wid >> 2, wc = wid & 3, fr = lane & 15, fq = lane >> 4;
    const int nt = K / BK;
    unsigned voffB[2];
#pragma unroll
    for (int i = 0; i < 2; ++i) { int R, C; stage_rc(tid * 16 + i * 8192, R, C); const int Rb = Epi::PERM ? ((R & ~31) + perm32(R & 31)) : R; voffB[i] = (unsigned)(Rb * K + C) * 2u; }
    const size_t kstep = (size_t)(BK * 2);
    const size_t hstep = (size_t)HALF * K * 2;
    const unsigned ldsw = (unsigned)wid * 1024u;
    const int aoff = lds_byte(wr * 64 + fr, fq * 8), boff = lds_byte(wc * 32 + fr, fq * 8);
#define PG8_SA(b, h) (((b) * 2 + (h)) * HTB)
#define PG8_SB(b, h) ((4 + (b) * 2 + (h)) * HTB)
#define PG8_STAGE2(bufoff, gbase, o0, o1) do { \
        __builtin_amdgcn_global_load_lds((const unsigned*)((const char*)(gbase) + (o0)), (PG8_LAS unsigned*)(lds + (bufoff) + ldsw), 16, 0, 0); \
        __builtin_amdgcn_global_load_lds((const unsigned*)((const char*)(gbase) + (o1)), (PG8_LAS unsigned*)(lds + (bufoff) + ldsw + 8192), 16, 0, 0); } while (0)
#define PG8_STAGEB(bufoff, gbase) PG8_STAGE2(bufoff, gbase, voffB[0], voffB[1])
#define PG8_LDA(dst, b, h) do { _Pragma("unroll") for (int m = 0; m < 4; ++m) _Pragma("unroll") for (int k = 0; k < 2; ++k) dst[m][k] = *(const PG8_LAS bf16x8*)(lds + PG8_SA(b, h) + aoff + m * 2048 + k * 1024); } while (0)
#define PG8_LDB(dst, b, h) do { _Pragma("unroll") for (int n = 0; n < 2; ++n) _Pragma("unroll") for (int k = 0; k < 2; ++k) dst[n][k] = *(const PG8_LAS bf16x8*)(lds + PG8_SB(b, h) + boff + n * 2048 + k * 1024); } while (0)
#define PG8_MMA(ai, bj, At, Bt) do { __builtin_amdgcn_s_setprio(1); _Pragma("unroll") for (int m = 0; m < 4; ++m) _Pragma("unroll") for (int n = 0; n < 2; ++n) _Pragma("unroll") for (int k = 0; k < 2; ++k) \
        acc[ai][bj][m][n] = __builtin_amdgcn_mfma_f32_16x16x32_bf16(Bt[n][k], At[m][k], acc[ai][bj][m][n], 0, 0, 0); __builtin_amdgcn_s_setprio(0); } while (0)
#define PG8_WAIT_V(n) asm volatile("s_waitcnt vmcnt(" #n ")" ::: "memory")
#define PG8_WAIT_V8_UNLESS(p) do { int pp_ = __builtin_amdgcn_readfirstlane(p); asm volatile("s_cmp_lt_i32 %0, 0\n\ts_cbranch_scc0 .Lpg8skip_%=\n\ts_waitcnt vmcnt(8)\n.Lpg8skip_%=:" : "+s"(pp_) :: "memory", "scc"); } while (0)
#define PG8_WAIT_L(n) asm volatile("s_waitcnt lgkmcnt(" #n ")" ::: "memory")
#define PG8_BAR __builtin_amdgcn_s_barrier()
#define PG8_SCHED __builtin_amdgcn_sched_barrier(0)
    Unit cur, nxt; int ui = 0;
    if (!S.next(0, cur)) return;
    f32x4 acc[2][2][4][2];
#pragma unroll
    for (int a = 0; a < 2; ++a)
#pragma unroll
        for (int b = 0; b < 2; ++b)
#pragma unroll
            for (int m = 0; m < 4; ++m)
#pragma unroll
                for (int n = 0; n < 2; ++n) acc[a][b][m][n] = (f32x4){0.f, 0.f, 0.f, 0.f};
    bf16x8 At[4][2], B0[2][2], B1[2][2];
    unsigned vc[4];
    S.a_ready(cur, wid, lane);
    S.a_off(cur, tid, vc);
    const char* cA = S.a_base(cur); const char* cB = S.b_base(cur);
    E.prefetch(cur, tid, (PG8_LAS unsigned*)(lds + STAGE_BYTES + 1024 + wid * 256));
    PG8_STAGEB(PG8_SB(0, 0), cB); PG8_STAGEB(PG8_SB(0, 1), cB + hstep); PG8_STAGE2(PG8_SA(0, 0), cA, vc[0], vc[1]); PG8_STAGE2(PG8_SA(0, 1), cA, vc[2], vc[3]);
    if (wr == 1) PG8_BAR;
    PG8_WAIT_V(2); PG8_BAR;
    PG8_STAGEB(PG8_SB(1, 0), cB + kstep); PG8_STAGE2(PG8_SA(1, 0), cA + kstep, vc[0], vc[1]); PG8_STAGEB(PG8_SB(1, 1), cB + hstep + kstep);
    PG8_WAIT_V(6); PG8_BAR;
    int pend = -1;
    for (;;) {
        const bool has_next = S.next(ui + 1, nxt);
        const char* nA = cA; const char* nB = cB;
        if (has_next) { nA = S.a_base(nxt); nB = S.b_base(nxt); }
        for (int t = 0; t < nt; t += 2) {
            const bool last = (t == nt - 2);
            if (last && has_next) S.a_ready(nxt, wid, lane);
            const char* a1 = cA + (size_t)(t + 1) * kstep;
            const char* a2 = last ? nA : cA + (size_t)(t + 2) * kstep; const char* b2 = last ? nB : cB + (size_t)(t + 2) * kstep;
            const char* a3 = a2 + kstep; const char* b3 = b2 + kstep;
            PG8_LDB(B0, 0, 0); PG8_LDB(B1, 0, 1); PG8_SCHED; PG8_LDA(At, 0, 0); PG8_STAGE2(PG8_SA(1, 1), a1, vc[2], vc[3]);
            if constexpr (Sched::GATHER) { if (last && has_next) S.a_off(nxt, tid, vc); }
            PG8_WAIT_V8_UNLESS(pend);
            PG8_WAIT_L(0); PG8_BAR; PG8_MMA(0, 0, At, B0); PG8_MMA(0, 1, At, B1); PG8_BAR; PG8_SCHED;
            PG8_LDA(At, 0, 1); PG8_STAGEB(PG8_SB(0, 0), b2); PG8_STAGEB(PG8_SB(0, 1), b2 + hstep); PG8_STAGE2(PG8_SA(0, 0), a2, vc[0], vc[1]);
            PG8_WAIT_V8_UNLESS(pend);
            PG8_WAIT_L(0); PG8_BAR; PG8_MMA(1, 0, At, B0); PG8_MMA(1, 1, At, B1); PG8_BAR; PG8_SCHED;
            PG8_LDB(B0, 1, 0); PG8_LDB(B1, 1, 1); PG8_SCHED; PG8_LDA(At, 1, 0); PG8_STAGE2(PG8_SA(0, 1), a2, vc[2], vc[3]);
            PG8_WAIT_V8_UNLESS(pend);
            PG8_WAIT_L(0); PG8_BAR; PG8_MMA(0, 0, At, B0); PG8_MMA(0, 1, At, B1); PG8_BAR; PG8_SCHED;
            PG8_LDA(At, 1, 1); PG8_STAGEB(PG8_SB(1, 0), b3); PG8_STAGEB(PG8_SB(1, 1), b3 + hstep); PG8_STAGE2(PG8_SA(1, 0), a3, vc[0], vc[1]);
            PG8_WAIT_V(8);
            if (pend >= 0) { S.publish(pend, lane); pend = -1; }
            PG8_WAIT_L(0); PG8_BAR; PG8_MMA(1, 0, At, B0); PG8_MMA(1, 1, At, B1); PG8_BAR; PG8_SCHED;
        }
        PG8_WAIT_V(0);
        if constexpr (ALIGN_EPI) { if (wr == 0) PG8_BAR; }
        E(acc, cur, wr, wc, fr, fq);
        pend = __builtin_amdgcn_readfirstlane(cur.pm);
        if (!has_next) break;
#pragma unroll
        for (int a = 0; a < 2; ++a)
#pragma unroll
            for (int b = 0; b < 2; ++b)
#pragma unroll
                for (int m = 0; m < 4; ++m)
#pragma unroll
                    for (int n = 0; n < 2; ++n) acc[a][b][m][n] = (f32x4){0.f, 0.f, 0.f, 0.f};
        cur = nxt; cA = nA; cB = nB; ++ui;
        if constexpr (ALIGN_EPI) { if (wr == 1) PG8_BAR; }
    }
    PG8_WAIT_V(0);
    if (pend >= 0) S.publish(pend, lane);
    if constexpr (!ALIGN_EPI) { if (wr == 0) PG8_BAR; }
    PG8_BAR;
#undef PG8_SA
#undef PG8_SB
#undef PG8_STAGE2
#undef PG8_STAGEB
#undef PG8_LDA
#undef PG8_LDB
#undef PG8_MMA
#undef PG8_WAIT_V
#undef PG8_WAIT_L
#undef PG8_WAIT_V8_UNLESS
#undef PG8_BAR
#undef PG8_SCHED
}
}

constexpr size_t MiB = 1u << 20;
constexpr size_t WS_CTL = 0, CTL_ZERO_BYTES = 1 * MiB;
constexpr size_t WS_MOD = 1 * MiB;
constexpr size_t WS_ALOWW = WS_MOD + 256 * 1024;
constexpr size_t WS_CNTW = WS_ALOWW + 64 * 1024;
constexpr size_t WS_EIDX = WS_CNTW + 16 * 1024;
constexpr size_t WS_EW = WS_EIDX + (size_t)2 * T * 4;
constexpr size_t WS_LOC = WS_EW + (size_t)2 * T * 4;
constexpr size_t WS_ALOW = WS_LOC + 1 * MiB;
constexpr size_t WS_WPT = WS_ALOW + 1 * MiB;
constexpr size_t WS_WIN0 = 5 * MiB;
constexpr size_t WS_WOUT0 = WS_WIN0 + (size_t)NIN0 * D * 2;
constexpr size_t WS_WIN1 = WS_WOUT0 + (size_t)D * D * 2;
constexpr size_t WS_WOUT1 = WS_WIN1 + (size_t)NIN1 * D * 2;
constexpr size_t WS_WGU = WS_WOUT1 + (size_t)D * D * 2;
constexpr size_t WS_WD = WS_WGU + (size_t)2 * NE * 1024 * D * 2;
constexpr size_t WS_X1 = WS_WD + (size_t)2 * NE * D * DE * 2;
constexpr size_t WS_XN = WS_X1 + (size_t)T * D * 2;
constexpr size_t WS_QKVY = WS_XN + (size_t)T * D * 2;
constexpr size_t WS_CAT = WS_QKVY + (size_t)T * QW * 2;
constexpr size_t WS_END = WS_CAT + (size_t)(2 * T + 256) * DE * 2;
static_assert(WS_WPT + 128 * 1024 <= WS_WIN0, "small tables fit below the weights");
static_assert(WS_END <= 346000000, "workspace budget");
constexpr int CW_BAR = 4096;
constexpr int CW_APANEL = 98304;
constexpr int CW_PANEL = 65536;

constexpr int RING_BYTES = 131072;
constexpr int LDSCTL_OFF = RING_BYTES;
constexpr int L_MISC = LDSCTL_OFF;
constexpr int L_NE = L_MISC + 256;
constexpr int L_ROWTAB = L_NE + 512;
constexpr int LDS_BYTES = 147456;
static_assert(L_ROWTAB + 8192 <= LDS_BYTES, "LDS map");

#define XB_TMO      128
#define XB_XCNT(j)  (256  + 64 * (j))
#define XB_XSUB(j)  (1280 + 64 * (j))
#define XB_XGEN(j)  (2304 + 64 * (j))
#define XB_TOP      3328
#define XB_TOPGEN   3392
#define XCD_BAR_WORDS 3456
#define XB_SPIN_CAP (1u << 18)
__device__ __forceinline__ unsigned xb_ld(unsigned* p)              { return __hip_atomic_load(p, __ATOMIC_RELAXED, __HIP_MEMORY_SCOPE_AGENT); }
__device__ __forceinline__ unsigned xb_add(unsigned* p, unsigned v) { return __hip_atomic_fetch_add(p, v, __ATOMIC_RELAXED, __HIP_MEMORY_SCOPE_AGENT); }
__device__ __forceinline__ unsigned xb_xcc_id() { return (unsigned)__builtin_amdgcn_s_getreg((3 << 11) | 20) & 0xFu; }
#define XB_SPIN(cond, bar) do { unsigned _sp = 0; while (cond) { __builtin_amdgcn_s_sleep(1); \
    if ((++_sp & 255u) == 0u) { if (xb_ld(&(bar)[XB_TMO])) break; if (_sp > XB_SPIN_CAP) { atomicAdd(&(bar)[XB_TMO], 1u); break; } } } } while (0)
struct XcdBarrier { unsigned* bar; unsigned x; volatile LAS unsigned* st; int wave; };
__device__ __forceinline__ XcdBarrier xcd_barrier_post(unsigned* bar, volatile LAS unsigned* st, int wave) {
    XcdBarrier b; b.bar = bar; b.x = xb_xcc_id(); b.st = st; b.wave = wave;
    if (wave == 0 && lane_id() == 0) (void)xb_add(&bar[XB_XCNT(b.x)], 1u);
    return b;
}
__device__ __forceinline__ void xcd_barrier_complete(unsigned* bar, unsigned x, unsigned& nloc, unsigned& nx) {
    const unsigned G = gridDim.x * gridDim.y * gridDim.z;
    unsigned sum, cnt, mine, sp = 0u;
    for (;;) {
        sum = 0u; cnt = 0u; mine = 0u;
#pragma unroll
        for (unsigned j = 0; j < 16; ++j) { const unsigned c = xb_ld(&bar[XB_XCNT(j)]); sum += c; cnt += (c > 0u) ? 1u : 0u; mine = (j == x) ? c : mine; }
        if (sum == G) break;
        __builtin_amdgcn_s_sleep(1);
        if ((++sp & 255u) == 0u) { if (xb_ld(&bar[XB_TMO])) break; if (sp > XB_SPIN_CAP) { atomicAdd(&bar[XB_TMO], 1u); break; } }
    }
    nloc = mine > 0u ? mine : 1u; nx = cnt > 0u ? cnt : 1u;
}
__device__ __forceinline__ void xcd_barrier(const XcdBarrier& b) {
    asm volatile("s_waitcnt vmcnt(0)" ::: "memory");
    __syncthreads();
    if (b.wave == 0 && lane_id() == 0) {
        unsigned* bar = b.bar;
        __builtin_amdgcn_s_waitcnt(0);
        unsigned nloc = b.st[0], nx = b.st[1];
        if (nloc == 0u) { xcd_barrier_complete(bar, b.x, nloc, nx); b.st[0] = nloc; b.st[1] = nx; }
        const unsigned old = xb_add(&bar[XB_XSUB(b.x)], 1u);
        const unsigned gen = old / nloc;
        if (old + 1u == (gen + 1u) * nloc) {
            __builtin_amdgcn_fence(__ATOMIC_RELEASE, "agent");
            asm volatile("s_waitcnt vmcnt(0)" ::: "memory");
            const unsigned og = xb_add(&bar[XB_TOP], 1u);
            const unsigned tg = og / nx;
            if (og + 1u == (tg + 1u) * nx) xb_add(&bar[XB_TOPGEN], 1u);
            else XB_SPIN(xb_ld(&bar[XB_TOPGEN]) == tg, bar);
            __builtin_amdgcn_fence(__ATOMIC_ACQUIRE, "agent");
            xb_add(&bar[XB_XGEN(b.x)], 1u);
            asm volatile("s_waitcnt vmcnt(0)" ::: "memory");
        } else {
            XB_SPIN(xb_ld(&bar[XB_XGEN(b.x)]) == gen, bar);
            __builtin_amdgcn_fence(__ATOMIC_ACQUIRE, "agent");
            asm volatile("s_waitcnt vmcnt(0)" ::: "memory");
        }
    }
    __syncthreads();
}

struct Args { const float* in[26]; float* out; unsigned char* ws; };
struct Frame {
    LAS unsigned char* lds; unsigned char* ws;
    int tid, lane, wave, vcu, G, bx;
};
typedef const __attribute__((address_space(4))) Args* KA;
__device__ __forceinline__ KA kargs() { auto p = __builtin_amdgcn_kernarg_segment_ptr(); asm volatile("" : "+s"(p)); return (KA)p; }
#define INP(k) (args->in[k])

struct P0Item { const float* s; bf16* d; int ldw, Kd; };
__device__ __forceinline__ void p0_load(const P0Item& it, float (&r)[32], int lane) {
#pragma unroll
    for (int i = 0; i < 32; ++i) r[i] = __builtin_nontemporal_load(it.s + (size_t)(2 * i + (lane >> 5)) * it.ldw + (lane & 31));
}
__device__ __forceinline__ void p0_store(const P0Item& it, const float (&r)[32], LAS float* scr, int lane) {
#pragma unroll
    for (int i = 0; i < 32; ++i) scr[(2 * i + (lane >> 5)) * 33 + (lane & 31)] = r[i];
    LDS_WAIT(); asm volatile("" ::: "memory");
    const int c = lane & 7;
#pragma unroll
    for (int j = 0; j < 4; ++j) { const int n = (lane >> 3) + 8 * j; const LAS float* sp = scr + (8 * c) * 33 + n;
        v4u o; o.x = pk2(sp[0 * 33], sp[1 * 33]); o.y = pk2(sp[2 * 33], sp[3 * 33]); o.z = pk2(sp[4 * 33], sp[5 * 33]); o.w = pk2(sp[6 * 33], sp[7 * 33]);
        __builtin_nontemporal_store(o, (GAS v4u*)(it.d + (size_t)n * it.Kd + 8 * c)); }
    LDS_WAIT(); asm volatile("" ::: "memory");
}
template <class DMap>
__device__ __forceinline__ P0Item p0_matrix(const float* W, int ldw, int K, int scol0, int ncols, bf16* WT, const DMap& dmap, int it) {
    const int nblk = ncols / 32, kb = it / nblk, nb = it % nblk, n0 = 32 * nb;
    return P0Item{W + (size_t)(64 * kb) * ldw + scol0 + n0, WT + (size_t)(dmap(n0 >> 7) + (n0 & 127)) * K + 64 * kb, ldw, K};
}
struct MapId { int base; __device__ int operator()(int g) const { return base + 128 * g; } };
struct MapGlu { int second; __device__ int operator()(int g) const { return 256 * g + second; } };

constexpr int P0_I_IN0A = 16 * 16, P0_I_IN0Q = 16 * 48, P0_I_OUT = 16 * 32, P0_I_IN1A = 16 * 48, P0_I_IN1P = 16 * 16, P0_I_G = 16 * 16, P0_I_D = 8 * 32;
constexpr int P0_I_MOE = 2 * P0_I_G + P0_I_D;
constexpr int P0_I_PW = 4 * 8;
constexpr int P0_NITEMS = 2 * P0_I_IN0A + P0_I_IN0Q + 2 * P0_I_OUT + P0_I_IN1A + P0_I_IN1P + P0_I_PW + 32 * P0_I_MOE;
constexpr int P0_NFILL = 8 * P0_I_MOE;
__device__ __forceinline__ void p0_items(KA args, Frame& F, int first, int last, int widx, int nw) {
    LAS float* scr = (LAS float*)(F.lds + F.wave * 16384);
    auto decode = [&](int it) -> P0Item {
        KA args = kargs();
        unsigned char* ws = args->ws;
        bf16* win0 = (bf16*)(ws + WS_WIN0); bf16* wout0 = (bf16*)(ws + WS_WOUT0); bf16* win1 = (bf16*)(ws + WS_WIN1); bf16* wout1 = (bf16*)(ws + WS_WOUT1);
        int r = it;
        if (r < P0_I_IN0A) return p0_matrix(INP(6), NIN0, D, 0, 512, win0, MapGlu{0}, r); r -= P0_I_IN0A;
        if (r < P0_I_IN0A) return p0_matrix(INP(6), NIN0, D, 512, 512, win0, MapGlu{128}, r); r -= P0_I_IN0A;
        if (r < P0_I_IN0Q) return p0_matrix(INP(6), NIN0, D, 1024, 1536, win0, MapId{1024}, r); r -= P0_I_IN0Q;
        if (r < P0_I_OUT) return p0_matrix(INP(7), D, D, 0, 1024, wout0, MapId{0}, r); r -= P0_I_OUT;
        if (r < P0_I_IN1A) return p0_matrix(INP(12), 2064, D, 0, 1536, win1, MapId{0}, r); r -= P0_I_IN1A;
        if (r < P0_I_IN1P) return p0_matrix(INP(12), 2064, D, 1552, 512, win1, MapId{1536}, r); r -= P0_I_IN1P;
        if (r < P0_I_OUT) return p0_matrix(INP(13), D, D, 0, 1024, wout1, MapId{0}, r); r -= P0_I_OUT;
        if (r < P0_I_PW) { const int g = r >> 3; return p0_matrix(INP(17) + (size_t)g * 128 * 128, 128, 128, 0, 128, (bf16*)(ws + WS_WPT) + (size_t)g * 128 * 128, MapId{0}, r & 7); } r -= P0_I_PW;
        const int le = r / P0_I_MOE; r -= le * P0_I_MOE;
        bf16* wgu = (bf16*)(ws + WS_WGU) + (size_t)le * 1024 * D; bf16* wd = (bf16*)(ws + WS_WD) + (size_t)le * D * DE;
        if (r < P0_I_G) return p0_matrix(INP(22) + (size_t)le * D * DE, DE, D, 0, 512, wgu, MapGlu{0}, r); r -= P0_I_G;
        if (r < P0_I_G) return p0_matrix(INP(23) + (size_t)le * D * DE, DE, D, 0, 512, wgu, MapGlu{128}, r); r -= P0_I_G;
        return p0_matrix(INP(24) + (size_t)le * DE * D, D, DE, 0, 1024, wd, MapId{0}, r);
    };
    const int i0 = first + widx;
    if (i0 < last) {
        P0Item cur = decode(i0); float rc[32]; p0_load(cur, rc, F.lane);
        for (int it = i0; it < last; it += nw) {
            P0Item nx = cur; float rn[32];
            if (it + nw < last) { nx = decode(it + nw); p0_load(nx, rn, F.lane); }
            p0_store(cur, rc, scr, F.lane);
            if (it + nw < last) { cur = nx;
#pragma unroll
                for (int i = 0; i < 32; ++i) rc[i] = rn[i]; }
        }
    }
}
__device__ __forceinline__ void p0_prologue(KA args, Frame& F) {
    unsigned char* ws = F.ws;
    if (F.vcu < 192) {
        LAS float* cs = (LAS float*)F.lds;
        LAS float* part = (LAS float*)(F.lds + 16384);
        const float* c = INP(1);
        for (int i = F.tid; i < 4096; i += 512) cs[i] = siluf_(c[i]);
        __syncthreads();
        const int l = F.vcu / 96, cg = F.vcu % 96;
        const float* wp = INP(2) + (size_t)l * 1024 * 6144 + 64 * cg + F.lane;
        float a0 = 0.f, a1 = 0.f, a2 = 0.f, a3 = 0.f;
#pragma unroll 16
        for (int kk = 0; kk < 128; ++kk) { const int k = 128 * F.wave + kk; const float wv = __builtin_nontemporal_load(wp + (size_t)k * 6144);
            a0 += cs[k] * wv; a1 += cs[1024 + k] * wv; a2 += cs[2048 + k] * wv; a3 += cs[3072 + k] * wv; }
        part[(F.wave * 4 + 0) * 64 + F.lane] = a0; part[(F.wave * 4 + 1) * 64 + F.lane] = a1; part[(F.wave * 4 + 2) * 64 + F.lane] = a2; part[(F.wave * 4 + 3) * 64 + F.lane] = a3;
        __syncthreads();
        float* mod = (float*)(ws + WS_MOD);
        if (F.tid < 256) { const int b = F.tid >> 6, col = F.tid & 63; float sm = INP(3)[l * 6144 + 64 * cg + col];
#pragma unroll
            for (int w = 0; w < 8; ++w) sm += part[(w * 4 + b) * 64 + col];
            mod[(l * 4 + b) * 6144 + 64 * cg + col] = sm; }
        __syncthreads();
    }
    { float* aw = (float*)(ws + WS_ALOWW); const float* w1 = INP(12);
      for (int i = F.vcu * 512 + F.tid; i < 1024 * 16; i += F.G * 512) aw[i] = w1[(size_t)(i >> 4) * 2064 + 1536 + (i & 15)]; }
    p0_items(args, F, 0, P0_NITEMS - P0_NFILL, F.vcu * 8 + F.wave, F.G * 8);
}

#ifdef PROBE_TS
#define TS_RAW(m) do { if (threadIdx.x == 0) ((unsigned long long*)(args->ws + 524288))[(26 + (m)) * 256 + blockIdx.x] = __builtin_amdgcn_s_memrealtime(); } while (0)
#else
#define TS_RAW(m) do {} while (0)
#endif
#ifdef PROBE_TS
#ifndef PROBE_LO
#define PROBE_LO 0
#define PROBE_HI 256
#endif
#define TSBUF ((unsigned long long*)(ws + WS_CTL + 524288))
#define TS_PUT(slot) do { if (F.tid == 0) TSBUF[(slot) * 256 + F.bx] = __builtin_amdgcn_s_memrealtime(); } while (0)
#define TS_PRE(idx) do { __syncthreads(); TS_PUT(1 + 2 * (idx)); } while (0)
#define TS_MARK(m) do { if (l == 0) { unsigned char* ws = F.ws; TS_PUT(26 + (m)); } } while (0)
#define TS_MARK1(m) do { if (l == 1) { unsigned char* ws = F.ws; TS_PUT(26 + (m)); } } while (0)
#define TS_POST(idx) TS_PUT(2 + 2 * (idx))
#define SEAM_IDX(k) ((k) == 0 ? 0 : (k) <= 4 ? (k) - 1 : (k) == 6 ? 4 : (k) == 9 ? 5 : (k) == 10 ? 8 : (k) == 11 ? 9 : 10)
#else
#define TS_PUT(slot) do {} while (0)
#define TS_MARK(m) do {} while (0)
#define TS_MARK1(m) do {} while (0)
#define TS_PRE(idx) do {} while (0)
#define TS_POST(idx) do {} while (0)
#define SEAM_IDX(k) 0
#endif
__device__ __forceinline__ void norm_row(f32x4 (&v)[4], int lane, const float* g, const float* sc, const float* sh) {
    float s = 0.f;
#pragma unroll
    for (int j = 0; j < 4; ++j) s += (v[j].x * v[j].x + v[j].y * v[j].y) + (v[j].z * v[j].z + v[j].w * v[j].w);
    const float r = rsqrtf(wave_sum(s) * (1.f / D) + 1e-6f);
#pragma unroll
    for (int j = 0; j < 4; ++j) { const int c = 4 * lane + 256 * j; const f32x4 gg = *(const f32x4*)(g + c);
        v[j] = v[j] * r * gg;
        if (sc) { const f32x4 s1 = *(const f32x4*)(sc + c), s0 = *(const f32x4*)(sh + c); v[j] = v[j] * (1.f + s1) + s0; } }
}
template <bool SHIFT> __device__ __forceinline__ void norm_row_pre(f32x4 (&v)[4], const f32x4 (&A)[4], const f32x4 (&Bv)[4]) {
    float s = 0.f;
#pragma unroll
    for (int j = 0; j < 4; ++j) s += (v[j].x * v[j].x + v[j].y * v[j].y) + (v[j].z * v[j].z + v[j].w * v[j].w);
    const float r = rsqrtf(wave_sum(s) * (1.f / D) + 1e-6f);
#pragma unroll
    for (int j = 0; j < 4; ++j) { v[j] = v[j] * r * A[j]; if (SHIFT) v[j] = v[j] + Bv[j]; }
}
__device__ __forceinline__ void load_colvec(f32x4 (&A)[4], f32x4 (&Bv)[4], int lane, const float* g, const float* sc, const float* sh) {
#pragma unroll
    for (int j = 0; j < 4; ++j) { const int c = 4 * lane + 256 * j; const f32x4 gg = *(const f32x4*)(g + c);
        if (sc) { const f32x4 s1 = *(const f32x4*)(sc + c); A[j] = gg * (1.f + s1); Bv[j] = *(const f32x4*)(sh + c); } else { A[j] = gg; Bv[j] = (f32x4){0.f, 0.f, 0.f, 0.f}; } }
}
__device__ __forceinline__ void store_row_bf16(const f32x4 (&v)[4], int lane, bf16* orow) {
    GAS v2u* o = (GAS v2u*)orow + lane;
#pragma unroll
    for (int j = 0; j < 4; ++j) { v2u w; w.x = pk2(v[j].x, v[j].y); w.y = pk2(v[j].z, v[j].w); o[64 * j] = w; }
}


__device__ __forceinline__ void load_row_bf16(const bf16* row, int lane, f32x4 (&v)[4]) {
    const GAS v2u* p = (const GAS v2u*)row + lane;
#pragma unroll
    for (int j = 0; j < 4; ++j) { const v2u w = p[64 * j]; v[j] = (f32x4){bflo(w.x), bfhi(w.x), bflo(w.y), bfhi(w.y)}; }
}
constexpr int W16_PITCH = 20;
__device__ __forceinline__ void stage_w16(LAS float* tabw, const float* w, int tid) {
    f32x4 v[8];
#pragma unroll
    for (int u = 0; u < 8; ++u) { const int i = tid + 512 * u; v[u] = *(const f32x4*)(w + (i >> 2) * 16 + 4 * (i & 3)); }
#pragma unroll
    for (int u = 0; u < 8; ++u) { const int i = tid + 512 * u, c = i >> 2, k4 = i & 3;
        const int sidx = ((c >> 8) * 4 + (c & 3)) * 64 + ((c >> 2) & 63); *(LAS f32x4*)(tabw + sidx * W16_PITCH + 4 * k4) = v[u]; }
}
__device__ __forceinline__ void dot16(const f32x4 (&v)[4], const LAS float* tabw, int lane, float (&lg)[16]) {
    float a[16];
#pragma unroll
    for (int e = 0; e < 16; ++e) a[e] = 0.f;
#pragma unroll
    for (int j = 0; j < 4; ++j)
#pragma unroll
        for (int q = 0; q < 4; ++q) { const float hv = v[j][q]; const LAS float* p = tabw + ((j * 4 + q) * 64 + lane) * W16_PITCH;
#pragma unroll
            for (int k = 0; k < 4; ++k) { const f32x4 w = *(const LAS f32x4*)(p + 4 * k); a[4 * k] += hv * w.x; a[4 * k + 1] += hv * w.y; a[4 * k + 2] += hv * w.z; a[4 * k + 3] += hv * w.w; } }
    float b[8], c[4];
#pragma unroll
    for (int i = 0; i < 8; ++i) { auto rr = __builtin_amdgcn_permlane32_swap(__float_as_uint(a[i]), __float_as_uint(a[i + 8]), false, false); b[i] = __uint_as_float(rr[0]) + __uint_as_float(rr[1]); }
#pragma unroll
    for (int i = 0; i < 4; ++i) { auto rr = __builtin_amdgcn_permlane16_swap(__float_as_uint(b[i]), __float_as_uint(b[i + 4]), false, false); c[i] = row_sum16(__uint_as_float(rr[0]) + __uint_as_float(rr[1])); }
#pragma unroll
    for (int e = 0; e < 16; ++e) lg[e] = rdlane(c[e & 3], 16 * (e >> 2));
}

__device__ __forceinline__ void store16_wt(void* p, v4u v) { asm volatile("global_store_dwordx4 %0, %1, off sc1\n\ts_nop 1" :: "v"(p), "v"(v) : "memory"); }

struct EpiIn0 {
    static constexpr bool PERM = true;
    __device__ __forceinline__ void prefetch(const pg8::Unit&, int, LAS unsigned*) const {}
    bf16* O;
    __device__ __forceinline__ void operator()(const f32x4 (&acc)[2][2][4][2], const pg8::Unit& u, int wr, int wc, int fr, int fq) const {
        const int row0 = u.pm * 256 + wr * 64 + fr;
        if (u.pn < 4) {
            const int col0 = u.pn * 128 + wc * 32 + 8 * fq;
#pragma unroll
            for (int ai = 0; ai < 2; ++ai)
#pragma unroll
                for (int m = 0; m < 4; ++m) { bf16* rowp = O + (size_t)(row0 + ai * 128 + m * 16) * QW + col0;
                    const f32x4 a0 = acc[ai][0][m][0], a1 = acc[ai][0][m][1], g0 = acc[ai][1][m][0], g1 = acc[ai][1][m][1];
                    v4u w; w.x = pk2(a0[0] * sigmoidf_(g0[0]), a0[1] * sigmoidf_(g0[1])); w.y = pk2(a0[2] * sigmoidf_(g0[2]), a0[3] * sigmoidf_(g0[3]));
                    w.z = pk2(a1[0] * sigmoidf_(g1[0]), a1[1] * sigmoidf_(g1[1])); w.w = pk2(a1[2] * sigmoidf_(g1[2]), a1[3] * sigmoidf_(g1[3]));
                    *(v4u*)rowp = w; }
        } else {
            const float sc = (u.pn < 6) ? QSCALE0 : 1.f;
            const int col0 = 512 + (u.pn - 4) * 256 + wc * 32 + 8 * fq;
#pragma unroll
            for (int ai = 0; ai < 2; ++ai)
#pragma unroll
                for (int m = 0; m < 4; ++m) { bf16* rowp = O + (size_t)(row0 + ai * 128 + m * 16) * QW + col0;
#pragma unroll
                    for (int bj = 0; bj < 2; ++bj) { const f32x4 v0 = acc[ai][bj][m][0] * sc, v1 = acc[ai][bj][m][1] * sc;
                        v4u w; w.x = pk2(v0[0], v0[1]); w.y = pk2(v0[2], v0[3]); w.z = pk2(v1[0], v1[1]); w.w = pk2(v1[2], v1[3]);
                        *(v4u*)(rowp + bj * 128) = w; } }
        }
    }
};
struct EpiIn1 {
    static constexpr bool PERM = true;
    __device__ __forceinline__ void prefetch(const pg8::Unit&, int, LAS unsigned*) const {}
    bf16* O;
    __device__ __forceinline__ void operator()(const f32x4 (&acc)[2][2][4][2], const pg8::Unit& u, int wr, int wc, int fr, int fq) const {
        const int row0 = u.pm * 256 + wr * 64 + fr;
        const float sc = (u.pn == 0) ? 0.125f : 1.f;
        const int col0 = u.pn * 256 + wc * 32 + 8 * fq;
#pragma unroll
        for (int ai = 0; ai < 2; ++ai)
#pragma unroll
            for (int m = 0; m < 4; ++m) { bf16* rowp = O + (size_t)(row0 + ai * 128 + m * 16) * QW + col0;
#pragma unroll
                for (int bj = 0; bj < 2; ++bj) { const f32x4 v0 = acc[ai][bj][m][0] * sc, v1 = acc[ai][bj][m][1] * sc;
                    v4u w; w.x = pk2(v0[0], v0[1]); w.y = pk2(v0[2], v0[3]); w.z = pk2(v1[0], v1[1]); w.w = pk2(v1[2], v1[3]);
                    *(v4u*)(rowp + bj * 128) = w; } }
    }
};
template <bool XIN_F32> struct EpiOut {
    static constexpr bool PERM = true;
    __device__ __forceinline__ void prefetch(const pg8::Unit&, int, LAS unsigned*) const {}
    const void* xin; bf16* xout; const float* gate;
#ifdef PROBE_TS
    void* tsb;
#endif
    __device__ __forceinline__ void operator()(const f32x4 (&acc)[2][2][4][2], const pg8::Unit& u, int wr, int wc, int fr, int fq) const {
#ifdef PROBE_TS
        if (XIN_F32 && threadIdx.x == 0) ((unsigned long long*)tsb)[(26 + 3) * 256 + blockIdx.x] = __builtin_amdgcn_s_memrealtime();
#endif
        const int row0 = u.pm * 256 + wr * 64 + fr, col0 = u.pn * 256 + wc * 32 + 8 * fq;
        const float* gb = gate + ((u.pm * 256) / S) * 6144 + col0;
        f32x4 gv[2][2];
#pragma unroll
        for (int bj = 0; bj < 2; ++bj)
#pragma unroll
            for (int n = 0; n < 2; ++n) gv[bj][n] = *(const f32x4*)(gb + bj * 128 + 4 * n);
#pragma unroll
        for (int ai = 0; ai < 2; ++ai) {
            f32x4 xf[4][2][2]; v4u xb[4][2];
#pragma unroll
            for (int m = 0; m < 4; ++m) { const size_t off = (size_t)(row0 + ai * 128 + m * 16) * D + col0;
#pragma unroll
                for (int bj = 0; bj < 2; ++bj) {
                    if (XIN_F32) { const float* xp = (const float*)xin + off + bj * 128; xf[m][bj][0] = *(const f32x4*)xp; xf[m][bj][1] = *(const f32x4*)(xp + 4); }
                    else xb[m][bj] = *(const v4u*)((const bf16*)xin + off + bj * 128); } }
            __builtin_amdgcn_sched_barrier(0);
#pragma unroll
            for (int m = 0; m < 4; ++m) { const size_t off = (size_t)(row0 + ai * 128 + m * 16) * D + col0;
#pragma unroll
                for (int bj = 0; bj < 2; ++bj) { f32x4 x0, x1;
                    if (XIN_F32) { x0 = xf[m][bj][0]; x1 = xf[m][bj][1]; }
                    else { const v4u w = xb[m][bj]; x0 = (f32x4){bflo(w.x), bfhi(w.x), bflo(w.y), bfhi(w.y)}; x1 = (f32x4){bflo(w.z), bfhi(w.z), bflo(w.w), bfhi(w.w)}; }
                    x0 += gv[bj][0] * acc[ai][bj][m][0]; x1 += gv[bj][1] * acc[ai][bj][m][1];
                    v4u o; o.x = pk2(x0[0], x0[1]); o.y = pk2(x0[2], x0[3]); o.z = pk2(x1[0], x1[1]); o.w = pk2(x1[2], x1[3]);
                    store16_wt(xout + off + bj * 128, o); } }
            __builtin_amdgcn_sched_barrier(0);
        }
    }
};

constexpr int CW_MOECNT = 32768;
__device__ __forceinline__ int moe_unit_index(int mode, int i, int c, int G, int U, int nlow, int nfull) {
    if (i >= 4) return -1;
    int X;
    if (mode == 1) X = i * G + c;
    else if (c >= nfull) { const int j = c - nfull; X = (i == 0) ? j : (i == 1) ? j + nlow : 2 * nlow + c + (i - 2) * G; }
    else X = 2 * nlow + c + i * G;
    return X < U ? X : -1;
}
template <int MODE> struct MoeSched {
    const bf16* A; const bf16* Bt; int K; size_t bstride;
    LAS int* tab; LAS int* rowtab;
    unsigned* cnt; int G, c;
    static constexpr bool GATHER = (MODE == 1);
    __device__ __forceinline__ bool next(int i, pg8::Unit& u) const {
        const int U = __builtin_amdgcn_readfirstlane(tab[49]);
        const int X = moe_unit_index(MODE, i, c, G, U, __builtin_amdgcn_readfirstlane(tab[61]), __builtin_amdgcn_readfirstlane(tab[62]));
        if (X < 0) return false;
        int e = 0;
#pragma unroll
        for (int j = 1; j < 16; ++j) if (X >= __builtin_amdgcn_readfirstlane(tab[33 + j])) e = j;
        const int r = X - __builtin_amdgcn_readfirstlane(tab[33 + e]); const int rt = r >> 2, ct = r & 3;
        u.pm = X >> 2; u.pn = ct; u.e = e; u.li = (MODE == 1 ? 0 : 4) + i; u.r0 = __builtin_amdgcn_readfirstlane(tab[16 + e]) + 256 * rt; u.nr = min(256, __builtin_amdgcn_readfirstlane(tab[e]) - 256 * rt); return true;
    }
    __device__ __forceinline__ const char* a_base(const pg8::Unit& u) const { return GATHER ? (const char*)A : (const char*)A + (size_t)u.r0 * K * 2; }
    __device__ __forceinline__ const char* b_base(const pg8::Unit& u) const { return (const char*)Bt + (size_t)u.e * bstride + (size_t)u.pn * 256 * K * 2; }
    __device__ __forceinline__ void a_off(const pg8::Unit& u, int tid, unsigned (&v)[4]) const {
#pragma unroll
        for (int i = 0; i < 2; ++i) { int R, C; pg8::stage_rc(tid * 16 + i * 8192, R, C);
#pragma unroll
            for (int h = 0; h < 2; ++h) {
                if (GATHER) v[2 * h + i] = (unsigned)(rowtab[u.li * 256 + h * 128 + R] >> 1) * (unsigned)(K * 2) + (unsigned)C * 2u;
                else v[2 * h + i] = (unsigned)((h * 128 + R) * K + C) * 2u;
            } }
    }
    __device__ __forceinline__ void a_ready(const pg8::Unit& u, int wid, int lane) const {
        if (MODE == 2) {
            if (wid == 0) { unsigned sp = 0;
                while ((unsigned)__builtin_amdgcn_readfirstlane(__hip_atomic_load(cnt + 64 * u.pm, __ATOMIC_RELAXED, __HIP_MEMORY_SCOPE_AGENT)) < 32u) { __builtin_amdgcn_s_sleep(2); if (++sp > (1u << 20)) break; }
                __builtin_amdgcn_fence(__ATOMIC_ACQUIRE, "agent");
                asm volatile("s_waitcnt vmcnt(0)" ::: "memory"); }
            asm volatile("" ::: "memory"); __builtin_amdgcn_s_barrier(); asm volatile("" ::: "memory");
        }
    }
    __device__ __forceinline__ void publish(int rtg, int lane) const {
        if (MODE == 1) { if (lane == 0) __hip_atomic_fetch_add(cnt + 64 * rtg, 1u, __ATOMIC_RELAXED, __HIP_MEMORY_SCOPE_AGENT); }
    }
};
__device__ __forceinline__ void moe_plan(Frame& F, const int* cntw, const int* loc, int c) {
    LAS int* tab = (LAS int*)(F.lds + L_NE); LAS int* rowtab = (LAS int*)(F.lds + L_ROWTAB);
    LAS int* pre = (LAS int*)F.lds + F.wave * 320;
    __syncthreads();
    { int v[8];
#pragma unroll
      for (int i = 0; i < 4; ++i) { v[i] = cntw[(F.lane + 64 * i) * 16 + 2 * F.wave]; v[4 + i] = cntw[(F.lane + 64 * i) * 16 + 2 * F.wave + 1]; }
      const int s0 = wave_sum_i((v[0] + v[1]) + (v[2] + v[3])), s1 = wave_sum_i((v[4] + v[5]) + (v[6] + v[7]));
      if (F.lane == 0) { tab[2 * F.wave] = s0; tab[2 * F.wave + 1] = s1; } }
    for (int i = F.tid; i < 2048; i += 512) rowtab[i] = 0;
    __syncthreads();
    if (F.tid == 0) { int a = 0, ub = 0; for (int e = 0; e < 16; ++e) { tab[16 + e] = a; tab[33 + e] = ub; a += tab[e]; ub += 4 * ((tab[e] + 255) >> 8); } tab[32] = a; tab[49] = ub;
        const int R = 1 + (ub > F.G) + (ub > 2 * F.G) + (ub > 3 * F.G), nfull = ub - (R - 1) * F.G;
        tab[60] = R; tab[61] = F.G - nfull; tab[62] = nfull; }
    __syncthreads();
    const int li = F.wave;
    const int X = moe_unit_index(li < 4 ? 1 : 2, li & 3, c, F.G, tab[49], tab[61], tab[62]);
    if (X >= 0) {
        int e = 0;
        for (int j = 1; j < 16; ++j) if (X >= tab[33 + j]) e = j;
        const int rt = (X - tab[33 + e]) >> 2, ne = tab[e];
        int cw[4], tot = 0;
#pragma unroll
        for (int i = 0; i < 4; ++i) { cw[i] = cntw[(4 * F.lane + i) * 16 + e]; tot += cw[i]; }
        int start = wave_scan_i(tot) - tot;
#pragma unroll
        for (int i = 0; i < 4; ++i) { pre[4 * F.lane + i] = start; start += cw[i]; }
        asm volatile("s_waitcnt lgkmcnt(0)" ::: "memory");
        int cidx[4], gidx[4];
#pragma unroll
        for (int k = 0; k < 4; ++k) { const int g = 256 * rt + 64 * k + F.lane; int lo = 0;
#pragma unroll
            for (int st = 128; st >= 1; st >>= 1) { if (pre[lo + st] <= g) lo += st; }
            cidx[k] = lo; gidx[k] = g; }
        int val[4];
#pragma unroll
        for (int k = 0; k < 4; ++k) { val[k] = 0; if (gidx[k] < ne) val[k] = loc[(cidx[k] * 16 + e) * 64 + (gidx[k] - pre[cidx[k]])]; }
#pragma unroll
        for (int k = 0; k < 4; ++k) if (gidx[k] < ne) rowtab[li * 256 + 64 * k + F.lane] = val[k];
    }
    __syncthreads();
}
struct EpiM1 {
    static constexpr bool PERM = true;
    __device__ __forceinline__ void prefetch(const pg8::Unit&, int, LAS unsigned*) const {}
    bf16* ACT; const float* ew; LAS int* rowtab;
    __device__ __forceinline__ void operator()(const f32x4 (&acc)[2][2][4][2], const pg8::Unit& u, int wr, int wc, int fr, int fq) const {
        const int col0 = u.pn * 128 + wc * 32 + 8 * fq;
#pragma unroll
        for (int ai = 0; ai < 2; ++ai)
#pragma unroll
            for (int m = 0; m < 4; ++m) { const int r = ai * 128 + wr * 64 + m * 16 + fr;
                if (r < u.nr) { const float w8 = ew[rowtab[u.li * 256 + r]];
                    const f32x4 g0 = acc[ai][0][m][0], g1 = acc[ai][0][m][1], u0 = acc[ai][1][m][0], u1 = acc[ai][1][m][1];
                    v4u w; w.x = pk2(siluf_(g0[0]) * u0[0] * w8, siluf_(g0[1]) * u0[1] * w8); w.y = pk2(siluf_(g0[2]) * u0[2] * w8, siluf_(g0[3]) * u0[3] * w8);
                    w.z = pk2(siluf_(g1[0]) * u1[0] * w8, siluf_(g1[1]) * u1[1] * w8); w.w = pk2(siluf_(g1[2]) * u1[2] * w8, siluf_(g1[3]) * u1[3] * w8);
                    store16_wt(ACT + (size_t)(u.r0 + r) * DE + col0, w); } }
    }
};
struct EpiM2 {
    static constexpr bool PERM = true;
    __device__ __forceinline__ void prefetch(const pg8::Unit&, int, LAS unsigned*) const {}
    bf16* YS; LAS int* rowtab;
    __device__ __forceinline__ void operator()(const f32x4 (&acc)[2][2][4][2], const pg8::Unit& u, int wr, int wc, int fr, int fq) const {
        const int col0 = u.pn * 256 + wc * 32 + 8 * fq;
#pragma unroll
        for (int ai = 0; ai < 2; ++ai)
#pragma unroll
            for (int m = 0; m < 4; ++m) { const int r = ai * 128 + wr * 64 + m * 16 + fr;
                if (r < u.nr) { bf16* rowp = YS + (size_t)rowtab[u.li * 256 + r] * D + col0;
#pragma unroll
                    for (int bj = 0; bj < 2; ++bj) { const f32x4 v0 = acc[ai][bj][m][0], v1 = acc[ai][bj][m][1];
                        v4u w; w.x = pk2(v0[0], v0[1]); w.y = pk2(v0[2], v0[3]); w.z = pk2(v1[0], v1[1]); w.w = pk2(v1[2], v1[3]);
                        *(v4u*)(rowp + bj * 128) = w; } } }
    }
};

constexpr int MX_PITCH = 520;
template <int HALO> __device__ __forceinline__ void stage_rows(LAS bf16* dst, const bf16* QKVY, int col0, int t0, int tid) {
    constexpr int NROW = 64 + HALO, NP = (NROW * 64 + 511) / 512;
    const int tt0 = t0 % S;
    v4u v[NP];
#pragma unroll
    for (int i = 0; i < NP; ++i) { const int p = tid + 512 * i, row = p >> 6, c8 = (p & 63) * 8; v[i] = (v4u){0u, 0u, 0u, 0u};
        if (p < NROW * 64 && tt0 - HALO + row >= 0) v[i] = *(const v4u*)(QKVY + (size_t)(t0 - HALO + row) * QW + col0 + c8); }
#pragma unroll
    for (int i = 0; i < NP; ++i) { const int p = tid + 512 * i, row = p >> 6, c8 = (p & 63) * 8;
        if (p < NROW * 64) *(LAS v4u*)(dst + row * MX_PITCH + c8) = v[i]; }
}
__device__ __forceinline__ void conv_phase(KA args, Frame& F, const bf16* QKVY, bf16* CAT) {
    typedef float f2 __attribute__((ext_vector_type(2)));
    LAS bf16* ys = (LAS bf16*)F.lds;
    const int half = F.tid >> 8, cp = (F.tid & 255) * 2;
    const float* cw = INP(8);
    f2 w[31];
#pragma unroll
    for (int j = 0; j < 31; ++j) w[j] = *(const f2*)(cw + j * 512 + cp);
    const f2 bb = *(const f2*)(INP(9) + cp), gg = *(const f2*)(INP(10) + cp), nn = *(const f2*)(INP(11) + cp);
    for (int chunk = F.vcu; chunk < T / 64; chunk += F.G) {
        const int t0 = chunk * 64;
        __syncthreads();
        stage_rows<30>(ys, QKVY, 0, t0, F.tid);
        __syncthreads();
        for (int blk = 0; blk < 4; ++blk) { const int tok0 = half * 32 + blk * 8;
            f2 y[38];
#pragma unroll
            for (int r = 0; r < 38; ++r) { const unsigned u = *(const LAS unsigned*)(ys + (tok0 + r) * MX_PITCH + cp); y[r] = (f2){bflo(u), bfhi(u)}; }
#pragma unroll
            for (int i = 0; i < 8; ++i) { f2 a = bb;
#pragma unroll
                for (int j = 0; j < 31; ++j) a = y[i + j] * w[j] + a;
                float s = xor16_add(row_sum16(a.x + a.y));
                const float mean = s * (1.f / 64.f); const f2 d = a - mean;
                float q = xor16_add(row_sum16(d.x * d.x + d.y * d.y));
                const float rs = rsqrtf(q * (1.f / 64.f) + 1e-5f);
                const f2 yn = d * rs * gg + nn;
                *(unsigned*)(CAT + (size_t)(t0 + tok0 + i) * D + cp) = pk2(siluf_(yn.x), siluf_(yn.y)); }
        }
    }
}
__device__ __forceinline__ void pool_phase(KA args, Frame& F, const bf16* QKVY, const bf16* WPT, bf16* CAT) {
    typedef float f32x16 __attribute__((ext_vector_type(16)));
    LAS bf16* us = (LAS bf16*)F.lds;
    const int g = (F.wave < 4) ? 3 - (F.wave >> 1) : ((F.wave - 4) >> 1), tt = F.wave & 1, r32 = F.lane & 31, hi = F.lane >> 5, win = 2 << g;
    const float* pb = INP(18); const float* ps = INP(19);
    for (int chunk = F.vcu; chunk < T / 64; chunk += F.G) {
        const int t0 = chunk * 64, tt0 = t0 % S;
        __syncthreads();
        stage_rows<15>(us, QKVY, 1536, t0, F.tid);
        __syncthreads();
        const int tok = tt * 32 + r32;
        const float inv = 1.f / (float)min(tt0 + tok + 1, win);
        f32x16 acc[4];
#pragma unroll
        for (int ct = 0; ct < 4; ++ct) acc[ct] = (f32x16){};
        bf16x8 bnx[4];
#pragma unroll
        for (int ct = 0; ct < 4; ++ct) bnx[ct] = *(const bf16x8*)(WPT + (size_t)(g * 128 + 32 * ct + r32) * 128 + 8 * hi);
#pragma unroll
        for (int ks = 0; ks < 8; ++ks) {
            bf16x8 bcur[4];
#pragma unroll
            for (int ct = 0; ct < 4; ++ct) bcur[ct] = bnx[ct];
            if (ks < 7) {
#pragma unroll
                for (int ct = 0; ct < 4; ++ct) bnx[ct] = *(const bf16x8*)(WPT + (size_t)(g * 128 + 32 * ct + r32) * 128 + 16 * (ks + 1) + 8 * hi); }
            const LAS bf16* col = us + (tok + 15) * MX_PITCH + g * 128 + 16 * ks + 8 * hi;
            float sm[8];
#pragma unroll
            for (int e = 0; e < 8; ++e) sm[e] = 0.f;
            for (int j = 0; j < win; ++j) { const v4u u = *(const LAS v4u*)(col - j * MX_PITCH);
                sm[0] += bflo(u.x); sm[1] += bfhi(u.x); sm[2] += bflo(u.y); sm[3] += bfhi(u.y); sm[4] += bflo(u.z); sm[5] += bfhi(u.z); sm[6] += bflo(u.w); sm[7] += bfhi(u.w); }
            const v4u c = *(const LAS v4u*)col;
            v4u pa; pa.x = pk2(sm[0] * inv - bflo(c.x), sm[1] * inv - bfhi(c.x)); pa.y = pk2(sm[2] * inv - bflo(c.y), sm[3] * inv - bfhi(c.y));
            pa.z = pk2(sm[4] * inv - bflo(c.z), sm[5] * inv - bfhi(c.z)); pa.w = pk2(sm[6] * inv - bflo(c.w), sm[7] * inv - bfhi(c.w));
            const bf16x8 af = __builtin_bit_cast(bf16x8, pa);
#pragma unroll
            for (int ct = 0; ct < 4; ++ct) acc[ct] = __builtin_amdgcn_mfma_f32_32x32x16_bf16(af, bcur[ct], acc[ct], 0, 0, 0);
        }
#pragma unroll
        for (int ct = 0; ct < 4; ++ct) { const int n = g * 128 + 32 * ct + r32; const float bb = pb[n], sc = ps[n];
#pragma unroll
            for (int r = 0; r < 16; ++r) { const int row = tt * 32 + (r & 3) + 8 * (r >> 2) + 4 * hi;
                CAT[(size_t)(t0 + row) * D + 512 + n] = (bf16)(pk2((acc[ct][r] + bb) * sc, 0.f) & 0xffffu); } }
    }
}

namespace sba {
typedef short bf16x8 __attribute__((ext_vector_type(8)));
typedef short s16x4 __attribute__((ext_vector_type(4)));
typedef short v4i16_t __attribute__((ext_vector_type(4)));
typedef _Float16 h8 __attribute__((ext_vector_type(8)));
typedef _Float16 h2 __attribute__((ext_vector_type(2)));
typedef float f2 __attribute__((ext_vector_type(2)));
typedef float f32x16 __attribute__((ext_vector_type(16)));
typedef unsigned u32x4 __attribute__((ext_vector_type(4)));
typedef __bf16 bf16x2_t __attribute__((ext_vector_type(2)));
constexpr int KVB = 64, SLOTB = 8192;
constexpr float THR = 160.f;
__device__ __forceinline__ void glds16(const void* gsrc, unsigned lds_dst) { unsigned keep;
    asm volatile("s_mov_b32 %0, m0\n\ts_mov_b32 m0, %2\n\ts_nop 0\n\tglobal_load_lds_dwordx4 %1, off\n\ts_mov_b32 m0, %0" : "=&s"(keep) : "v"(gsrc), "s"(lds_dst) : "memory"); }
__device__ __forceinline__ unsigned cvtpk_bf(float lo, float hi) { f2 v = {lo, hi}; bf16x2_t b = __builtin_convertvector(v, bf16x2_t); return __builtin_bit_cast(unsigned, b); }
__device__ __forceinline__ unsigned cvtpk_h(float lo, float hi) { f2 v = {lo, hi}; h2 b = __builtin_convertvector(v, h2); return __builtin_bit_cast(unsigned, b); }
__device__ __forceinline__ float min30(float a) { float r; asm("v_min_f32_e32 %0, 0x41f00000, %1" : "=v"(r) : "v"(a)); return r; }
__device__ __forceinline__ float maxf_(float a, float b) { float r; asm("v_max_f32_e32 %0, %1, %2" : "=v"(r) : "v"(a), "v"(b)); return r; }
typedef __attribute__((address_space(3))) const char* lds_cptr;
__device__ __forceinline__ s16x4 vtr(lds_cptr p) { return __builtin_bit_cast(s16x4, __builtin_amdgcn_ds_read_tr16_b64_v4i16((__attribute__((address_space(3))) v4i16_t*)p)); }
#define SBA_H(x) __builtin_bit_cast(h8, x)
#define SBA_P(x) __builtin_bit_cast(bf16x8, x)

template <bool DIAG> __device__ __forceinline__ void tile(f32x16& p0, f32x16& p1, f32x16& o0, f32x16& o1, float& C, const h8& T0, const h8& T1, const h8& ONES, int kvb, int hi, lds_cptr vp) {
    const float z0 = p0[0];
    u32x4 lf0, lf1, lf2, lf3;
    {
        float l[16];
#pragma unroll
        for (int r = 0; r < 16; ++r) { const float z = p0[r]; float v = maxf_(__builtin_amdgcn_logf(1.f + __builtin_amdgcn_exp2f(min30(z))), z);
            if (DIAG) { if (kvb + (r & 3) + 8 * (r >> 2) >= 0) v = 0.f; } l[r] = v; }
        lf0 = (u32x4){cvtpk_h(l[0], l[1]), cvtpk_h(l[2], l[3]), cvtpk_h(l[4], l[5]), cvtpk_h(l[6], l[7])};
        lf1 = (u32x4){cvtpk_h(l[8], l[9]), cvtpk_h(l[10], l[11]), cvtpk_h(l[12], l[13]), cvtpk_h(l[14], l[15])};
#pragma unroll
        for (int r = 0; r < 16; ++r) { const float z = p1[r]; float v = maxf_(__builtin_amdgcn_logf(1.f + __builtin_amdgcn_exp2f(min30(z))), z);
            if (DIAG) { if (kvb + 32 + (r & 3) + 8 * (r >> 2) >= 0) v = 0.f; } l[r] = v; }
        if (!DIAG) l[15] += hi ? C : 0.f;
        lf2 = (u32x4){cvtpk_h(l[0], l[1]), cvtpk_h(l[2], l[3]), cvtpk_h(l[4], l[5]), cvtpk_h(l[6], l[7])};
        lf3 = (u32x4){cvtpk_h(l[8], l[9]), cvtpk_h(l[10], l[11]), cvtpk_h(l[12], l[13]), cvtpk_h(l[14], l[15])};
    }
    p0 = __builtin_amdgcn_mfma_f32_32x32x16_f16(T0, SBA_H(lf0), p0, 0, 0, 0);
    p0 = __builtin_amdgcn_mfma_f32_32x32x16_f16(T1, SBA_H(lf1), p0, 0, 0, 0);
    p0 = __builtin_amdgcn_mfma_f32_32x32x16_f16(ONES, SBA_H(lf2), p0, 0, 0, 0);
    p0 = __builtin_amdgcn_mfma_f32_32x32x16_f16(ONES, SBA_H(lf3), p0, 0, 0, 0);
    p1 = __builtin_amdgcn_mfma_f32_32x32x16_f16(T0, SBA_H(lf2), p1, 0, 0, 0);
    p1 = __builtin_amdgcn_mfma_f32_32x32x16_f16(T1, SBA_H(lf3), p1, 0, 0, 0);
    float cn = z0 - p0[0];
    { auto rr = __builtin_amdgcn_permlane32_swap(__float_as_uint(cn), __float_as_uint(cn), false, false); cn = __uint_as_float(rr[0]); }
    C = cn;
    u32x4 pw0, pw1, pw2, pw3;
    {
        float a[16];
#pragma unroll
        for (int r = 0; r < 16; ++r) { float v = __builtin_amdgcn_exp2f(p0[r]); if (DIAG) { if (kvb + (r & 3) + 8 * (r >> 2) >= 0) v = 0.f; } a[r] = v; }
        pw0 = (u32x4){cvtpk_bf(a[0], a[1]), cvtpk_bf(a[2], a[3]), cvtpk_bf(a[4], a[5]), cvtpk_bf(a[6], a[7])};
        pw1 = (u32x4){cvtpk_bf(a[8], a[9]), cvtpk_bf(a[10], a[11]), cvtpk_bf(a[12], a[13]), cvtpk_bf(a[14], a[15])};
#pragma unroll
        for (int r = 0; r < 16; ++r) { float v = __builtin_amdgcn_exp2f(p1[r]); if (DIAG) { if (kvb + 32 + (r & 3) + 8 * (r >> 2) >= 0) v = 0.f; } a[r] = v; }
        pw2 = (u32x4){cvtpk_bf(a[0], a[1]), cvtpk_bf(a[2], a[3]), cvtpk_bf(a[4], a[5]), cvtpk_bf(a[6], a[7])};
        pw3 = (u32x4){cvtpk_bf(a[8], a[9]), cvtpk_bf(a[10], a[11]), cvtpk_bf(a[12], a[13]), cvtpk_bf(a[14], a[15])};
    }
#define SBA_VFR(i) ({ const s16x4 lo_ = vtr(vp + (((i) >> 2) * 4096 + ((i) & 3) * 1024)); const s16x4 hi_ = vtr(vp + (((i) >> 2) * 4096 + ((i) & 3) * 1024 + 512)); (bf16x8){lo_[0], lo_[1], lo_[2], lo_[3], hi_[0], hi_[1], hi_[2], hi_[3]}; })
    o0 = __builtin_amdgcn_mfma_f32_32x32x16_bf16(SBA_P(pw0), SBA_VFR(0), o0, 0, 0, 0);
    o1 = __builtin_amdgcn_mfma_f32_32x32x16_bf16(SBA_P(pw0), SBA_VFR(4), o1, 0, 0, 0);
    o0 = __builtin_amdgcn_mfma_f32_32x32x16_bf16(SBA_P(pw1), SBA_VFR(1), o0, 0, 0, 0);
    o1 = __builtin_amdgcn_mfma_f32_32x32x16_bf16(SBA_P(pw1), SBA_VFR(5), o1, 0, 0, 0);
    o0 = __builtin_amdgcn_mfma_f32_32x32x16_bf16(SBA_P(pw2), SBA_VFR(2), o0, 0, 0, 0);
    o1 = __builtin_amdgcn_mfma_f32_32x32x16_bf16(SBA_P(pw2), SBA_VFR(6), o1, 0, 0, 0);
    o0 = __builtin_amdgcn_mfma_f32_32x32x16_bf16(SBA_P(pw3), SBA_VFR(3), o0, 0, 0, 0);
    o1 = __builtin_amdgcn_mfma_f32_32x32x16_bf16(SBA_P(pw3), SBA_VFR(7), o1, 0, 0, 0);
#undef SBA_VFR
}

__device__ __forceinline__ void wave_unit(int b, int h, int qi, const bf16* QKVY, bf16* CAT, char* shm_wave, int lane) {
    const int r32 = lane & 31, hi = lane >> 5;
    const long rowbase = (long)b * S; const int r0 = qi * 32;
    const bf16* Qw = QKVY + (rowbase + r0) * QW + 512 + h * 64;
    const bf16* Kl = QKVY + (rowbase + r32) * QW + 1024 + h * 64 + 8 * hi;
    const bf16* Vl = QKVY + (rowbase + (lane >> 2)) * QW + 1536 + h * 64 + (lane & 3) * 8;
    const unsigned lds0 = (unsigned)(uintptr_t)shm_wave;
    const lds_cptr vp0 = (lds_cptr)shm_wave + ((lane >> 4) & 1) * 32 + (lane & 3) * 8 + (4 * hi + ((lane & 15) >> 2)) * 64;
#define SBA_LOAD_V(t) do { _Pragma("unroll") for (int p_ = 0; p_ < 8; ++p_) vreg[p_] = *reinterpret_cast<const u32x4*>(Vl + ((long)(t) * KVB + 16 * (p_ & 3)) * QW + (p_ >> 2) * 32); } while (0)
#define SBA_STORE_V(slot) do { _Pragma("unroll") for (int p_ = 0; p_ < 8; ++p_) *(__attribute__((address_space(3))) u32x4*)((lds_cptr)shm_wave + (slot) * SLOTB + p_ * 1024 + lane * 16) = vreg[p_]; } while (0)
#define SBA_LOAD_K(t) do { _Pragma("unroll") for (int d0_ = 0; d0_ < 4; ++d0_) { kf[2 * d0_] = *reinterpret_cast<const bf16x8*>(Kl + (long)(t) * KVB * QW + 16 * d0_); kf[2 * d0_ + 1] = *reinterpret_cast<const bf16x8*>(Kl + ((long)(t) * KVB + 32) * QW + 16 * d0_); } } while (0)
    const int td = (r0 + 31) >> 6;
    bf16x8 kf[8], qr[4]; u32x4 vreg[8];
    SBA_LOAD_V(td); SBA_STORE_V(0);
    SBA_LOAD_K(td);
#pragma unroll
    for (int d0 = 0; d0 < 4; ++d0) qr[d0] = *reinterpret_cast<const bf16x8*>(&Qw[(long)r32 * QW + d0 * 16 + hi * 8]);
    h8 T0, T1, ONES;
#pragma unroll
    for (int jj = 0; jj < 8; ++jj) { const int kap = 8 * (jj >> 2) + 4 * hi + (jj & 3); T0[jj] = (kap >= r32) ? (_Float16)-1.0f : (_Float16)0.0f; T1[jj] = (16 + kap >= r32) ? (_Float16)-1.0f : (_Float16)0.0f; ONES[jj] = (_Float16)-1.0f; }
    f32x16 o0 = {}, o1 = {};
    float C = 0.f;
    for (int it = 0;; ++it) {
        const int t = td - it, slot = it & 1;
        f32x16 p0 = {}, p1 = {};
#pragma unroll
        for (int d0 = 0; d0 < 4; ++d0) { p0 = __builtin_amdgcn_mfma_f32_32x32x16_bf16(kf[2 * d0], qr[d0], p0, 0, 0, 0); p1 = __builtin_amdgcn_mfma_f32_32x32x16_bf16(kf[2 * d0 + 1], qr[d0], p1, 0, 0, 0); }
        if (t > 0) { SBA_LOAD_K(t - 1); SBA_LOAD_V(t - 1); }
        const lds_cptr vp = vp0 + slot * SLOTB;
        if (it == 0) tile<true>(p0, p1, o0, o1, C, T0, T1, ONES, KVB * t + 4 * hi - (r0 + r32), hi, vp);
        else tile<false>(p0, p1, o0, o1, C, T0, T1, ONES, 0, hi, vp);
        if (t == 0 || __all(C >= THR)) break;
        SBA_STORE_V(slot ^ 1);
    }
    bf16* Ow = CAT + (rowbase + r0) * D + 512 + h * 64;
#pragma unroll
    for (int r = 0; r < 16; ++r) { const int orow = (r & 3) + 8 * (r >> 2) + 4 * hi;
        Ow[(long)orow * D + r32] = (bf16)(cvtpk_bf(o0[r], 0.f) & 0xffffu); Ow[(long)orow * D + 32 + r32] = (bf16)(cvtpk_bf(o1[r], 0.f) & 0xffffu); }
#undef SBA_LOAD_V
#undef SBA_STORE_V
#undef SBA_LOAD_K
}
#undef SBA_H
#undef SBA_P
__device__ __forceinline__ void phase(const bf16* QKVY, bf16* CAT, char* lds, int vcu, int G, int wid, int lane) {
    for (int wu = vcu * 8 + wid; wu < NB * 8 * (S / 32); wu += G * 8) {
        const int bh = wu >> 7, qi = wu & 127;
        wave_unit(bh >> 3, bh & 7, qi, QKVY, CAT, lds + wid * 2 * SLOTB, lane);
    }
}
}


namespace gla {
typedef short bf16x8 __attribute__((ext_vector_type(8)));
typedef short s16x4 __attribute__((ext_vector_type(4)));
typedef short v4i16_t __attribute__((ext_vector_type(4)));
typedef float f32x16 __attribute__((ext_vector_type(16)));
typedef __attribute__((address_space(3))) const char* lds_cptr;
constexpr int NCH = NB * 4 * 64;
constexpr int L_VP = 0, L_KP = 16384, L_TOT = 24576, L_DL = 26624, L_PS = 16384, QSTR = 27136;
__device__ __forceinline__ void glds16(const void* gsrc, unsigned lds_dst) { unsigned keep;
    asm volatile("s_mov_b32 %0, m0\n\ts_mov_b32 m0, %2\n\ts_nop 0\n\tglobal_load_lds_dwordx4 %1, off\n\ts_mov_b32 m0, %0" : "=&s"(keep) : "v"(gsrc), "s"(lds_dst) : "memory"); }
__device__ __forceinline__ s16x4 vtr(lds_cptr p) { return __builtin_bit_cast(s16x4, __builtin_amdgcn_ds_read_tr16_b64_v4i16((__attribute__((address_space(3))) v4i16_t*)p)); }
#define GLA_WAIT_BAR() asm volatile("s_waitcnt vmcnt(0) lgkmcnt(0)\n\ts_barrier" ::: "memory")
__device__ __forceinline__ void dma_v(const bf16* QKVY, long t0, int h, unsigned lds0, int wid, int lane) {
#pragma unroll
    for (int i = 0; i < 2; ++i) { const int p = wid * 2 + i, ctile = p >> 2, tg = p & 3;
        glds16(QKVY + (t0 + 16 * tg + (lane >> 2)) * QW + 512 + h * 128 + 32 * ctile + (lane & 3) * 8, (unsigned)__builtin_amdgcn_readfirstlane(lds0 + L_VP + p * 1024)); }
}
__device__ __forceinline__ bf16x8 trfrag(lds_cptr base, int piece, int lane) {
    const int hi = lane >> 5; const lds_cptr p = base + piece * 1024 + ((lane >> 4) & 1) * 32 + (lane & 3) * 8 + (4 * hi + ((lane & 15) >> 2)) * 64;
    const s16x4 lo = vtr(p), hh = vtr(p + 512); return (bf16x8){lo[0], lo[1], lo[2], lo[3], hh[0], hh[1], hh[2], hh[3]};
}
__device__ __forceinline__ void pass_a(KA args, const bf16* QKVY, const float* ALOW, bf16* QIN, bf16* KIN, float* KVT, float* DEC, char* shm, int vcu, int G, int wid, int lane) {
    const unsigned lds0 = (unsigned)(uintptr_t)shm; const lds_cptr shm3 = (lds_cptr)shm;
    const float* gw = INP(14); const float* gb = INP(15);
    for (int base = 4 * vcu; base < NCH; base += 4 * G) {
        const int bh = base >> 6, b = bh >> 2, h = bh & 3;
        float gwv[16];
#pragma unroll
        for (int r = 0; r < 16; ++r) gwv[r] = gw[r * 256 + h * 64 + lane];
        const float gbv = gb[h * 64 + lane];
        float bl[4][8], qv[4][8], kv[4][8];
#pragma unroll
        for (int q = 0; q < 4; ++q) { const long t0 = (long)b * S + ((base + q) & 63) * 64;
            dma_v(QKVY, t0, h, lds0 + q * QSTR, wid, lane);
#pragma unroll
            for (int tt = 0; tt < 8; ++tt) { const long t = t0 + 8 * wid + tt; const f32x4* al = (const f32x4*)(ALOW + t * 16); float x = gbv;
#pragma unroll
                for (int r4 = 0; r4 < 4; ++r4) { const f32x4 a4 = al[r4]; x += a4.x * gwv[4 * r4] + a4.y * gwv[4 * r4 + 1] + a4.z * gwv[4 * r4 + 2] + a4.w * gwv[4 * r4 + 3]; }
                const float la = -softplusf_(-x) * (1.f / 16.f);
                bl[q][tt] = (tt ? bl[q][tt - 1] : 0.f) + la;
                qv[q][tt] = bf2f(QKVY[t * QW + h * 64 + lane]); kv[q][tt] = bf2f(QKVY[t * QW + 256 + h * 64 + lane]); }
            ((__attribute__((address_space(3))) float*)(shm3 + q * QSTR + L_TOT))[wid * 64 + lane] = bl[q][7]; }
        asm volatile("s_waitcnt lgkmcnt(0)\n\ts_barrier" ::: "memory");
#pragma unroll
        for (int q = 0; q < 4; ++q) { const int ch = base + q; const long t0 = (long)b * S + (ch & 63) * 64;
            __attribute__((address_space(3))) float* tot = (__attribute__((address_space(3))) float*)(shm3 + q * QSTR + L_TOT);
            __attribute__((address_space(3))) bf16* kp = (__attribute__((address_space(3))) bf16*)(shm3 + q * QSTR + L_KP);
            float off = 0.f, blast = 0.f;
#pragma unroll
            for (int w = 0; w < 8; ++w) { const float v = tot[w * 64 + lane]; if (w < wid) off += v; blast += v; }
#pragma unroll
            for (int tt = 0; tt < 8; ++tt) { const long t = t0 + 8 * wid + tt; const float bb = bl[q][tt] + off; const int tk = 8 * wid + tt;
                const float qi = qv[q][tt] * __expf(bb), ki = kv[q][tt] * __expf(-bb);
                QIN[t * 256 + h * 64 + lane] = (bf16)f2bf(qi); const bf16 kb = (bf16)f2bf(ki); KIN[t * 256 + h * 64 + lane] = kb;
                kp[((lane >> 5) * 4 + (tk >> 4)) * 512 + (tk & 15) * 32 + (lane & 31)] = kb; }
            if (wid == 0) { const float dd = __expf(blast); ((__attribute__((address_space(3))) float*)(shm3 + q * QSTR + L_DL))[lane] = dd; DEC[ch * 64 + lane] = dd; } }
        GLA_WAIT_BAR();
        const int dvt = wid & 3, dt = wid >> 2;
#pragma unroll
        for (int q = 0; q < 4; ++q) { const int ch = base + q;
            f32x16 acc = {};
#pragma unroll
            for (int ks = 0; ks < 4; ++ks) acc = __builtin_amdgcn_mfma_f32_32x32x16_bf16(trfrag(shm3 + q * QSTR + L_VP, dvt * 4 + ks, lane), trfrag(shm3 + q * QSTR + L_KP, dt * 4 + ks, lane), acc, 0, 0, 0);
            const int dcol = 32 * dt + (lane & 31); const float dsc = ((__attribute__((address_space(3))) float*)(shm3 + q * QSTR + L_DL))[dcol];
            float* kvo = KVT + ((size_t)ch * 128 + 32 * dvt) * 64 + dcol;
#pragma unroll
            for (int r = 0; r < 16; ++r) kvo[(size_t)((r & 3) + 8 * (r >> 2) + 4 * (lane >> 5)) * 64] = acc[r] * dsc; }
        GLA_WAIT_BAR();
    }
}
__device__ __forceinline__ void pass_b(const float* KVT, const float* DEC, bf16* SINT, int vcu, int G, int tid) {
    for (int e = vcu * 512 + tid; e < NB * 4 * 128 * 64; e += G * 512) {
        const int bh = e >> 13, rem = e & 8191, d = e & 63;
        float st = 0.f;
        for (int n0 = 0; n0 < 64; n0 += 8) {
            float kvv[8], dc[8];
#pragma unroll
            for (int i = 0; i < 8; ++i) { const size_t ch = (size_t)bh * 64 + n0 + i; kvv[i] = KVT[ch * 8192 + rem]; dc[i] = DEC[ch * 64 + d]; }
#pragma unroll
            for (int i = 0; i < 8; ++i) { const size_t ch = (size_t)bh * 64 + n0 + i; SINT[ch * 8192 + rem] = (bf16)f2bf(st); st = dc[i] * st + kvv[i]; }
        }
    }
}
__device__ __forceinline__ void pass_c(KA args, const bf16* QKVY, const bf16* QIN, const bf16* KIN, const bf16* SINT, bf16* CAT, char* shm, int vcu, int G, int wid, int lane) {
    const unsigned lds0 = (unsigned)(uintptr_t)shm; const lds_cptr shm3 = (lds_cptr)shm;
    const int r32 = lane & 31, hi = lane >> 5, it = wid >> 2, ct = wid & 3;
    const float* gng = INP(16);
    for (int base = 4 * vcu; base < NCH; base += 4 * G) {
        const int bh = base >> 6, b = bh >> 2, h = bh & 3;
        f32x16 o[4]; unsigned pw[4][2][8];
#pragma unroll
        for (int q = 0; q < 4; ++q) { const int ch = base + q; const long t0 = (long)b * S + (ch & 63) * 64;
            dma_v(QKVY, t0, h, lds0 + q * QSTR, wid, lane);
            bf16x8 qf[4];
#pragma unroll
            for (int d0 = 0; d0 < 4; ++d0) qf[d0] = *(const bf16x8*)(QIN + (t0 + 32 * it + r32) * 256 + h * 64 + 16 * d0 + 8 * hi);
            f32x16 oo = {};
#pragma unroll
            for (int ks = 0; ks < 4; ++ks) { const bf16x8 sf = *(const bf16x8*)(SINT + ((size_t)ch * 128 + 32 * ct + r32) * 64 + 16 * ks + 8 * hi);
                oo = __builtin_amdgcn_mfma_f32_32x32x16_bf16(qf[ks], sf, oo, 0, 0, 0); }
            o[q] = oo;
            f32x16 pt0 = {}, pt1 = {};
#pragma unroll
            for (int d0 = 0; d0 < 4; ++d0) { const bf16x8 kf = *(const bf16x8*)(KIN + (t0 + r32) * 256 + h * 64 + 16 * d0 + 8 * hi);
                pt0 = __builtin_amdgcn_mfma_f32_32x32x16_bf16(kf, qf[d0], pt0, 0, 0, 0); }
            if (it == 1) {
#pragma unroll
                for (int d0 = 0; d0 < 4; ++d0) { const bf16x8 kf = *(const bf16x8*)(KIN + (t0 + 32 + r32) * 256 + h * 64 + 16 * d0 + 8 * hi);
                    pt1 = __builtin_amdgcn_mfma_f32_32x32x16_bf16(kf, qf[d0], pt1, 0, 0, 0); }
            }
#pragma unroll
            for (int r = 0; r < 16; r += 2) { const int j0 = (r & 3) + 8 * (r >> 2) + 4 * hi;
                float a0 = pt0[r], a1 = pt0[r + 1], c0 = pt1[r], c1 = pt1[r + 1];
                if (it == 0) { if (j0 > r32) a0 = 0.f; if (j0 + 1 > r32) a1 = 0.f; } else { if (j0 > r32) c0 = 0.f; if (j0 + 1 > r32) c1 = 0.f; }
                pw[q][0][r >> 1] = pk2(a0, a1); pw[q][1][r >> 1] = pk2(c0, c1); } }
        GLA_WAIT_BAR();
#pragma unroll
        for (int q = 0; q < 4; ++q) { f32x16 oo = o[q];
#pragma unroll
            for (int ks2 = 0; ks2 < 2; ++ks2) { const v4u a = {pw[q][0][4 * ks2], pw[q][0][4 * ks2 + 1], pw[q][0][4 * ks2 + 2], pw[q][0][4 * ks2 + 3]};
                oo = __builtin_amdgcn_mfma_f32_32x32x16_bf16(__builtin_bit_cast(bf16x8, a), trfrag(shm3 + q * QSTR + L_VP, ct * 4 + ks2, lane), oo, 0, 0, 0); }
            if (it == 1) {
#pragma unroll
                for (int ks2 = 0; ks2 < 2; ++ks2) { const v4u a = {pw[q][1][4 * ks2], pw[q][1][4 * ks2 + 1], pw[q][1][4 * ks2 + 2], pw[q][1][4 * ks2 + 3]};
                    oo = __builtin_amdgcn_mfma_f32_32x32x16_bf16(__builtin_bit_cast(bf16x8, a), trfrag(shm3 + q * QSTR + L_VP, ct * 4 + 2 + ks2, lane), oo, 0, 0, 0); }
            }
            o[q] = oo;
            __attribute__((address_space(3))) float* ps = (__attribute__((address_space(3))) float*)(shm3 + q * QSTR + L_PS);
#pragma unroll
            for (int r = 0; r < 16; ++r) { float v = xor16_add(row_sum16(oo[r] * oo[r]));
                if ((lane & 31) == 0) ps[(32 * it + (r & 3) + 8 * (r >> 2) + 4 * hi) * 4 + ct] = v; } }
        asm volatile("s_waitcnt lgkmcnt(0)\n\ts_barrier" ::: "memory");
        const float gv = gng[h * 128 + 32 * ct + r32];
#pragma unroll
        for (int q = 0; q < 4; ++q) { const int ch = base + q; const long t0 = (long)b * S + (ch & 63) * 64;
            const __attribute__((address_space(3))) float* ps = (const __attribute__((address_space(3))) float*)(shm3 + q * QSTR + L_PS);
#pragma unroll
            for (int r = 0; r < 16; ++r) { const int row = 32 * it + (r & 3) + 8 * (r >> 2) + 4 * hi; const long t = t0 + row;
                const f32x4 p4 = *(const __attribute__((address_space(3))) f32x4*)(ps + row * 4);
                const float rr = rsqrtf(((p4.x + p4.y) + (p4.z + p4.w)) * (1.f / 128.f) + 1e-6f);
                const float rg = bf2f(QKVY[t * QW + 1024 + h * 128 + 32 * ct + r32]);
                CAT[t * D + h * 128 + 32 * ct + r32] = (bf16)f2bf(o[q][r] * rr * gv * siluf_(rg)); } }
        asm volatile("s_waitcnt lgkmcnt(0)\n\ts_barrier" ::: "memory");
    }
}
typedef unsigned u32x4 __attribute__((ext_vector_type(4)));
constexpr int W_VP = 0, W_KP = 16384, W_AL = 24576, W_DL = 28672, WSTR = 29696;
__device__ __forceinline__ void stage_v_wave(const bf16* QKVY, long t0, int h, lds_cptr blk, int lane) {
#pragma unroll
    for (int half = 0; half < 2; ++half) { u32x4 r[8];
#pragma unroll
        for (int i = 0; i < 8; ++i) { const int p = half * 8 + i; r[i] = *(const u32x4*)(QKVY + (t0 + 16 * (p & 3) + (lane >> 2)) * QW + 512 + h * 128 + 32 * (p >> 2) + (lane & 3) * 8); }
#pragma unroll
        for (int i = 0; i < 8; ++i) { const int p = half * 8 + i; *(__attribute__((address_space(3))) u32x4*)(blk + W_VP + p * 1024 + lane * 16) = r[i]; } }
}
__device__ __forceinline__ void pass_a_w(KA args, const bf16* QKVY, const float* ALOW, bf16* QIN, bf16* KIN, float* KVT, float* DEC, char* shm, int vcu, int G, int wid, int lane) {
    if (wid >= 4) return;
    const lds_cptr blk = (lds_cptr)shm + wid * WSTR;
    __attribute__((address_space(3))) float* al = (__attribute__((address_space(3))) float*)(blk + W_AL);
    __attribute__((address_space(3))) float* dl = (__attribute__((address_space(3))) float*)(blk + W_DL);
    __attribute__((address_space(3))) bf16* kp = (__attribute__((address_space(3))) bf16*)(blk + W_KP);
    const float* gw = INP(14); const float* gb = INP(15);
    for (int ch = 4 * vcu + wid; ch < NCH; ch += 4 * G) {
        const int bh = ch >> 6, n = ch & 63, b = bh >> 2, h = bh & 3; const long t0 = (long)b * S + n * 64;
        stage_v_wave(QKVY, t0, h, blk, lane);
#pragma unroll
        for (int j = 0; j < 4; ++j) *(__attribute__((address_space(3))) f32x4*)(al + 4 * (lane + 64 * j)) = *(const f32x4*)(ALOW + t0 * 16 + 4 * (lane + 64 * j));
        float gwv[16];
#pragma unroll
        for (int r = 0; r < 16; ++r) gwv[r] = gw[r * 256 + h * 64 + lane];
        const float gbv = gb[h * 64 + lane];
        float bcum = 0.f, qn[8], kn[8];
#pragma unroll
        for (int tt = 0; tt < 8; ++tt) { qn[tt] = bf2f(QKVY[(t0 + tt) * QW + h * 64 + lane]); kn[tt] = bf2f(QKVY[(t0 + tt) * QW + 256 + h * 64 + lane]); }
        asm volatile("s_waitcnt lgkmcnt(0)" ::: "memory");
        TS_RAW(17);
        for (int t8 = 0; t8 < 64; t8 += 8) {
            float qv[8], kv[8];
#pragma unroll
            for (int tt = 0; tt < 8; ++tt) { qv[tt] = qn[tt]; kv[tt] = kn[tt]; }
            if (t8 < 56) {
#pragma unroll
                for (int tt = 0; tt < 8; ++tt) { qn[tt] = bf2f(QKVY[(t0 + t8 + 8 + tt) * QW + h * 64 + lane]); kn[tt] = bf2f(QKVY[(t0 + t8 + 8 + tt) * QW + 256 + h * 64 + lane]); } }
#pragma unroll
            for (int tt = 0; tt < 8; ++tt) { const int tk = t8 + tt; const long t = t0 + tk; float x = gbv;
#pragma unroll
                for (int r4 = 0; r4 < 4; ++r4) { const f32x4 a4 = *(const __attribute__((address_space(3))) f32x4*)(al + tk * 16 + 4 * r4); x += a4.x * gwv[4 * r4] + a4.y * gwv[4 * r4 + 1] + a4.z * gwv[4 * r4 + 2] + a4.w * gwv[4 * r4 + 3]; }
                bcum += -softplusf_(-x) * (1.f / 16.f);
                const float qi = qv[tt] * __expf(bcum), ki = kv[tt] * __expf(-bcum);
                QIN[t * 256 + h * 64 + lane] = (bf16)f2bf(qi); const bf16 kb = (bf16)f2bf(ki); KIN[t * 256 + h * 64 + lane] = kb;
                kp[((lane >> 5) * 4 + (tk >> 4)) * 512 + (tk & 15) * 32 + (lane & 31)] = kb; }
        }
        { const float dd = __expf(bcum); dl[lane] = dd; DEC[ch * 64 + lane] = dd; }
        asm volatile("s_waitcnt lgkmcnt(0)" ::: "memory");
        TS_RAW(18);
#pragma unroll
        for (int dt = 0; dt < 2; ++dt) { bf16x8 kf[4];
#pragma unroll
            for (int ks = 0; ks < 4; ++ks) kf[ks] = trfrag(blk + W_KP, dt * 4 + ks, lane);
            const int dcol = 32 * dt + (lane & 31); const float dsc = dl[dcol];
#pragma unroll
            for (int dvt = 0; dvt < 4; ++dvt) { f32x16 acc = {};
#pragma unroll
                for (int ks = 0; ks < 4; ++ks) acc = __builtin_amdgcn_mfma_f32_32x32x16_bf16(trfrag(blk + W_VP, dvt * 4 + ks, lane), kf[ks], acc, 0, 0, 0);
                float* kvo = KVT + ((size_t)ch * 128 + 32 * dvt) * 64 + dcol;
#pragma unroll
                for (int r = 0; r < 16; ++r) kvo[(size_t)((r & 3) + 8 * (r >> 2) + 4 * (lane >> 5)) * 64] = acc[r] * dsc; } }
        asm volatile("s_waitcnt lgkmcnt(0)" ::: "memory");
    }
}
__device__ __forceinline__ void pass_c_w(KA args, const bf16* QKVY, const bf16* QIN, const bf16* KIN, const bf16* SINT, bf16* CAT, char* shm, int vcu, int G, int wid, int lane) {
    const lds_cptr blk = (lds_cptr)shm + wid * 16384;
    const int r32 = lane & 31, hi = lane >> 5, it = wid >> 2;
    const float* gng = INP(16);
    for (int ch = 4 * vcu + (wid & 3); ch < NCH; ch += 4 * G) {
        const int bh = ch >> 6, n = ch & 63, b = bh >> 2, h = bh & 3; const long t0 = (long)b * S + n * 64;
        stage_v_wave(QKVY, t0, h, blk, lane);
        bf16x8 qf[4];
#pragma unroll
        for (int d0 = 0; d0 < 4; ++d0) qf[d0] = *(const bf16x8*)(QIN + (t0 + 32 * it + r32) * 256 + h * 64 + 16 * d0 + 8 * hi);
        unsigned short rgv[4][16];
#pragma unroll
        for (int ct = 0; ct < 4; ++ct)
#pragma unroll
            for (int r = 0; r < 16; ++r) rgv[ct][r] = QKVY[(t0 + 32 * it + (r & 3) + 8 * (r >> 2) + 4 * hi) * QW + 1024 + h * 128 + 32 * ct + r32];
        f32x16 pt0 = {}, pt1 = {};
#pragma unroll
        for (int d0 = 0; d0 < 4; ++d0) { const bf16x8 kf = *(const bf16x8*)(KIN + (t0 + r32) * 256 + h * 64 + 16 * d0 + 8 * hi);
            pt0 = __builtin_amdgcn_mfma_f32_32x32x16_bf16(kf, qf[d0], pt0, 0, 0, 0); }
        if (it == 1) {
#pragma unroll
            for (int d0 = 0; d0 < 4; ++d0) { const bf16x8 kf = *(const bf16x8*)(KIN + (t0 + 32 + r32) * 256 + h * 64 + 16 * d0 + 8 * hi);
                pt1 = __builtin_amdgcn_mfma_f32_32x32x16_bf16(kf, qf[d0], pt1, 0, 0, 0); } }
        unsigned pw[2][8];
#pragma unroll
        for (int r = 0; r < 16; r += 2) { const int j0 = (r & 3) + 8 * (r >> 2) + 4 * hi;
            float a0 = pt0[r], a1 = pt0[r + 1], c0 = pt1[r], c1 = pt1[r + 1];
            if (it == 0) { if (j0 > r32) a0 = 0.f; if (j0 + 1 > r32) a1 = 0.f; } else { if (j0 > r32) c0 = 0.f; if (j0 + 1 > r32) c1 = 0.f; }
            pw[0][r >> 1] = pk2(a0, a1); pw[1][r >> 1] = pk2(c0, c1); }
        asm volatile("s_waitcnt lgkmcnt(0)" ::: "memory");
        f32x16 o[4]; float ss[16];
#pragma unroll
        for (int r = 0; r < 16; ++r) ss[r] = 0.f;
#pragma unroll
        for (int ct = 0; ct < 4; ++ct) { f32x16 oo = {};
#pragma unroll
            for (int ks = 0; ks < 4; ++ks) { const bf16x8 sf = *(const bf16x8*)(SINT + ((size_t)ch * 128 + 32 * ct + r32) * 64 + 16 * ks + 8 * hi);
                oo = __builtin_amdgcn_mfma_f32_32x32x16_bf16(qf[ks], sf, oo, 0, 0, 0); }
#pragma unroll
            for (int ks2 = 0; ks2 < 2; ++ks2) { const v4u a = {pw[0][4 * ks2], pw[0][4 * ks2 + 1], pw[0][4 * ks2 + 2], pw[0][4 * ks2 + 3]};
                oo = __builtin_amdgcn_mfma_f32_32x32x16_bf16(__builtin_bit_cast(bf16x8, a), trfrag(blk + W_VP, ct * 4 + ks2, lane), oo, 0, 0, 0); }
            if (it == 1) {
#pragma unroll
                for (int ks2 = 0; ks2 < 2; ++ks2) { const v4u a = {pw[1][4 * ks2], pw[1][4 * ks2 + 1], pw[1][4 * ks2 + 2], pw[1][4 * ks2 + 3]};
                    oo = __builtin_amdgcn_mfma_f32_32x32x16_bf16(__builtin_bit_cast(bf16x8, a), trfrag(blk + W_VP, ct * 4 + 2 + ks2, lane), oo, 0, 0, 0); } }
            o[ct] = oo;
#pragma unroll
            for (int r = 0; r < 16; ++r) ss[r] += oo[r] * oo[r]; }
#pragma unroll
        for (int r = 0; r < 16; ++r) ss[r] = rsqrtf(xor16_add(row_sum16(ss[r])) * (1.f / 128.f) + 1e-6f);
#pragma unroll
        for (int ct = 0; ct < 4; ++ct) { const float gv = gng[h * 128 + 32 * ct + r32];
#pragma unroll
            for (int r = 0; r < 16; ++r) { const long t = t0 + 32 * it + (r & 3) + 8 * (r >> 2) + 4 * hi;
                const float rg = bf2f(rgv[ct][r]);
                CAT[t * D + h * 128 + 32 * ct + r32] = (bf16)f2bf(o[ct][r] * ss[r] * gv * siluf_(rg)); } }
        asm volatile("s_waitcnt lgkmcnt(0)" ::: "memory");
    }
}
#undef GLA_WAIT_BAR
}

__device__ __forceinline__ void dot16x2(const f32x4 (&v0)[4], const f32x4 (&v1)[4], const LAS float* tabw, int lane, float (&c0)[4], float (&c1)[4]) {
    typedef float f2 __attribute__((ext_vector_type(2)));
    f2 a[8], b[8];
#pragma unroll
    for (int e = 0; e < 8; ++e) { a[e] = (f2){0.f, 0.f}; b[e] = (f2){0.f, 0.f}; }
    f32x4 wn[4];
    const LAS float* pb0 = tabw + lane * W16_PITCH;
    unsigned pb1u = (unsigned)(uintptr_t)(pb0 + 8 * 64 * W16_PITCH); asm volatile("" : "+v"(pb1u));
    const LAS float* pb1 = (const LAS float*)(uintptr_t)pb1u;
#pragma unroll
    for (int k = 0; k < 4; ++k) wn[k] = *(const LAS f32x4*)(pb0 + 4 * k);
#pragma unroll
    for (int jq = 0; jq < 16; ++jq) { const int j = jq >> 2, q = jq & 3;
        f32x4 w[4];
#pragma unroll
        for (int k = 0; k < 4; ++k) w[k] = wn[k];
        if (jq < 15) { const LAS float* p = (jq + 1 < 8) ? pb0 + (jq + 1) * 64 * W16_PITCH : pb1 + (jq + 1 - 8) * 64 * W16_PITCH;
#pragma unroll
            for (int k = 0; k < 4; ++k) wn[k] = *(const LAS f32x4*)(p + 4 * k); }
        const float h0 = v0[j][q], h1 = v1[j][q]; const f2 hh0 = {h0, h0}, hh1 = {h1, h1};
#pragma unroll
        for (int k = 0; k < 4; ++k) { const f2 wl = {w[k].x, w[k].y}, wh = {w[k].z, w[k].w};
            a[2 * k] = hh0 * wl + a[2 * k]; a[2 * k + 1] = hh0 * wh + a[2 * k + 1];
            b[2 * k] = hh1 * wl + b[2 * k]; b[2 * k + 1] = hh1 * wh + b[2 * k + 1]; } }
    float t8[8];
#pragma unroll
    for (int i = 0; i < 8; ++i) { const float lo = a[i >> 1][i & 1], hi = a[4 + (i >> 1)][i & 1]; auto rr = __builtin_amdgcn_permlane32_swap(__float_as_uint(lo), __float_as_uint(hi), false, false); t8[i] = __uint_as_float(rr[0]) + __uint_as_float(rr[1]); }
#pragma unroll
    for (int i = 0; i < 4; ++i) { auto rr = __builtin_amdgcn_permlane16_swap(__float_as_uint(t8[i]), __float_as_uint(t8[i + 4]), false, false); c0[i] = row_sum16(__uint_as_float(rr[0]) + __uint_as_float(rr[1])); }
#pragma unroll
    for (int i = 0; i < 8; ++i) { const float lo = b[i >> 1][i & 1], hi = b[4 + (i >> 1)][i & 1]; auto rr = __builtin_amdgcn_permlane32_swap(__float_as_uint(lo), __float_as_uint(hi), false, false); t8[i] = __uint_as_float(rr[0]) + __uint_as_float(rr[1]); }
#pragma unroll
    for (int i = 0; i < 4; ++i) { auto rr = __builtin_amdgcn_permlane16_swap(__float_as_uint(t8[i]), __float_as_uint(t8[i + 4]), false, false); c1[i] = row_sum16(__uint_as_float(rr[0]) + __uint_as_float(rr[1])); }
}
__device__ __forceinline__ void router_pass(KA args, Frame& F, int l, const bf16* X1, bf16* XN, int* eidx, float* ew, int* cntw, int* loc, unsigned* pcnt, unsigned pneed) {
    const float* mod = (const float*)(F.ws + WS_MOD) + (size_t)l * 4 * 6144;
    const float* rb = INP(21); const float* g = INP(5) + l * D;
    LAS float* tabw = (LAS float*)F.lds;
    LAS float* lg = (LAS float*)(F.lds + 1024 * W16_PITCH * 4);
    __syncthreads();
    TS_MARK(0);
    stage_w16(tabw, INP(20), F.tid);
    for (int chunk = F.vcu; chunk < T / 64; chunk += F.G) {
        if (F.wave == 0) { unsigned sp = 0;
            while ((unsigned)__builtin_amdgcn_readfirstlane(__hip_atomic_load(pcnt + 64 * (chunk >> 2), __ATOMIC_RELAXED, __HIP_MEMORY_SCOPE_AGENT)) < pneed) { __builtin_amdgcn_s_sleep(2); if (++sp > (1u << 20)) break; }
            __builtin_amdgcn_fence(__ATOMIC_ACQUIRE, "agent"); asm volatile("s_waitcnt vmcnt(0)" ::: "memory"); }
        __syncthreads();
        TS_MARK(1);
        const int tb = chunk * 64 + F.wave * 8, b = tb / S;
        f32x4 cA[4], cB[4];
        v2u rw[2][4];
#pragma unroll
        for (int q = 0; q < 2; ++q) { const v2u* xp = (const v2u*)(X1 + (size_t)(tb + q) * D) + F.lane;
#pragma unroll
            for (int j = 0; j < 4; ++j) rw[q][j] = xp[64 * j]; }
        load_colvec(cA, cB, F.lane, g, mod + b * 6144 + 4096, mod + b * 6144 + 3072);
#pragma unroll
        for (int i = 0; i < 4; ++i) { const int t = tb + 2 * i;
            f32x4 v0[4], v1[4];
#pragma unroll
            for (int j = 0; j < 4; ++j) { const v2u a = rw[0][j], c = rw[1][j]; v0[j] = (f32x4){bflo(a.x), bfhi(a.x), bflo(a.y), bfhi(a.y)}; v1[j] = (f32x4){bflo(c.x), bfhi(c.x), bflo(c.y), bfhi(c.y)}; }
            if (i < 3) {
#pragma unroll
                for (int q = 0; q < 2; ++q) { const v2u* xp = (const v2u*)(X1 + (size_t)(t + 2 + q) * D) + F.lane;
#pragma unroll
                    for (int j = 0; j < 4; ++j) rw[q][j] = xp[64 * j]; } }
            norm_row_pre<true>(v0, cA, cB); norm_row_pre<true>(v1, cA, cB);
            store_row_bf16(v0, F.lane, XN + (size_t)t * D); store_row_bf16(v1, F.lane, XN + (size_t)(t + 1) * D);
            float c0[4], c1[4];
            dot16x2(v0, v1, tabw, F.lane, c0, c1);
            if ((F.lane & 15) == 0) { const int r = F.lane >> 4, tl = F.wave * 8 + 2 * i;
                *(LAS f32x4*)(lg + tl * W16_PITCH + 4 * r) = (f32x4){c0[0], c0[1], c0[2], c0[3]}; *(LAS f32x4*)(lg + (tl + 1) * W16_PITCH + 4 * r) = (f32x4){c1[0], c1[1], c1[2], c1[3]}; }
        }
        __syncthreads();
        TS_MARK(2);
        if (F.wave == 0) {
            const int t = chunk * 64 + F.lane;
            float acc[16], rbv[16];
#pragma unroll
            for (int k = 0; k < 4; ++k) { const f32x4 w = *(const LAS f32x4*)(lg + F.lane * W16_PITCH + 4 * k); acc[4 * k] = w.x; acc[4 * k + 1] = w.y; acc[4 * k + 2] = w.z; acc[4 * k + 3] = w.w; }
#pragma unroll
            for (int e = 0; e < 16; ++e) rbv[e] = rb[e];
            float m = acc[0];
#pragma unroll
            for (int e = 1; e < 16; ++e) m = fmaxf(m, acc[e]);
            float sc16[16], ssum = 0.f;
#pragma unroll
            for (int e = 0; e < 16; ++e) { sc16[e] = expf(acc[e] - m); ssum += sc16[e]; }
            float sel[16];
#pragma unroll
            for (int e = 0; e < 16; ++e) { sc16[e] = sc16[e] / ssum; sel[e] = sc16[e] + rbv[e]; }
            int gi = 0; float gbest = -1e30f; int l0s[4], l1s[4];
#pragma unroll
            for (int gg = 0; gg < 4; ++gg) {
                int i0 = 0; float v0 = sel[4 * gg];
#pragma unroll
                for (int k = 1; k < 4; ++k) if (sel[4 * gg + k] > v0) { v0 = sel[4 * gg + k]; i0 = k; }
                int i1 = -1; float v1 = -1e30f;
#pragma unroll
                for (int k = 0; k < 4; ++k) if (k != i0 && sel[4 * gg + k] > v1) { v1 = sel[4 * gg + k]; i1 = k; }
                l0s[gg] = i0; l1s[gg] = i1;
                const float gs = v0 + v1; if (gs > gbest) { gbest = gs; gi = gg; }
            }
            int e0 = 0, e1 = 0;
#pragma unroll
            for (int gg = 0; gg < 4; ++gg) if (gg == gi) { e0 = 4 * gg + l0s[gg]; e1 = 4 * gg + l1s[gg]; }
            float w0 = 0.f, w1 = 0.f;
#pragma unroll
            for (int e = 0; e < 16; ++e) { if (e == e0) w0 = sc16[e]; if (e == e1) w1 = sc16[e]; }
            const float wsum = w0 + w1;
            *(int2*)(eidx + 2 * t) = make_int2(e0, e1); *(float2*)(ew + 2 * t) = make_float2(w0 / wsum, w1 / wsum);
            const unsigned long long below = (1ull << F.lane) - 1ull;
            for (int e = 0; e < 16; ++e) { const unsigned long long m0 = __ballot(e0 == e), m1 = __ballot(e1 == e); const int cc = __popcll(m0);
                if (e0 == e) loc[(chunk * 16 + e) * 64 + __popcll(m0 & below)] = 2 * t;
                if (e1 == e) loc[(chunk * 16 + e) * 64 + cc + __popcll(m1 & below)] = 2 * t + 1;
                if (F.lane == 0) cntw[chunk * 16 + e] = cc + __popcll(m1); }
        }
    }
}
__device__ __forceinline__ void chunk_publish(Frame& F, unsigned* cnt, int panel) {
    asm volatile("s_waitcnt vmcnt(0)" ::: "memory");
    __syncthreads();
    if (F.tid == 0) { __builtin_amdgcn_fence(__ATOMIC_RELEASE, "agent"); asm volatile("s_waitcnt vmcnt(0)" ::: "memory");
        __hip_atomic_fetch_add(cnt + 64 * panel, 1u, __ATOMIC_RELAXED, __HIP_MEMORY_SCOPE_AGENT); }
}
__device__ __forceinline__ void xn0_pass(KA args, Frame& F, bf16* XN, unsigned* cnt) {
    const float* mod = (const float*)(F.ws + WS_MOD);
    for (int chunk = F.vcu; chunk < T / 64; chunk += F.G) {
        const int tb = chunk * 64 + F.wave * 8, b = tb / S;
        f32x4 raw[3][4], cA[4], cB[4];
#pragma unroll
        for (int p = 0; p < 3; ++p) { const f32x4* xr = (const f32x4*)(INP(0) + (size_t)(tb + p) * D) + F.lane;
#pragma unroll
            for (int j = 0; j < 4; ++j) raw[p][j] = xr[64 * j]; }
        load_colvec(cA, cB, F.lane, INP(4), mod + b * 6144 + 1024, mod + b * 6144);
#pragma unroll
        for (int i = 0; i < 8; ++i) { const int t = tb + i; f32x4 v[4];
#pragma unroll
            for (int j = 0; j < 4; ++j) v[j] = raw[i % 3][j];
            if (i + 3 < 8) { const f32x4* xr = (const f32x4*)(INP(0) + (size_t)(t + 3) * D) + F.lane;
#pragma unroll
                for (int j = 0; j < 4; ++j) raw[i % 3][j] = xr[64 * j]; }
            norm_row_pre<true>(v, cA, cB);
            store_row_bf16(v, F.lane, XN + (size_t)t * D); }
        chunk_publish(F, cnt, chunk >> 2);
    }
}
__device__ __forceinline__ void combine_pass(KA args, Frame& F, int l, bf16* X1, const bf16* YS, bf16* XN, float* ALOW, float* out, unsigned* cnt) {
    const float* mod = (const float*)(F.ws + WS_MOD) + (size_t)l * 4 * 6144;
    const float* modn = (const float*)(F.ws + WS_MOD) + (size_t)(l + 1) * 4 * 6144;
    LAS float* tabw = (LAS float*)F.lds;
    __syncthreads();
    if (l == 0) stage_w16(tabw, (const float*)(F.ws + WS_ALOWW), F.tid);
    __syncthreads();
    for (int chunk = F.vcu; chunk < T / 64; chunk += F.G) {
      const int tb = chunk * 64 + F.wave * 8, b = tb / S;
      v2u rw[3][3][4];
#pragma unroll
      for (int p = 0; p < 3; ++p) { const v2u* x0 = (const v2u*)(X1 + (size_t)(tb + p) * D) + F.lane; const v2u* y0 = (const v2u*)(YS + (size_t)(2 * (tb + p)) * D) + F.lane;
#pragma unroll
          for (int j = 0; j < 4; ++j) { rw[p][0][j] = x0[64 * j]; rw[p][1][j] = y0[64 * j]; rw[p][2][j] = y0[64 * j + 256]; } }
      f32x4 g2v[4], cA[4], cB[4];
#pragma unroll
      for (int j = 0; j < 4; ++j) g2v[j] = *(const f32x4*)(mod + b * 6144 + 5120 + 4 * F.lane + 256 * j);
      if (l == 0) load_colvec(cA, cB, F.lane, INP(4) + D, modn + b * 6144 + 1024, modn + b * 6144); else load_colvec(cA, cB, F.lane, INP(25), nullptr, nullptr);
#pragma unroll
      for (int i = 0; i < 8; ++i) { const int t = tb + i;
        f32x4 v[4];
#pragma unroll
        for (int j = 0; j < 4; ++j) { const f32x4 g2 = g2v[j]; const v2u x = rw[i % 3][0][j], a = rw[i % 3][1][j], c = rw[i % 3][2][j];
            const f32x4 ys = {bflo(a.x) + bflo(c.x), bfhi(a.x) + bfhi(c.x), bflo(a.y) + bflo(c.y), bfhi(a.y) + bfhi(c.y)};
            v[j] = (f32x4){bflo(x.x), bfhi(x.x), bflo(x.y), bfhi(x.y)} + g2 * ys; }
        if (i + 3 < 8) { const v2u* x0 = (const v2u*)(X1 + (size_t)(t + 3) * D) + F.lane; const v2u* y0 = (const v2u*)(YS + (size_t)(2 * (t + 3)) * D) + F.lane;
#pragma unroll
            for (int j = 0; j < 4; ++j) { rw[i % 3][0][j] = x0[64 * j]; rw[i % 3][1][j] = y0[64 * j]; rw[i % 3][2][j] = y0[64 * j + 256]; } }
        if (l == 0) {
            store_row_bf16(v, F.lane, X1 + (size_t)t * D);
            norm_row_pre<true>(v, cA, cB);
            store_row_bf16(v, F.lane, XN + (size_t)t * D);
            float acc[16];
            dot16(v, tabw, F.lane, acc);
            if (F.lane == 0) {
#pragma unroll
                for (int k = 0; k < 4; ++k) *(f32x4*)(ALOW + (size_t)t * 16 + 4 * k) = (f32x4){acc[4 * k], acc[4 * k + 1], acc[4 * k + 2], acc[4 * k + 3]}; }
        } else {
            norm_row_pre<false>(v, cA, cB);
            f32x4* o = (f32x4*)(out + (size_t)t * D) + F.lane;
#pragma unroll
            for (int j = 0; j < 4; ++j) __builtin_nontemporal_store(v[j], o + 64 * j);
        }
      }
      if (cnt) chunk_publish(F, cnt, chunk >> 2);
    }
}

__global__ void __launch_bounds__(512, 2) mega_fwd(Args args_) {
    KA args = kargs();
    extern __shared__ __attribute__((aligned(16))) unsigned char lds[];
    Frame F;
    F.lds = (LAS unsigned char*)lds; F.ws = args->ws;
    F.wave = __builtin_amdgcn_readfirstlane((int)threadIdx.x >> 6); F.lane = lane_id(); F.tid = F.wave * 64 + F.lane;
    { int g_ = (int)gridDim.x, b_ = (int)blockIdx.x; asm volatile("" : "+s"(g_), "+s"(b_)); F.G = g_; F.bx = b_; F.vcu = (g_ % 8 == 0) ? (b_ % 8) * (g_ / 8) + b_ / 8 : b_; }
    unsigned char* ws = args->ws;
    for (int u = F.tid; u < (LDS_BYTES - LDSCTL_OFF) / 4; u += 512) ((LAS unsigned*)(F.lds + LDSCTL_OFF))[u] = 0u;
    __syncthreads();
    (void)xcd_barrier_post((unsigned*)(ws + WS_CTL) + CW_BAR, (volatile LAS unsigned*)(F.lds + L_MISC) + 8, F.wave);
#define MKBAR() XcdBarrier{(unsigned*)(ws + WS_CTL) + CW_BAR, xb_xcc_id(), (volatile LAS unsigned*)(F.lds + L_MISC) + 8, F.wave}
#ifndef PHMASK
#define PHMASK 0xFFFFFFFFu
#endif
#ifndef PROBE_MASK
#define PROBE_MASK 0u
#endif
#define NREP(k) ((((PROBE_MASK) >> (k)) & 1u) ? 4 : 1)
#define IN(k) ((((PHMASK) >> ((k) >= 9 ? (k) - 7 : (k))) & 1u) != 0u)
#define MIDBAR() do { xcd_barrier(MKBAR()); F.lane = lane_id(); F.tid = F.wave * 64 + F.lane; args = kargs(); ws = args->ws; F.ws = ws; { int g_ = (int)gridDim.x, b_ = (int)blockIdx.x; asm volatile("" : "+s"(g_), "+s"(b_)); F.G = g_; F.bx = b_; F.vcu = (g_ % 8 == 0) ? (b_ % 8) * (g_ / 8) + b_ / 8 : b_; } } while (0)
#define SEAM(k) do { if (IN(k) && IN((k) + 1)) { TS_PRE(SEAM_IDX(k)); xcd_barrier(MKBAR()); } F.lane = lane_id(); F.tid = F.wave * 64 + F.lane; args = kargs(); ws = args->ws; F.ws = ws; { int g_ = (int)gridDim.x, b_ = (int)blockIdx.x; asm volatile("" : "+s"(g_), "+s"(b_)); F.G = g_; F.bx = b_; F.vcu = (g_ % 8 == 0) ? (b_ % 8) * (g_ / 8) + b_ / 8 : b_; } TS_POST(SEAM_IDX(k)); } while (0)

    TS_PUT(0);
#define mod ((float*)(ws + WS_MOD))
#define XN ((bf16*)(ws + WS_XN))
#define QKVY ((bf16*)(ws + WS_QKVY))
#define YS ((bf16*)(ws + WS_QKVY))
#define CAT ((bf16*)(ws + WS_CAT))
#define ACT ((bf16*)(ws + WS_CAT))
#define X1 ((bf16*)(ws + WS_X1))
#define ALOW ((float*)(ws + WS_ALOW))
#define cntw ((int*)(ws + WS_CNTW))
#define eidx ((int*)(ws + WS_EIDX))
#define ew ((float*)(ws + WS_EW))
#define loc ((int*)(ws + WS_LOC))
    LAS int* tab = (LAS int*)(F.lds + L_NE); LAS int* rowtab = (LAS int*)(F.lds + L_ROWTAB);

    if (IN(0)) for (int rep_ = 0; rep_ < NREP(0); ++rep_) { if (rep_) MIDBAR(); p0_prologue(args, F); } SEAM(0);
#pragma unroll
    for (int l = 0; l < 2; ++l) {
        const int pb = 2 + 7 * l;
        const float* modl = mod + (size_t)l * 4 * 6144;
        if (IN(pb)) for (int rep_ = 0; rep_ < NREP(pb); ++rep_) { if (rep_) MIDBAR();
            unsigned* acnt = (unsigned*)(ws + WS_CTL) + CW_APANEL + l * 8192;
            if (l == 0) xn0_pass(args, F, XN, acnt); else combine_pass(args, F, 0, X1, YS, XN, ALOW, args->out, acnt);
            TS_MARK(8); TS_MARK1(12);
            pg8::DenseSched Sd; Sd.acnt = acnt; Sd.aneed = 4u * (unsigned)(rep_ + 1);
            if (l == 0) { Sd.init(XN, (const bf16*)(ws + WS_WIN0), T, NIN0, D, F.G, F.bx); EpiIn0 E{QKVY}; pg8::gemm_phase<EpiIn0, pg8::DenseSched, true>(F.lds, D, Sd, E, F.wave); TS_MARK(9);
                int nwg_ = (T / 256) * (NIN0 / 256), bx_ = F.bx; asm volatile("" : "+s"(nwg_), "+s"(bx_));
                const int nidle = F.G - (nwg_ - 2 * F.G), cid = bx_ - (nwg_ - 2 * F.G);
                if (nwg_ > 2 * F.G && nwg_ <= 3 * F.G) { if (cid >= 0) { __syncthreads(); p0_items(args, F, P0_NITEMS - P0_NFILL, P0_NITEMS, cid * 8 + F.wave, nidle * 8); } }
                else { __syncthreads(); p0_items(args, F, P0_NITEMS - P0_NFILL, P0_NITEMS, F.vcu * 8 + F.wave, F.G * 8); } }
            else { Sd.init(XN, (const bf16*)(ws + WS_WIN1), T, NIN1, D, F.G, F.bx); EpiIn1 E{QKVY}; pg8::gemm_phase<EpiIn1, pg8::DenseSched, true>(F.lds, D, Sd, E, F.wave); TS_MARK1(13); }
        } SEAM(pb);
        if (IN(pb + 1)) for (int rep_ = 0; rep_ < NREP(pb + 1); ++rep_) { if (rep_) MIDBAR();
            if (l == 0) {
#if defined(PROBE_CONV)
                for (int r3 = 0; r3 < 3; ++r3) { conv_phase(args, F, QKVY, CAT); __syncthreads(); }
#endif
#if defined(PROBE_SBA)
                for (int r3 = 0; r3 < 3; ++r3) { sba::phase(QKVY, CAT, (char*)lds, F.vcu, F.G, F.wave, F.lane); __syncthreads(); }
#endif
                conv_phase(args, F, QKVY, CAT); __syncthreads(); TS_MARK(10); sba::phase(QKVY, CAT, (char*)lds, F.vcu, F.G, F.wave, F.lane); }
            else {
                float* KVT = (float*)(ws + WS_XN); bf16* SINT = (bf16*)(ws + WS_WGU); bf16* QIN = SINT + (size_t)gla::NCH * 8192; bf16* KIN = QIN + (size_t)T * 256; float* DEC = (float*)(ws + WS_WD);
#ifndef PROBE_M1SUB
#define PROBE_M1SUB 0
#endif
                for (int r3 = 0; r3 < (PROBE_M1SUB == 1 ? 4 : 1); ++r3) { pool_phase(args, F, QKVY, (const bf16*)(ws + WS_WPT), CAT); __syncthreads(); }
                TS_MARK1(16);
                for (int r3 = 0; r3 < (PROBE_M1SUB == 2 ? 4 : 1); ++r3) { gla::pass_a_w(args, QKVY, ALOW, QIN, KIN, KVT, DEC, (char*)lds, F.vcu, F.G, F.wave, F.lane); __syncthreads(); }
                TS_PRE(6); MIDBAR(); TS_POST(6);
                for (int r3 = 0; r3 < (PROBE_M1SUB == 3 ? 4 : 1); ++r3) { gla::pass_b(KVT, DEC, SINT, F.vcu, F.G, F.tid); __syncthreads(); }
                TS_PRE(7); MIDBAR(); TS_POST(7);
                for (int r3 = 0; r3 < (PROBE_M1SUB == 4 ? 4 : 1); ++r3) { gla::pass_c_w(args, QKVY, QIN, KIN, SINT, CAT, (char*)lds, F.vcu, F.G, F.wave, F.lane); __syncthreads(); } }
        } SEAM(pb + 1);
        if (IN(pb + 2)) for (int rep_ = 0; rep_ < NREP(pb + 2); ++rep_) { if (rep_) MIDBAR();
            unsigned* pcnt = (unsigned*)(ws + WS_CTL) + CW_PANEL + l * 8192;
            pg8::DenseSched Sd; Sd.init(CAT, (const bf16*)(ws + (l == 0 ? WS_WOUT0 : WS_WOUT1)), T, D, D, F.G, F.bx); Sd.pcnt = pcnt;
#ifdef PROBE_TS
            if (l == 0) { EpiOut<true> E{INP(0), X1, modl + 2048, (void*)TSBUF}; pg8::gemm_phase<EpiOut<true>, pg8::DenseSched, false>(F.lds, D, Sd, E, F.wave); }
            else { EpiOut<false> E{X1, X1, modl + 2048, nullptr}; pg8::gemm_phase<EpiOut<false>, pg8::DenseSched, false>(F.lds, D, Sd, E, F.wave); }
#else
            if (l == 0) { EpiOut<true> E{INP(0), X1, modl + 2048}; pg8::gemm_phase<EpiOut<true>, pg8::DenseSched, false>(F.lds, D, Sd, E, F.wave); }
            else { EpiOut<false> E{X1, X1, modl + 2048}; pg8::gemm_phase<EpiOut<false>, pg8::DenseSched, false>(F.lds, D, Sd, E, F.wave); }
#endif
            router_pass(args, F, l, X1, XN, eidx, ew, cntw, loc, pcnt, 32u * (unsigned)(rep_ + 1));
        } SEAM(pb + 2);
        if (IN(pb + 4)) for (int rep_ = 0; rep_ < NREP(pb + 4); ++rep_) { if (rep_) MIDBAR();
            TS_MARK(4); moe_plan(F, cntw, loc, F.vcu); TS_MARK(5);
            unsigned* mcnt = (unsigned*)(ws + WS_CTL) + CW_MOECNT + l * 16384;
            { MoeSched<1> Sm{XN, (const bf16*)(ws + WS_WGU) + (size_t)l * NE * 1024 * D, D, (size_t)1024 * D * 2, tab, rowtab, mcnt, F.G, F.vcu};
              EpiM1 E{ACT, ew, rowtab};
              pg8::gemm_phase<EpiM1, MoeSched<1>, true>(F.lds, D, Sm, E, F.wave); TS_MARK(6); }
            { MoeSched<2> Sm{ACT, (const bf16*)(ws + WS_WD) + (size_t)l * NE * D * DE, DE, (size_t)D * DE * 2, tab, rowtab, mcnt, F.G, F.vcu};
              EpiM2 E{YS, rowtab};
              pg8::gemm_phase<EpiM2, MoeSched<2>, true>(F.lds, DE, Sm, E, F.wave); }
        } SEAM(pb + 4);
        if (l == 1) { if (IN(pb + 6)) { combine_pass(args, F, 1, X1, YS, XN, ALOW, args->out, nullptr); } }
    }
#ifdef PROBE_TS
    { TS_PRE(11); MIDBAR();
      if (F.bx == 0 && F.wave == 0) {
          const unsigned long long rlast = __builtin_amdgcn_s_memrealtime();
          int qq[2];
#pragma unroll
          for (int j = 0; j < 2; ++j) { const int id = j == 0 ? (PROBE_Q1) : (PROBE_Q2); int q;
              if (id == 31) q = 10;
              else { const int k = id & 15; const unsigned long long prev = (k == 0) ? TSBUF[0] : TSBUF[(2 + 2 * (k - 1)) * 256];
                  float dt;
                  if (id < 16) { const unsigned long long cur = (k == 11) ? rlast : TSBUF[(2 + 2 * k) * 256]; dt = (float)(long long)(cur - prev); }
                  else if (id >= 200 || (id >= 64 && id < 80)) {
                      float mx = 0.f; const int mx_ = id - 200; const unsigned long long p0_ = (id >= 200) ? TSBUF[(2 + 2 * (mx_ >= 16 ? 5 : mx_ >= 12 ? 4 : mx_ >= 10 ? 1 : mx_ >= 8 ? 0 : mx_ >= 4 ? 3 : 2)) * 256] : prev; const int slot = (id >= 200) ? 26 + (id - 200) : 1 + 2 * k;
                      for (int w = F.lane; w < F.G; w += 64) mx = fmaxf(mx, (float)(long long)(TSBUF[slot * 256 + w] - p0_));
                      for (int o = 1; o < 64; o <<= 1) mx = fmaxf(mx, __int_as_float(__builtin_amdgcn_ds_bpermute(((F.lane ^ o) & 63) << 2, __float_as_int(mx))));
                      dt = mx; }
                  else if (id >= 100) { float sacc = 0.f; const int mm_ = id - 100; const unsigned long long p2 = TSBUF[(2 + 2 * (mm_ >= 16 ? 5 : mm_ >= 12 ? 4 : mm_ >= 10 ? 1 : mm_ >= 8 ? 0 : mm_ >= 4 ? 3 : 2)) * 256]; for (int w = F.lane; w < F.G; w += 64) sacc += (float)(long long)(TSBUF[(26 + (id - 100)) * 256 + w] - p2); dt = wave_sum(sacc) / (float)F.G; }
                  else if (id < 32) { float sacc = 0.f; for (int w = F.lane; w < F.G; w += 64) sacc += (float)(long long)(TSBUF[(1 + 2 * k) * 256 + w] - prev); dt = wave_sum(sacc) / (float)F.G; }
                  else { float sacc = 0.f, nacc = 0.f;
                      for (int w = F.lane; w < F.G; w += 64) { const int vc = (w % 8) * (F.G / 8) + w / 8; if (vc >= (PROBE_LO) && vc < (PROBE_HI)) { sacc += (float)(long long)(TSBUF[(1 + 2 * k) * 256 + w] - prev); nacc += 1.f; } }
                      dt = wave_sum(sacc) / fmaxf(wave_sum(nacc), 1.f); }
                  q = (int)(dt * (1.f / 250.f) + 0.5f); q = q < 0 ? 0 : q > 63 ? 63 : q; }
              qq[j] = __builtin_amdgcn_readfirstlane(q); }
          const unsigned long long tend = __builtin_amdgcn_s_memrealtime() + (unsigned long long)(qq[0] + 64 * qq[1]) * 1600ull;
          while (__builtin_amdgcn_s_memrealtime() < tend) __builtin_amdgcn_s_sleep(8);
      } }
#endif
#undef IN
#undef SEAM
}

extern "C" void kernel_launch(void* const* d_in, const int* in_sizes, int n_in, void* d_out, int out_size, void* d_ws, size_t ws_size, hipStream_t stream) {
    static int grid = 0;
    if (grid == 0) {
        if (n_in != 26 || out_size != T * D || ws_size < WS_END) { fprintf(stderr, "kernel_launch: unexpected shapes / workspace (%zu < %zu)\n", ws_size, (size_t)WS_END); grid = -1; return; }
        int dev = 0, cus = 0;
        if (hipGetDevice(&dev) != hipSuccess || hipDeviceGetAttribute(&cus, hipDeviceAttributeMultiprocessorCount, dev) != hipSuccess) { grid = -1; return; }
        if (hipFuncSetAttribute((const void*)mega_fwd, hipFuncAttributeMaxDynamicSharedMemorySize, LDS_BYTES) != hipSuccess) { fprintf(stderr, "kernel_launch: hipFuncSetAttribute failed\n"); grid = -1; return; }
        grid = cus;
    }
    if (grid < 0) return;
    (void)hipMemsetAsync((char*)d_ws + WS_CTL, 0, CTL_ZERO_BYTES, stream);
    Args a{};
    for (int i = 0; i < 26; ++i) a.in[i] = (const float*)d_in[i];
    a.out = (float*)d_out; a.ws = (unsigned char*)d_ws;
    hipLaunchKernelGGL(mega_fwd, dim3(grid), dim3(512), LDS_BYTES, stream, a);
}
```

```cpp
#include <hip/hip_runtime.h>
#include <cstdint>
#include <cstdio>

constexpr int D = 1024, NB = 4, S = 4096, T = NB * S, NE = 16, DE = 512;
constexpr int NIN0 = 2560, NIN1 = 2048, QW = 2048;
constexpr float QSCALE0 = 0.125f * 1.4426950408889634f;

#define GAS __attribute__((address_space(1)))
#define LAS __attribute__((address_space(3)))
typedef unsigned short bf16;
typedef unsigned v4u __attribute__((ext_vector_type(4)));
typedef unsigned v2u __attribute__((ext_vector_type(2)));
typedef float f32x4 __attribute__((ext_vector_type(4)));
typedef short bf16x8 __attribute__((ext_vector_type(8)));
typedef GAS unsigned gu32;
#define RLX_AGENT __ATOMIC_RELAXED, __HIP_MEMORY_SCOPE_AGENT
#define LDS_WAIT() asm volatile("s_waitcnt lgkmcnt(0)" ::: "memory")
#define VM_WAIT() asm volatile("s_waitcnt vmcnt(0)" ::: "memory")

__device__ __forceinline__ unsigned f2bf(float f) { unsigned u = __builtin_bit_cast(unsigned, f); return (u + 0x7fffu + ((u >> 16) & 1u)) >> 16; }
__device__ __forceinline__ unsigned pk2(float lo, float hi) { unsigned r; asm volatile("v_cvt_pk_bf16_f32 %0, %1, %2" : "=v"(r) : "v"(lo), "v"(hi)); return r; }
__device__ __forceinline__ float bflo(unsigned u) { return __uint_as_float(u << 16); }
__device__ __forceinline__ float bfhi(unsigned u) { return __uint_as_float(u & 0xffff0000u); }
__device__ __forceinline__ float bf2f(bf16 h) { return __uint_as_float((unsigned)h << 16); }
__device__ __forceinline__ int lane_id() { int l; asm volatile("v_mbcnt_lo_u32_b32 %0, -1, 0\n\tv_mbcnt_hi_u32_b32 %0, -1, %0" : "=v"(l)); return l; }
template <int CTRL> __device__ __forceinline__ float dpp_add(float v) { return v + __int_as_float(__builtin_amdgcn_update_dpp(0, __float_as_int(v), CTRL, 0xF, 0xF, false)); }
__device__ __forceinline__ float row_sum16(float v) {
    v = dpp_add<0xB1>(v); v = dpp_add<0x4E>(v); v = dpp_add<0x141>(v); v = dpp_add<0x140>(v); return v; }
__device__ __forceinline__ float rdlane(float v, int l) { return __int_as_float(__builtin_amdgcn_readlane(__float_as_int(v), l)); }
__device__ __forceinline__ float wave_sum(float v) { v = row_sum16(v); return (rdlane(v, 0) + rdlane(v, 16)) + (rdlane(v, 32) + rdlane(v, 48)); }
__device__ __forceinline__ float xor16_add(float v) { auto rr = __builtin_amdgcn_permlane16_swap(__float_as_uint(v), __float_as_uint(v), false, false); return __uint_as_float(rr[0]) + __uint_as_float(rr[1]); }
__device__ __forceinline__ int wave_sum_i(int v) { return (int)wave_sum((float)v); }
__device__ __forceinline__ int wave_scan_i(int v) { const int l = lane_id();
#pragma unroll
    for (int d = 1; d < 64; d <<= 1) { const int n = __builtin_amdgcn_ds_bpermute((l - d) << 2, v); if (l >= d) v += n; }
    return v; }
__device__ __forceinline__ float sigmoidf_(float x) { return __builtin_amdgcn_rcpf(1.f + __builtin_amdgcn_exp2f(-1.4426950408889634f * x)); }
__device__ __forceinline__ float siluf_(float x) { return x * __builtin_amdgcn_rcpf(1.f + __builtin_amdgcn_exp2f(-1.4426950408889634f * x)); }
__device__ __forceinline__ float softplusf_(float z) { return fmaxf(z, 0.f) + 0.6931471805599453f * __builtin_amdgcn_logf(1.f + __builtin_amdgcn_exp2f(-1.4426950408889634f * fabsf(z))); }

namespace pg8 {
#define PG8_LAS __attribute__((address_space(3)))
typedef unsigned short bf16_t;
typedef short bf16x8 __attribute__((ext_vector_type(8)));
typedef float f32x4 __attribute__((ext_vector_type(4)));
typedef unsigned u32x4 __attribute__((ext_vector_type(4)));
constexpr int BM = 256, BK = 64, HALF = 128, HTB = HALF * BK * 2, STAGE_BYTES = 8 * HTB, NXCD = 8, WGM = 8;

__host__ __device__ __forceinline__ int lds_byte(int r, int c) { const int st = (r >> 4) * 2 + (c >> 5), rr = r & 15, cc = c & 31, ob = rr * 64 + cc * 2; return st * 1024 + (ob ^ (((ob >> 9) & 1) << 5)); }
__host__ __device__ __forceinline__ void stage_rc(int b, int& R, int& C) { const int st = b / 1024, sb = b % 1024, swz = sb ^ (((sb >> 9) & 1) << 5); R = (st >> 1) * 16 + swz / 64; C = (st & 1) * 32 + (swz % 64) / 2; }
__host__ __device__ __forceinline__ int perm32(int rho) { const int n = rho >> 4, i = rho & 15; return 8 * (i >> 2) + 4 * n + (i & 3); }

struct Unit { int pm, pn, e, li, nr, r0; };

struct DenseSched {
    const bf16_t* A; const bf16_t* Bt; int K; int nM, nN, nwg, G, c; unsigned* pcnt = nullptr; unsigned* acnt = nullptr; unsigned aneed = 0;
    __device__ void init(const bf16_t* A_, const bf16_t* Bt_, int M, int N, int K_, int G_, int c_) { A = A_; Bt = Bt_; K = K_; nM = M / BM; nN = N / BM; nwg = nM * nN; G = G_; c = c_; }
    __device__ __forceinline__ bool next(int i, Unit& u) const {
        const long L = (long)i * G + c; if (L >= nwg) return false;
        int wgid = (int)L; { const int q = nwg / NXCD, r = nwg % NXCD, xcd = wgid % NXCD, off = wgid / NXCD; wgid = (xcd < r ? xcd * (q + 1) : r * (q + 1) + (xcd - r) * q) + off; }
        const int nig = WGM * nN, gid = wgid / nig, fm = gid * WGM, gsz = (nM - fm) < WGM ? (nM - fm) : WGM;
        u.pm = fm + ((wgid % nig) % gsz); u.pn = (wgid % nig) / gsz; u.e = 0; u.li = i; u.nr = 256; u.r0 = u.pm * BM; return true;
    }
    __device__ __forceinline__ const char* a_base(const Unit& u) const { return (const char*)A + (size_t)u.pm * BM * K * 2; }
    __device__ __forceinline__ const char* b_base(const Unit& u) const { return (const char*)Bt + (size_t)u.pn * BM * K * 2; }
    static constexpr bool GATHER = false;
    __device__ __forceinline__ void a_ready(const Unit& u, int wid, int lane) const {
        if (acnt) {
            if (wid == 0) { unsigned sp = 0;
                while ((unsigned)__builtin_amdgcn_readfirstlane(__hip_atomic_load(acnt + 64 * u.pm, __ATOMIC_RELAXED, __HIP_MEMORY_SCOPE_AGENT)) < aneed) { __builtin_amdgcn_s_sleep(2); if (++sp > (1u << 20)) break; }
                __builtin_amdgcn_fence(__ATOMIC_ACQUIRE, "agent");
                asm volatile("s_waitcnt vmcnt(0)" ::: "memory"); }
            asm volatile("" ::: "memory"); __builtin_amdgcn_s_barrier(); asm volatile("" ::: "memory");
        }
    }
    __device__ __forceinline__ void publish(int pm, int lane) const { if (pcnt && lane == 0) __hip_atomic_fetch_add(pcnt + 64 * pm, 1u, __ATOMIC_RELAXED, __HIP_MEMORY_SCOPE_AGENT); }
    __device__ __forceinline__ void a_off(const Unit&, int tid, unsigned (&v)[4]) const {
#pragma unroll
        for (int i = 0; i < 2; ++i) { int R, C; stage_rc(tid * 16 + i * 8192, R, C);
#pragma unroll
            for (int h = 0; h < 2; ++h) v[2 * h + i] = (unsigned)((h * HALF + R) * K + C) * 2u; }
    }
};

template <class Epi, class Sched, bool ALIGN_EPI>
__device__ __forceinline__ void gemm_phase(PG8_LAS unsigned char* lds, const int K, const Sched& S, const Epi& E, const int wave_id) {
    int wid_ = wave_id; asm volatile("" : "+s"(wid_));
    const int wid = wid_, lane = lane_id(), tid = wid * 64 + lane,
        wr = wid >> 2, wc = wid & 3, fr = lane & 15, fq = lane >> 4;
    const int nt = K / BK;
    unsigned voffB[2];
#pragma unroll
    for (int i = 0; i < 2; ++i) { int R, C; stage_rc(tid * 16 + i * 8192, R, C); const int Rb = Epi::PERM ? ((R & ~31) + perm32(R & 31)) : R; voffB[i] = (unsigned)(Rb * K + C) * 2u; }
    const size_t kstep = (size_t)(BK * 2);
    const size_t hstep = (size_t)HALF * K * 2;
    const unsigned ldsw = (unsigned)wid * 1024u;
    const int aoff = lds_byte(wr * 64 + fr, fq * 8), boff = lds_byte(wc * 32 + fr, fq * 8);
#define PG8_SA(b, h) (((b) * 2 + (h)) * HTB)
#define PG8_SB(b, h) ((4 + (b) * 2 + (h)) * HTB)
#define PG8_STAGE2(bufoff, gbase, o0, o1) do { \
        __builtin_amdgcn_global_load_lds((const unsigned*)((const char*)(gbase) + (o0)), (PG8_LAS unsigned*)(lds + (bufoff) + ldsw), 16, 0, 0); \
        __builtin_amdgcn_global_load_lds((const unsigned*)((const char*)(gbase) + (o1)), (PG8_LAS unsigned*)(lds + (bufoff) + ldsw + 8192), 16, 0, 0); } while (0)
#define PG8_STAGEB(bufoff, gbase) PG8_STAGE2(bufoff, gbase, voffB[0], voffB[1])
#define PG8_LDA(dst, b, h) do { _Pragma("unroll") for (int m = 0; m < 4; ++m) _Pragma("unroll") for (int k = 0; k < 2; ++k) dst[m][k] = *(const PG8_LAS bf16x8*)(lds + PG8_SA(b, h) + aoff + m * 2048 + k * 1024); } while (0)
#define PG8_LDB(dst, b, h) do { _Pragma("unroll") for (int n = 0; n < 2; ++n) _Pragma("unroll") for (int k = 0; k < 2; ++k) dst[n][k] = *(const PG8_LAS bf16x8*)(lds + PG8_SB(b, h) + boff + n * 2048 + k * 1024); } while (0)
#define PG8_MMA(ai, bj, At, Bt) do { __builtin_amdgcn_s_setprio(1); _Pragma("unroll") for (int m = 0; m < 4; ++m) _Pragma("unroll") for (int n = 0; n < 2; ++n) _Pragma("unroll") for (int k = 0; k < 2; ++k) \
        acc[ai][bj][m][n] = __builtin_amdgcn_mfma_f32_16x16x32_bf16(Bt[n][k], At[m][k], acc[ai][bj][m][n], 0, 0, 0); __builtin_amdgcn_s_setprio(0); } while (0)
#define PG8_WAIT_V(n) asm volatile("s_waitcnt vmcnt(" #n ")" ::: "memory")
#define PG8_WAIT_V8_UNLESS(p) do { int pp_ = __builtin_amdgcn_readfirstlane(p); asm volatile("s_cmp_lt_i32 %0, 0\n\ts_cbranch_scc0 .Lpg8skip_%=\n\ts_waitcnt vmcnt(8)\n.Lpg8skip_%=:" : "+s"(pp_) :: "memory", "scc"); } while (0)
#define PG8_WAIT_L(n) asm volatile("s_waitcnt lgkmcnt(" #n ")" ::: "memory")
#define PG8_BAR __builtin_amdgcn_s_barrier()
#define PG8_SCHED __builtin_amdgcn_sched_barrier(0)
    Unit cur, nxt; int ui = 0;
    if (!S.next(0, cur)) return;
    f32x4 acc[2][2][4][2];
#pragma unroll
    for (int a = 0; a < 2; ++a)
#pragma unroll
        for (int b = 0; b < 2; ++b)
#pragma unroll
            for (int m = 0; m < 4; ++m)
#pragma unroll
                for (int n = 0; n < 2; ++n) acc[a][b][m][n] = (f32x4){0.f, 0.f, 0.f, 0.f};
    bf16x8 At[4][2], B0[2][2], B1[2][2];
    unsigned vc[4];
    S.a_ready(cur, wid, lane);
    S.a_off(cur, tid, vc);
    const char* cA = S.a_base(cur); const char* cB = S.b_base(cur);
    E.prefetch(cur, tid, (PG8_LAS unsigned*)(lds + STAGE_BYTES + 1024 + wid * 256));
    PG8_STAGEB(PG8_SB(0, 0), cB); PG8_STAGEB(PG8_SB(0, 1), cB + hstep); PG8_STAGE2(PG8_SA(0, 0), cA, vc[0], vc[1]); PG8_STAGE2(PG8_SA(0, 1), cA, vc[2], vc[3]);
    if (wr == 1) PG8_BAR;
    PG8_WAIT_V(2); PG8_BAR;
    PG8_STAGEB(PG8_SB(1, 0), cB + kstep); PG8_STAGE2(PG8_SA(1, 0), cA + kstep, vc[0], vc[1]); PG8_STAGEB(PG8_SB(1, 1), cB + hstep + kstep);
    PG8_WAIT_V(6); PG8_BAR;
    int pend = -1;
    for (;;) {
        const bool has_next = S.next(ui + 1, nxt);
        const char* nA = cA; const char* nB = cB;
        if (has_next) { nA = S.a_base(nxt); nB = S.b_base(nxt); }
        for (int t = 0; t < nt; t += 2) {
            const bool last = (t == nt - 2);
            if (last && has_next) S.a_ready(nxt, wid, lane);
            const char* a1 = cA + (size_t)(t + 1) * kstep;
            const char* a2 = last ? nA : cA + (size_t)(t + 2) * kstep; const char* b2 = last ? nB : cB + (size_t)(t + 2) * kstep;
            const char* a3 = a2 + kstep; const char* b3 = b2 + kstep;
            PG8_LDB(B0, 0, 0); PG8_LDB(B1, 0, 1); PG8_SCHED; PG8_LDA(At, 0, 0); PG8_STAGE2(PG8_SA(1, 1), a1, vc[2], vc[3]);
            if constexpr (Sched::GATHER) { if (last && has_next) S.a_off(nxt, tid, vc); }
            PG8_WAIT_V8_UNLESS(pend);
            PG8_WAIT_L(0); PG8_BAR; PG8_MMA(0, 0, At, B0); PG8_MMA(0, 1, At, B1); PG8_BAR; PG8_SCHED;
            PG8_LDA(At, 0, 1); PG8_STAGEB(PG8_SB(0, 0), b2); PG8_STAGEB(PG8_SB(0, 1), b2 + hstep); PG8_STAGE2(PG8_SA(0, 0), a2, vc[0], vc[1]);
            PG8_WAIT_V8_UNLESS(pend);
            PG8_WAIT_L(0); PG8_BAR; PG8_MMA(1, 0, At, B0); PG8_MMA(1, 1, At, B1); PG8_BAR; PG8_SCHED;
            PG8_LDB(B0, 1, 0); PG8_LDB(B1, 1, 1); PG8_SCHED; PG8_LDA(At, 1, 0); PG8_STAGE2(PG8_SA(0, 1), a2, vc[2], vc[3]);
            PG8_WAIT_V8_UNLESS(pend);
            PG8_WAIT_L(0); PG8_BAR; PG8_MMA(0, 0, At, B0); PG8_MMA(0, 1, At, B1); PG8_BAR; PG8_SCHED;
            PG8_LDA(At, 1, 1); PG8_STAGEB(PG8_SB(1, 0), b3); PG8_STAGEB(PG8_SB(1, 1), b3 + hstep); PG8_STAGE2(PG8_SA(1, 0), a3, vc[0], vc[1]);
            PG8_WAIT_V(8);
            if (pend >= 0) { S.publish(pend, lane); pend = -1; }
            PG8_WAIT_L(0); PG8_BAR; PG8_MMA(1, 0, At, B0); PG8_MMA(1, 1, At, B1); PG8_BAR; PG8_SCHED;
        }
        PG8_WAIT_V(0);
        if constexpr (ALIGN_EPI) { if (wr == 0) PG8_BAR; }
        E(acc, cur, wr, wc, fr, fq);
        pend = __builtin_amdgcn_readfirstlane(cur.pm);
        if (!has_next) break;
#pragma unroll
        for (int a = 0; a < 2; ++a)
#pragma unroll
            for (int b = 0; b < 2; ++b)
#pragma unroll
                for (int m = 0; m < 4; ++m)
#pragma unroll
                    for (int n = 0; n < 2; ++n) acc[a][b][m][n] = (f32x4){0.f, 0.f, 0.f, 0.f};
        cur = nxt; cA = nA; cB = nB; ++ui;
        if constexpr (ALIGN_EPI) { if (wr == 1) PG8_BAR; }
    }
    PG8_WAIT_V(0);
    if (pend >= 0) S.publish(pend, lane);
    if constexpr (!ALIGN_EPI) { if (wr == 0) PG8_BAR; }
    PG8_BAR;
#undef PG8_SA
#undef PG8_SB
#undef PG8_STAGE2
#undef PG8_STAGEB
#undef PG8_LDA
#undef PG8_LDB
#undef PG8_MMA
#undef PG8_WAIT_V
#undef PG8_WAIT_L
#undef PG8_WAIT_V8_UNLESS
#undef PG8_BAR
#undef PG8_SCHED
}
}

constexpr size_t MiB = 1u << 20;
constexpr size_t WS_CTL = 0, CTL_ZERO_BYTES = 1 * MiB;
constexpr size_t WS_MOD = 1 * MiB;
constexpr size_t WS_ALOWW = WS_MOD + 256 * 1024;
constexpr size_t WS_CNTW = WS_ALOWW + 64 * 1024;
constexpr size_t WS_EIDX = WS_CNTW + 16 * 1024;
constexpr size_t WS_EW = WS_EIDX + (size_t)2 * T * 4;
constexpr size_t WS_LOC = WS_EW + (size_t)2 * T * 4;
constexpr size_t WS_ALOW = WS_LOC + 1 * MiB;
constexpr size_t WS_WPT = WS_ALOW + 1 * MiB;
constexpr size_t WS_WIN0 = 5 * MiB;
constexpr size_t WS_WOUT0 = WS_WIN0 + (size_t)NIN0 * D * 2;
constexpr size_t WS_WIN1 = WS_WOUT0 + (size_t)D * D * 2;
constexpr size_t WS_WOUT1 = WS_WIN1 + (size_t)NIN1 * D * 2;
constexpr size_t WS_WGU = WS_WOUT1 + (size_t)D * D * 2;
constexpr size_t WS_WD = WS_WGU + (size_t)2 * NE * 1024 * D * 2;
constexpr size_t WS_X1 = WS_WD + (size_t)2 * NE * D * DE * 2;
constexpr size_t WS_XN = WS_X1 + (size_t)T * D * 2;
constexpr size_t WS_QKVY = WS_XN + (size_t)T * D * 2;
constexpr size_t WS_CAT = WS_QKVY + (size_t)T * QW * 2;
constexpr size_t WS_END = WS_CAT + (size_t)(2 * T + 256) * DE * 2;
static_assert(WS_WPT + 128 * 1024 <= WS_WIN0, "small tables fit below the weights");
static_assert(WS_END <= 346000000, "workspace budget");
constexpr int CW_BAR = 4096;
constexpr int CW_APANEL = 98304;
constexpr int CW_PANEL = 65536;

constexpr int RING_BYTES = 131072;
constexpr int LDSCTL_OFF = RING_BYTES;
constexpr int L_MISC = LDSCTL_OFF;
constexpr int L_NE = L_MISC + 256;
constexpr int L_ROWTAB = L_NE + 512;
constexpr int LDS_BYTES = 147456;
static_assert(L_ROWTAB + 8192 <= LDS_BYTES, "LDS map");

#define XB_TMO      128
#define XB_XCNT(j)  (256  + 64 * (j))
#define XB_XSUB(j)  (1280 + 64 * (j))
#define XB_XGEN(j)  (2304 + 64 * (j))
#define XB_TOP      3328
#define XB_TOPGEN   3392
#define XCD_BAR_WORDS 3456
#define XB_SPIN_CAP (1u << 18)
__device__ __forceinline__ unsigned xb_ld(unsigned* p)              { return __hip_atomic_load(p, __ATOMIC_RELAXED, __HIP_MEMORY_SCOPE_AGENT); }
__device__ __forceinline__ unsigned xb_add(unsigned* p, unsigned v) { return __hip_atomic_fetch_add(p, v, __ATOMIC_RELAXED, __HIP_MEMORY_SCOPE_AGENT); }
__device__ __forceinline__ unsigned xb_xcc_id() { return (unsigned)__builtin_amdgcn_s_getreg((3 << 11) | 20) & 0xFu; }
#define XB_SPIN(cond, bar) do { unsigned _sp = 0; while (cond) { __builtin_amdgcn_s_sleep(1); \
    if ((++_sp & 255u) == 0u) { if (xb_ld(&(bar)[XB_TMO])) break; if (_sp > XB_SPIN_CAP) { atomicAdd(&(bar)[XB_TMO], 1u); break; } } } } while (0)
struct XcdBarrier { unsigned* bar; unsigned x; volatile LAS unsigned* st; int wave; };
__device__ __forceinline__ XcdBarrier xcd_barrier_post(unsigned* bar, volatile LAS unsigned* st, int wave) {
    XcdBarrier b; b.bar = bar; b.x = xb_xcc_id(); b.st = st; b.wave = wave;
    if (wave == 0 && lane_id() == 0) (void)xb_add(&bar[XB_XCNT(b.x)], 1u);
    return b;
}
__device__ __forceinline__ void xcd_barrier_complete(unsigned* bar, unsigned x, unsigned& nloc, unsigned& nx) {
    const unsigned G = gridDim.x * gridDim.y * gridDim.z;
    unsigned sum, cnt, mine, sp = 0u;
    for (;;) {
        sum = 0u; cnt = 0u; mine = 0u;
#pragma unroll
        for (unsigned j = 0; j < 16; ++j) { const unsigned c = xb_ld(&bar[XB_XCNT(j)]); sum += c; cnt += (c > 0u) ? 1u : 0u; mine = (j == x) ? c : mine; }
        if (sum == G) break;
        __builtin_amdgcn_s_sleep(1);
        if ((++sp & 255u) == 0u) { if (xb_ld(&bar[XB_TMO])) break; if (sp > XB_SPIN_CAP) { atomicAdd(&bar[XB_TMO], 1u); break; } }
    }
    nloc = mine > 0u ? mine : 1u; nx = cnt > 0u ? cnt : 1u;
}
__device__ __forceinline__ void xcd_barrier(const XcdBarrier& b) {
    asm volatile("s_waitcnt vmcnt(0)" ::: "memory");
    __syncthreads();
    if (b.wave == 0 && lane_id() == 0) {
        unsigned* bar = b.bar;
        __builtin_amdgcn_s_waitcnt(0);
        unsigned nloc = b.st[0], nx = b.st[1];
        if (nloc == 0u) { xcd_barrier_complete(bar, b.x, nloc, nx); b.st[0] = nloc; b.st[1] = nx; }
        const unsigned old = xb_add(&bar[XB_XSUB(b.x)], 1u);
        const unsigned gen = old / nloc;
        if (old + 1u == (gen + 1u) * nloc) {
            __builtin_amdgcn_fence(__ATOMIC_RELEASE, "agent");
            asm volatile("s_waitcnt vmcnt(0)" ::: "memory");
            const unsigned og = xb_add(&bar[XB_TOP], 1u);
            const unsigned tg = og / nx;
            if (og + 1u == (tg + 1u) * nx) xb_add(&bar[XB_TOPGEN], 1u);
            else XB_SPIN(xb_ld(&bar[XB_TOPGEN]) == tg, bar);
            __builtin_amdgcn_fence(__ATOMIC_ACQUIRE, "agent");
            xb_add(&bar[XB_XGEN(b.x)], 1u);
            asm volatile("s_waitcnt vmcnt(0)" ::: "memory");
        } else {
            XB_SPIN(xb_ld(&bar[XB_XGEN(b.x)]) == gen, bar);
            __builtin_amdgcn_fence(__ATOMIC_ACQUIRE, "agent");
            asm volatile("s_waitcnt vmcnt(0)" ::: "memory");
        }
    }
    __syncthreads();
}

struct Args { const float* in[26]; float* out; unsigned char* ws; };
struct Frame {
    LAS unsigned char* lds; unsigned char* ws;
    int tid, lane, wave, vcu, G, bx;
};
typedef const __attribute__((address_space(4))) Args* KA;
__device__ __forceinline__ KA kargs() { auto p = __builtin_amdgcn_kernarg_segment_ptr(); asm volatile("" : "+s"(p)); return (KA)p; }
#define INP(k) (args->in[k])

struct P0Item { const float* s; bf16* d; int ldw, Kd; };
__device__ __forceinline__ void p0_load(const P0Item& it, float (&r)[32], int lane) {
#pragma unroll
    for (int i = 0; i < 32; ++i) r[i] = __builtin_nontemporal_load(it.s + (size_t)(2 * i + (lane >> 5)) * it.ldw + (lane & 31));
}
__device__ __forceinline__ void p0_store(const P0Item& it, const float (&r)[32], LAS float* scr, int lane) {
#pragma unroll
    for (int i = 0; i < 32; ++i) scr[(2 * i + (lane >> 5)) * 33 + (lane & 31)] = r[i];
    LDS_WAIT(); asm volatile("" ::: "memory");
    const int c = lane & 7;
#pragma unroll
    for (int j = 0; j < 4; ++j) { const int n = (lane >> 3) + 8 * j; const LAS float* sp = scr + (8 * c) * 33 + n;
        v4u o; o.x = pk2(sp[0 * 33], sp[1 * 33]); o.y = pk2(sp[2 * 33], sp[3 * 33]); o.z = pk2(sp[4 * 33], sp[5 * 33]); o.w = pk2(sp[6 * 33], sp[7 * 33]);
        __builtin_nontemporal_store(o, (GAS v4u*)(it.d + (size_t)n * it.Kd + 8 * c)); }
    LDS_WAIT(); asm volatile("" ::: "memory");
}
template <class DMap>
__device__ __forceinline__ P0Item p0_matrix(const float* W, int ldw, int K, int scol0, int ncols, bf16* WT, const DMap& dmap, int it) {
    const int nblk = ncols / 32, kb = it / nblk, nb = it % nblk, n0 = 32 * nb;
    return P0Item{W + (size_t)(64 * kb) * ldw + scol0 + n0, WT + (size_t)(dmap(n0 >> 7) + (n0 & 127)) * K + 64 * kb, ldw, K};
}
struct MapId { int base; __device__ int operator()(int g) const { return base + 128 * g; } };
struct MapGlu { int second; __device__ int operator()(int g) const { return 256 * g + second; } };

constexpr int P0_I_IN0A = 16 * 16, P0_I_IN0Q = 16 * 48, P0_I_OUT = 16 * 32, P0_I_IN1A = 16 * 48, P0_I_IN1P = 16 * 16, P0_I_G = 16 * 16, P0_I_D = 8 * 32;
constexpr int P0_I_MOE = 2 * P0_I_G + P0_I_D;
constexpr int P0_I_PW = 4 * 8;
constexpr int P0_NITEMS = 2 * P0_I_IN0A + P0_I_IN0Q + 2 * P0_I_OUT + P0_I_IN1A + P0_I_IN1P + P0_I_PW + 32 * P0_I_MOE;
constexpr int P0_NFILL = 8 * P0_I_MOE;
__device__ __forceinline__ void p0_items(KA args, Frame& F, int first, int last, int widx, int nw) {
    LAS float* scr = (LAS float*)(F.lds + F.wave * 16384);
    auto decode = [&](int it) -> P0Item {
        KA args = kargs();
        unsigned char* ws = args->ws;
        bf16* win0 = (bf16*)(ws + WS_WIN0); bf16* wout0 = (bf16*)(ws + WS_WOUT0); bf16* win1 = (bf16*)(ws + WS_WIN1); bf16* wout1 = (bf16*)(ws + WS_WOUT1);
        int r = it;
        if (r < P0_I_IN0A) return p0_matrix(INP(6), NIN0, D, 0, 512, win0, MapGlu{0}, r); r -= P0_I_IN0A;
        if (r < P0_I_IN0A) return p0_matrix(INP(6), NIN0, D, 512, 512, win0, MapGlu{128}, r); r -= P0_I_IN0A;
        if (r < P0_I_IN0Q) return p0_matrix(INP(6), NIN0, D, 1024, 1536, win0, MapId{1024}, r); r -= P0_I_IN0Q;
        if (r < P0_I_OUT) return p0_matrix(INP(7), D, D, 0, 1024, wout0, MapId{0}, r); r -= P0_I_OUT;
        if (r < P0_I_IN1A) return p0_matrix(INP(12), 2064, D, 0, 1536, win1, MapId{0}, r); r -= P0_I_IN1A;
        if (r < P0_I_IN1P) return p0_matrix(INP(12), 2064, D, 1552, 512, win1, MapId{1536}, r); r -= P0_I_IN1P;
        if (r < P0_I_OUT) return p0_matrix(INP(13), D, D, 0, 1024, wout1, MapId{0}, r); r -= P0_I_OUT;
        if (r < P0_I_PW) { const int g = r >> 3; return p0_matrix(INP(17) + (size_t)g * 128 * 128, 128, 128, 0, 128, (bf16*)(ws + WS_WPT) + (size_t)g * 128 * 128, MapId{0}, r & 7); } r -= P0_I_PW;
        const int le = r / P0_I_MOE; r -= le * P0_I_MOE;
        bf16* wgu = (bf16*)(ws + WS_WGU) + (size_t)le * 1024 * D; bf16* wd = (bf16*)(ws + WS_WD) + (size_t)le * D * DE;
        if (r < P0_I_G) return p0_matrix(INP(22) + (size_t)le * D * DE, DE, D, 0, 512, wgu, MapGlu{0}, r); r -= P0_I_G;
        if (r < P0_I_G) return p0_matrix(INP(23) + (size_t)le * D * DE, DE, D, 0, 512, wgu, MapGlu{128}, r); r -= P0_I_G;
        return p0_matrix(INP(24) + (size_t)le * DE * D, D, DE, 0, 1024, wd, MapId{0}, r);
    };
    const int i0 = first + widx;
    if (i0 < last) {
        P0Item cur = decode(i0); float rc[32]; p0_load(cur, rc, F.lane);
        for (int it = i0; it < last; it += nw) {
            P0Item nx = cur; float rn[32];
            if (it + nw < last) { nx = decode(it + nw); p0_load(nx, rn, F.lane); }
            p0_store(cur, rc, scr, F.lane);
            if (it + nw < last) { cur = nx;
#pragma unroll
                for (int i = 0; i < 32; ++i) rc[i] = rn[i]; }
        }
    }
}
__device__ __forceinline__ void p0_prologue(KA args, Frame& F) {
    unsigned char* ws = F.ws;
    if (F.vcu < 192) {
        LAS float* cs = (LAS float*)F.lds;
        LAS float* part = (LAS float*)(F.lds + 16384);
        const float* c = INP(1);
        for (int i = F.tid; i < 4096; i += 512) cs[i] = siluf_(c[i]);
        __syncthreads();
        const int l = F.vcu / 96, cg = F.vcu % 96;
        const float* wp = INP(2) + (size_t)l * 1024 * 6144 + 64 * cg + F.lane;
        float a0 = 0.f, a1 = 0.f, a2 = 0.f, a3 = 0.f;
#pragma unroll 16
        for (int kk = 0; kk < 128; ++kk) { const int k = 128 * F.wave + kk; const float wv = __builtin_nontemporal_load(wp + (size_t)k * 6144);
            a0 += cs[k] * wv; a1 += cs[1024 + k] * wv; a2 += cs[2048 + k] * wv; a3 += cs[3072 + k] * wv; }
        part[(F.wave * 4 + 0) * 64 + F.lane] = a0; part[(F.wave * 4 + 1) * 64 + F.lane] = a1; part[(F.wave * 4 + 2) * 64 + F.lane] = a2; part[(F.wave * 4 + 3) * 64 + F.lane] = a3;
        __syncthreads();
        float* mod = (float*)(ws + WS_MOD);
        if (F.tid < 256) { const int b = F.tid >> 6, col = F.tid & 63; float sm = INP(3)[l * 6144 + 64 * cg + col];
#pragma unroll
            for (int w = 0; w < 8; ++w) sm += part[(w * 4 + b) * 64 + col];
            mod[(l * 4 + b) * 6144 + 64 * cg + col] = sm; }
        __syncthreads();
    }
    { float* aw = (float*)(ws + WS_ALOWW); const float* w1 = INP(12);
      for (int i = F.vcu * 512 + F.tid; i < 1024 * 16; i += F.G * 512) aw[i] = w1[(size_t)(i >> 4) * 2064 + 1536 + (i & 15)]; }
    p0_items(args, F, 0, P0_NITEMS - P0_NFILL, F.vcu * 8 + F.wave, F.G * 8);
}

#ifdef PROBE_TS
#define TS_RAW(m) do { if (threadIdx.x == 0) ((unsigned long long*)(args->ws + 524288))[(26 + (m)) * 256 + blockIdx.x] = __builtin_amdgcn_s_memrealtime(); } while (0)
#else
#define TS_RAW(m) do {} while (0)
#endif
#ifdef PROBE_TS
#ifndef PROBE_LO
#define PROBE_LO 0
#define PROBE_HI 256
#endif
#define TSBUF ((unsigned long long*)(ws + WS_CTL + 524288))
#define TS_PUT(slot) do { if (F.tid == 0) TSBUF[(slot) * 256 + F.bx] = __builtin_amdgcn_s_memrealtime(); } while (0)
#define TS_PRE(idx) do { __syncthreads(); TS_PUT(1 + 2 * (idx)); } while (0)
#define TS_MARK(m) do { if (l == 0) { unsigned char* ws = F.ws; TS_PUT(26 + (m)); } } while (0)
#define TS_MARK1(m) do { if (l == 1) { unsigned char* ws = F.ws; TS_PUT(26 + (m)); } } while (0)
#define TS_POST(idx) TS_PUT(2 + 2 * (idx))
#define SEAM_IDX(k) ((k) == 0 ? 0 : (k) <= 4 ? (k) - 1 : (k) == 6 ? 4 : (k) == 9 ? 5 : (k) == 10 ? 8 : (k) == 11 ? 9 : 10)
#else
#define TS_PUT(slot) do {} while (0)
#define TS_MARK(m) do {} while (0)
#define TS_MARK1(m) do {} while (0)
#define TS_PRE(idx) do {} while (0)
#define TS_POST(idx) do {} while (0)
#define SEAM_IDX(k) 0
#endif
__device__ __forceinline__ void norm_row(f32x4 (&v)[4], int lane, const float* g, const float* sc, const float* sh) {
    float s = 0.f;
#pragma unroll
    for (int j = 0; j < 4; ++j) s += (v[j].x * v[j].x + v[j].y * v[j].y) + (v[j].z * v[j].z + v[j].w * v[j].w);
    const float r = rsqrtf(wave_sum(s) * (1.f / D) + 1e-6f);
#pragma unroll
    for (int j = 0; j < 4; ++j) { const int c = 4 * lane + 256 * j; const f32x4 gg = *(const f32x4*)(g + c);
        v[j] = v[j] * r * gg;
        if (sc) { const f32x4 s1 = *(const f32x4*)(sc + c), s0 = *(const f32x4*)(sh + c); v[j] = v[j] * (1.f + s1) + s0; } }
}
template <bool SHIFT> __device__ __forceinline__ void norm_row_pre(f32x4 (&v)[4], const f32x4 (&A)[4], const f32x4 (&Bv)[4]) {
    float s = 0.f;
#pragma unroll
    for (int j = 0; j < 4; ++j) s += (v[j].x * v[j].x + v[j].y * v[j].y) + (v[j].z * v[j].z + v[j].w * v[j].w);
    const float r = rsqrtf(wave_sum(s) * (1.f / D) + 1e-6f);
#pragma unroll
    for (int j = 0; j < 4; ++j) { v[j] = v[j] * r * A[j]; if (SHIFT) v[j] = v[j] + Bv[j]; }
}
__device__ __forceinline__ void load_colvec(f32x4 (&A)[4], f32x4 (&Bv)[4], int lane, const float* g, const float* sc, const float* sh) {
#pragma unroll
    for (int j = 0; j < 4; ++j) { const int c = 4 * lane + 256 * j; const f32x4 gg = *(const f32x4*)(g + c);
        if (sc) { const f32x4 s1 = *(const f32x4*)(sc + c); A[j] = gg * (1.f + s1); Bv[j] = *(const f32x4*)(sh + c); } else { A[j] = gg; Bv[j] = (f32x4){0.f, 0.f, 0.f, 0.f}; } }
}
__device__ __forceinline__ void store_row_bf16_wt(const f32x4 (&v)[4], int lane, bf16* orow) {
    bf16* o = orow + 4 * lane;
#pragma unroll
    for (int j = 0; j < 4; ++j) { v2u w; w.x = pk2(v[j].x, v[j].y); w.y = pk2(v[j].z, v[j].w); asm volatile("global_store_dwordx2 %0, %1, off sc1" :: "v"(o + 256 * j), "v"(w) : "memory"); }
}
__device__ __forceinline__ void store_row_bf16(const f32x4 (&v)[4], int lane, bf16* orow) {
    GAS v2u* o = (GAS v2u*)orow + lane;
#pragma unroll
    for (int j = 0; j < 4; ++j) { v2u w; w.x = pk2(v[j].x, v[j].y); w.y = pk2(v[j].z, v[j].w); o[64 * j] = w; }
}


__device__ __forceinline__ void load_row_bf16(const bf16* row, int lane, f32x4 (&v)[4]) {
    const GAS v2u* p = (const GAS v2u*)row + lane;
#pragma unroll
    for (int j = 0; j < 4; ++j) { const v2u w = p[64 * j]; v[j] = (f32x4){bflo(w.x), bfhi(w.x), bflo(w.y), bfhi(w.y)}; }
}
constexpr int W16_PITCH = 20;
__device__ __forceinline__ void stage_w16(LAS float* tabw, const float* w, int tid) {
    f32x4 v[8];
#pragma unroll
    for (int u = 0; u < 8; ++u) { const int i = tid + 512 * u; v[u] = *(const f32x4*)(w + (i >> 2) * 16 + 4 * (i & 3)); }
#pragma unroll
    for (int u = 0; u < 8; ++u) { const int i = tid + 512 * u, c = i >> 2, k4 = i & 3;
        const int sidx = ((c >> 8) * 4 + (c & 3)) * 64 + ((c >> 2) & 63); *(LAS f32x4*)(tabw + sidx * W16_PITCH + 4 * k4) = v[u]; }
}
__device__ __forceinline__ void dot16(const f32x4 (&v)[4], const LAS float* tabw, int lane, float (&lg)[16]) {
    float a[16];
#pragma unroll
    for (int e = 0; e < 16; ++e) a[e] = 0.f;
#pragma unroll
    for (int j = 0; j < 4; ++j)
#pragma unroll
        for (int q = 0; q < 4; ++q) { const float hv = v[j][q]; const LAS float* p = tabw + ((j * 4 + q) * 64 + lane) * W16_PITCH;
#pragma unroll
            for (int k = 0; k < 4; ++k) { const f32x4 w = *(const LAS f32x4*)(p + 4 * k); a[4 * k] += hv * w.x; a[4 * k + 1] += hv * w.y; a[4 * k + 2] += hv * w.z; a[4 * k + 3] += hv * w.w; } }
    float b[8], c[4];
#pragma unroll
    for (int i = 0; i < 8; ++i) { auto rr = __builtin_amdgcn_permlane32_swap(__float_as_uint(a[i]), __float_as_uint(a[i + 8]), false, false); b[i] = __uint_as_float(rr[0]) + __uint_as_float(rr[1]); }
#pragma unroll
    for (int i = 0; i < 4; ++i) { auto rr = __builtin_amdgcn_permlane16_swap(__float_as_uint(b[i]), __float_as_uint(b[i + 4]), false, false); c[i] = row_sum16(__uint_as_float(rr[0]) + __uint_as_float(rr[1])); }
#pragma unroll
    for (int e = 0; e < 16; ++e) lg[e] = rdlane(c[e & 3], 16 * (e >> 2));
}

__device__ __forceinline__ void store16_wt(void* p, v4u v) { asm volatile("global_store_dwordx4 %0, %1, off sc1\n\ts_nop 1" :: "v"(p), "v"(v) : "memory"); }

struct EpiIn0 {
    static constexpr bool PERM = true;
    __device__ __forceinline__ void prefetch(const pg8::Unit&, int, LAS unsigned*) const {}
    bf16* O;
    __device__ __forceinline__ void operator()(const f32x4 (&acc)[2][2][4][2], const pg8::Unit& u, int wr, int wc, int fr, int fq) const {
        const int row0 = u.pm * 256 + wr * 64 + fr;
        if (u.pn < 4) {
            const int col0 = u.pn * 128 + wc * 32 + 8 * fq;
#pragma unroll
            for (int ai = 0; ai < 2; ++ai)
#pragma unroll
                for (int m = 0; m < 4; ++m) { bf16* rowp = O + (size_t)(row0 + ai * 128 + m * 16) * QW + col0;
                    const f32x4 a0 = acc[ai][0][m][0], a1 = acc[ai][0][m][1], g0 = acc[ai][1][m][0], g1 = acc[ai][1][m][1];
                    v4u w; w.x = pk2(a0[0] * sigmoidf_(g0[0]), a0[1] * sigmoidf_(g0[1])); w.y = pk2(a0[2] * sigmoidf_(g0[2]), a0[3] * sigmoidf_(g0[3]));
                    w.z = pk2(a1[0] * sigmoidf_(g1[0]), a1[1] * sigmoidf_(g1[1])); w.w = pk2(a1[2] * sigmoidf_(g1[2]), a1[3] * sigmoidf_(g1[3]));
                    *(v4u*)rowp = w; }
        } else {
            const float sc = (u.pn < 6) ? QSCALE0 : 1.f;
            const int col0 = 512 + (u.pn - 4) * 256 + wc * 32 + 8 * fq;
#pragma unroll
            for (int ai = 0; ai < 2; ++ai)
#pragma unroll
                for (int m = 0; m < 4; ++m) { bf16* rowp = O + (size_t)(row0 + ai * 128 + m * 16) * QW + col0;
#pragma unroll
                    for (int bj = 0; bj < 2; ++bj) { const f32x4 v0 = acc[ai][bj][m][0] * sc, v1 = acc[ai][bj][m][1] * sc;
                        v4u w; w.x = pk2(v0[0], v0[1]); w.y = pk2(v0[2], v0[3]); w.z = pk2(v1[0], v1[1]); w.w = pk2(v1[2], v1[3]);
                        *(v4u*)(rowp + bj * 128) = w; } }
        }
    }
};
struct EpiIn1 {
    static constexpr bool PERM = true;
    __device__ __forceinline__ void prefetch(const pg8::Unit&, int, LAS unsigned*) const {}
    bf16* O;
    __device__ __forceinline__ void operator()(const f32x4 (&acc)[2][2][4][2], const pg8::Unit& u, int wr, int wc, int fr, int fq) const {
        const int row0 = u.pm * 256 + wr * 64 + fr;
        const float sc = (u.pn == 0) ? 0.125f : 1.f;
        const int col0 = u.pn * 256 + wc * 32 + 8 * fq;
#pragma unroll
        for (int ai = 0; ai < 2; ++ai)
#pragma unroll
            for (int m = 0; m < 4; ++m) { bf16* rowp = O + (size_t)(row0 + ai * 128 + m * 16) * QW + col0;
#pragma unroll
                for (int bj = 0; bj < 2; ++bj) { const f32x4 v0 = acc[ai][bj][m][0] * sc, v1 = acc[ai][bj][m][1] * sc;
                    v4u w; w.x = pk2(v0[0], v0[1]); w.y = pk2(v0[2], v0[3]); w.z = pk2(v1[0], v1[1]); w.w = pk2(v1[2], v1[3]);
                    *(v4u*)(rowp + bj * 128) = w; } }
    }
};
template <bool XIN_F32> struct EpiOut {
    static constexpr bool PERM = true;
    __device__ __forceinline__ void prefetch(const pg8::Unit&, int, LAS unsigned*) const {}
    const void* xin; bf16* xout; const float* gate;
#ifdef PROBE_TS
    void* tsb;
#endif
    __device__ __forceinline__ void operator()(const f32x4 (&acc)[2][2][4][2], const pg8::Unit& u, int wr, int wc, int fr, int fq) const {
#ifdef PROBE_TS
        if (XIN_F32 && threadIdx.x == 0) ((unsigned long long*)tsb)[(26 + 3) * 256 + blockIdx.x] = __builtin_amdgcn_s_memrealtime();
#endif
        const int row0 = u.pm * 256 + wr * 64 + fr, col0 = u.pn * 256 + wc * 32 + 8 * fq;
        const float* gb = gate + ((u.pm * 256) / S) * 6144 + col0;
        f32x4 gv[2][2];
#pragma unroll
        for (int bj = 0; bj < 2; ++bj)
#pragma unroll
            for (int n = 0; n < 2; ++n) gv[bj][n] = *(const f32x4*)(gb + bj * 128 + 4 * n);
#pragma unroll
        for (int ai = 0; ai < 2; ++ai) {
            f32x4 xf[4][2][2]; v4u xb[4][2];
#pragma unroll
            for (int m = 0; m < 4; ++m) { const size_t off = (size_t)(row0 + ai * 128 + m * 16) * D + col0;
#pragma unroll
                for (int bj = 0; bj < 2; ++bj) {
                    if (XIN_F32) { const float* xp = (const float*)xin + off + bj * 128; xf[m][bj][0] = *(const f32x4*)xp; xf[m][bj][1] = *(const f32x4*)(xp + 4); }
                    else xb[m][bj] = *(const v4u*)((const bf16*)xin + off + bj * 128); } }
            __builtin_amdgcn_sched_barrier(0);
#pragma unroll
            for (int m = 0; m < 4; ++m) { const size_t off = (size_t)(row0 + ai * 128 + m * 16) * D + col0;
#pragma unroll
                for (int bj = 0; bj < 2; ++bj) { f32x4 x0, x1;
                    if (XIN_F32) { x0 = xf[m][bj][0]; x1 = xf[m][bj][1]; }
                    else { const v4u w = xb[m][bj]; x0 = (f32x4){bflo(w.x), bfhi(w.x), bflo(w.y), bfhi(w.y)}; x1 = (f32x4){bflo(w.z), bfhi(w.z), bflo(w.w), bfhi(w.w)}; }
                    x0 += gv[bj][0] * acc[ai][bj][m][0]; x1 += gv[bj][1] * acc[ai][bj][m][1];
                    v4u o; o.x = pk2(x0[0], x0[1]); o.y = pk2(x0[2], x0[3]); o.z = pk2(x1[0], x1[1]); o.w = pk2(x1[2], x1[3]);
                    store16_wt(xout + off + bj * 128, o); } }
            __builtin_amdgcn_sched_barrier(0);
        }
    }
};

constexpr int CW_MOECNT = 32768;
__device__ __forceinline__ int moe_unit_index(int mode, int i, int c, int G, int U, int nlow, int nfull) {
    if (i >= 4) return -1;
    int X;
    if (mode == 1) X = i * G + c;
    else if (c >= nfull) { const int j = c - nfull; X = (i == 0) ? j : (i == 1) ? j + nlow : 2 * nlow + c + (i - 2) * G; }
    else X = 2 * nlow + c + i * G;
    return X < U ? X : -1;
}
template <int MODE> struct MoeSched {
    const bf16* A; const bf16* Bt; int K; size_t bstride;
    LAS int* tab; LAS int* rowtab;
    unsigned* cnt; int G, c;
    static constexpr bool GATHER = (MODE == 1);
    __device__ __forceinline__ bool next(int i, pg8::Unit& u) const {
        const int U = __builtin_amdgcn_readfirstlane(tab[49]);
        const int X = moe_unit_index(MODE, i, c, G, U, __builtin_amdgcn_readfirstlane(tab[61]), __builtin_amdgcn_readfirstlane(tab[62]));
        if (X < 0) return false;
        int e = 0;
#pragma unroll
        for (int j = 1; j < 16; ++j) if (X >= __builtin_amdgcn_readfirstlane(tab[33 + j])) e = j;
        const int r = X - __builtin_amdgcn_readfirstlane(tab[33 + e]); const int rt = r >> 2, ct = r & 3;
        u.pm = X >> 2; u.pn = ct; u.e = e; u.li = (MODE == 1 ? 0 : 4) + i; u.r0 = __builtin_amdgcn_readfirstlane(tab[16 + e]) + 256 * rt; u.nr = min(256, __builtin_amdgcn_readfirstlane(tab[e]) - 256 * rt); return true;
    }
    __device__ __forceinline__ const char* a_base(const pg8::Unit& u) const { return GATHER ? (const char*)A : (const char*)A + (size_t)u.r0 * K * 2; }
    __device__ __forceinline__ const char* b_base(const pg8::Unit& u) const { return (const char*)Bt + (size_t)u.e * bstride + (size_t)u.pn * 256 * K * 2; }
    __device__ __forceinline__ void a_off(const pg8::Unit& u, int tid, unsigned (&v)[4]) const {
#pragma unroll
        for (int i = 0; i < 2; ++i) { int R, C; pg8::stage_rc(tid * 16 + i * 8192, R, C);
#pragma unroll
            for (int h = 0; h < 2; ++h) {
                if (GATHER) v[2 * h + i] = (unsigned)(rowtab[u.li * 256 + h * 128 + R] >> 1) * (unsigned)(K * 2) + (unsigned)C * 2u;
                else v[2 * h + i] = (unsigned)((h * 128 + R) * K + C) * 2u;
            } }
    }
    __device__ __forceinline__ void a_ready(const pg8::Unit& u, int wid, int lane) const {
        if (MODE == 2) {
            if (wid == 0) { unsigned sp = 0;
                while ((unsigned)__builtin_amdgcn_readfirstlane(__hip_atomic_load(cnt + 64 * u.pm, __ATOMIC_RELAXED, __HIP_MEMORY_SCOPE_AGENT)) < 32u) { __builtin_amdgcn_s_sleep(2); if (++sp > (1u << 20)) break; }
                __builtin_amdgcn_fence(__ATOMIC_ACQUIRE, "agent");
                asm volatile("s_waitcnt vmcnt(0)" ::: "memory"); }
            asm volatile("" ::: "memory"); __builtin_amdgcn_s_barrier(); asm volatile("" ::: "memory");
        }
    }
    __device__ __forceinline__ void publish(int rtg, int lane) const {
        if (MODE == 1) { if (lane == 0) __hip_atomic_fetch_add(cnt + 64 * rtg, 1u, __ATOMIC_RELAXED, __HIP_MEMORY_SCOPE_AGENT); }
    }
};
__device__ __forceinline__ void moe_plan(Frame& F, const int* cntw, const int* loc, int c) {
    LAS int* tab = (LAS int*)(F.lds + L_NE); LAS int* rowtab = (LAS int*)(F.lds + L_ROWTAB);
    LAS int* pre = (LAS int*)F.lds + F.wave * 320;
    __syncthreads();
    { int v[8];
#pragma unroll
      for (int i = 0; i < 4; ++i) { v[i] = cntw[(F.lane + 64 * i) * 16 + 2 * F.wave]; v[4 + i] = cntw[(F.lane + 64 * i) * 16 + 2 * F.wave + 1]; }
      const int s0 = wave_sum_i((v[0] + v[1]) + (v[2] + v[3])), s1 = wave_sum_i((v[4] + v[5]) + (v[6] + v[7]));
      if (F.lane == 0) { tab[2 * F.wave] = s0; tab[2 * F.wave + 1] = s1; } }
    for (int i = F.tid; i < 2048; i += 512) rowtab[i] = 0;
    __syncthreads();
    if (F.tid == 0) { int a = 0, ub = 0; for (int e = 0; e < 16; ++e) { tab[16 + e] = a; tab[33 + e] = ub; a += tab[e]; ub += 4 * ((tab[e] + 255) >> 8); } tab[32] = a; tab[49] = ub;
        const int R = 1 + (ub > F.G) + (ub > 2 * F.G) + (ub > 3 * F.G), nfull = ub - (R - 1) * F.G;
        tab[60] = R; tab[61] = F.G - nfull; tab[62] = nfull; }
    __syncthreads();
    const int li = F.wave;
    const int X = moe_unit_index(li < 4 ? 1 : 2, li & 3, c, F.G, tab[49], tab[61], tab[62]);
    if (X >= 0) {
        int e = 0;
        for (int j = 1; j < 16; ++j) if (X >= tab[33 + j]) e = j;
        const int rt = (X - tab[33 + e]) >> 2, ne = tab[e];
        int cw[4], tot = 0;
#pragma unroll
        for (int i = 0; i < 4; ++i) { cw[i] = cntw[(4 * F.lane + i) * 16 + e]; tot += cw[i]; }
        int start = wave_scan_i(tot) - tot;
#pragma unroll
        for (int i = 0; i < 4; ++i) { pre[4 * F.lane + i] = start; start += cw[i]; }
        asm volatile("s_waitcnt lgkmcnt(0)" ::: "memory");
        int cidx[4], gidx[4];
#pragma unroll
        for (int k = 0; k < 4; ++k) { const int g = 256 * rt + 64 * k + F.lane; int lo = 0;
#pragma unroll
            for (int st = 128; st >= 1; st >>= 1) { if (pre[lo + st] <= g) lo += st; }
            cidx[k] = lo; gidx[k] = g; }
        int val[4];
#pragma unroll
        for (int k = 0; k < 4; ++k) { val[k] = 0; if (gidx[k] < ne) val[k] = loc[(cidx[k] * 16 + e) * 64 + (gidx[k] - pre[cidx[k]])]; }
#pragma unroll
        for (int k = 0; k < 4; ++k) if (gidx[k] < ne) rowtab[li * 256 + 64 * k + F.lane] = val[k];
    }
    __syncthreads();
}
struct EpiM1 {
    static constexpr bool PERM = true;
    __device__ __forceinline__ void prefetch(const pg8::Unit&, int, LAS unsigned*) const {}
    bf16* ACT; const float* ew; LAS int* rowtab;
    __device__ __forceinline__ void operator()(const f32x4 (&acc)[2][2][4][2], const pg8::Unit& u, int wr, int wc, int fr, int fq) const {
        const int col0 = u.pn * 128 + wc * 32 + 8 * fq;
#pragma unroll
        for (int ai = 0; ai < 2; ++ai)
#pragma unroll
            for (int m = 0; m < 4; ++m) { const int r = ai * 128 + wr * 64 + m * 16 + fr;
                if (r < u.nr) { const float w8 = ew[rowtab[u.li * 256 + r]];
                    const f32x4 g0 = acc[ai][0][m][0], g1 = acc[ai][0][m][1], u0 = acc[ai][1][m][0], u1 = acc[ai][1][m][1];
                    v4u w; w.x = pk2(siluf_(g0[0]) * u0[0] * w8, siluf_(g0[1]) * u0[1] * w8); w.y = pk2(siluf_(g0[2]) * u0[2] * w8, siluf_(g0[3]) * u0[3] * w8);
                    w.z = pk2(siluf_(g1[0]) * u1[0] * w8, siluf_(g1[1]) * u1[1] * w8); w.w = pk2(siluf_(g1[2]) * u1[2] * w8, siluf_(g1[3]) * u1[3] * w8);
                    store16_wt(ACT + (size_t)(u.r0 + r) * DE + col0, w); } }
    }
};
struct EpiM2 {
    static constexpr bool PERM = true;
    __device__ __forceinline__ void prefetch(const pg8::Unit&, int, LAS unsigned*) const {}
    bf16* YS; LAS int* rowtab;
    __device__ __forceinline__ void operator()(const f32x4 (&acc)[2][2][4][2], const pg8::Unit& u, int wr, int wc, int fr, int fq) const {
        const int col0 = u.pn * 256 + wc * 32 + 8 * fq;
#pragma unroll
        for (int ai = 0; ai < 2; ++ai)
#pragma unroll
            for (int m = 0; m < 4; ++m) { const int r = ai * 128 + wr * 64 + m * 16 + fr;
                if (r < u.nr) { bf16* rowp = YS + (size_t)rowtab[u.li * 256 + r] * D + col0;
#pragma unroll
                    for (int bj = 0; bj < 2; ++bj) { const f32x4 v0 = acc[ai][bj][m][0], v1 = acc[ai][bj][m][1];
                        v4u w; w.x = pk2(v0[0], v0[1]); w.y = pk2(v0[2], v0[3]); w.z = pk2(v1[0], v1[1]); w.w = pk2(v1[2], v1[3]);
                        *(v4u*)(rowp + bj * 128) = w; } } }
    }
};

constexpr int MX_PITCH = 520;
template <int HALO> __device__ __forceinline__ void stage_rows(LAS bf16* dst, const bf16* QKVY, int col0, int t0, int tid) {
    constexpr int NROW = 64 + HALO, NP = (NROW * 64 + 511) / 512;
    const int tt0 = t0 % S;
    v4u v[NP];
#pragma unroll
    for (int i = 0; i < NP; ++i) { const int p = tid + 512 * i, row = p >> 6, c8 = (p & 63) * 8; v[i] = (v4u){0u, 0u, 0u, 0u};
        if (p < NROW * 64 && tt0 - HALO + row >= 0) v[i] = *(const v4u*)(QKVY + (size_t)(t0 - HALO + row) * QW + col0 + c8); }
#pragma unroll
    for (int i = 0; i < NP; ++i) { const int p = tid + 512 * i, row = p >> 6, c8 = (p & 63) * 8;
        if (p < NROW * 64) *(LAS v4u*)(dst + row * MX_PITCH + c8) = v[i]; }
}
__device__ __forceinline__ void conv_phase(KA args, Frame& F, const bf16* QKVY, bf16* CAT) {
    typedef float f2 __attribute__((ext_vector_type(2)));
    LAS bf16* ys = (LAS bf16*)F.lds;
    const int half = F.tid >> 8, cp = (F.tid & 255) * 2;
    const float* cw = INP(8);
    f2 w[31];
#pragma unroll
    for (int j = 0; j < 31; ++j) w[j] = *(const f2*)(cw + j * 512 + cp);
    const f2 bb = *(const f2*)(INP(9) + cp), gg = *(const f2*)(INP(10) + cp), nn = *(const f2*)(INP(11) + cp);
    for (int chunk = F.vcu; chunk < T / 64; chunk += F.G) {
        const int t0 = chunk * 64;
        __syncthreads();
        stage_rows<30>(ys, QKVY, 0, t0, F.tid);
        __syncthreads();
        for (int blk = 0; blk < 4; ++blk) { const int tok0 = half * 32 + blk * 8;
            f2 y[38];
#pragma unroll
            for (int r = 0; r < 38; ++r) { const unsigned u = *(const LAS unsigned*)(ys + (tok0 + r) * MX_PITCH + cp); y[r] = (f2){bflo(u), bfhi(u)}; }
#pragma unroll
            for (int i = 0; i < 8; ++i) { f2 a = bb;
#pragma unroll
                for (int j = 0; j < 31; ++j) a = y[i + j] * w[j] + a;
                float s = xor16_add(row_sum16(a.x + a.y));
                const float mean = s * (1.f / 64.f); const f2 d = a - mean;
                float q = xor16_add(row_sum16(d.x * d.x + d.y * d.y));
                const float rs = rsqrtf(q * (1.f / 64.f) + 1e-5f);
                const f2 yn = d * rs * gg + nn;
                *(unsigned*)(CAT + (size_t)(t0 + tok0 + i) * D + cp) = pk2(siluf_(yn.x), siluf_(yn.y)); }
        }
    }
}
__device__ __forceinline__ void pool_phase(KA args, Frame& F, const bf16* QKVY, const bf16* WPT, bf16* CAT) {
    typedef float f32x16 __attribute__((ext_vector_type(16)));
    LAS bf16* us = (LAS bf16*)F.lds;
    const int g = (F.wave < 4) ? 3 - (F.wave >> 1) : ((F.wave - 4) >> 1), tt = F.wave & 1, r32 = F.lane & 31, hi = F.lane >> 5, win = 2 << g;
    const float* pb = INP(18); const float* ps = INP(19);
    for (int chunk = F.vcu; chunk < T / 64; chunk += F.G) {
        const int t0 = chunk * 64, tt0 = t0 % S;
        __syncthreads();
        stage_rows<15>(us, QKVY, 1536, t0, F.tid);
        __syncthreads();
        const int tok = tt * 32 + r32;
        const float inv = 1.f / (float)min(tt0 + tok + 1, win);
        f32x16 acc[4];
#pragma unroll
        for (int ct = 0; ct < 4; ++ct) acc[ct] = (f32x16){};
        bf16x8 bnx[4];
#pragma unroll
        for (int ct = 0; ct < 4; ++ct) bnx[ct] = *(const bf16x8*)(WPT + (size_t)(g * 128 + 32 * ct + r32) * 128 + 8 * hi);
#pragma unroll
        for (int ks = 0; ks < 8; ++ks) {
            bf16x8 bcur[4];
#pragma unroll
            for (int ct = 0; ct < 4; ++ct) bcur[ct] = bnx[ct];
            if (ks < 7) {
#pragma unroll
                for (int ct = 0; ct < 4; ++ct) bnx[ct] = *(const bf16x8*)(WPT + (size_t)(g * 128 + 32 * ct + r32) * 128 + 16 * (ks + 1) + 8 * hi); }
            const LAS bf16* col = us + (tok + 15) * MX_PITCH + g * 128 + 16 * ks + 8 * hi;
            float sm[8];
#pragma unroll
            for (int e = 0; e < 8; ++e) sm[e] = 0.f;
            for (int j = 0; j < win; ++j) { const v4u u = *(const LAS v4u*)(col - j * MX_PITCH);
                sm[0] += bflo(u.x); sm[1] += bfhi(u.x); sm[2] += bflo(u.y); sm[3] += bfhi(u.y); sm[4] += bflo(u.z); sm[5] += bfhi(u.z); sm[6] += bflo(u.w); sm[7] += bfhi(u.w); }
            const v4u c = *(const LAS v4u*)col;
            v4u pa; pa.x = pk2(sm[0] * inv - bflo(c.x), sm[1] * inv - bfhi(c.x)); pa.y = pk2(sm[2] * inv - bflo(c.y), sm[3] * inv - bfhi(c.y));
            pa.z = pk2(sm[4] * inv - bflo(c.z), sm[5] * inv - bfhi(c.z)); pa.w = pk2(sm[6] * inv - bflo(c.w), sm[7] * inv - bfhi(c.w));
            const bf16x8 af = __builtin_bit_cast(bf16x8, pa);
#pragma unroll
            for (int ct = 0; ct < 4; ++ct) acc[ct] = __builtin_amdgcn_mfma_f32_32x32x16_bf16(af, bcur[ct], acc[ct], 0, 0, 0);
        }
#pragma unroll
        for (int ct = 0; ct < 4; ++ct) { const int n = g * 128 + 32 * ct + r32; const float bb = pb[n], sc = ps[n];
#pragma unroll
            for (int r = 0; r < 16; ++r) { const int row = tt * 32 + (r & 3) + 8 * (r >> 2) + 4 * hi;
                CAT[(size_t)(t0 + row) * D + 512 + n] = (bf16)(pk2((acc[ct][r] + bb) * sc, 0.f) & 0xffffu); } }
    }
}

namespace sba {
typedef short bf16x8 __attribute__((ext_vector_type(8)));
typedef short s16x4 __attribute__((ext_vector_type(4)));
typedef short v4i16_t __attribute__((ext_vector_type(4)));
typedef _Float16 h8 __attribute__((ext_vector_type(8)));
typedef _Float16 h2 __attribute__((ext_vector_type(2)));
typedef float f2 __attribute__((ext_vector_type(2)));
typedef float f32x16 __attribute__((ext_vector_type(16)));
typedef unsigned u32x4 __attribute__((ext_vector_type(4)));
typedef __bf16 bf16x2_t __attribute__((ext_vector_type(2)));
constexpr int KVB = 64, SLOTB = 8192;
constexpr float THR = 160.f;
__device__ __forceinline__ void glds16(const void* gsrc, unsigned lds_dst) { unsigned keep;
    asm volatile("s_mov_b32 %0, m0\n\ts_mov_b32 m0, %2\n\ts_nop 0\n\tglobal_load_lds_dwordx4 %1, off\n\ts_mov_b32 m0, %0" : "=&s"(keep) : "v"(gsrc), "s"(lds_dst) : "memory"); }
__device__ __forceinline__ unsigned cvtpk_bf(float lo, float hi) { f2 v = {lo, hi}; bf16x2_t b = __builtin_convertvector(v, bf16x2_t); return __builtin_bit_cast(unsigned, b); }
__device__ __forceinline__ unsigned cvtpk_h(float lo, float hi) { f2 v = {lo, hi}; h2 b = __builtin_convertvector(v, h2); return __builtin_bit_cast(unsigned, b); }
__device__ __forceinline__ float min30(float a) { float r; asm("v_min_f32_e32 %0, 0x41f00000, %1" : "=v"(r) : "v"(a)); return r; }
__device__ __forceinline__ float maxf_(float a, float b) { float r; asm("v_max_f32_e32 %0, %1, %2" : "=v"(r) : "v"(a), "v"(b)); return r; }
typedef __attribute__((address_space(3))) const char* lds_cptr;
__device__ __forceinline__ s16x4 vtr(lds_cptr p) { return __builtin_bit_cast(s16x4, __builtin_amdgcn_ds_read_tr16_b64_v4i16((__attribute__((address_space(3))) v4i16_t*)p)); }
#define SBA_H(x) __builtin_bit_cast(h8, x)
#define SBA_P(x) __builtin_bit_cast(bf16x8, x)

template <bool DIAG> __device__ __forceinline__ void tile(f32x16& p0, f32x16& p1, f32x16& o0, f32x16& o1, float& C, const h8& T0, const h8& T1, const h8& ONES, int kvb, int hi, lds_cptr vp) {
    const float z0 = p0[0];
    u32x4 lf0, lf1, lf2, lf3;
    {
        float l[16];
#pragma unroll
        for (int r = 0; r < 16; ++r) { const float z = p0[r]; float v = maxf_(__builtin_amdgcn_logf(1.f + __builtin_amdgcn_exp2f(min30(z))), z);
            if (DIAG) { if (kvb + (r & 3) + 8 * (r >> 2) >= 0) v = 0.f; } l[r] = v; }
        lf0 = (u32x4){cvtpk_h(l[0], l[1]), cvtpk_h(l[2], l[3]), cvtpk_h(l[4], l[5]), cvtpk_h(l[6], l[7])};
        lf1 = (u32x4){cvtpk_h(l[8], l[9]), cvtpk_h(l[10], l[11]), cvtpk_h(l[12], l[13]), cvtpk_h(l[14], l[15])};
#pragma unroll
        for (int r = 0; r < 16; ++r) { const float z = p1[r]; float v = maxf_(__builtin_amdgcn_logf(1.f + __builtin_amdgcn_exp2f(min30(z))), z);
            if (DIAG) { if (kvb + 32 + (r & 3) + 8 * (r >> 2) >= 0) v = 0.f; } l[r] = v; }
        if (!DIAG) l[15] += hi ? C : 0.f;
        lf2 = (u32x4){cvtpk_h(l[0], l[1]), cvtpk_h(l[2], l[3]), cvtpk_h(l[4], l[5]), cvtpk_h(l[6], l[7])};
        lf3 = (u32x4){cvtpk_h(l[8], l[9]), cvtpk_h(l[10], l[11]), cvtpk_h(l[12], l[13]), cvtpk_h(l[14], l[15])};
    }
    p0 = __builtin_amdgcn_mfma_f32_32x32x16_f16(T0, SBA_H(lf0), p0, 0, 0, 0);
    p0 = __builtin_amdgcn_mfma_f32_32x32x16_f16(T1, SBA_H(lf1), p0, 0, 0, 0);
    p0 = __builtin_amdgcn_mfma_f32_32x32x16_f16(ONES, SBA_H(lf2), p0, 0, 0, 0);
    p0 = __builtin_amdgcn_mfma_f32_32x32x16_f16(ONES, SBA_H(lf3), p0, 0, 0, 0);
    p1 = __builtin_amdgcn_mfma_f32_32x32x16_f16(T0, SBA_H(lf2), p1, 0, 0, 0);
    p1 = __builtin_amdgcn_mfma_f32_32x32x16_f16(T1, SBA_H(lf3), p1, 0, 0, 0);
    float cn = z0 - p0[0];
    { auto rr = __builtin_amdgcn_permlane32_swap(__float_as_uint(cn), __float_as_uint(cn), false, false); cn = __uint_as_float(rr[0]); }
    C = cn;
    u32x4 pw0, pw1, pw2, pw3;
    {
        float a[16];
#pragma unroll
        for (int r = 0; r < 16; ++r) { float v = __builtin_amdgcn_exp2f(p0[r]); if (DIAG) { if (kvb + (r & 3) + 8 * (r >> 2) >= 0) v = 0.f; } a[r] = v; }
        pw0 = (u32x4){cvtpk_bf(a[0], a[1]), cvtpk_bf(a[2], a[3]), cvtpk_bf(a[4], a[5]), cvtpk_bf(a[6], a[7])};
        pw1 = (u32x4){cvtpk_bf(a[8], a[9]), cvtpk_bf(a[10], a[11]), cvtpk_bf(a[12], a[13]), cvtpk_bf(a[14], a[15])};
#pragma unroll
        for (int r = 0; r < 16; ++r) { float v = __builtin_amdgcn_exp2f(p1[r]); if (DIAG) { if (kvb + 32 + (r & 3) + 8 * (r >> 2) >= 0) v = 0.f; } a[r] = v; }
        pw2 = (u32x4){cvtpk_bf(a[0], a[1]), cvtpk_bf(a[2], a[3]), cvtpk_bf(a[4], a[5]), cvtpk_bf(a[6], a[7])};
        pw3 = (u32x4){cvtpk_bf(a[8], a[9]), cvtpk_bf(a[10], a[11]), cvtpk_bf(a[12], a[13]), cvtpk_bf(a[14], a[15])};
    }
#define SBA_VFR(i) ({ const s16x4 lo_ = vtr(vp + (((i) >> 2) * 4096 + ((i) & 3) * 1024)); const s16x4 hi_ = vtr(vp + (((i) >> 2) * 4096 + ((i) & 3) * 1024 + 512)); (bf16x8){lo_[0], lo_[1], lo_[2], lo_[3], hi_[0], hi_[1], hi_[2], hi_[3]}; })
    o0 = __builtin_amdgcn_mfma_f32_32x32x16_bf16(SBA_P(pw0), SBA_VFR(0), o0, 0, 0, 0);
    o1 = __builtin_amdgcn_mfma_f32_32x32x16_bf16(SBA_P(pw0), SBA_VFR(4), o1, 0, 0, 0);
    o0 = __builtin_amdgcn_mfma_f32_32x32x16_bf16(SBA_P(pw1), SBA_VFR(1), o0, 0, 0, 0);
    o1 = __builtin_amdgcn_mfma_f32_32x32x16_bf16(SBA_P(pw1), SBA_VFR(5), o1, 0, 0, 0);
    o0 = __builtin_amdgcn_mfma_f32_32x32x16_bf16(SBA_P(pw2), SBA_VFR(2), o0, 0, 0, 0);
    o1 = __builtin_amdgcn_mfma_f32_32x32x16_bf16(SBA_P(pw2), SBA_VFR(6), o1, 0, 0, 0);
    o0 = __builtin_amdgcn_mfma_f32_32x32x16_bf16(SBA_P(pw3), SBA_VFR(3), o0, 0, 0, 0);
    o1 = __builtin_amdgcn_mfma_f32_32x32x16_bf16(SBA_P(pw3), SBA_VFR(7), o1, 0, 0, 0);
#undef SBA_VFR
}

__device__ __forceinline__ void wave_unit(int b, int h, int qi, const bf16* QKVY, bf16* CAT, char* shm_wave, int lane) {
    const int r32 = lane & 31, hi = lane >> 5;
    const long rowbase = (long)b * S; const int r0 = qi * 32;
    const bf16* Qw = QKVY + (rowbase + r0) * QW + 512 + h * 64;
    const bf16* Kl = QKVY + (rowbase + r32) * QW + 1024 + h * 64 + 8 * hi;
    const bf16* Vl = QKVY + (rowbase + (lane >> 2)) * QW + 1536 + h * 64 + (lane & 3) * 8;
    const unsigned lds0 = (unsigned)(uintptr_t)shm_wave;
    const lds_cptr vp0 = (lds_cptr)shm_wave + ((lane >> 4) & 1) * 32 + (lane & 3) * 8 + (4 * hi + ((lane & 15) >> 2)) * 64;
#define SBA_LOAD_V(t) do { _Pragma("unroll") for (int p_ = 0; p_ < 8; ++p_) vreg[p_] = *reinterpret_cast<const u32x4*>(Vl + ((long)(t) * KVB + 16 * (p_ & 3)) * QW + (p_ >> 2) * 32); } while (0)
#define SBA_STORE_V(slot) do { _Pragma("unroll") for (int p_ = 0; p_ < 8; ++p_) *(__attribute__((address_space(3))) u32x4*)((lds_cptr)shm_wave + (slot) * SLOTB + p_ * 1024 + lane * 16) = vreg[p_]; } while (0)
#define SBA_LOAD_K(t) do { _Pragma("unroll") for (int d0_ = 0; d0_ < 4; ++d0_) { kf[2 * d0_] = *reinterpret_cast<const bf16x8*>(Kl + (long)(t) * KVB * QW + 16 * d0_); kf[2 * d0_ + 1] = *reinterpret_cast<const bf16x8*>(Kl + ((long)(t) * KVB + 32) * QW + 16 * d0_); } } while (0)
    const int td = (r0 + 31) >> 6;
    bf16x8 kf[8], qr[4]; u32x4 vreg[8];
    SBA_LOAD_V(td); SBA_STORE_V(0);
    SBA_LOAD_K(td);
#pragma unroll
    for (int d0 = 0; d0 < 4; ++d0) qr[d0] = *reinterpret_cast<const bf16x8*>(&Qw[(long)r32 * QW + d0 * 16 + hi * 8]);
    h8 T0, T1, ONES;
#pragma unroll
    for (int jj = 0; jj < 8; ++jj) { const int kap = 8 * (jj >> 2) + 4 * hi + (jj & 3); T0[jj] = (kap >= r32) ? (_Float16)-1.0f : (_Float16)0.0f; T1[jj] = (16 + kap >= r32) ? (_Float16)-1.0f : (_Float16)0.0f; ONES[jj] = (_Float16)-1.0f; }
    f32x16 o0 = {}, o1 = {};
    float C = 0.f;
    for (int it = 0;; ++it) {
        const int t = td - it, slot = it & 1;
        f32x16 p0 = {}, p1 = {};
#pragma unroll
        for (int d0 = 0; d0 < 4; ++d0) { p0 = __builtin_amdgcn_mfma_f32_32x32x16_bf16(kf[2 * d0], qr[d0], p0, 0, 0, 0); p1 = __builtin_amdgcn_mfma_f32_32x32x16_bf16(kf[2 * d0 + 1], qr[d0], p1, 0, 0, 0); }
        if (t > 0) { SBA_LOAD_K(t - 1); SBA_LOAD_V(t - 1); }
        const lds_cptr vp = vp0 + slot * SLOTB;
        if (it == 0) tile<true>(p0, p1, o0, o1, C, T0, T1, ONES, KVB * t + 4 * hi - (r0 + r32), hi, vp);
        else tile<false>(p0, p1, o0, o1, C, T0, T1, ONES, 0, hi, vp);
        if (t == 0 || __all(C >= THR)) break;
        SBA_STORE_V(slot ^ 1);
    }
    bf16* Ow = CAT + (rowbase + r0) * D + 512 + h * 64;
#pragma unroll
    for (int r = 0; r < 16; ++r) { const int orow = (r & 3) + 8 * (r >> 2) + 4 * hi;
        Ow[(long)orow * D + r32] = (bf16)(cvtpk_bf(o0[r], 0.f) & 0xffffu); Ow[(long)orow * D + 32 + r32] = (bf16)(cvtpk_bf(o1[r], 0.f) & 0xffffu); }
#undef SBA_LOAD_V
#undef SBA_STORE_V
#undef SBA_LOAD_K
}
#undef SBA_H
#undef SBA_P
__device__ __forceinline__ void phase(const bf16* QKVY, bf16* CAT, char* lds, int vcu, int G, int wid, int lane) {
    for (int wu = vcu * 8 + wid; wu < NB * 8 * (S / 32); wu += G * 8) {
        const int bh = wu >> 7, qi = wu & 127;
        wave_unit(bh >> 3, bh & 7, qi, QKVY, CAT, lds + wid * 2 * SLOTB, lane);
    }
}
}


namespace gla {
typedef short bf16x8 __attribute__((ext_vector_type(8)));
typedef short s16x4 __attribute__((ext_vector_type(4)));
typedef short v4i16_t __attribute__((ext_vector_type(4)));
typedef float f32x16 __attribute__((ext_vector_type(16)));
typedef __attribute__((address_space(3))) const char* lds_cptr;
constexpr int NCH = NB * 4 * 64;
constexpr int L_VP = 0, L_KP = 16384, L_TOT = 24576, L_DL = 26624, L_PS = 16384, QSTR = 27136;
__device__ __forceinline__ void glds16(const void* gsrc, unsigned lds_dst) { unsigned keep;
    asm volatile("s_mov_b32 %0, m0\n\ts_mov_b32 m0, %2\n\ts_nop 0\n\tglobal_load_lds_dwordx4 %1, off\n\ts_mov_b32 m0, %0" : "=&s"(keep) : "v"(gsrc), "s"(lds_dst) : "memory"); }
__device__ __forceinline__ s16x4 vtr(lds_cptr p) { return __builtin_bit_cast(s16x4, __builtin_amdgcn_ds_read_tr16_b64_v4i16((__attribute__((address_space(3))) v4i16_t*)p)); }
#define GLA_WAIT_BAR() asm volatile("s_waitcnt vmcnt(0) lgkmcnt(0)\n\ts_barrier" ::: "memory")
__device__ __forceinline__ void dma_v(const bf16* QKVY, long t0, int h, unsigned lds0, int wid, int lane) {
#pragma unroll
    for (int i = 0; i < 2; ++i) { const int p = wid * 2 + i, ctile = p >> 2, tg = p & 3;
        glds16(QKVY + (t0 + 16 * tg + (lane >> 2)) * QW + 512 + h * 128 + 32 * ctile + (lane & 3) * 8, (unsigned)__builtin_amdgcn_readfirstlane(lds0 + L_VP + p * 1024)); }
}
__device__ __forceinline__ bf16x8 trfrag(lds_cptr base, int piece, int lane) {
    const int hi = lane >> 5; const lds_cptr p = base + piece * 1024 + ((lane >> 4) & 1) * 32 + (lane & 3) * 8 + (4 * hi + ((lane & 15) >> 2)) * 64;
    const s16x4 lo = vtr(p), hh = vtr(p + 512); return (bf16x8){lo[0], lo[1], lo[2], lo[3], hh[0], hh[1], hh[2], hh[3]};
}
__device__ __forceinline__ void pass_a(KA args, const bf16* QKVY, const float* ALOW, bf16* QIN, bf16* KIN, float* KVT, float* DEC, char* shm, int vcu, int G, int wid, int lane) {
    const unsigned lds0 = (unsigned)(uintptr_t)shm; const lds_cptr shm3 = (lds_cptr)shm;
    const float* gw = INP(14); const float* gb = INP(15);
    for (int base = 4 * vcu; base < NCH; base += 4 * G) {
        const int bh = base >> 6, b = bh >> 2, h = bh & 3;
        float gwv[16];
#pragma unroll
        for (int r = 0; r < 16; ++r) gwv[r] = gw[r * 256 + h * 64 + lane];
        const float gbv = gb[h * 64 + lane];
        float bl[4][8], qv[4][8], kv[4][8];
#pragma unroll
        for (int q = 0; q < 4; ++q) { const long t0 = (long)b * S + ((base + q) & 63) * 64;
            dma_v(QKVY, t0, h, lds0 + q * QSTR, wid, lane);
#pragma unroll
            for (int tt = 0; tt < 8; ++tt) { const long t = t0 + 8 * wid + tt; const f32x4* al = (const f32x4*)(ALOW + t * 16); float x = gbv;
#pragma unroll
                for (int r4 = 0; r4 < 4; ++r4) { const f32x4 a4 = al[r4]; x += a4.x * gwv[4 * r4] + a4.y * gwv[4 * r4 + 1] + a4.z * gwv[4 * r4 + 2] + a4.w * gwv[4 * r4 + 3]; }
                const float la = -softplusf_(-x) * (1.f / 16.f);
                bl[q][tt] = (tt ? bl[q][tt - 1] : 0.f) + la;
                qv[q][tt] = bf2f(QKVY[t * QW + h * 64 + lane]); kv[q][tt] = bf2f(QKVY[t * QW + 256 + h * 64 + lane]); }
            ((__attribute__((address_space(3))) float*)(shm3 + q * QSTR + L_TOT))[wid * 64 + lane] = bl[q][7]; }
        asm volatile("s_waitcnt lgkmcnt(0)\n\ts_barrier" ::: "memory");
#pragma unroll
        for (int q = 0; q < 4; ++q) { const int ch = base + q; const long t0 = (long)b * S + (ch & 63) * 64;
            __attribute__((address_space(3))) float* tot = (__attribute__((address_space(3))) float*)(shm3 + q * QSTR + L_TOT);
            __attribute__((address_space(3))) bf16* kp = (__attribute__((address_space(3))) bf16*)(shm3 + q * QSTR + L_KP);
            float off = 0.f, blast = 0.f;
#pragma unroll
            for (int w = 0; w < 8; ++w) { const float v = tot[w * 64 + lane]; if (w < wid) off += v; blast += v; }
#pragma unroll
            for (int tt = 0; tt < 8; ++tt) { const long t = t0 + 8 * wid + tt; const float bb = bl[q][tt] + off; const int tk = 8 * wid + tt;
                const float qi = qv[q][tt] * __expf(bb), ki = kv[q][tt] * __expf(-bb);
                QIN[t * 256 + h * 64 + lane] = (bf16)f2bf(qi); const bf16 kb = (bf16)f2bf(ki); KIN[t * 256 + h * 64 + lane] = kb;
                kp[((lane >> 5) * 4 + (tk >> 4)) * 512 + (tk & 15) * 32 + (lane & 31)] = kb; }
            if (wid == 0) { const float dd = __expf(blast); ((__attribute__((address_space(3))) float*)(shm3 + q * QSTR + L_DL))[lane] = dd; DEC[ch * 64 + lane] = dd; } }
        GLA_WAIT_BAR();
        const int dvt = wid & 3, dt = wid >> 2;
#pragma unroll
        for (int q = 0; q < 4; ++q) { const int ch = base + q;
            f32x16 acc = {};
#pragma unroll
            for (int ks = 0; ks < 4; ++ks) acc = __builtin_amdgcn_mfma_f32_32x32x16_bf16(trfrag(shm3 + q * QSTR + L_VP, dvt * 4 + ks, lane), trfrag(shm3 + q * QSTR + L_KP, dt * 4 + ks, lane), acc, 0, 0, 0);
            const int dcol = 32 * dt + (lane & 31); const float dsc = ((__attribute__((address_space(3))) float*)(shm3 + q * QSTR + L_DL))[dcol];
            float* kvo = KVT + ((size_t)ch * 128 + 32 * dvt) * 64 + dcol;
#pragma unroll
            for (int r = 0; r < 16; ++r) kvo[(size_t)((r & 3) + 8 * (r >> 2) + 4 * (lane >> 5)) * 64] = acc[r] * dsc; }
        GLA_WAIT_BAR();
    }
}
__device__ __forceinline__ void pass_b(const float* KVT, const float* DEC, bf16* SINT, int vcu, int G, int tid) {
    for (int e = vcu * 512 + tid; e < NB * 4 * 128 * 64; e += G * 512) {
        const int bh = e >> 13, rem = e & 8191, d = e & 63;
        float st = 0.f;
        for (int n0 = 0; n0 < 64; n0 += 8) {
            float kvv[8], dc[8];
#pragma unroll
            for (int i = 0; i < 8; ++i) { const size_t ch = (size_t)bh * 64 + n0 + i; kvv[i] = KVT[ch * 8192 + rem]; dc[i] = DEC[ch * 64 + d]; }
#pragma unroll
            for (int i = 0; i < 8; ++i) { const size_t ch = (size_t)bh * 64 + n0 + i; SINT[ch * 8192 + rem] = (bf16)f2bf(st); st = dc[i] * st + kvv[i]; }
        }
    }
}
__device__ __forceinline__ void pass_c(KA args, const bf16* QKVY, const bf16* QIN, const bf16* KIN, const bf16* SINT, bf16* CAT, char* shm, int vcu, int G, int wid, int lane) {
    const unsigned lds0 = (unsigned)(uintptr_t)shm; const lds_cptr shm3 = (lds_cptr)shm;
    const int r32 = lane & 31, hi = lane >> 5, it = wid >> 2, ct = wid & 3;
    const float* gng = INP(16);
    for (int base = 4 * vcu; base < NCH; base += 4 * G) {
        const int bh = base >> 6, b = bh >> 2, h = bh & 3;
        f32x16 o[4]; unsigned pw[4][2][8];
#pragma unroll
        for (int q = 0; q < 4; ++q) { const int ch = base + q; const long t0 = (long)b * S + (ch & 63) * 64;
            dma_v(QKVY, t0, h, lds0 + q * QSTR, wid, lane);
            bf16x8 qf[4];
#pragma unroll
            for (int d0 = 0; d0 < 4; ++d0) qf[d0] = *(const bf16x8*)(QIN + (t0 + 32 * it + r32) * 256 + h * 64 + 16 * d0 + 8 * hi);
            f32x16 oo = {};
#pragma unroll
            for (int ks = 0; ks < 4; ++ks) { const bf16x8 sf = *(const bf16x8*)(SINT + ((size_t)ch * 128 + 32 * ct + r32) * 64 + 16 * ks + 8 * hi);
                oo = __builtin_amdgcn_mfma_f32_32x32x16_bf16(qf[ks], sf, oo, 0, 0, 0); }
            o[q] = oo;
            f32x16 pt0 = {}, pt1 = {};
#pragma unroll
            for (int d0 = 0; d0 < 4; ++d0) { const bf16x8 kf = *(const bf16x8*)(KIN + (t0 + r32) * 256 + h * 64 + 16 * d0 + 8 * hi);
                pt0 = __builtin_amdgcn_mfma_f32_32x32x16_bf16(kf, qf[d0], pt0, 0, 0, 0); }
            if (it == 1) {
#pragma unroll
                for (int d0 = 0; d0 < 4; ++d0) { const bf16x8 kf = *(const bf16x8*)(KIN + (t0 + 32 + r32) * 256 + h * 64 + 16 * d0 + 8 * hi);
                    pt1 = __builtin_amdgcn_mfma_f32_32x32x16_bf16(kf, qf[d0], pt1, 0, 0, 0); }
            }
#pragma unroll
            for (int r = 0; r < 16; r += 2) { const int j0 = (r & 3) + 8 * (r >> 2) + 4 * hi;
                float a0 = pt0[r], a1 = pt0[r + 1], c0 = pt1[r], c1 = pt1[r + 1];
                if (it == 0) { if (j0 > r32) a0 = 0.f; if (j0 + 1 > r32) a1 = 0.f; } else { if (j0 > r32) c0 = 0.f; if (j0 + 1 > r32) c1 = 0.f; }
                pw[q][0][r >> 1] = pk2(a0, a1); pw[q][1][r >> 1] = pk2(c0, c1); } }
        GLA_WAIT_BAR();
#pragma unroll
        for (int q = 0; q < 4; ++q) { f32x16 oo = o[q];
#pragma unroll
            for (int ks2 = 0; ks2 < 2; ++ks2) { const v4u a = {pw[q][0][4 * ks2], pw[q][0][4 * ks2 + 1], pw[q][0][4 * ks2 + 2], pw[q][0][4 * ks2 + 3]};
                oo = __builtin_amdgcn_mfma_f32_32x32x16_bf16(__builtin_bit_cast(bf16x8, a), trfrag(shm3 + q * QSTR + L_VP, ct * 4 + ks2, lane), oo, 0, 0, 0); }
            if (it == 1) {
#pragma unroll
                for (int ks2 = 0; ks2 < 2; ++ks2) { const v4u a = {pw[q][1][4 * ks2], pw[q][1][4 * ks2 + 1], pw[q][1][4 * ks2 + 2], pw[q][1][4 * ks2 + 3]};
                    oo = __builtin_amdgcn_mfma_f32_32x32x16_bf16(__builtin_bit_cast(bf16x8, a), trfrag(shm3 + q * QSTR + L_VP, ct * 4 + 2 + ks2, lane), oo, 0, 0, 0); }
            }
            o[q] = oo;
            __attribute__((address_space(3))) float* ps = (__attribute__((address_space(3))) float*)(shm3 + q * QSTR + L_PS);
#pragma unroll
            for (int r = 0; r < 16; ++r) { float v = xor16_add(row_sum16(oo[r] * oo[r]));
                if ((lane & 31) == 0) ps[(32 * it + (r & 3) + 8 * (r >> 2) + 4 * hi) * 4 + ct] = v; } }
        asm volatile("s_waitcnt lgkmcnt(0)\n\ts_barrier" ::: "memory");
        const float gv = gng[h * 128 + 32 * ct + r32];
#pragma unroll
        for (int q = 0; q < 4; ++q) { const int ch = base + q; const long t0 = (long)b * S + (ch & 63) * 64;
            const __attribute__((address_space(3))) float* ps = (const __attribute__((address_space(3))) float*)(shm3 + q * QSTR + L_PS);
#pragma unroll
            for (int r = 0; r < 16; ++r) { const int row = 32 * it + (r & 3) + 8 * (r >> 2) + 4 * hi; const long t = t0 + row;
                const f32x4 p4 = *(const __attribute__((address_space(3))) f32x4*)(ps + row * 4);
                const float rr = rsqrtf(((p4.x + p4.y) + (p4.z + p4.w)) * (1.f / 128.f) + 1e-6f);
                const float rg = bf2f(QKVY[t * QW + 1024 + h * 128 + 32 * ct + r32]);
                CAT[t * D + h * 128 + 32 * ct + r32] = (bf16)f2bf(o[q][r] * rr * gv * siluf_(rg)); } }
        asm volatile("s_waitcnt lgkmcnt(0)\n\ts_barrier" ::: "memory");
    }
}
typedef unsigned u32x4 __attribute__((ext_vector_type(4)));
constexpr int W_VP = 0, W_KP = 16384, W_AL = 24576, W_DL = 28672, WSTR = 29696;
__device__ __forceinline__ void stage_v_wave(const bf16* QKVY, long t0, int h, lds_cptr blk, int lane) {
#pragma unroll
    for (int half = 0; half < 2; ++half) { u32x4 r[8];
#pragma unroll
        for (int i = 0; i < 8; ++i) { const int p = half * 8 + i; r[i] = *(const u32x4*)(QKVY + (t0 + 16 * (p & 3) + (lane >> 2)) * QW + 512 + h * 128 + 32 * (p >> 2) + (lane & 3) * 8); }
#pragma unroll
        for (int i = 0; i < 8; ++i) { const int p = half * 8 + i; *(__attribute__((address_space(3))) u32x4*)(blk + W_VP + p * 1024 + lane * 16) = r[i]; } }
}
__device__ __forceinline__ void pass_a_w(KA args, const bf16* QKVY, const float* ALOW, bf16* QIN, bf16* KIN, float* KVT, float* DEC, char* shm, int vcu, int G, int wid, int lane) {
    if (wid >= 4) return;
    const lds_cptr blk = (lds_cptr)shm + wid * WSTR;
    __attribute__((address_space(3))) float* al = (__attribute__((address_space(3))) float*)(blk + W_AL);
    __attribute__((address_space(3))) float* dl = (__attribute__((address_space(3))) float*)(blk + W_DL);
    __attribute__((address_space(3))) bf16* kp = (__attribute__((address_space(3))) bf16*)(blk + W_KP);
    const float* gw = INP(14); const float* gb = INP(15);
    for (int ch = 4 * vcu + wid; ch < NCH; ch += 4 * G) {
        const int bh = ch >> 6, n = ch & 63, b = bh >> 2, h = bh & 3; const long t0 = (long)b * S + n * 64;
        stage_v_wave(QKVY, t0, h, blk, lane);
#pragma unroll
        for (int j = 0; j < 4; ++j) *(__attribute__((address_space(3))) f32x4*)(al + 4 * (lane + 64 * j)) = *(const f32x4*)(ALOW + t0 * 16 + 4 * (lane + 64 * j));
        float gwv[16];
#pragma unroll
        for (int r = 0; r < 16; ++r) gwv[r] = gw[r * 256 + h * 64 + lane];
        const float gbv = gb[h * 64 + lane];
        float bcum = 0.f, qn[8], kn[8];
#pragma unroll
        for (int tt = 0; tt < 8; ++tt) { qn[tt] = bf2f(QKVY[(t0 + tt) * QW + h * 64 + lane]); kn[tt] = bf2f(QKVY[(t0 + tt) * QW + 256 + h * 64 + lane]); }
        asm volatile("s_waitcnt lgkmcnt(0)" ::: "memory");
        TS_RAW(17);
        for (int t8 = 0; t8 < 64; t8 += 8) {
            float qv[8], kv[8];
#pragma unroll
            for (int tt = 0; tt < 8; ++tt) { qv[tt] = qn[tt]; kv[tt] = kn[tt]; }
            if (t8 < 56) {
#pragma unroll
                for (int tt = 0; tt < 8; ++tt) { qn[tt] = bf2f(QKVY[(t0 + t8 + 8 + tt) * QW + h * 64 + lane]); kn[tt] = bf2f(QKVY[(t0 + t8 + 8 + tt) * QW + 256 + h * 64 + lane]); } }
#pragma unroll
            for (int tt = 0; tt < 8; ++tt) { const int tk = t8 + tt; const long t = t0 + tk; float x = gbv;
#pragma unroll
                for (int r4 = 0; r4 < 4; ++r4) { const f32x4 a4 = *(const __attribute__((address_space(3))) f32x4*)(al + tk * 16 + 4 * r4); x += a4.x * gwv[4 * r4] + a4.y * gwv[4 * r4 + 1] + a4.z * gwv[4 * r4 + 2] + a4.w * gwv[4 * r4 + 3]; }
                bcum += -softplusf_(-x) * (1.f / 16.f);
                const float qi = qv[tt] * __expf(bcum), ki = kv[tt] * __expf(-bcum);
                QIN[t * 256 + h * 64 + lane] = (bf16)f2bf(qi); const bf16 kb = (bf16)f2bf(ki); KIN[t * 256 + h * 64 + lane] = kb;
                kp[((lane >> 5) * 4 + (tk >> 4)) * 512 + (tk & 15) * 32 + (lane & 31)] = kb; }
        }
        { const float dd = __expf(bcum); dl[lane] = dd; DEC[ch * 64 + lane] = dd; }
        asm volatile("s_waitcnt lgkmcnt(0)" ::: "memory");
        TS_RAW(18);
#pragma unroll
        for (int dt = 0; dt < 2; ++dt) { bf16x8 kf[4];
#pragma unroll
            for (int ks = 0; ks < 4; ++ks) kf[ks] = trfrag(blk + W_KP, dt * 4 + ks, lane);
            const int dcol = 32 * dt + (lane & 31); const float dsc = dl[dcol];
#pragma unroll
            for (int dvt = 0; dvt < 4; ++dvt) { f32x16 acc = {};
#pragma unroll
                for (int ks = 0; ks < 4; ++ks) acc = __builtin_amdgcn_mfma_f32_32x32x16_bf16(trfrag(blk + W_VP, dvt * 4 + ks, lane), kf[ks], acc, 0, 0, 0);
                float* kvo = KVT + ((size_t)ch * 128 + 32 * dvt) * 64 + dcol;
#pragma unroll
                for (int r = 0; r < 16; ++r) kvo[(size_t)((r & 3) + 8 * (r >> 2) + 4 * (lane >> 5)) * 64] = acc[r] * dsc; } }
        asm volatile("s_waitcnt lgkmcnt(0)" ::: "memory");
    }
}
__device__ __forceinline__ void pass_c_w(KA args, const bf16* QKVY, const bf16* QIN, const bf16* KIN, const bf16* SINT, bf16* CAT, char* shm, int vcu, int G, int wid, int lane) {
    const lds_cptr blk = (lds_cptr)shm + wid * 16384;
    const int r32 = lane & 31, hi = lane >> 5, it = wid >> 2;
    const float* gng = INP(16);
    for (int ch = 4 * vcu + (wid & 3); ch < NCH; ch += 4 * G) {
        const int bh = ch >> 6, n = ch & 63, b = bh >> 2, h = bh & 3; const long t0 = (long)b * S + n * 64;
        stage_v_wave(QKVY, t0, h, blk, lane);
        bf16x8 qf[4];
#pragma unroll
        for (int d0 = 0; d0 < 4; ++d0) qf[d0] = *(const bf16x8*)(QIN + (t0 + 32 * it + r32) * 256 + h * 64 + 16 * d0 + 8 * hi);
        unsigned short rgv[4][16];
#pragma unroll
        for (int ct = 0; ct < 4; ++ct)
#pragma unroll
            for (int r = 0; r < 16; ++r) rgv[ct][r] = QKVY[(t0 + 32 * it + (r & 3) + 8 * (r >> 2) + 4 * hi) * QW + 1024 + h * 128 + 32 * ct + r32];
        f32x16 pt0 = {}, pt1 = {};
#pragma unroll
        for (int d0 = 0; d0 < 4; ++d0) { const bf16x8 kf = *(const bf16x8*)(KIN + (t0 + r32) * 256 + h * 64 + 16 * d0 + 8 * hi);
            pt0 = __builtin_amdgcn_mfma_f32_32x32x16_bf16(kf, qf[d0], pt0, 0, 0, 0); }
        if (it == 1) {
#pragma unroll
            for (int d0 = 0; d0 < 4; ++d0) { const bf16x8 kf = *(const bf16x8*)(KIN + (t0 + 32 + r32) * 256 + h * 64 + 16 * d0 + 8 * hi);
                pt1 = __builtin_amdgcn_mfma_f32_32x32x16_bf16(kf, qf[d0], pt1, 0, 0, 0); } }
        unsigned pw[2][8];
#pragma unroll
        for (int r = 0; r < 16; r += 2) { const int j0 = (r & 3) + 8 * (r >> 2) + 4 * hi;
            float a0 = pt0[r], a1 = pt0[r + 1], c0 = pt1[r], c1 = pt1[r + 1];
            if (it == 0) { if (j0 > r32) a0 = 0.f; if (j0 + 1 > r32) a1 = 0.f; } else { if (j0 > r32) c0 = 0.f; if (j0 + 1 > r32) c1 = 0.f; }
            pw[0][r >> 1] = pk2(a0, a1); pw[1][r >> 1] = pk2(c0, c1); }
        asm volatile("s_waitcnt lgkmcnt(0)" ::: "memory");
        f32x16 o[4]; float ss[16];
#pragma unroll
        for (int r = 0; r < 16; ++r) ss[r] = 0.f;
#pragma unroll
        for (int ct = 0; ct < 4; ++ct) { f32x16 oo = {};
#pragma unroll
            for (int ks = 0; ks < 4; ++ks) { const bf16x8 sf = *(const bf16x8*)(SINT + ((size_t)ch * 128 + 32 * ct + r32) * 64 + 16 * ks + 8 * hi);
                oo = __builtin_amdgcn_mfma_f32_32x32x16_bf16(qf[ks], sf, oo, 0, 0, 0); }
#pragma unroll
            for (int ks2 = 0; ks2 < 2; ++ks2) { const v4u a = {pw[0][4 * ks2], pw[0][4 * ks2 + 1], pw[0][4 * ks2 + 2], pw[0][4 * ks2 + 3]};
                oo = __builtin_amdgcn_mfma_f32_32x32x16_bf16(__builtin_bit_cast(bf16x8, a), trfrag(blk + W_VP, ct * 4 + ks2, lane), oo, 0, 0, 0); }
            if (it == 1) {
#pragma unroll
                for (int ks2 = 0; ks2 < 2; ++ks2) { const v4u a = {pw[1][4 * ks2], pw[1][4 * ks2 + 1], pw[1][4 * ks2 + 2], pw[1][4 * ks2 + 3]};
                    oo = __builtin_amdgcn_mfma_f32_32x32x16_bf16(__builtin_bit_cast(bf16x8, a), trfrag(blk + W_VP, ct * 4 + 2 + ks2, lane), oo, 0, 0, 0); } }
            o[ct] = oo;
#pragma unroll
            for (int r = 0; r < 16; ++r) ss[r] += oo[r] * oo[r]; }
#pragma unroll
        for (int r = 0; r < 16; ++r) ss[r] = rsqrtf(xor16_add(row_sum16(ss[r])) * (1.f / 128.f) + 1e-6f);
#pragma unroll
        for (int ct = 0; ct < 4; ++ct) { const float gv = gng[h * 128 + 32 * ct + r32];
#pragma unroll
            for (int r = 0; r < 16; ++r) { const long t = t0 + 32 * it + (r & 3) + 8 * (r >> 2) + 4 * hi;
                const float rg = bf2f(rgv[ct][r]);
                CAT[t * D + h * 128 + 32 * ct + r32] = (bf16)f2bf(o[ct][r] * ss[r] * gv * siluf_(rg)); } }
        asm volatile("s_waitcnt lgkmcnt(0)" ::: "memory");
    }
}
#undef GLA_WAIT_BAR
}

__device__ __forceinline__ void dot16x2(const f32x4 (&v0)[4], const f32x4 (&v1)[4], const LAS float* tabw, int lane, float (&c0)[4], float (&c1)[4]) {
    typedef float f2 __attribute__((ext_vector_type(2)));
    f2 a[8], b[8];
#pragma unroll
    for (int e = 0; e < 8; ++e) { a[e] = (f2){0.f, 0.f}; b[e] = (f2){0.f, 0.f}; }
    f32x4 wn[4];
    const LAS float* pb0 = tabw + lane * W16_PITCH;
    unsigned pb1u = (unsigned)(uintptr_t)(pb0 + 8 * 64 * W16_PITCH); asm volatile("" : "+v"(pb1u));
    const LAS float* pb1 = (const LAS float*)(uintptr_t)pb1u;
#pragma unroll
    for (int k = 0; k < 4; ++k) wn[k] = *(const LAS f32x4*)(pb0 + 4 * k);
#pragma unroll
    for (int jq = 0; jq < 16; ++jq) { const int j = jq >> 2, q = jq & 3;
        f32x4 w[4];
#pragma unroll
        for (int k = 0; k < 4; ++k) w[k] = wn[k];
        if (jq < 15) { const LAS float* p = (jq + 1 < 8) ? pb0 + (jq + 1) * 64 * W16_PITCH : pb1 + (jq + 1 - 8) * 64 * W16_PITCH;
#pragma unroll
            for (int k = 0; k < 4; ++k) wn[k] = *(const LAS f32x4*)(p + 4 * k); }
        const float h0 = v0[j][q], h1 = v1[j][q]; const f2 hh0 = {h0, h0}, hh1 = {h1, h1};
#pragma unroll
        for (int k = 0; k < 4; ++k) { const f2 wl = {w[k].x, w[k].y}, wh = {w[k].z, w[k].w};
            a[2 * k] = hh0 * wl + a[2 * k]; a[2 * k + 1] = hh0 * wh + a[2 * k + 1];
            b[2 * k] = hh1 * wl + b[2 * k]; b[2 * k + 1] = hh1 * wh + b[2 * k + 1]; } }
    float t8[8];
#pragma unroll
    for (int i = 0; i < 8; ++i) { const float lo = a[i >> 1][i & 1], hi = a[4 + (i >> 1)][i & 1]; auto rr = __builtin_amdgcn_permlane32_swap(__float_as_uint(lo), __float_as_uint(hi), false, false); t8[i] = __uint_as_float(rr[0]) + __uint_as_float(rr[1]); }
#pragma unroll
    for (int i = 0; i < 4; ++i) { auto rr = __builtin_amdgcn_permlane16_swap(__float_as_uint(t8[i]), __float_as_uint(t8[i + 4]), false, false); c0[i] = row_sum16(__uint_as_float(rr[0]) + __uint_as_float(rr[1])); }
#pragma unroll
    for (int i = 0; i < 8; ++i) { const float lo = b[i >> 1][i & 1], hi = b[4 + (i >> 1)][i & 1]; auto rr = __builtin_amdgcn_permlane32_swap(__float_as_uint(lo), __float_as_uint(hi), false, false); t8[i] = __uint_as_float(rr[0]) + __uint_as_float(rr[1]); }
#pragma unroll
    for (int i = 0; i < 4; ++i) { auto rr = __builtin_amdgcn_permlane16_swap(__float_as_uint(t8[i]), __float_as_uint(t8[i + 4]), false, false); c1[i] = row_sum16(__uint_as_float(rr[0]) + __uint_as_float(rr[1])); }
}
__device__ __forceinline__ void router_pass(KA args, Frame& F, int l, const bf16* X1, bf16* XN, int* eidx, float* ew, int* cntw, int* loc, unsigned* pcnt, unsigned pneed) {
    const float* mod = (const float*)(F.ws + WS_MOD) + (size_t)l * 4 * 6144;
    const float* rb = INP(21); const float* g = INP(5) + l * D;
    LAS float* tabw = (LAS float*)F.lds;
    LAS float* lg = (LAS float*)(F.lds + 1024 * W16_PITCH * 4);
    __syncthreads();
    TS_MARK(0);
    stage_w16(tabw, INP(20), F.tid);
    for (int chunk = F.vcu; chunk < T / 64; chunk += F.G) {
        if (F.wave == 0) { unsigned sp = 0;
            while ((unsigned)__builtin_amdgcn_readfirstlane(__hip_atomic_load(pcnt + 64 * (chunk >> 2), __ATOMIC_RELAXED, __HIP_MEMORY_SCOPE_AGENT)) < pneed) { __builtin_amdgcn_s_sleep(2); if (++sp > (1u << 20)) break; }
            __builtin_amdgcn_fence(__ATOMIC_ACQUIRE, "agent"); asm volatile("s_waitcnt vmcnt(0)" ::: "memory"); }
        __syncthreads();
        TS_MARK(1);
        const int tb = chunk * 64 + F.wave * 8, b = tb / S;
        f32x4 cA[4], cB[4];
        v2u rw[2][4];
#pragma unroll
        for (int q = 0; q < 2; ++q) { const v2u* xp = (const v2u*)(X1 + (size_t)(tb + q) * D) + F.lane;
#pragma unroll
            for (int j = 0; j < 4; ++j) rw[q][j] = xp[64 * j]; }
        load_colvec(cA, cB, F.lane, g, mod + b * 6144 + 4096, mod + b * 6144 + 3072);
#pragma unroll
        for (int i = 0; i < 4; ++i) { const int t = tb + 2 * i;
            f32x4 v0[4], v1[4];
#pragma unroll
            for (int j = 0; j < 4; ++j) { const v2u a = rw[0][j], c = rw[1][j]; v0[j] = (f32x4){bflo(a.x), bfhi(a.x), bflo(a.y), bfhi(a.y)}; v1[j] = (f32x4){bflo(c.x), bfhi(c.x), bflo(c.y), bfhi(c.y)}; }
            if (i < 3) {
#pragma unroll
                for (int q = 0; q < 2; ++q) { const v2u* xp = (const v2u*)(X1 + (size_t)(t + 2 + q) * D) + F.lane;
#pragma unroll
                    for (int j = 0; j < 4; ++j) rw[q][j] = xp[64 * j]; } }
            norm_row_pre<true>(v0, cA, cB); norm_row_pre<true>(v1, cA, cB);
            store_row_bf16(v0, F.lane, XN + (size_t)t * D); store_row_bf16(v1, F.lane, XN + (size_t)(t + 1) * D);
            float c0[4], c1[4];
            dot16x2(v0, v1, tabw, F.lane, c0, c1);
            if ((F.lane & 15) == 0) { const int r = F.lane >> 4, tl = F.wave * 8 + 2 * i;
                *(LAS f32x4*)(lg + tl * W16_PITCH + 4 * r) = (f32x4){c0[0], c0[1], c0[2], c0[3]}; *(LAS f32x4*)(lg + (tl + 1) * W16_PITCH + 4 * r) = (f32x4){c1[0], c1[1], c1[2], c1[3]}; }
        }
        __syncthreads();
        TS_MARK(2);
        if (F.wave == 0) {
            const int t = chunk * 64 + F.lane;
            float acc[16], rbv[16];
#pragma unroll
            for (int k = 0; k < 4; ++k) { const f32x4 w = *(const LAS f32x4*)(lg + F.lane * W16_PITCH + 4 * k); acc[4 * k] = w.x; acc[4 * k + 1] = w.y; acc[4 * k + 2] = w.z; acc[4 * k + 3] = w.w; }
#pragma unroll
            for (int e = 0; e < 16; ++e) rbv[e] = rb[e];
            float m = acc[0];
#pragma unroll
            for (int e = 1; e < 16; ++e) m = fmaxf(m, acc[e]);
            float sc16[16], ssum = 0.f;
#pragma unroll
            for (int e = 0; e < 16; ++e) { sc16[e] = expf(acc[e] - m); ssum += sc16[e]; }
            float sel[16];
#pragma unroll
            for (int e = 0; e < 16; ++e) { sc16[e] = sc16[e] / ssum; sel[e] = sc16[e] + rbv[e]; }
            int gi = 0; float gbest = -1e30f; int l0s[4], l1s[4];
#pragma unroll
            for (int gg = 0; gg < 4; ++gg) {
                int i0 = 0; float v0 = sel[4 * gg];
#pragma unroll
                for (int k = 1; k < 4; ++k) if (sel[4 * gg + k] > v0) { v0 = sel[4 * gg + k]; i0 = k; }
                int i1 = -1; float v1 = -1e30f;
#pragma unroll
                for (int k = 0; k < 4; ++k) if (k != i0 && sel[4 * gg + k] > v1) { v1 = sel[4 * gg + k]; i1 = k; }
                l0s[gg] = i0; l1s[gg] = i1;
                const float gs = v0 + v1; if (gs > gbest) { gbest = gs; gi = gg; }
            }
            int e0 = 0, e1 = 0;
#pragma unroll
            for (int gg = 0; gg < 4; ++gg) if (gg == gi) { e0 = 4 * gg + l0s[gg]; e1 = 4 * gg + l1s[gg]; }
            float w0 = 0.f, w1 = 0.f;
#pragma unroll
            for (int e = 0; e < 16; ++e) { if (e == e0) w0 = sc16[e]; if (e == e1) w1 = sc16[e]; }
            const float wsum = w0 + w1;
            *(int2*)(eidx + 2 * t) = make_int2(e0, e1); *(float2*)(ew + 2 * t) = make_float2(w0 / wsum, w1 / wsum);
            const unsigned long long below = (1ull << F.lane) - 1ull;
            for (int e = 0; e < 16; ++e) { const unsigned long long m0 = __ballot(e0 == e), m1 = __ballot(e1 == e); const int cc = __popcll(m0);
                if (e0 == e) loc[(chunk * 16 + e) * 64 + __popcll(m0 & below)] = 2 * t;
                if (e1 == e) loc[(chunk * 16 + e) * 64 + cc + __popcll(m1 & below)] = 2 * t + 1;
                if (F.lane == 0) cntw[chunk * 16 + e] = cc + __popcll(m1); }
        }
    }
}
__device__ __forceinline__ void chunk_publish(Frame& F, unsigned* cnt, int panel) {
    asm volatile("s_waitcnt vmcnt(0)" ::: "memory");
    __syncthreads();
    if (F.tid == 0) __hip_atomic_fetch_add(cnt + 64 * panel, 1u, __ATOMIC_RELAXED, __HIP_MEMORY_SCOPE_AGENT);
}
__device__ __forceinline__ void xn0_pass(KA args, Frame& F, bf16* XN, unsigned* cnt) {
    const float* mod = (const float*)(F.ws + WS_MOD);
    for (int chunk = F.vcu; chunk < T / 64; chunk += F.G) {
        const int tb = chunk * 64 + F.wave * 8, b = tb / S;
        f32x4 raw[3][4], cA[4], cB[4];
#pragma unroll
        for (int p = 0; p < 3; ++p) { const f32x4* xr = (const f32x4*)(INP(0) + (size_t)(tb + p) * D) + F.lane;
#pragma unroll
            for (int j = 0; j < 4; ++j) raw[p][j] = xr[64 * j]; }
        load_colvec(cA, cB, F.lane, INP(4), mod + b * 6144 + 1024, mod + b * 6144);
#pragma unroll
        for (int i = 0; i < 8; ++i) { const int t = tb + i; f32x4 v[4];
#pragma unroll
            for (int j = 0; j < 4; ++j) v[j] = raw[i % 3][j];
            if (i + 3 < 8) { const f32x4* xr = (const f32x4*)(INP(0) + (size_t)(t + 3) * D) + F.lane;
#pragma unroll
                for (int j = 0; j < 4; ++j) raw[i % 3][j] = xr[64 * j]; }
            norm_row_pre<true>(v, cA, cB);
            store_row_bf16_wt(v, F.lane, XN + (size_t)t * D); }
        chunk_publish(F, cnt, chunk >> 2);
    }
}
__device__ __forceinline__ void combine_pass(KA args, Frame& F, int l, bf16* X1, const bf16* YS, bf16* XN, float* ALOW, float* out, unsigned* cnt) {
    const float* mod = (const float*)(F.ws + WS_MOD) + (size_t)l * 4 * 6144;
    const float* modn = (const float*)(F.ws + WS_MOD) + (size_t)(l + 1) * 4 * 6144;
    LAS float* tabw = (LAS float*)F.lds;
    __syncthreads();
    if (l == 0) stage_w16(tabw, (const float*)(F.ws + WS_ALOWW), F.tid);
    __syncthreads();
    for (int chunk = F.vcu; chunk < T / 64; chunk += F.G) {
      const int tb = chunk * 64 + F.wave * 8, b = tb / S;
      v2u rw[3][3][4];
#pragma unroll
      for (int p = 0; p < 3; ++p) { const v2u* x0 = (const v2u*)(X1 + (size_t)(tb + p) * D) + F.lane; const v2u* y0 = (const v2u*)(YS + (size_t)(2 * (tb + p)) * D) + F.lane;
#pragma unroll
          for (int j = 0; j < 4; ++j) { rw[p][0][j] = x0[64 * j]; rw[p][1][j] = y0[64 * j]; rw[p][2][j] = y0[64 * j + 256]; } }
      f32x4 g2v[4], cA[4], cB[4];
#pragma unroll
      for (int j = 0; j < 4; ++j) g2v[j] = *(const f32x4*)(mod + b * 6144 + 5120 + 4 * F.lane + 256 * j);
      if (l == 0) load_colvec(cA, cB, F.lane, INP(4) + D, modn + b * 6144 + 1024, modn + b * 6144); else load_colvec(cA, cB, F.lane, INP(25), nullptr, nullptr);
#pragma unroll
      for (int i = 0; i < 8; ++i) { const int t = tb + i;
        f32x4 v[4];
#pragma unroll
        for (int j = 0; j < 4; ++j) { const f32x4 g2 = g2v[j]; const v2u x = rw[i % 3][0][j], a = rw[i % 3][1][j], c = rw[i % 3][2][j];
            const f32x4 ys = {bflo(a.x) + bflo(c.x), bfhi(a.x) + bfhi(c.x), bflo(a.y) + bflo(c.y), bfhi(a.y) + bfhi(c.y)};
            v[j] = (f32x4){bflo(x.x), bfhi(x.x), bflo(x.y), bfhi(x.y)} + g2 * ys; }
        if (i + 3 < 8) { const v2u* x0 = (const v2u*)(X1 + (size_t)(t + 3) * D) + F.lane; const v2u* y0 = (const v2u*)(YS + (size_t)(2 * (t + 3)) * D) + F.lane;
#pragma unroll
            for (int j = 0; j < 4; ++j) { rw[i % 3][0][j] = x0[64 * j]; rw[i % 3][1][j] = y0[64 * j]; rw[i % 3][2][j] = y0[64 * j + 256]; } }
        if (l == 0) {
            store_row_bf16(v, F.lane, X1 + (size_t)t * D);
            norm_row_pre<true>(v, cA, cB);
            store_row_bf16_wt(v, F.lane, XN + (size_t)t * D);
            float acc[16];
            dot16(v, tabw, F.lane, acc);
            if (F.lane == 0) {
#pragma unroll
                for (int k = 0; k < 4; ++k) *(f32x4*)(ALOW + (size_t)t * 16 + 4 * k) = (f32x4){acc[4 * k], acc[4 * k + 1], acc[4 * k + 2], acc[4 * k + 3]}; }
        } else {
            norm_row_pre<false>(v, cA, cB);
            f32x4* o = (f32x4*)(out + (size_t)t * D) + F.lane;
#pragma unroll
            for (int j = 0; j < 4; ++j) __builtin_nontemporal_store(v[j], o + 64 * j);
        }
      }
      if (cnt) chunk_publish(F, cnt, chunk >> 2);
    }
}

__global__ void __launch_bounds__(512, 2) mega_fwd(Args args_) {
    KA args = kargs();
    extern __shared__ __attribute__((aligned(16))) unsigned char lds[];
    Frame F;
    F.lds = (LAS unsigned char*)lds; F.ws = args->ws;
    F.wave = __builtin_amdgcn_readfirstlane((int)threadIdx.x >> 6); F.lane = lane_id(); F.tid = F.wave * 64 + F.lane;
    { int g_ = (int)gridDim.x, b_ = (int)blockIdx.x; asm volatile("" : "+s"(g_), "+s"(b_)); F.G = g_; F.bx = b_; F.vcu = (g_ % 8 == 0) ? (b_ % 8) * (g_ / 8) + b_ / 8 : b_; }
    unsigned char* ws = args->ws;
    for (int u = F.tid; u < (LDS_BYTES - LDSCTL_OFF) / 4; u += 512) ((LAS unsigned*)(F.lds + LDSCTL_OFF))[u] = 0u;
    __syncthreads();
    (void)xcd_barrier_post((unsigned*)(ws + WS_CTL) + CW_BAR, (volatile LAS unsigned*)(F.lds + L_MISC) + 8, F.wave);
#define MKBAR() XcdBarrier{(unsigned*)(ws + WS_CTL) + CW_BAR, xb_xcc_id(), (volatile LAS unsigned*)(F.lds + L_MISC) + 8, F.wave}
#ifndef PHMASK
#define PHMASK 0xFFFFFFFFu
#endif
#ifndef PROBE_MASK
#define PROBE_MASK 0u
#endif
#define NREP(k) ((((PROBE_MASK) >> (k)) & 1u) ? 4 : 1)
#define IN(k) ((((PHMASK) >> ((k) >= 9 ? (k) - 7 : (k))) & 1u) != 0u)
#define MIDBAR() do { xcd_barrier(MKBAR()); F.lane = lane_id(); F.tid = F.wave * 64 + F.lane; args = kargs(); ws = args->ws; F.ws = ws; { int g_ = (int)gridDim.x, b_ = (int)blockIdx.x; asm volatile("" : "+s"(g_), "+s"(b_)); F.G = g_; F.bx = b_; F.vcu = (g_ % 8 == 0) ? (b_ % 8) * (g_ / 8) + b_ / 8 : b_; } } while (0)
#define SEAM(k) do { if (IN(k) && IN((k) + 1)) { TS_PRE(SEAM_IDX(k)); xcd_barrier(MKBAR()); } F.lane = lane_id(); F.tid = F.wave * 64 + F.lane; args = kargs(); ws = args->ws; F.ws = ws; { int g_ = (int)gridDim.x, b_ = (int)blockIdx.x; asm volatile("" : "+s"(g_), "+s"(b_)); F.G = g_; F.bx = b_; F.vcu = (g_ % 8 == 0) ? (b_ % 8) * (g_ / 8) + b_ / 8 : b_; } TS_POST(SEAM_IDX(k)); } while (0)

    TS_PUT(0);
#define mod ((float*)(ws + WS_MOD))
#define XN ((bf16*)(ws + WS_XN))
#define QKVY ((bf16*)(ws + WS_QKVY))
#define YS ((bf16*)(ws + WS_QKVY))
#define CAT ((bf16*)(ws + WS_CAT))
#define ACT ((bf16*)(ws + WS_CAT))
#define X1 ((bf16*)(ws + WS_X1))
#define ALOW ((float*)(ws + WS_ALOW))
#define cntw ((int*)(ws + WS_CNTW))
#define eidx ((int*)(ws + WS_EIDX))
#define ew ((float*)(ws + WS_EW))
#define loc ((int*)(ws + WS_LOC))
    LAS int* tab = (LAS int*)(F.lds + L_NE); LAS int* rowtab = (LAS int*)(F.lds + L_ROWTAB);

    if (IN(0)) for (int rep_ = 0; rep_ < NREP(0); ++rep_) { if (rep_) MIDBAR(); p0_prologue(args, F); } SEAM(0);
#pragma unroll
    for (int l = 0; l < 2; ++l) {
        const int pb = 2 + 7 * l;
        const float* modl = mod + (size_t)l * 4 * 6144;
        if (IN(pb)) for (int rep_ = 0; rep_ < NREP(pb); ++rep_) { if (rep_) MIDBAR();
            unsigned* acnt = (unsigned*)(ws + WS_CTL) + CW_APANEL + l * 8192;
            if (l == 0) xn0_pass(args, F, XN, acnt); else combine_pass(args, F, 0, X1, YS, XN, ALOW, args->out, acnt);
            TS_MARK(8); TS_MARK1(12);
            pg8::DenseSched Sd; Sd.acnt = acnt; Sd.aneed = 4u * (unsigned)(rep_ + 1);
            if (l == 0) { Sd.init(XN, (const bf16*)(ws + WS_WIN0), T, NIN0, D, F.G, F.bx); EpiIn0 E{QKVY}; pg8::gemm_phase<EpiIn0, pg8::DenseSched, true>(F.lds, D, Sd, E, F.wave); TS_MARK(9);
                int nwg_ = (T / 256) * (NIN0 / 256), bx_ = F.bx; asm volatile("" : "+s"(nwg_), "+s"(bx_));
                const int nidle = F.G - (nwg_ - 2 * F.G), cid = bx_ - (nwg_ - 2 * F.G);
                if (nwg_ > 2 * F.G && nwg_ <= 3 * F.G) { if (cid >= 0) { __syncthreads(); p0_items(args, F, P0_NITEMS - P0_NFILL, P0_NITEMS, cid * 8 + F.wave, nidle * 8); } }
                else { __syncthreads(); p0_items(args, F, P0_NITEMS - P0_NFILL, P0_NITEMS, F.vcu * 8 + F.wave, F.G * 8); } }
            else { Sd.init(XN, (const bf16*)(ws + WS_WIN1), T, NIN1, D, F.G, F.bx); EpiIn1 E{QKVY}; pg8::gemm_phase<EpiIn1, pg8::DenseSched, true>(F.lds, D, Sd, E, F.wave); TS_MARK1(13); }
        } SEAM(pb);
        if (IN(pb + 1)) for (int rep_ = 0; rep_ < NREP(pb + 1); ++rep_) { if (rep_) MIDBAR();
            if (l == 0) {
#if defined(PROBE_CONV)
                for (int r3 = 0; r3 < 3; ++r3) { conv_phase(args, F, QKVY, CAT); __syncthreads(); }
#endif
#if defined(PROBE_SBA)
                for (int r3 = 0; r3 < 3; ++r3) { sba::phase(QKVY, CAT, (char*)lds, F.vcu, F.G, F.wave, F.lane); __syncthreads(); }
#endif
                conv_phase(args, F, QKVY, CAT); __syncthreads(); TS_MARK(10); sba::phase(QKVY, CAT, (char*)lds, F.vcu, F.G, F.wave, F.lane); }
            else {
                float* KVT = (float*)(ws + WS_XN); bf16* SINT = (bf16*)(ws + WS_WGU); bf16* QIN = SINT + (size_t)gla::NCH * 8192; bf16* KIN = QIN + (size_t)T * 256; float* DEC = (float*)(ws + WS_WD);
#ifndef PROBE_M1SUB
#define PROBE_M1SUB 0
#endif
                for (int r3 = 0; r3 < (PROBE_M1SUB == 1 ? 4 : 1); ++r3) { pool_phase(args, F, QKVY, (const bf16*)(ws + WS_WPT), CAT); __syncthreads(); }
                TS_MARK1(16);
                for (int r3 = 0; r3 < (PROBE_M1SUB == 2 ? 4 : 1); ++r3) { gla::pass_a_w(args, QKVY, ALOW, QIN, KIN, KVT, DEC, (char*)lds, F.vcu, F.G, F.wave, F.lane); __syncthreads(); }
                TS_PRE(6); MIDBAR(); TS_POST(6);
                for (int r3 = 0; r3 < (PROBE_M1SUB == 3 ? 4 : 1); ++r3) { gla::pass_b(KVT, DEC, SINT, F.vcu, F.G, F.tid); __syncthreads(); }
                TS_PRE(7); MIDBAR(); TS_POST(7);
                for (int r3 = 0; r3 < (PROBE_M1SUB == 4 ? 4 : 1); ++r3) { gla::pass_c_w(args, QKVY, QIN, KIN, SINT, CAT, (char*)lds, F.vcu, F.G, F.wave, F.lane); __syncthreads(); } }
        } SEAM(pb + 1);
        if (IN(pb + 2)) for (int rep_ = 0; rep_ < NREP(pb + 2); ++rep_) { if (rep_) MIDBAR();
            unsigned* pcnt = (unsigned*)(ws + WS_CTL) + CW_PANEL + l * 8192;
            pg8::DenseSched Sd; Sd.init(CAT, (const bf16*)(ws + (l == 0 ? WS_WOUT0 : WS_WOUT1)), T, D, D, F.G, F.bx); Sd.pcnt = pcnt;
#ifdef PROBE_TS
            if (l == 0) { EpiOut<true> E{INP(0), X1, modl + 2048, (void*)TSBUF}; pg8::gemm_phase<EpiOut<true>, pg8::DenseSched, false>(F.lds, D, Sd, E, F.wave); }
            else { EpiOut<false> E{X1, X1, modl + 2048, nullptr}; pg8::gemm_phase<EpiOut<false>, pg8::DenseSched, false>(F.lds, D, Sd, E, F.wave); }
#else
            if (l == 0) { EpiOut<true> E{INP(0), X1, modl + 2048}; pg8::gemm_phase<EpiOut<true>, pg8::DenseSched, false>(F.lds, D, Sd, E, F.wave); }
            else { EpiOut<false> E{X1, X1, modl + 2048}; pg8::gemm_phase<EpiOut<false>, pg8::DenseSched, false>(F.lds, D, Sd, E, F.wave); }
#endif
            router_pass(args, F, l, X1, XN, eidx, ew, cntw, loc, pcnt, 32u * (unsigned)(rep_ + 1));
        } SEAM(pb + 2);
        if (IN(pb + 4)) for (int rep_ = 0; rep_ < NREP(pb + 4); ++rep_) { if (rep_) MIDBAR();
            TS_MARK(4); moe_plan(F, cntw, loc, F.vcu); TS_MARK(5);
            unsigned* mcnt = (unsigned*)(ws + WS_CTL) + CW_MOECNT + l * 16384;
            { MoeSched<1> Sm{XN, (const bf16*)(ws + WS_WGU) + (size_t)l * NE * 1024 * D, D, (size_t)1024 * D * 2, tab, rowtab, mcnt, F.G, F.vcu};
              EpiM1 E{ACT, ew, rowtab};
              pg8::gemm_phase<EpiM1, MoeSched<1>, true>(F.lds, D, Sm, E, F.wave); TS_MARK(6); }
            { MoeSched<2> Sm{ACT, (const bf16*)(ws + WS_WD) + (size_t)l * NE * D * DE, DE, (size_t)D * DE * 2, tab, rowtab, mcnt, F.G, F.vcu};
              EpiM2 E{YS, rowtab};
              pg8::gemm_phase<EpiM2, MoeSched<2>, true>(F.lds, DE, Sm, E, F.wave); }
        } SEAM(pb + 4);
        if (l == 1) { if (IN(pb + 6)) { combine_pass(args, F, 1, X1, YS, XN, ALOW, args->out, nullptr); } }
    }
#ifdef PROBE_TS
    { TS_PRE(11); MIDBAR();
      if (F.bx == 0 && F.wave == 0) {
          const unsigned long long rlast = __builtin_amdgcn_s_memrealtime();
          int qq[2];
#pragma unroll
          for (int j = 0; j < 2; ++j) { const int id = j == 0 ? (PROBE_Q1) : (PROBE_Q2); int q;
              if (id == 31) q = 10;
              else { const int k = id & 15; const unsigned long long prev = (k == 0) ? TSBUF[0] : TSBUF[(2 + 2 * (k - 1)) * 256];
                  float dt;
                  if (id < 16) { const unsigned long long cur = (k == 11) ? rlast : TSBUF[(2 + 2 * k) * 256]; dt = (float)(long long)(cur - prev); }
                  else if (id >= 200 || (id >= 64 && id < 80)) {
                      float mx = 0.f; const int mx_ = id - 200; const unsigned long long p0_ = (id >= 200) ? TSBUF[(2 + 2 * (mx_ >= 16 ? 5 : mx_ >= 12 ? 4 : mx_ >= 10 ? 1 : mx_ >= 8 ? 0 : mx_ >= 4 ? 3 : 2)) * 256] : prev; const int slot = (id >= 200) ? 26 + (id - 200) : 1 + 2 * k;
                      for (int w = F.lane; w < F.G; w += 64) mx = fmaxf(mx, (float)(long long)(TSBUF[slot * 256 + w] - p0_));
                      for (int o = 1; o < 64; o <<= 1) mx = fmaxf(mx, __int_as_float(__builtin_amdgcn_ds_bpermute(((F.lane ^ o) & 63) << 2, __float_as_int(mx))));
                      dt = mx; }
                  else if (id >= 100) { float sacc = 0.f; const int mm_ = id - 100; const unsigned long long p2 = TSBUF[(2 + 2 * (mm_ >= 16 ? 5 : mm_ >= 12 ? 4 : mm_ >= 10 ? 1 : mm_ >= 8 ? 0 : mm_ >= 4 ? 3 : 2)) * 256]; for (int w = F.lane; w < F.G; w += 64) sacc += (float)(long long)(TSBUF[(26 + (id - 100)) * 256 + w] - p2); dt = wave_sum(sacc) / (float)F.G; }
                  else if (id < 32) { float sacc = 0.f; for (int w = F.lane; w < F.G; w += 64) sacc += (float)(long long)(TSBUF[(1 + 2 * k) * 256 + w] - prev); dt = wave_sum(sacc) / (float)F.G; }
                  else { float sacc = 0.f, nacc = 0.f;
                      for (int w = F.lane; w < F.G; w += 64) { const int vc = (w % 8) * (F.G / 8) + w / 8; if (vc >= (PROBE_LO) && vc < (PROBE_HI)) { sacc += (float)(long long)(TSBUF[(1 + 2 * k) * 256 + w] - prev); nacc += 1.f; } }
                      dt = wave_sum(sacc) / fmaxf(wave_sum(nacc), 1.f); }
                  q = (int)(dt * (1.f / 250.f) + 0.5f); q = q < 0 ? 0 : q > 63 ? 63 : q; }
              qq[j] = __builtin_amdgcn_readfirstlane(q); }
          const unsigned long long tend = __builtin_amdgcn_s_memrealtime() + (unsigned long long)(qq[0] + 64 * qq[1]) * 1600ull;
          while (__builtin_amdgcn_s_memrealtime() < tend) __builtin_amdgcn_s_sleep(8);
      } }
#endif
#undef IN
#undef SEAM
}

extern "C" void kernel_launch(void* const* d_in, const int* in_sizes, int n_in, void* d_out, int out_size, void* d_ws, size_t ws_size, hipStream_t stream) {
    static int grid = 0;
    if (grid == 0) {
        if (n_in != 26 || out_size != T * D || ws_size < WS_END) { fprintf(stderr, "kernel_launch: unexpected shapes / workspace (%zu < %zu)\n", ws_size, (size_t)WS_END); grid = -1; return; }
        int dev = 0, cus = 0;
        if (hipGetDevice(&dev) != hipSuccess || hipDeviceGetAttribute(&cus, hipDeviceAttributeMultiprocessorCount, dev) != hipSuccess) { grid = -1; return; }
        if (hipFuncSetAttribute((const void*)mega_fwd, hipFuncAttributeMaxDynamicSharedMemorySize, LDS_BYTES) != hipSuccess) { fprintf(stderr, "kernel_launch: hipFuncSetAttribute failed\n"); grid = -1; return; }
        grid = cus;
    }
    if (grid < 0) return;
    (void)hipMemsetAsync((char*)d_ws + WS_CTL, 0, CTL_ZERO_BYTES, stream);
    Args a{};
    for (int i = 0; i < 26; ++i) a.in[i] = (const float*)d_in[i];
    a.out = (float*)d_out; a.ws = (unsigned char*)d_ws;
    hipLaunchKernelGGL(mega_fwd, dim3(grid), dim3(512), LDS_BYTES, stream, a);
}
```

```cpp
#include <hip/hip_runtime.h>
#include <cstdint>
#include <cstdio>

constexpr int D = 1024, NB = 4, S = 4096, T = NB * S, NE = 16, DE = 512;
constexpr int NIN0 = 2560, NIN1 = 2048, QW = 2048;
constexpr float QSCALE0 = 0.125f * 1.4426950408889634f;

#define GAS __attribute__((address_space(1)))
#define LAS __attribute__((address_space(3)))
typedef unsigned short bf16;
typedef unsigned v4u __attribute__((ext_vector_type(4)));
typedef unsigned v2u __attribute__((ext_vector_type(2)));
typedef float f32x4 __attribute__((ext_vector_type(4)));
typedef short bf16x8 __attribute__((ext_vector_type(8)));
typedef GAS unsigned gu32;
#define RLX_AGENT __ATOMIC_RELAXED, __HIP_MEMORY_SCOPE_AGENT
#define LDS_WAIT() asm volatile("s_waitcnt lgkmcnt(0)" ::: "memory")
#define VM_WAIT() asm volatile("s_waitcnt vmcnt(0)" ::: "memory")

__device__ __forceinline__ unsigned f2bf(float f) { unsigned u = __builtin_bit_cast(unsigned, f); return (u + 0x7fffu + ((u >> 16) & 1u)) >> 16; }
__device__ __forceinline__ unsigned pk2(float lo, float hi) { unsigned r; asm volatile("v_cvt_pk_bf16_f32 %0, %1, %2" : "=v"(r) : "v"(lo), "v"(hi)); return r; }
__device__ __forceinline__ float bflo(unsigned u) { return __uint_as_float(u << 16); }
__device__ __forceinline__ float bfhi(unsigned u) { return __uint_as_float(u & 0xffff0000u); }
__device__ __forceinline__ float bf2f(bf16 h) { return __uint_as_float((unsigned)h << 16); }
__device__ __forceinline__ int lane_id() { int l; asm volatile("v_mbcnt_lo_u32_b32 %0, -1, 0\n\tv_mbcnt_hi_u32_b32 %0, -1, %0" : "=v"(l)); return l; }
template <int CTRL> __device__ __forceinline__ float dpp_add(float v) { return v + __int_as_float(__builtin_amdgcn_update_dpp(0, __float_as_int(v), CTRL, 0xF, 0xF, false)); }
__device__ __forceinline__ float row_sum16(float v) {
    v = dpp_add<0xB1>(v); v = dpp_add<0x4E>(v); v = dpp_add<0x141>(v); v = dpp_add<0x140>(v); return v; }
__device__ __forceinline__ float rdlane(float v, int l) { return __int_as_float(__builtin_amdgcn_readlane(__float_as_int(v), l)); }
__device__ __forceinline__ float wave_sum(float v) { v = row_sum16(v); return (rdlane(v, 0) + rdlane(v, 16)) + (rdlane(v, 32) + rdlane(v, 48)); }
__device__ __forceinline__ float xor16_add(float v) { auto rr = __builtin_amdgcn_permlane16_swap(__float_as_uint(v), __float_as_uint(v), false, false); return __uint_as_float(rr[0]) + __uint_as_float(rr[1]); }
__device__ __forceinline__ int wave_sum_i(int v) { return (int)wave_sum((float)v); }
__device__ __forceinline__ int wave_scan_i(int v) { const int l = lane_id();
#pragma unroll
    for (int d = 1; d < 64; d <<= 1) { const int n = __builtin_amdgcn_ds_bpermute((l - d) << 2, v); if (l >= d) v += n; }
    return v; }
__device__ __forceinline__ float sigmoidf_(float x) { return __builtin_amdgcn_rcpf(1.f + __builtin_amdgcn_exp2f(-1.4426950408889634f * x)); }
__device__ __forceinline__ float siluf_(float x) { return x * __builtin_amdgcn_rcpf(1.f + __builtin_amdgcn_exp2f(-1.4426950408889634f * x)); }
__device__ __forceinline__ float softplusf_(float z) { return fmaxf(z, 0.f) + 0.6931471805599453f * __builtin_amdgcn_logf(1.f + __builtin_amdgcn_exp2f(-1.4426950408889634f * fabsf(z))); }

namespace pg8 {
#define PG8_LAS __attribute__((address_space(3)))
typedef unsigned short bf16_t;
typedef short bf16x8 __attribute__((ext_vector_type(8)));
typedef float f32x4 __attribute__((ext_vector_type(4)));
typedef unsigned u32x4 __attribute__((ext_vector_type(4)));
constexpr int BM = 256, BK = 64, HALF = 128, HTB = HALF * BK * 2, STAGE_BYTES = 8 * HTB, NXCD = 8, WGM = 8;

__host__ __device__ __forceinline__ int lds_byte(int r, int c) { const int st = (r >> 4) * 2 + (c >> 5), rr = r & 15, cc = c & 31, ob = rr * 64 + cc * 2; return st * 1024 + (ob ^ (((ob >> 9) & 1) << 5)); }
__host__ __device__ __forceinline__ void stage_rc(int b, int& R, int& C) { const int st = b / 1024, sb = b % 1024, swz = sb ^ (((sb >> 9) & 1) << 5); R = (st >> 1) * 16 + swz / 64; C = (st & 1) * 32 + (swz % 64) / 2; }
__host__ __device__ __forceinline__ int perm32(int rho) { const int n = rho >> 4, i = rho & 15; return 8 * (i >> 2) + 4 * n + (i & 3); }

struct Unit { int pm, pn, e, li, nr, r0; };

struct DenseSched {
    const bf16_t* A; const bf16_t* Bt; int K; int nM, nN, nwg, G, c; unsigned* pcnt = nullptr; unsigned* acnt = nullptr; unsigned aneed = 0;
    __device__ void init(const bf16_t* A_, const bf16_t* Bt_, int M, int N, int K_, int G_, int c_) { A = A_; Bt = Bt_; K = K_; nM = M / BM; nN = N / BM; nwg = nM * nN; G = G_; c = c_; }
    __device__ __forceinline__ bool next(int i, Unit& u) const {
        const long L = (long)i * G + c; if (L >= nwg) return false;
        int wgid = (int)L; { const int q = nwg / NXCD, r = nwg % NXCD, xcd = wgid % NXCD, off = wgid / NXCD; wgid = (xcd < r ? xcd * (q + 1) : r * (q + 1) + (xcd - r) * q) + off; }
        const int nig = WGM * nN, gid = wgid / nig, fm = gid * WGM, gsz = (nM - fm) < WGM ? (nM - fm) : WGM;
        u.pm = fm + ((wgid % nig) % gsz); u.pn = (wgid % nig) / gsz; u.e = 0; u.li = i; u.nr = 256; u.r0 = u.pm * BM; return true;
    }
    __device__ __forceinline__ const char* a_base(const Unit& u) const { return (const char*)A + (size_t)u.pm * BM * K * 2; }
    __device__ __forceinline__ const char* b_base(const Unit& u) const { return (const char*)Bt + (size_t)u.pn * BM * K * 2; }
    static constexpr bool GATHER = false;
    __device__ __forceinline__ void a_ready(const Unit& u, int wid, int lane) const {
        if (acnt) {
            if (wid == 0) { unsigned sp = 0;
                while ((unsigned)__builtin_amdgcn_readfirstlane(__hip_atomic_load(acnt + 64 * u.pm, __ATOMIC_RELAXED, __HIP_MEMORY_SCOPE_AGENT)) < aneed) { __builtin_amdgcn_s_sleep(2); if (++sp > (1u << 20)) break; }
                __builtin_amdgcn_fence(__ATOMIC_ACQUIRE, "agent");
                asm volatile("s_waitcnt vmcnt(0)" ::: "memory"); }
            asm volatile("" ::: "memory"); __builtin_amdgcn_s_barrier(); asm volatile("" ::: "memory");
        }
    }
    __device__ __forceinline__ void publish(int pm, int lane) const { if (pcnt && lane == 0) __hip_atomic_fetch_add(pcnt + 64 * pm, 1u, __ATOMIC_RELAXED, __HIP_MEMORY_SCOPE_AGENT); }
    __device__ __forceinline__ void a_off(const Unit&, int tid, unsigned (&v)[4]) const {
#pragma unroll
        for (int i = 0; i < 2; ++i) { int R, C; stage_rc(tid * 16 + i * 8192, R, C);
#pragma unroll
            for (int h = 0; h < 2; ++h) v[2 * h + i] = (unsigned)((h * HALF + R) * K + C) * 2u; }
    }
};

template <class Epi, class Sched, bool ALIGN_EPI>
__device__ __forceinline__ void gemm_phase(PG8_LAS unsigned char* lds, const int K, const Sched& S, const Epi& E, const int wave_id) {
    int wid_ = wave_id; asm volatile("" : "+s"(wid_));
    const int wid = wid_, lane = lane_id(), tid = wid * 64 + lane,
        wr = wid >> 2, wc = wid & 3, fr = lane & 15, fq = lane >> 4;
    const int nt = K / BK;
    unsigned voffB[2];
#pragma unroll
    for (int i = 0; i < 2; ++i) { int R, C; stage_rc(tid * 16 + i * 8192, R, C); const int Rb = Epi::PERM ? ((R & ~31) + perm32(R & 31)) : R; voffB[i] = (unsigned)(Rb * K + C) * 2u; }
    const size_t kstep = (size_t)(BK * 2);
    const size_t hstep = (size_t)HALF * K * 2;
    const unsigned ldsw = (unsigned)wid * 1024u;
    const int aoff = lds_byte(wr * 64 + fr, fq * 8), boff = lds_byte(wc * 32 + fr, fq * 8);
#define PG8_SA(b, h) (((b) * 2 + (h)) * HTB)
#define PG8_SB(b, h) ((4 + (b) * 2 + (h)) * HTB)
#define PG8_STAGE2(bufoff, gbase, o0, o1) do { \
        __builtin_amdgcn_global_load_lds((const unsigned*)((const char*)(gbase) + (o0)), (PG8_LAS unsigned*)(lds + (bufoff) + ldsw), 16, 0, 0); \
        __builtin_amdgcn_global_load_lds((const unsigned*)((const char*)(gbase) + (o1)), (PG8_LAS unsigned*)(lds + (bufoff) + ldsw + 8192), 16, 0, 0); } while (0)
#define PG8_STAGEB(bufoff, gbase) PG8_STAGE2(bufoff, gbase, voffB[0], voffB[1])
#define PG8_LDA(dst, b, h) do { _Pragma("unroll") for (int m = 0; m < 4; ++m) _Pragma("unroll") for (int k = 0; k < 2; ++k) dst[m][k] = *(const PG8_LAS bf16x8*)(lds + PG8_SA(b, h) + aoff + m * 2048 + k * 1024); } while (0)
#define PG8_LDB(dst, b, h) do { _Pragma("unroll") for (int n = 0; n < 2; ++n) _Pragma("unroll") for (int k = 0; k < 2; ++k) dst[n][k] = *(const PG8_LAS bf16x8*)(lds + PG8_SB(b, h) + boff + n * 2048 + k * 1024); } while (0)
#define PG8_MMA(ai, bj, At, Bt) do { __builtin_amdgcn_s_setprio(1); _Pragma("unroll") for (int m = 0; m < 4; ++m) _Pragma("unroll") for (int n = 0; n < 2; ++n) _Pragma("unroll") for (int k = 0; k < 2; ++k) \
        acc[ai][bj][m][n] = __builtin_amdgcn_mfma_f32_16x16x32_bf16(Bt[n][k], At[m][k], acc[ai][bj][m][n], 0, 0, 0); __builtin_amdgcn_s_setprio(0); } while (0)
#define PG8_WAIT_V(n) asm volatile("s_waitcnt vmcnt(" #n ")" ::: "memory")
#define PG8_WAIT_V8_UNLESS(p) do { int pp_ = __builtin_amdgcn_readfirstlane(p); asm volatile("s_cmp_lt_i32 %0, 0\n\ts_cbranch_scc0 .Lpg8skip_%=\n\ts_waitcnt vmcnt(8)\n.Lpg8skip_%=:" : "+s"(pp_) :: "memory", "scc"); } while (0)
#define PG8_WAIT_L(n) asm volatile("s_waitcnt lgkmcnt(" #n ")" ::: "memory")
#define PG8_BAR __builtin_amdgcn_s_barrier()
#define PG8_SCHED __builtin_amdgcn_sched_barrier(0)
    Unit cur, nxt; int ui = 0;
    if (!S.next(0, cur)) { E.tail(lds, wave_id, lane_id()); asm volatile("s_waitcnt vmcnt(0)" ::: "memory"); return; }
    f32x4 acc[2][2][4][2];
#pragma unroll
    for (int a = 0; a < 2; ++a)
#pragma unroll
        for (int b = 0; b < 2; ++b)
#pragma unroll
            for (int m = 0; m < 4; ++m)
#pragma unroll
                for (int n = 0; n < 2; ++n) acc[a][b][m][n] = (f32x4){0.f, 0.f, 0.f, 0.f};
    bf16x8 At[4][2], B0[2][2], B1[2][2];
    unsigned vc[4];
    S.a_ready(cur, wid, lane);
    S.a_off(cur, tid, vc);
    const char* cA = S.a_base(cur); const char* cB = S.b_base(cur);
    E.prefetch(cur, tid, (PG8_LAS unsigned*)(lds + STAGE_BYTES + 1024 + wid * 256));
    PG8_STAGEB(PG8_SB(0, 0), cB); PG8_STAGEB(PG8_SB(0, 1), cB + hstep); PG8_STAGE2(PG8_SA(0, 0), cA, vc[0], vc[1]); PG8_STAGE2(PG8_SA(0, 1), cA, vc[2], vc[3]);
    if (wr == 1) PG8_BAR;
    PG8_WAIT_V(2); PG8_BAR;
    PG8_STAGEB(PG8_SB(1, 0), cB + kstep); PG8_STAGE2(PG8_SA(1, 0), cA + kstep, vc[0], vc[1]); PG8_STAGEB(PG8_SB(1, 1), cB + hstep + kstep);
    PG8_WAIT_V(6); PG8_BAR;
    int pend = -1;
    for (;;) {
        const bool has_next = S.next(ui + 1, nxt);
        const char* nA = cA; const char* nB = cB;
        if (has_next) { nA = S.a_base(nxt); nB = S.b_base(nxt); }
        for (int t = 0; t < nt; t += 2) {
            const bool last = (t == nt - 2);
            if (last && has_next) S.a_ready(nxt, wid, lane);
            const char* a1 = cA + (size_t)(t + 1) * kstep;
            const char* a2 = last ? nA : cA + (size_t)(t + 2) * kstep; const char* b2 = last ? nB : cB + (size_t)(t + 2) * kstep;
            const char* a3 = a2 + kstep; const char* b3 = b2 + kstep;
            PG8_LDB(B0, 0, 0); PG8_LDB(B1, 0, 1); PG8_SCHED; PG8_LDA(At, 0, 0); PG8_STAGE2(PG8_SA(1, 1), a1, vc[2], vc[3]);
            if constexpr (Sched::GATHER) { if (last && has_next) S.a_off(nxt, tid, vc); }
            PG8_WAIT_V8_UNLESS(pend);
            PG8_WAIT_L(0); PG8_BAR; PG8_MMA(0, 0, At, B0); PG8_MMA(0, 1, At, B1); PG8_BAR; PG8_SCHED;
            PG8_LDA(At, 0, 1); PG8_STAGEB(PG8_SB(0, 0), b2); PG8_STAGEB(PG8_SB(0, 1), b2 + hstep); PG8_STAGE2(PG8_SA(0, 0), a2, vc[0], vc[1]);
            PG8_WAIT_V8_UNLESS(pend);
            PG8_WAIT_L(0); PG8_BAR; PG8_MMA(1, 0, At, B0); PG8_MMA(1, 1, At, B1); PG8_BAR; PG8_SCHED;
            PG8_LDB(B0, 1, 0); PG8_LDB(B1, 1, 1); PG8_SCHED; PG8_LDA(At, 1, 0); PG8_STAGE2(PG8_SA(0, 1), a2, vc[2], vc[3]);
            PG8_WAIT_V8_UNLESS(pend);
            PG8_WAIT_L(0); PG8_BAR; PG8_MMA(0, 0, At, B0); PG8_MMA(0, 1, At, B1); PG8_BAR; PG8_SCHED;
            PG8_LDA(At, 1, 1); PG8_STAGEB(PG8_SB(1, 0), b3); PG8_STAGEB(PG8_SB(1, 1), b3 + hstep); PG8_STAGE2(PG8_SA(1, 0), a3, vc[0], vc[1]);
            PG8_WAIT_V(8);
            if (pend >= 0) { S.publish(pend, lane); pend = -1; }
            PG8_WAIT_L(0); PG8_BAR; PG8_MMA(1, 0, At, B0); PG8_MMA(1, 1, At, B1); PG8_BAR; PG8_SCHED;
        }
        PG8_WAIT_V(0);
        if constexpr (ALIGN_EPI) { if (wr == 0) PG8_BAR; }
        E(acc, cur, wr, wc, fr, fq);
        pend = __builtin_amdgcn_readfirstlane(cur.pm);
        if (!has_next) break;
#pragma unroll
        for (int a = 0; a < 2; ++a)
#pragma unroll
            for (int b = 0; b < 2; ++b)
#pragma unroll
                for (int m = 0; m < 4; ++m)
#pragma unroll
                    for (int n = 0; n < 2; ++n) acc[a][b][m][n] = (f32x4){0.f, 0.f, 0.f, 0.f};
        cur = nxt; cA = nA; cB = nB; ++ui;
        if constexpr (ALIGN_EPI) { if (wr == 1) PG8_BAR; }
    }
    E.tail(lds, wid, lane);
    PG8_WAIT_V(0);
    if (pend >= 0) S.publish(pend, lane);
    if constexpr (!ALIGN_EPI) { if (wr == 0) PG8_BAR; }
    PG8_BAR;
#undef PG8_SA
#undef PG8_SB
#undef PG8_STAGE2
#undef PG8_STAGEB
#undef PG8_LDA
#undef PG8_LDB
#undef PG8_MMA
#undef PG8_WAIT_V
#undef PG8_WAIT_L
#undef PG8_WAIT_V8_UNLESS
#undef PG8_BAR
#undef PG8_SCHED
}
}

constexpr size_t MiB = 1u << 20;
constexpr size_t WS_CTL = 0, CTL_ZERO_BYTES = 1 * MiB;
constexpr size_t WS_MOD = 1 * MiB;
constexpr size_t WS_ALOWW = WS_MOD + 256 * 1024;
constexpr size_t WS_CNTW = WS_ALOWW + 64 * 1024;
constexpr size_t WS_EIDX = WS_CNTW + 16 * 1024;
constexpr size_t WS_EW = WS_EIDX + (size_t)2 * T * 4;
constexpr size_t WS_LOC = WS_EW + (size_t)2 * T * 4;
constexpr size_t WS_ALOW = WS_LOC + 1 * MiB;
constexpr size_t WS_WPT = WS_ALOW + 1 * MiB;
constexpr size_t WS_WIN0 = 5 * MiB;
constexpr size_t WS_WOUT0 = WS_WIN0 + (size_t)NIN0 * D * 2;
constexpr size_t WS_WIN1 = WS_WOUT0 + (size_t)D * D * 2;
constexpr size_t WS_WOUT1 = WS_WIN1 + (size_t)NIN1 * D * 2;
constexpr size_t WS_WGU = WS_WOUT1 + (size_t)D * D * 2;
constexpr size_t WS_WD = WS_WGU + (size_t)2 * NE * 1024 * D * 2;
constexpr size_t WS_X1 = WS_WD + (size_t)2 * NE * D * DE * 2;
constexpr size_t WS_XN = WS_X1 + (size_t)T * D * 2;
constexpr size_t WS_QKVY = WS_XN + (size_t)T * D * 2;
constexpr size_t WS_CAT = WS_QKVY + (size_t)T * QW * 2;
constexpr size_t WS_END = WS_CAT + (size_t)(2 * T + 256) * DE * 2;
static_assert(WS_WPT + 128 * 1024 <= WS_WIN0, "small tables fit below the weights");
static_assert(WS_END <= 346000000, "workspace budget");
constexpr int CW_BAR = 4096;
constexpr int CW_APANEL = 98304;
constexpr int CW_PANEL = 65536;

constexpr int RING_BYTES = 131072;
constexpr int LDSCTL_OFF = RING_BYTES;
constexpr int L_MISC = LDSCTL_OFF;
constexpr int L_NE = L_MISC + 256;
constexpr int L_ROWTAB = L_NE + 512;
constexpr int LDS_BYTES = 147456;
static_assert(L_ROWTAB + 8192 <= LDS_BYTES, "LDS map");

#define XB_TMO      128
#define XB_XCNT(j)  (256  + 64 * (j))
#define XB_XSUB(j)  (1280 + 64 * (j))
#define XB_XGEN(j)  (2304 + 64 * (j))
#define XB_TOP      3328
#define XB_TOPGEN   3392
#define XCD_BAR_WORDS 3456
#define XB_SPIN_CAP (1u << 18)
__device__ __forceinline__ unsigned xb_ld(unsigned* p)              { return __hip_atomic_load(p, __ATOMIC_RELAXED, __HIP_MEMORY_SCOPE_AGENT); }
__device__ __forceinline__ unsigned xb_add(unsigned* p, unsigned v) { return __hip_atomic_fetch_add(p, v, __ATOMIC_RELAXED, __HIP_MEMORY_SCOPE_AGENT); }
__device__ __forceinline__ unsigned xb_xcc_id() { return (unsigned)__builtin_amdgcn_s_getreg((3 << 11) | 20) & 0xFu; }
#define XB_SPIN(cond, bar) do { unsigned _sp = 0; while (cond) { __builtin_amdgcn_s_sleep(1); \
    if ((++_sp & 255u) == 0u) { if (xb_ld(&(bar)[XB_TMO])) break; if (_sp > XB_SPIN_CAP) { atomicAdd(&(bar)[XB_TMO], 1u); break; } } } } while (0)
struct XcdBarrier { unsigned* bar; unsigned x; volatile LAS unsigned* st; int wave; };
__device__ __forceinline__ XcdBarrier xcd_barrier_post(unsigned* bar, volatile LAS unsigned* st, int wave) {
    XcdBarrier b; b.bar = bar; b.x = xb_xcc_id(); b.st = st; b.wave = wave;
    if (wave == 0 && lane_id() == 0) (void)xb_add(&bar[XB_XCNT(b.x)], 1u);
    return b;
}
__device__ __forceinline__ void xcd_barrier_complete(unsigned* bar, unsigned x, unsigned& nloc, unsigned& nx) {
    const unsigned G = gridDim.x * gridDim.y * gridDim.z;
    unsigned sum, cnt, mine, sp = 0u;
    for (;;) {
        sum = 0u; cnt = 0u; mine = 0u;
#pragma unroll
        for (unsigned j = 0; j < 16; ++j) { const unsigned c = xb_ld(&bar[XB_XCNT(j)]); sum += c; cnt += (c > 0u) ? 1u : 0u; mine = (j == x) ? c : mine; }
        if (sum == G) break;
        __builtin_amdgcn_s_sleep(1);
        if ((++sp & 255u) == 0u) { if (xb_ld(&bar[XB_TMO])) break; if (sp > XB_SPIN_CAP) { atomicAdd(&bar[XB_TMO], 1u); break; } }
    }
    nloc = mine > 0u ? mine : 1u; nx = cnt > 0u ? cnt : 1u;
}
__device__ __forceinline__ void xcd_barrier(const XcdBarrier& b) {
    asm volatile("s_waitcnt vmcnt(0)" ::: "memory");
    __syncthreads();
    if (b.wave == 0 && lane_id() == 0) {
        unsigned* bar = b.bar;
        __builtin_amdgcn_s_waitcnt(0);
        unsigned nloc = b.st[0], nx = b.st[1];
        if (nloc == 0u) { xcd_barrier_complete(bar, b.x, nloc, nx); b.st[0] = nloc; b.st[1] = nx; }
        const unsigned old = xb_add(&bar[XB_XSUB(b.x)], 1u);
        const unsigned gen = old / nloc;
        if (old + 1u == (gen + 1u) * nloc) {
            __builtin_amdgcn_fence(__ATOMIC_RELEASE, "agent");
            asm volatile("s_waitcnt vmcnt(0)" ::: "memory");
            const unsigned og = xb_add(&bar[XB_TOP], 1u);
            const unsigned tg = og / nx;
            if (og + 1u == (tg + 1u) * nx) xb_add(&bar[XB_TOPGEN], 1u);
            else XB_SPIN(xb_ld(&bar[XB_TOPGEN]) == tg, bar);
            __builtin_amdgcn_fence(__ATOMIC_ACQUIRE, "agent");
            xb_add(&bar[XB_XGEN(b.x)], 1u);
            asm volatile("s_waitcnt vmcnt(0)" ::: "memory");
        } else {
            XB_SPIN(xb_ld(&bar[XB_XGEN(b.x)]) == gen, bar);
            __builtin_amdgcn_fence(__ATOMIC_ACQUIRE, "agent");
            asm volatile("s_waitcnt vmcnt(0)" ::: "memory");
        }
    }
    __syncthreads();
}

struct Args { const float* in[26]; float* out; unsigned char* ws; };
struct Frame {
    LAS unsigned char* lds; unsigned char* ws;
    int tid, lane, wave, vcu, G, bx;
};
typedef const __attribute__((address_space(4))) Args* KA;
__device__ __forceinline__ KA kargs() { auto p = __builtin_amdgcn_kernarg_segment_ptr(); asm volatile("" : "+s"(p)); return (KA)p; }
#define INP(k) (args->in[k])

struct P0Item { const float* s; bf16* d; int ldw, Kd; };
__device__ __forceinline__ void p0_load(const P0Item& it, float (&r)[32], int lane) {
#pragma unroll
    for (int i = 0; i < 32; ++i) r[i] = __builtin_nontemporal_load(it.s + (size_t)(2 * i + (lane >> 5)) * it.ldw + (lane & 31));
}
__device__ __forceinline__ void p0_store(const P0Item& it, const float (&r)[32], LAS float* scr, int lane) {
#pragma unroll
    for (int i = 0; i < 32; ++i) scr[(2 * i + (lane >> 5)) * 33 + (lane & 31)] = r[i];
    LDS_WAIT(); asm volatile("" ::: "memory");
    const int c = lane & 7;
#pragma unroll
    for (int j = 0; j < 4; ++j) { const int n = (lane >> 3) + 8 * j; const LAS float* sp = scr + (8 * c) * 33 + n;
        v4u o; o.x = pk2(sp[0 * 33], sp[1 * 33]); o.y = pk2(sp[2 * 33], sp[3 * 33]); o.z = pk2(sp[4 * 33], sp[5 * 33]); o.w = pk2(sp[6 * 33], sp[7 * 33]);
        __builtin_nontemporal_store(o, (GAS v4u*)(it.d + (size_t)n * it.Kd + 8 * c)); }
    LDS_WAIT(); asm volatile("" ::: "memory");
}
template <class DMap>
__device__ __forceinline__ P0Item p0_matrix(const float* W, int ldw, int K, int scol0, int ncols, bf16* WT, const DMap& dmap, int it) {
    const int nblk = ncols / 32, kb = it / nblk, nb = it % nblk, n0 = 32 * nb;
    return P0Item{W + (size_t)(64 * kb) * ldw + scol0 + n0, WT + (size_t)(dmap(n0 >> 7) + (n0 & 127)) * K + 64 * kb, ldw, K};
}
struct MapId { int base; __device__ int operator()(int g) const { return base + 128 * g; } };
struct MapGlu { int second; __device__ int operator()(int g) const { return 256 * g + second; } };

constexpr int P0_I_IN0A = 16 * 16, P0_I_IN0Q = 16 * 48, P0_I_OUT = 16 * 32, P0_I_IN1A = 16 * 48, P0_I_IN1P = 16 * 16, P0_I_G = 16 * 16, P0_I_D = 8 * 32;
constexpr int P0_I_MOE = 2 * P0_I_G + P0_I_D;
constexpr int P0_I_PW = 4 * 8;
constexpr int P0_NITEMS = 2 * P0_I_IN0A + P0_I_IN0Q + 2 * P0_I_OUT + P0_I_IN1A + P0_I_IN1P + P0_I_PW + 32 * P0_I_MOE;
constexpr int P0_NFILL = 10 * P0_I_MOE;
__device__ __forceinline__ void p0_items(KA args, Frame& F, int first, int last, int widx, int nw) {
    LAS float* scr = (LAS float*)(F.lds + F.wave * 16384);
    auto decode = [&](int it) -> P0Item {
        KA args = kargs();
        unsigned char* ws = args->ws;
        bf16* win0 = (bf16*)(ws + WS_WIN0); bf16* wout0 = (bf16*)(ws + WS_WOUT0); bf16* win1 = (bf16*)(ws + WS_WIN1); bf16* wout1 = (bf16*)(ws + WS_WOUT1);
        int r = it;
        if (r < P0_I_IN0A) return p0_matrix(INP(6), NIN0, D, 0, 512, win0, MapGlu{0}, r); r -= P0_I_IN0A;
        if (r < P0_I_IN0A) return p0_matrix(INP(6), NIN0, D, 512, 512, win0, MapGlu{128}, r); r -= P0_I_IN0A;
        if (r < P0_I_IN0Q) return p0_matrix(INP(6), NIN0, D, 1024, 1536, win0, MapId{1024}, r); r -= P0_I_IN0Q;
        if (r < P0_I_OUT) return p0_matrix(INP(7), D, D, 0, 1024, wout0, MapId{0}, r); r -= P0_I_OUT;
        if (r < P0_I_IN1A) return p0_matrix(INP(12), 2064, D, 0, 1536, win1, MapId{0}, r); r -= P0_I_IN1A;
        if (r < P0_I_IN1P) return p0_matrix(INP(12), 2064, D, 1552, 512, win1, MapId{1536}, r); r -= P0_I_IN1P;
        if (r < P0_I_OUT) return p0_matrix(INP(13), D, D, 0, 1024, wout1, MapId{0}, r); r -= P0_I_OUT;
        if (r < P0_I_PW) { const int g = r >> 3; return p0_matrix(INP(17) + (size_t)g * 128 * 128, 128, 128, 0, 128, (bf16*)(ws + WS_WPT) + (size_t)g * 128 * 128, MapId{0}, r & 7); } r -= P0_I_PW;
        const int le = r / P0_I_MOE; r -= le * P0_I_MOE;
        bf16* wgu = (bf16*)(ws + WS_WGU) + (size_t)le * 1024 * D; bf16* wd = (bf16*)(ws + WS_WD) + (size_t)le * D * DE;
        if (r < P0_I_G) return p0_matrix(INP(22) + (size_t)le * D * DE, DE, D, 0, 512, wgu, MapGlu{0}, r); r -= P0_I_G;
        if (r < P0_I_G) return p0_matrix(INP(23) + (size_t)le * D * DE, DE, D, 0, 512, wgu, MapGlu{128}, r); r -= P0_I_G;
        return p0_matrix(INP(24) + (size_t)le * DE * D, D, DE, 0, 1024, wd, MapId{0}, r);
    };
    const int lane = lane_id();
    int i = first + widx;
    if (i < last) {
        P0Item t0 = decode(i), t1 = t0, t2 = t0; float r0[32], r1[32], r2[32];
        p0_load(t0, r0, lane);
        if (i + nw < last) { t1 = decode(i + nw); p0_load(t1, r1, lane); }
        for (;;) {
            if (i + 2 * nw < last) { t2 = decode(i + 2 * nw); p0_load(t2, r2, lane); }
            p0_store(t0, r0, scr, lane); i += nw; if (i >= last) break;
            if (i + 2 * nw < last) { t0 = decode(i + 2 * nw); p0_load(t0, r0, lane); }
            p0_store(t1, r1, scr, lane); i += nw; if (i >= last) break;
            if (i + 2 * nw < last) { t1 = decode(i + 2 * nw); p0_load(t1, r1, lane); }
            p0_store(t2, r2, scr, lane); i += nw; if (i >= last) break;
        }
    }
}
__device__ __forceinline__ void p0_prologue(KA args, Frame& F) {
    unsigned char* ws = F.ws;
    if (F.vcu < 192) {
        LAS float* cs = (LAS float*)F.lds;
        LAS float* part = (LAS float*)(F.lds + 16384);
        const float* c = INP(1);
        for (int i = F.tid; i < 4096; i += 512) cs[i] = siluf_(c[i]);
        __syncthreads();
        const int l = F.vcu / 96, cg = F.vcu % 96;
        const float* wp = INP(2) + (size_t)l * 1024 * 6144 + 64 * cg + F.lane;
        float a0 = 0.f, a1 = 0.f, a2 = 0.f, a3 = 0.f;
#pragma unroll 32
        for (int kk = 0; kk < 128; ++kk) { const int k = 128 * F.wave + kk; const float wv = __builtin_nontemporal_load(wp + (size_t)k * 6144);
            a0 += cs[k] * wv; a1 += cs[1024 + k] * wv; a2 += cs[2048 + k] * wv; a3 += cs[3072 + k] * wv; }
        part[(F.wave * 4 + 0) * 64 + F.lane] = a0; part[(F.wave * 4 + 1) * 64 + F.lane] = a1; part[(F.wave * 4 + 2) * 64 + F.lane] = a2; part[(F.wave * 4 + 3) * 64 + F.lane] = a3;
        __syncthreads();
        float* mod = (float*)(ws + WS_MOD);
        if (F.tid < 256) { const int b = F.tid >> 6, col = F.tid & 63; float sm = INP(3)[l * 6144 + 64 * cg + col];
#pragma unroll
            for (int w = 0; w < 8; ++w) sm += part[(w * 4 + b) * 64 + col];
            mod[(l * 4 + b) * 6144 + 64 * cg + col] = sm; }
        __syncthreads();
    }
    { float* aw = (float*)(ws + WS_ALOWW); const float* w1 = INP(12);
      for (int i = F.vcu * 512 + F.tid; i < 1024 * 16; i += F.G * 512) aw[i] = w1[(size_t)(i >> 4) * 2064 + 1536 + (i & 15)]; }
    { int nall = ((P0_NITEMS - P0_NFILL) / (F.G * 8)) * (F.G * 8); if (F.G <= 192) nall = P0_NITEMS - P0_NFILL;
      p0_items(args, F, 0, nall, F.vcu * 8 + F.wave, F.G * 8);
      if (F.vcu >= 192) p0_items(args, F, nall, P0_NITEMS - P0_NFILL, (F.vcu - 192) * 8 + F.wave, (F.G - 192) * 8); }
}

#ifdef PROBE_TS
#define TS_RAW(m) do { if (threadIdx.x == 0) ((unsigned long long*)(args->ws + 524288))[(26 + (m)) * 256 + blockIdx.x] = __builtin_amdgcn_s_memrealtime(); } while (0)
#else
#define TS_RAW(m) do {} while (0)
#endif
#ifdef PROBE_TS
#ifndef PROBE_LO
#define PROBE_LO 0
#define PROBE_HI 256
#endif
#define TSBUF ((unsigned long long*)(ws + WS_CTL + 524288))
#define TS_PUT(slot) do { if (F.tid == 0) TSBUF[(slot) * 256 + F.bx] = __builtin_amdgcn_s_memrealtime(); } while (0)
#define TS_PRE(idx) do { __syncthreads(); TS_PUT(1 + 2 * (idx)); } while (0)
#define TS_MARK(m) do { if (l == 0) { unsigned char* ws = F.ws; TS_PUT(26 + (m)); } } while (0)
#define TS_MARK1(m) do { if (l == 1) { unsigned char* ws = F.ws; TS_PUT(26 + (m)); } } while (0)
#define TS_POST(idx) TS_PUT(2 + 2 * (idx))
#define SEAM_IDX(k) ((k) == 0 ? 0 : (k) <= 4 ? (k) - 1 : (k) == 6 ? 4 : (k) == 9 ? 5 : (k) == 10 ? 8 : (k) == 11 ? 9 : 10)
#else
#define TS_PUT(slot) do {} while (0)
#define TS_MARK(m) do {} while (0)
#define TS_MARK1(m) do {} while (0)
#define TS_PRE(idx) do {} while (0)
#define TS_POST(idx) do {} while (0)
#define SEAM_IDX(k) 0
#endif
__device__ __forceinline__ void norm_row(f32x4 (&v)[4], int lane, const float* g, const float* sc, const float* sh) {
    float s = 0.f;
#pragma unroll
    for (int j = 0; j < 4; ++j) s += (v[j].x * v[j].x + v[j].y * v[j].y) + (v[j].z * v[j].z + v[j].w * v[j].w);
    const float r = rsqrtf(wave_sum(s) * (1.f / D) + 1e-6f);
#pragma unroll
    for (int j = 0; j < 4; ++j) { const int c = 4 * lane + 256 * j; const f32x4 gg = *(const f32x4*)(g + c);
        v[j] = v[j] * r * gg;
        if (sc) { const f32x4 s1 = *(const f32x4*)(sc + c), s0 = *(const f32x4*)(sh + c); v[j] = v[j] * (1.f + s1) + s0; } }
}
template <bool SHIFT> __device__ __forceinline__ void norm_row_pre(f32x4 (&v)[4], const f32x4 (&A)[4], const f32x4 (&Bv)[4]) {
    float s = 0.f;
#pragma unroll
    for (int j = 0; j < 4; ++j) s += (v[j].x * v[j].x + v[j].y * v[j].y) + (v[j].z * v[j].z + v[j].w * v[j].w);
    const float r = rsqrtf(wave_sum(s) * (1.f / D) + 1e-6f);
#pragma unroll
    for (int j = 0; j < 4; ++j) { v[j] = v[j] * r * A[j]; if (SHIFT) v[j] = v[j] + Bv[j]; }
}
__device__ __forceinline__ void load_colvec(f32x4 (&A)[4], f32x4 (&Bv)[4], int lane, const float* g, const float* sc, const float* sh) {
#pragma unroll
    for (int j = 0; j < 4; ++j) { const int c = 4 * lane + 256 * j; const f32x4 gg = *(const f32x4*)(g + c);
        if (sc) { const f32x4 s1 = *(const f32x4*)(sc + c); A[j] = gg * (1.f + s1); Bv[j] = *(const f32x4*)(sh + c); } else { A[j] = gg; Bv[j] = (f32x4){0.f, 0.f, 0.f, 0.f}; } }
}
__device__ __forceinline__ void store_row_bf16_wt(const f32x4 (&v)[4], int lane, bf16* orow) {
    bf16* o = orow + 4 * lane;
#pragma unroll
    for (int j = 0; j < 4; ++j) { v2u w; w.x = pk2(v[j].x, v[j].y); w.y = pk2(v[j].z, v[j].w); asm volatile("global_store_dwordx2 %0, %1, off sc1" :: "v"(o + 256 * j), "v"(w) : "memory"); }
}
__device__ __forceinline__ void store_row_bf16(const f32x4 (&v)[4], int lane, bf16* orow) {
    GAS v2u* o = (GAS v2u*)orow + lane;
#pragma unroll
    for (int j = 0; j < 4; ++j) { v2u w; w.x = pk2(v[j].x, v[j].y); w.y = pk2(v[j].z, v[j].w); o[64 * j] = w; }
}


__device__ __forceinline__ void load_row_bf16(const bf16* row, int lane, f32x4 (&v)[4]) {
    const GAS v2u* p = (const GAS v2u*)row + lane;
#pragma unroll
    for (int j = 0; j < 4; ++j) { const v2u w = p[64 * j]; v[j] = (f32x4){bflo(w.x), bfhi(w.x), bflo(w.y), bfhi(w.y)}; }
}
constexpr int W16_PITCH = 20;
__device__ __forceinline__ void stage_w16(LAS float* tabw, const float* w, int tid) {
    f32x4 v[8];
#pragma unroll
    for (int u = 0; u < 8; ++u) { const int i = tid + 512 * u; v[u] = *(const f32x4*)(w + (i >> 2) * 16 + 4 * (i & 3)); }
#pragma unroll
    for (int u = 0; u < 8; ++u) { const int i = tid + 512 * u, c = i >> 2, k4 = i & 3;
        const int sidx = ((c >> 8) * 4 + (c & 3)) * 64 + ((c >> 2) & 63); *(LAS f32x4*)(tabw + sidx * W16_PITCH + 4 * k4) = v[u]; }
}
__device__ __forceinline__ void dot16(const f32x4 (&v)[4], const LAS float* tabw, int lane, float (&lg)[16]) {
    float a[16];
#pragma unroll
    for (int e = 0; e < 16; ++e) a[e] = 0.f;
#pragma unroll
    for (int j = 0; j < 4; ++j)
#pragma unroll
        for (int q = 0; q < 4; ++q) { const float hv = v[j][q]; const LAS float* p = tabw + ((j * 4 + q) * 64 + lane) * W16_PITCH;
#pragma unroll
            for (int k = 0; k < 4; ++k) { const f32x4 w = *(const LAS f32x4*)(p + 4 * k); a[4 * k] += hv * w.x; a[4 * k + 1] += hv * w.y; a[4 * k + 2] += hv * w.z; a[4 * k + 3] += hv * w.w; } }
    float b[8], c[4];
#pragma unroll
    for (int i = 0; i < 8; ++i) { auto rr = __builtin_amdgcn_permlane32_swap(__float_as_uint(a[i]), __float_as_uint(a[i + 8]), false, false); b[i] = __uint_as_float(rr[0]) + __uint_as_float(rr[1]); }
#pragma unroll
    for (int i = 0; i < 4; ++i) { auto rr = __builtin_amdgcn_permlane16_swap(__float_as_uint(b[i]), __float_as_uint(b[i + 4]), false, false); c[i] = row_sum16(__uint_as_float(rr[0]) + __uint_as_float(rr[1])); }
#pragma unroll
    for (int e = 0; e < 16; ++e) lg[e] = rdlane(c[e & 3], 16 * (e >> 2));
}

__device__ __forceinline__ void stage_w16_dma(LAS unsigned char* lds, const float* w, int wid, int lane) {
#pragma unroll
    for (int uu = 0; uu < 10; ++uu) { const int p = wid * 64 + lane + 512 * uu, sidx = (p * 52429) >> 18, k5 = p - 5 * sidx, jq = sidx >> 6, ln = sidx & 63;
        const int c = (jq >> 2) * 256 + ln * 4 + (jq & 3);
        __builtin_amdgcn_global_load_lds((const unsigned*)(w + c * 16 + 4 * (k5 < 4 ? k5 : 3)), (LAS unsigned*)(lds + (wid * 64 + 512 * uu) * 16), 16, 0, 0); }
}
__device__ __forceinline__ void store16_wt(void* p, v4u v) { asm volatile("global_store_dwordx4 %0, %1, off sc1\n\ts_nop 1" :: "v"(p), "v"(v) : "memory"); }

struct EpiIn0 {
    static constexpr bool PERM = true;
    __device__ __forceinline__ void prefetch(const pg8::Unit&, int, LAS unsigned*) const {}
    __device__ __forceinline__ void tail(LAS unsigned char*, int, int) const {}
    bf16* O;
    __device__ __forceinline__ void operator()(const f32x4 (&acc)[2][2][4][2], const pg8::Unit& u, int wr, int wc, int fr, int fq) const {
        const int row0 = u.pm * 256 + wr * 64 + fr;
        if (u.pn < 4) {
            const int col0 = u.pn * 128 + wc * 32 + 8 * fq;
#pragma unroll
            for (int ai = 0; ai < 2; ++ai)
#pragma unroll
                for (int m = 0; m < 4; ++m) { bf16* rowp = O + (size_t)(row0 + ai * 128 + m * 16) * QW + col0;
                    const f32x4 a0 = acc[ai][0][m][0], a1 = acc[ai][0][m][1], g0 = acc[ai][1][m][0], g1 = acc[ai][1][m][1];
                    v4u w; w.x = pk2(a0[0] * sigmoidf_(g0[0]), a0[1] * sigmoidf_(g0[1])); w.y = pk2(a0[2] * sigmoidf_(g0[2]), a0[3] * sigmoidf_(g0[3]));
                    w.z = pk2(a1[0] * sigmoidf_(g1[0]), a1[1] * sigmoidf_(g1[1])); w.w = pk2(a1[2] * sigmoidf_(g1[2]), a1[3] * sigmoidf_(g1[3]));
                    *(v4u*)rowp = w; }
        } else {
            const float sc = (u.pn < 6) ? QSCALE0 : 1.f;
            const int col0 = 512 + (u.pn - 4) * 256 + wc * 32 + 8 * fq;
#pragma unroll
            for (int ai = 0; ai < 2; ++ai)
#pragma unroll
                for (int m = 0; m < 4; ++m) { bf16* rowp = O + (size_t)(row0 + ai * 128 + m * 16) * QW + col0;
#pragma unroll
                    for (int bj = 0; bj < 2; ++bj) { const f32x4 v0 = acc[ai][bj][m][0] * sc, v1 = acc[ai][bj][m][1] * sc;
                        v4u w; w.x = pk2(v0[0], v0[1]); w.y = pk2(v0[2], v0[3]); w.z = pk2(v1[0], v1[1]); w.w = pk2(v1[2], v1[3]);
                        *(v4u*)(rowp + bj * 128) = w; } }
        }
    }
};
struct EpiIn1 {
    static constexpr bool PERM = true;
    __device__ __forceinline__ void prefetch(const pg8::Unit&, int, LAS unsigned*) const {}
    __device__ __forceinline__ void tail(LAS unsigned char*, int, int) const {}
    bf16* O;
    __device__ __forceinline__ void operator()(const f32x4 (&acc)[2][2][4][2], const pg8::Unit& u, int wr, int wc, int fr, int fq) const {
        const int row0 = u.pm * 256 + wr * 64 + fr;
        const float sc = (u.pn == 0) ? 0.125f : 1.f;
        const int col0 = u.pn * 256 + wc * 32 + 8 * fq;
#pragma unroll
        for (int ai = 0; ai < 2; ++ai)
#pragma unroll
            for (int m = 0; m < 4; ++m) { bf16* rowp = O + (size_t)(row0 + ai * 128 + m * 16) * QW + col0;
#pragma unroll
                for (int bj = 0; bj < 2; ++bj) { const f32x4 v0 = acc[ai][bj][m][0] * sc, v1 = acc[ai][bj][m][1] * sc;
                    v4u w; w.x = pk2(v0[0], v0[1]); w.y = pk2(v0[2], v0[3]); w.z = pk2(v1[0], v1[1]); w.w = pk2(v1[2], v1[3]);
                    *(v4u*)(rowp + bj * 128) = w; } }
    }
};
template <bool XIN_F32> struct EpiOut {
    static constexpr bool PERM = true;
    __device__ __forceinline__ void prefetch(const pg8::Unit&, int, LAS unsigned*) const {}
    __device__ __forceinline__ void tail(LAS unsigned char* lds, int wid, int lane) const { if (rw) stage_w16_dma(lds, rw, wid, lane); }
    const void* xin; bf16* xout; const float* gate;
#ifdef PROBE_TS
    void* tsb;
#endif
    const float* rw;
    __device__ __forceinline__ void operator()(const f32x4 (&acc)[2][2][4][2], const pg8::Unit& u, int wr, int wc, int fr, int fq) const {
#ifdef PROBE_TS
        if (XIN_F32 && threadIdx.x == 0) ((unsigned long long*)tsb)[(26 + 3) * 256 + blockIdx.x] = __builtin_amdgcn_s_memrealtime();
#endif
        const int row0 = u.pm * 256 + wr * 64 + fr, col0 = u.pn * 256 + wc * 32 + 8 * fq;
        const float* gb = gate + ((u.pm * 256) / S) * 6144 + col0;
        f32x4 gv[2][2];
#pragma unroll
        for (int bj = 0; bj < 2; ++bj)
#pragma unroll
            for (int n = 0; n < 2; ++n) gv[bj][n] = *(const f32x4*)(gb + bj * 128 + 4 * n);
#pragma unroll
        for (int ai = 0; ai < 2; ++ai) {
            f32x4 xf[4][2][2]; v4u xb[4][2];
#pragma unroll
            for (int m = 0; m < 4; ++m) { const size_t off = (size_t)(row0 + ai * 128 + m * 16) * D + col0;
#pragma unroll
                for (int bj = 0; bj < 2; ++bj) {
                    if (XIN_F32) { const float* xp = (const float*)xin + off + bj * 128; xf[m][bj][0] = *(const f32x4*)xp; xf[m][bj][1] = *(const f32x4*)(xp + 4); }
                    else xb[m][bj] = *(const v4u*)((const bf16*)xin + off + bj * 128); } }
            __builtin_amdgcn_sched_barrier(0);
#pragma unroll
            for (int m = 0; m < 4; ++m) { const size_t off = (size_t)(row0 + ai * 128 + m * 16) * D + col0;
#pragma unroll
                for (int bj = 0; bj < 2; ++bj) { f32x4 x0, x1;
                    if (XIN_F32) { x0 = xf[m][bj][0]; x1 = xf[m][bj][1]; }
                    else { const v4u w = xb[m][bj]; x0 = (f32x4){bflo(w.x), bfhi(w.x), bflo(w.y), bfhi(w.y)}; x1 = (f32x4){bflo(w.z), bfhi(w.z), bflo(w.w), bfhi(w.w)}; }
                    x0 += gv[bj][0] * acc[ai][bj][m][0]; x1 += gv[bj][1] * acc[ai][bj][m][1];
                    v4u o; o.x = pk2(x0[0], x0[1]); o.y = pk2(x0[2], x0[3]); o.z = pk2(x1[0], x1[1]); o.w = pk2(x1[2], x1[3]);
                    store16_wt(xout + off + bj * 128, o); } }
            __builtin_amdgcn_sched_barrier(0);
        }
    }
};

constexpr int CW_MOECNT = 32768;
__device__ __forceinline__ int moe_unit_index(int mode, int i, int c, int G, int U, int nlow, int nfull) {
    if (i >= 4) return -1;
    const int d = U - 2 * G;
    if (d >= 0 && 5 * d <= G) {
        const int nB = 2 * d, nC = G - 5 * d;
        if (mode == 1) {
            if (i == 0) return c;
            if (c < 3 * d) return i == 1 ? G + c : i == 2 ? 2 * G - 2 * d + c : -1;
            if (c >= 5 * d) return i == 1 ? G + 3 * d + (c - 5 * d) : -1;
            return -1;
        }
        if (c < 3 * d) return i == 0 ? 4 * nB + 2 * nC + c : -1;
        if (c < 5 * d) { const int j = c - 3 * d; return i == 0 ? j : i == 1 ? nB + j : i == 2 ? 2 * nB + nC + j : 3 * nB + 2 * nC + j; }
        { const int j = c - 5 * d; return i == 0 ? 2 * nB + j : i == 1 ? 3 * nB + nC + j : -1; }
    }
    int X;
    if (mode == 1) X = i * G + c;
    else if (c >= nfull) { const int j = c - nfull; X = (i == 0) ? j : (i == 1) ? j + nlow : 2 * nlow + c + (i - 2) * G; }
    else X = 2 * nlow + c + i * G;
    return X < U ? X : -1;
}
template <int MODE> struct MoeSched {
    const bf16* A; const bf16* Bt; int K; size_t bstride;
    LAS int* tab; LAS int* rowtab;
    unsigned* cnt; int G, c;
    static constexpr bool GATHER = (MODE == 1);
    __device__ __forceinline__ bool next(int i, pg8::Unit& u) const {
        const int U = __builtin_amdgcn_readfirstlane(tab[49]);
        const int X = moe_unit_index(MODE, i, c, G, U, __builtin_amdgcn_readfirstlane(tab[61]), __builtin_amdgcn_readfirstlane(tab[62]));
        if (X < 0) return false;
        int e = 0;
#pragma unroll
        for (int j = 1; j < 16; ++j) if (X >= __builtin_amdgcn_readfirstlane(tab[33 + j])) e = j;
        const int r = X - __builtin_amdgcn_readfirstlane(tab[33 + e]); const int rt = r >> 2, ct = r & 3;
        u.pm = X >> 2; u.pn = ct; u.e = e; u.li = (MODE == 1 ? 0 : 4) + i; u.r0 = __builtin_amdgcn_readfirstlane(tab[16 + e]) + 256 * rt; u.nr = min(256, __builtin_amdgcn_readfirstlane(tab[e]) - 256 * rt); return true;
    }
    __device__ __forceinline__ const char* a_base(const pg8::Unit& u) const { return GATHER ? (const char*)A : (const char*)A + (size_t)u.r0 * K * 2; }
    __device__ __forceinline__ const char* b_base(const pg8::Unit& u) const { return (const char*)Bt + (size_t)u.e * bstride + (size_t)u.pn * 256 * K * 2; }
    __device__ __forceinline__ void a_off(const pg8::Unit& u, int tid, unsigned (&v)[4]) const {
#pragma unroll
        for (int i = 0; i < 2; ++i) { int R, C; pg8::stage_rc(tid * 16 + i * 8192, R, C);
#pragma unroll
            for (int h = 0; h < 2; ++h) {
                if (GATHER) v[2 * h + i] = (unsigned)(rowtab[u.li * 256 + h * 128 + R] >> 1) * (unsigned)(K * 2) + (unsigned)C * 2u;
                else v[2 * h + i] = (unsigned)((h * 128 + R) * K + C) * 2u;
            } }
    }
    __device__ __forceinline__ void a_ready(const pg8::Unit& u, int wid, int lane) const {
        if (MODE == 2) {
            if (wid == 0) { unsigned sp = 0;
                while ((unsigned)__builtin_amdgcn_readfirstlane(__hip_atomic_load(cnt + 64 * u.pm, __ATOMIC_RELAXED, __HIP_MEMORY_SCOPE_AGENT)) < 32u) { __builtin_amdgcn_s_sleep(2); if (++sp > (1u << 20)) break; }
                __builtin_amdgcn_fence(__ATOMIC_ACQUIRE, "agent");
                asm volatile("s_waitcnt vmcnt(0)" ::: "memory"); }
            asm volatile("" ::: "memory"); __builtin_amdgcn_s_barrier(); asm volatile("" ::: "memory");
        }
    }
    __device__ __forceinline__ void publish(int rtg, int lane) const {
        if (MODE == 1) { if (lane == 0) __hip_atomic_fetch_add(cnt + 64 * rtg, 1u, __ATOMIC_RELAXED, __HIP_MEMORY_SCOPE_AGENT); }
    }
};
__device__ __forceinline__ void moe_plan(Frame& F, const int* cntw, const int* loc, int c) {
    LAS int* tab = (LAS int*)(F.lds + L_NE); LAS int* rowtab = (LAS int*)(F.lds + L_ROWTAB);
    LAS int* pre = (LAS int*)F.lds + F.wave * 320;
    __syncthreads();
    { int v[8];
#pragma unroll
      for (int i = 0; i < 4; ++i) { v[i] = cntw[(F.lane + 64 * i) * 16 + 2 * F.wave]; v[4 + i] = cntw[(F.lane + 64 * i) * 16 + 2 * F.wave + 1]; }
      const int s0 = wave_sum_i((v[0] + v[1]) + (v[2] + v[3])), s1 = wave_sum_i((v[4] + v[5]) + (v[6] + v[7]));
      if (F.lane == 0) { tab[2 * F.wave] = s0; tab[2 * F.wave + 1] = s1; } }
    for (int i = F.tid; i < 2048; i += 512) rowtab[i] = 0;
    __syncthreads();
    if (F.tid == 0) { int a = 0, ub = 0; for (int e = 0; e < 16; ++e) { tab[16 + e] = a; tab[33 + e] = ub; a += tab[e]; ub += 4 * ((tab[e] + 255) >> 8); } tab[32] = a; tab[49] = ub;
        const int R = 1 + (ub > F.G) + (ub > 2 * F.G) + (ub > 3 * F.G), nfull = ub - (R - 1) * F.G;
        tab[60] = R; tab[61] = F.G - nfull; tab[62] = nfull; }
    __syncthreads();
    const int li = F.wave;
    const int X = moe_unit_index(li < 4 ? 1 : 2, li & 3, c, F.G, tab[49], tab[61], tab[62]);
    if (X >= 0) {
        int e = 0;
        for (int j = 1; j < 16; ++j) if (X >= tab[33 + j]) e = j;
        const int rt = (X - tab[33 + e]) >> 2, ne = tab[e];
        int cw[4], tot = 0;
#pragma unroll
        for (int i = 0; i < 4; ++i) { cw[i] = cntw[(4 * F.lane + i) * 16 + e]; tot += cw[i]; }
        int start = wave_scan_i(tot) - tot;
#pragma unroll
        for (int i = 0; i < 4; ++i) { pre[4 * F.lane + i] = start; start += cw[i]; }
        asm volatile("s_waitcnt lgkmcnt(0)" ::: "memory");
        int cidx[4], gidx[4];
#pragma unroll
        for (int k = 0; k < 4; ++k) { const int g = 256 * rt + 64 * k + F.lane; int lo = 0;
#pragma unroll
            for (int st = 128; st >= 1; st >>= 1) { if (pre[lo + st] <= g) lo += st; }
            cidx[k] = lo; gidx[k] = g; }
        int val[4];
#pragma unroll
        for (int k = 0; k < 4; ++k) { val[k] = 0; if (gidx[k] < ne) val[k] = loc[(cidx[k] * 16 + e) * 64 + (gidx[k] - pre[cidx[k]])]; }
#pragma unroll
        for (int k = 0; k < 4; ++k) if (gidx[k] < ne) rowtab[li * 256 + 64 * k + F.lane] = val[k];
    }
    __syncthreads();
}
struct EpiM1 {
    static constexpr bool PERM = true;
    __device__ __forceinline__ void prefetch(const pg8::Unit&, int, LAS unsigned*) const {}
    __device__ __forceinline__ void tail(LAS unsigned char*, int, int) const {}
    bf16* ACT; const float* ew; LAS int* rowtab;
    __device__ __forceinline__ void operator()(const f32x4 (&acc)[2][2][4][2], const pg8::Unit& u, int wr, int wc, int fr, int fq) const {
        const int col0 = u.pn * 128 + wc * 32 + 8 * fq;
#pragma unroll
        for (int ai = 0; ai < 2; ++ai)
#pragma unroll
            for (int m = 0; m < 4; ++m) { const int r = ai * 128 + wr * 64 + m * 16 + fr;
                if (r < u.nr) { const float w8 = ew[rowtab[u.li * 256 + r]];
                    const f32x4 g0 = acc[ai][0][m][0], g1 = acc[ai][0][m][1], u0 = acc[ai][1][m][0], u1 = acc[ai][1][m][1];
                    v4u w; w.x = pk2(siluf_(g0[0]) * u0[0] * w8, siluf_(g0[1]) * u0[1] * w8); w.y = pk2(siluf_(g0[2]) * u0[2] * w8, siluf_(g0[3]) * u0[3] * w8);
                    w.z = pk2(siluf_(g1[0]) * u1[0] * w8, siluf_(g1[1]) * u1[1] * w8); w.w = pk2(siluf_(g1[2]) * u1[2] * w8, siluf_(g1[3]) * u1[3] * w8);
                    store16_wt(ACT + (size_t)(u.r0 + r) * DE + col0, w); } }
    }
};
struct EpiM2 {
    static constexpr bool PERM = true;
    __device__ __forceinline__ void prefetch(const pg8::Unit&, int, LAS unsigned*) const {}
    __device__ __forceinline__ void tail(LAS unsigned char* lds, int wid, int lane) const { if (rw) stage_w16_dma(lds, rw, wid, lane); }
    bf16* YS; LAS int* rowtab; const float* rw;
    __device__ __forceinline__ void operator()(const f32x4 (&acc)[2][2][4][2], const pg8::Unit& u, int wr, int wc, int fr, int fq) const {
        const int col0 = u.pn * 256 + wc * 32 + 8 * fq;
#pragma unroll
        for (int ai = 0; ai < 2; ++ai)
#pragma unroll
            for (int m = 0; m < 4; ++m) { const int r = ai * 128 + wr * 64 + m * 16 + fr;
                if (r < u.nr) { bf16* rowp = YS + (size_t)rowtab[u.li * 256 + r] * D + col0;
#pragma unroll
                    for (int bj = 0; bj < 2; ++bj) { const f32x4 v0 = acc[ai][bj][m][0], v1 = acc[ai][bj][m][1];
                        v4u w; w.x = pk2(v0[0], v0[1]); w.y = pk2(v0[2], v0[3]); w.z = pk2(v1[0], v1[1]); w.w = pk2(v1[2], v1[3]);
                        *(v4u*)(rowp + bj * 128) = w; } } }
    }
};

constexpr int MX_PITCH = 520;
template <int HALO> __device__ __forceinline__ void stage_rows(LAS bf16* dst, const bf16* QKVY, int col0, int t0, int tid) {
    constexpr int NROW = 64 + HALO, NP = (NROW * 64 + 511) / 512;
    const int tt0 = t0 % S;
    v4u v[NP];
#pragma unroll
    for (int i = 0; i < NP; ++i) { const int p = tid + 512 * i, row = p >> 6, c8 = (p & 63) * 8; v[i] = (v4u){0u, 0u, 0u, 0u};
        if (p < NROW * 64 && tt0 - HALO + row >= 0) v[i] = *(const v4u*)(QKVY + (size_t)(t0 - HALO + row) * QW + col0 + c8); }
#pragma unroll
    for (int i = 0; i < NP; ++i) { const int p = tid + 512 * i, row = p >> 6, c8 = (p & 63) * 8;
        if (p < NROW * 64) *(LAS v4u*)(dst + row * MX_PITCH + c8) = v[i]; }
}
__device__ __forceinline__ void conv_phase(KA args, Frame& F, const bf16* QKVY, bf16* CAT) {
    typedef float f2 __attribute__((ext_vector_type(2)));
    LAS bf16* ys = (LAS bf16*)F.lds;
    const int half = F.tid >> 8, cp = (F.tid & 255) * 2;
    const float* cw = INP(8);
    f2 w[31];
#pragma unroll
    for (int j = 0; j < 31; ++j) w[j] = *(const f2*)(cw + j * 512 + cp);
    const f2 bb = *(const f2*)(INP(9) + cp), gg = *(const f2*)(INP(10) + cp), nn = *(const f2*)(INP(11) + cp);
    for (int chunk = F.vcu; chunk < T / 64; chunk += F.G) {
        const int t0 = chunk * 64;
        __syncthreads();
        stage_rows<30>(ys, QKVY, 0, t0, F.tid);
        __syncthreads();
        for (int blk = 0; blk < 4; ++blk) { const int tok0 = half * 32 + blk * 8;
            f2 y[38];
#pragma unroll
            for (int r = 0; r < 38; ++r) { const unsigned u = *(const LAS unsigned*)(ys + (tok0 + r) * MX_PITCH + cp); y[r] = (f2){bflo(u), bfhi(u)}; }
#pragma unroll
            for (int i = 0; i < 8; ++i) { f2 a = bb;
#pragma unroll
                for (int j = 0; j < 31; ++j) a = y[i + j] * w[j] + a;
                float s = xor16_add(row_sum16(a.x + a.y));
                const float mean = s * (1.f / 64.f); const f2 d = a - mean;
                float q = xor16_add(row_sum16(d.x * d.x + d.y * d.y));
                const float rs = rsqrtf(q * (1.f / 64.f) + 1e-5f);
                const f2 yn = d * rs * gg + nn;
                *(unsigned*)(CAT + (size_t)(t0 + tok0 + i) * D + cp) = pk2(siluf_(yn.x), siluf_(yn.y)); }
        }
    }
}
__device__ __forceinline__ void pool_phase(KA args, Frame& F, const bf16* QKVY, const bf16* WPT, bf16* CAT) {
    typedef float f32x16 __attribute__((ext_vector_type(16)));
    LAS bf16* us = (LAS bf16*)F.lds;
    const int g = (F.wave < 4) ? 3 - (F.wave >> 1) : ((F.wave - 4) >> 1), tt = F.wave & 1, r32 = F.lane & 31, hi = F.lane >> 5, win = 2 << g;
    const float* pb = INP(18); const float* ps = INP(19);
    for (int chunk = F.vcu; chunk < T / 64; chunk += F.G) {
        const int t0 = chunk * 64, tt0 = t0 % S;
        __syncthreads();
        stage_rows<15>(us, QKVY, 1536, t0, F.tid);
        __syncthreads();
        const int tok = tt * 32 + r32;
        const float inv = 1.f / (float)min(tt0 + tok + 1, win);
        f32x16 acc[4];
#pragma unroll
        for (int ct = 0; ct < 4; ++ct) acc[ct] = (f32x16){};
        bf16x8 bnx[4];
#pragma unroll
        for (int ct = 0; ct < 4; ++ct) bnx[ct] = *(const bf16x8*)(WPT + (size_t)(g * 128 + 32 * ct + r32) * 128 + 8 * hi);
#pragma unroll
        for (int ks = 0; ks < 8; ++ks) {
            bf16x8 bcur[4];
#pragma unroll
            for (int ct = 0; ct < 4; ++ct) bcur[ct] = bnx[ct];
            if (ks < 7) {
#pragma unroll
                for (int ct = 0; ct < 4; ++ct) bnx[ct] = *(const bf16x8*)(WPT + (size_t)(g * 128 + 32 * ct + r32) * 128 + 16 * (ks + 1) + 8 * hi); }
            const LAS bf16* col = us + (tok + 15) * MX_PITCH + g * 128 + 16 * ks + 8 * hi;
            float sm[8];
#pragma unroll
            for (int e = 0; e < 8; ++e) sm[e] = 0.f;
            for (int j = 0; j < win; ++j) { const v4u u = *(const LAS v4u*)(col - j * MX_PITCH);
                sm[0] += bflo(u.x); sm[1] += bfhi(u.x); sm[2] += bflo(u.y); sm[3] += bfhi(u.y); sm[4] += bflo(u.z); sm[5] += bfhi(u.z); sm[6] += bflo(u.w); sm[7] += bfhi(u.w); }
            const v4u c = *(const LAS v4u*)col;
            v4u pa; pa.x = pk2(sm[0] * inv - bflo(c.x), sm[1] * inv - bfhi(c.x)); pa.y = pk2(sm[2] * inv - bflo(c.y), sm[3] * inv - bfhi(c.y));
            pa.z = pk2(sm[4] * inv - bflo(c.z), sm[5] * inv - bfhi(c.z)); pa.w = pk2(sm[6] * inv - bflo(c.w), sm[7] * inv - bfhi(c.w));
            const bf16x8 af = __builtin_bit_cast(bf16x8, pa);
#pragma unroll
            for (int ct = 0; ct < 4; ++ct) acc[ct] = __builtin_amdgcn_mfma_f32_32x32x16_bf16(af, bcur[ct], acc[ct], 0, 0, 0);
        }
#pragma unroll
        for (int ct = 0; ct < 4; ++ct) { const int n = g * 128 + 32 * ct + r32; const float bb = pb[n], sc = ps[n];
#pragma unroll
            for (int r = 0; r < 16; ++r) { const int row = tt * 32 + (r & 3) + 8 * (r >> 2) + 4 * hi;
                CAT[(size_t)(t0 + row) * D + 512 + n] = (bf16)(pk2((acc[ct][r] + bb) * sc, 0.f) & 0xffffu); } }
    }
}

namespace sba {
typedef short bf16x8 __attribute__((ext_vector_type(8)));
typedef short s16x4 __attribute__((ext_vector_type(4)));
typedef short v4i16_t __attribute__((ext_vector_type(4)));
typedef _Float16 h8 __attribute__((ext_vector_type(8)));
typedef _Float16 h2 __attribute__((ext_vector_type(2)));
typedef float f2 __attribute__((ext_vector_type(2)));
typedef float f32x16 __attribute__((ext_vector_type(16)));
typedef unsigned u32x4 __attribute__((ext_vector_type(4)));
typedef __bf16 bf16x2_t __attribute__((ext_vector_type(2)));
constexpr int KVB = 64, SLOTB = 8192;
constexpr float THR = 56.f;
__device__ __forceinline__ void glds16(const void* gsrc, unsigned lds_dst) { unsigned keep;
    asm volatile("s_mov_b32 %0, m0\n\ts_mov_b32 m0, %2\n\ts_nop 0\n\tglobal_load_lds_dwordx4 %1, off\n\ts_mov_b32 m0, %0" : "=&s"(keep) : "v"(gsrc), "s"(lds_dst) : "memory"); }
__device__ __forceinline__ unsigned cvtpk_bf(float lo, float hi) { f2 v = {lo, hi}; bf16x2_t b = __builtin_convertvector(v, bf16x2_t); return __builtin_bit_cast(unsigned, b); }
__device__ __forceinline__ unsigned cvtpk_h(float lo, float hi) { f2 v = {lo, hi}; h2 b = __builtin_convertvector(v, h2); return __builtin_bit_cast(unsigned, b); }
__device__ __forceinline__ float min30(float a) { float r; asm("v_min_f32_e32 %0, 0x41f00000, %1" : "=v"(r) : "v"(a)); return r; }
__device__ __forceinline__ float maxf_(float a, float b) { float r; asm("v_max_f32_e32 %0, %1, %2" : "=v"(r) : "v"(a), "v"(b)); return r; }
typedef __attribute__((address_space(3))) const char* lds_cptr;
__device__ __forceinline__ s16x4 vtr(lds_cptr p) { return __builtin_bit_cast(s16x4, __builtin_amdgcn_ds_read_tr16_b64_v4i16((__attribute__((address_space(3))) v4i16_t*)p)); }
#define SBA_H(x) __builtin_bit_cast(h8, x)
#define SBA_P(x) __builtin_bit_cast(bf16x8, x)

template <bool DIAG> __device__ __forceinline__ void tile(f32x16& p0, f32x16& p1, f32x16& o0, f32x16& o1, float& C, const h8& T0, const h8& T1, const h8& ONES, int kvb, int hi, lds_cptr vp) {
    asm volatile("s_nop 7\n\ts_nop 7\n\ts_nop 3" : "+v"(p0), "+v"(p1));
    const float z0 = p0[0];
    u32x4 lf0, lf1, lf2, lf3;
    {
        float l[16];
#pragma unroll
        for (int r = 0; r < 16; ++r) { const float z = p0[r]; float v = maxf_(__builtin_amdgcn_logf(1.f + __builtin_amdgcn_exp2f(min30(z))), z);
            if (DIAG) { if (kvb + (r & 3) + 8 * (r >> 2) >= 0) v = 0.f; } l[r] = v; }
        lf0 = (u32x4){cvtpk_h(l[0], l[1]), cvtpk_h(l[2], l[3]), cvtpk_h(l[4], l[5]), cvtpk_h(l[6], l[7])};
        lf1 = (u32x4){cvtpk_h(l[8], l[9]), cvtpk_h(l[10], l[11]), cvtpk_h(l[12], l[13]), cvtpk_h(l[14], l[15])};
#pragma unroll
        for (int r = 0; r < 16; ++r) { const float z = p1[r]; float v = maxf_(__builtin_amdgcn_logf(1.f + __builtin_amdgcn_exp2f(min30(z))), z);
            if (DIAG) { if (kvb + 32 + (r & 3) + 8 * (r >> 2) >= 0) v = 0.f; } l[r] = v; }
        if (!DIAG) l[15] += hi ? C : 0.f;
        lf2 = (u32x4){cvtpk_h(l[0], l[1]), cvtpk_h(l[2], l[3]), cvtpk_h(l[4], l[5]), cvtpk_h(l[6], l[7])};
        lf3 = (u32x4){cvtpk_h(l[8], l[9]), cvtpk_h(l[10], l[11]), cvtpk_h(l[12], l[13]), cvtpk_h(l[14], l[15])};
    }
    p0 = __builtin_amdgcn_mfma_f32_32x32x16_f16(T0, SBA_H(lf0), p0, 0, 0, 0);
    p0 = __builtin_amdgcn_mfma_f32_32x32x16_f16(T1, SBA_H(lf1), p0, 0, 0, 0);
    p0 = __builtin_amdgcn_mfma_f32_32x32x16_f16(ONES, SBA_H(lf2), p0, 0, 0, 0);
    p0 = __builtin_amdgcn_mfma_f32_32x32x16_f16(ONES, SBA_H(lf3), p0, 0, 0, 0);
    p1 = __builtin_amdgcn_mfma_f32_32x32x16_f16(T0, SBA_H(lf2), p1, 0, 0, 0);
    p1 = __builtin_amdgcn_mfma_f32_32x32x16_f16(T1, SBA_H(lf3), p1, 0, 0, 0);
    float cn = z0 - p0[0];
    { auto rr = __builtin_amdgcn_permlane32_swap(__float_as_uint(cn), __float_as_uint(cn), false, false); cn = __uint_as_float(rr[0]); }
    C = cn;
    u32x4 pw0, pw1, pw2, pw3;
    {
        float a[16];
#pragma unroll
        for (int r = 0; r < 16; ++r) { float v = __builtin_amdgcn_exp2f(p0[r]); if (DIAG) { if (kvb + (r & 3) + 8 * (r >> 2) >= 0) v = 0.f; } a[r] = v; }
        pw0 = (u32x4){cvtpk_bf(a[0], a[1]), cvtpk_bf(a[2], a[3]), cvtpk_bf(a[4], a[5]), cvtpk_bf(a[6], a[7])};
        pw1 = (u32x4){cvtpk_bf(a[8], a[9]), cvtpk_bf(a[10], a[11]), cvtpk_bf(a[12], a[13]), cvtpk_bf(a[14], a[15])};
#pragma unroll
        for (int r = 0; r < 16; ++r) { float v = __builtin_amdgcn_exp2f(p1[r]); if (DIAG) { if (kvb + 32 + (r & 3) + 8 * (r >> 2) >= 0) v = 0.f; } a[r] = v; }
        pw2 = (u32x4){cvtpk_bf(a[0], a[1]), cvtpk_bf(a[2], a[3]), cvtpk_bf(a[4], a[5]), cvtpk_bf(a[6], a[7])};
        pw3 = (u32x4){cvtpk_bf(a[8], a[9]), cvtpk_bf(a[10], a[11]), cvtpk_bf(a[12], a[13]), cvtpk_bf(a[14], a[15])};
    }
#define SBA_VFR(i) ({ const s16x4 lo_ = vtr(vp + (((i) >> 2) * 4096 + ((i) & 3) * 1024)); const s16x4 hi_ = vtr(vp + (((i) >> 2) * 4096 + ((i) & 3) * 1024 + 512)); (bf16x8){lo_[0], lo_[1], lo_[2], lo_[3], hi_[0], hi_[1], hi_[2], hi_[3]}; })
    o0 = __builtin_amdgcn_mfma_f32_32x32x16_bf16(SBA_P(pw0), SBA_VFR(0), o0, 0, 0, 0);
    o1 = __builtin_amdgcn_mfma_f32_32x32x16_bf16(SBA_P(pw0), SBA_VFR(4), o1, 0, 0, 0);
    o0 = __builtin_amdgcn_mfma_f32_32x32x16_bf16(SBA_P(pw1), SBA_VFR(1), o0, 0, 0, 0);
    o1 = __builtin_amdgcn_mfma_f32_32x32x16_bf16(SBA_P(pw1), SBA_VFR(5), o1, 0, 0, 0);
    o0 = __builtin_amdgcn_mfma_f32_32x32x16_bf16(SBA_P(pw2), SBA_VFR(2), o0, 0, 0, 0);
    o1 = __builtin_amdgcn_mfma_f32_32x32x16_bf16(SBA_P(pw2), SBA_VFR(6), o1, 0, 0, 0);
    o0 = __builtin_amdgcn_mfma_f32_32x32x16_bf16(SBA_P(pw3), SBA_VFR(3), o0, 0, 0, 0);
    o1 = __builtin_amdgcn_mfma_f32_32x32x16_bf16(SBA_P(pw3), SBA_VFR(7), o1, 0, 0, 0);
#undef SBA_VFR
}

__device__ __forceinline__ void wave_unit(int b, int h, int qi, const bf16* QKVY, bf16* CAT, char* shm_wave, int lane) {
    const int r32 = lane & 31, hi = lane >> 5;
    const long rowbase = (long)b * S; const int r0 = qi * 32;
    const bf16* Qw = QKVY + (rowbase + r0) * QW + 512 + h * 64;
    const bf16* Kl = QKVY + (rowbase + r32) * QW + 1024 + h * 64 + 8 * hi;
    const bf16* Vl = QKVY + (rowbase + (lane >> 2)) * QW + 1536 + h * 64 + (lane & 3) * 8;
    const unsigned lds0 = (unsigned)(uintptr_t)shm_wave;
    const lds_cptr vp0 = (lds_cptr)shm_wave + ((lane >> 4) & 1) * 32 + (lane & 3) * 8 + (4 * hi + ((lane & 15) >> 2)) * 64;
#define SBA_LOAD_V(t) do { _Pragma("unroll") for (int p_ = 0; p_ < 8; ++p_) vreg[p_] = *reinterpret_cast<const u32x4*>(Vl + ((long)(t) * KVB + 16 * (p_ & 3)) * QW + (p_ >> 2) * 32); } while (0)
#define SBA_STORE_V(slot) do { _Pragma("unroll") for (int p_ = 0; p_ < 8; ++p_) *(__attribute__((address_space(3))) u32x4*)((lds_cptr)shm_wave + (slot) * SLOTB + p_ * 1024 + lane * 16) = vreg[p_]; } while (0)
#define SBA_LOAD_K(t) do { _Pragma("unroll") for (int d0_ = 0; d0_ < 4; ++d0_) { kf[2 * d0_] = *reinterpret_cast<const bf16x8*>(Kl + (long)(t) * KVB * QW + 16 * d0_); kf[2 * d0_ + 1] = *reinterpret_cast<const bf16x8*>(Kl + ((long)(t) * KVB + 32) * QW + 16 * d0_); } } while (0)
    const int td = (r0 + 31) >> 6;
    bf16x8 kf[8], qr[4]; u32x4 vreg[8];
    SBA_LOAD_V(td); SBA_STORE_V(0);
    SBA_LOAD_K(td);
#pragma unroll
    for (int d0 = 0; d0 < 4; ++d0) qr[d0] = *reinterpret_cast<const bf16x8*>(&Qw[(long)r32 * QW + d0 * 16 + hi * 8]);
    h8 T0, T1, ONES;
#pragma unroll
    for (int jj = 0; jj < 8; ++jj) { const int kap = 8 * (jj >> 2) + 4 * hi + (jj & 3); T0[jj] = (kap >= r32) ? (_Float16)-1.0f : (_Float16)0.0f; T1[jj] = (16 + kap >= r32) ? (_Float16)-1.0f : (_Float16)0.0f; ONES[jj] = (_Float16)-1.0f; }
    f32x16 o0 = {}, o1 = {};
    float C = 0.f;
    for (int it = 0;; ++it) {
        const int t = td - it, slot = it & 1;
        f32x16 p0 = {}, p1 = {};
#pragma unroll
        for (int d0 = 0; d0 < 4; ++d0) { p0 = __builtin_amdgcn_mfma_f32_32x32x16_bf16(kf[2 * d0], qr[d0], p0, 0, 0, 0); p1 = __builtin_amdgcn_mfma_f32_32x32x16_bf16(kf[2 * d0 + 1], qr[d0], p1, 0, 0, 0); }
        if (t > 0) { SBA_LOAD_K(t - 1); SBA_LOAD_V(t - 1); }
        const lds_cptr vp = vp0 + slot * SLOTB;
        if (it == 0) tile<true>(p0, p1, o0, o1, C, T0, T1, ONES, KVB * t + 4 * hi - (r0 + r32), hi, vp);
        else tile<false>(p0, p1, o0, o1, C, T0, T1, ONES, 0, hi, vp);
        if (t == 0 || __all(C >= THR)) break;
        SBA_STORE_V(slot ^ 1);
    }
    bf16* Ow = CAT + (rowbase + r0) * D + 512 + h * 64;
#pragma unroll
    for (int r = 0; r < 16; ++r) { const int orow = (r & 3) + 8 * (r >> 2) + 4 * hi;
        Ow[(long)orow * D + r32] = (bf16)(cvtpk_bf(o0[r], 0.f) & 0xffffu); Ow[(long)orow * D + 32 + r32] = (bf16)(cvtpk_bf(o1[r], 0.f) & 0xffffu); }
#undef SBA_LOAD_V
#undef SBA_STORE_V
#undef SBA_LOAD_K
}
#undef SBA_H
#undef SBA_P
__device__ __forceinline__ void phase(const bf16* QKVY, bf16* CAT, char* lds, int vcu, int G, int wid, int lane) {
    for (int wu = vcu * 8 + wid; wu < NB * 8 * (S / 32); wu += G * 8) {
        const int bh = wu >> 7, qi = (wu & 127) ^ ((bh >> 4) & 1);
        wave_unit(bh >> 3, bh & 7, qi, QKVY, CAT, lds + wid * 2 * SLOTB, lane);
    }
}
}


namespace gla {
typedef short bf16x8 __attribute__((ext_vector_type(8)));
typedef short s16x4 __attribute__((ext_vector_type(4)));
typedef short v4i16_t __attribute__((ext_vector_type(4)));
typedef float f32x16 __attribute__((ext_vector_type(16)));
typedef __attribute__((address_space(3))) const char* lds_cptr;
constexpr int NCH = NB * 4 * 64;
constexpr int L_VP = 0, L_KP = 16384, L_TOT = 24576, L_DL = 26624, L_PS = 16384, QSTR = 27136;
__device__ __forceinline__ void glds16(const void* gsrc, unsigned lds_dst) { unsigned keep;
    asm volatile("s_mov_b32 %0, m0\n\ts_mov_b32 m0, %2\n\ts_nop 0\n\tglobal_load_lds_dwordx4 %1, off\n\ts_mov_b32 m0, %0" : "=&s"(keep) : "v"(gsrc), "s"(lds_dst) : "memory"); }
__device__ __forceinline__ s16x4 vtr(lds_cptr p) { return __builtin_bit_cast(s16x4, __builtin_amdgcn_ds_read_tr16_b64_v4i16((__attribute__((address_space(3))) v4i16_t*)p)); }
#define GLA_WAIT_BAR() asm volatile("s_waitcnt vmcnt(0) lgkmcnt(0)\n\ts_barrier" ::: "memory")
__device__ __forceinline__ void dma_v(const bf16* QKVY, long t0, int h, unsigned lds0, int wid, int lane) {
#pragma unroll
    for (int i = 0; i < 2; ++i) { const int p = wid * 2 + i, ctile = p >> 2, tg = p & 3;
        glds16(QKVY + (t0 + 16 * tg + (lane >> 2)) * QW + 512 + h * 128 + 32 * ctile + (lane & 3) * 8, (unsigned)__builtin_amdgcn_readfirstlane(lds0 + L_VP + p * 1024)); }
}
__device__ __forceinline__ bf16x8 trfrag(lds_cptr base, int piece, int lane) {
    const int hi = lane >> 5; const lds_cptr p = base + piece * 1024 + ((lane >> 4) & 1) * 32 + (lane & 3) * 8 + (4 * hi + ((lane & 15) >> 2)) * 64;
    const s16x4 lo = vtr(p), hh = vtr(p + 512); return (bf16x8){lo[0], lo[1], lo[2], lo[3], hh[0], hh[1], hh[2], hh[3]};
}
__device__ __forceinline__ void pass_a(KA args, const bf16* QKVY, const float* ALOW, bf16* QIN, bf16* KIN, float* KVT, float* DEC, char* shm, int vcu, int G, int wid, int lane) {
    const unsigned lds0 = (unsigned)(uintptr_t)shm; const lds_cptr shm3 = (lds_cptr)shm;
    const float* gw = INP(14); const float* gb = INP(15);
    for (int base = 4 * vcu; base < NCH; base += 4 * G) {
        const int bh = base >> 6, b = bh >> 2, h = bh & 3;
        float gwv[16];
#pragma unroll
        for (int r = 0; r < 16; ++r) gwv[r] = gw[r * 256 + h * 64 + lane];
        const float gbv = gb[h * 64 + lane];
        float bl[4][8], qv[4][8], kv[4][8];
#pragma unroll
        for (int q = 0; q < 4; ++q) { const long t0 = (long)b * S + ((base + q) & 63) * 64;
            dma_v(QKVY, t0, h, lds0 + q * QSTR, wid, lane);
#pragma unroll
            for (int tt = 0; tt < 8; ++tt) { const long t = t0 + 8 * wid + tt; const f32x4* al = (const f32x4*)(ALOW + t * 16); float x = gbv;
#pragma unroll
                for (int r4 = 0; r4 < 4; ++r4) { const f32x4 a4 = al[r4]; x += a4.x * gwv[4 * r4] + a4.y * gwv[4 * r4 + 1] + a4.z * gwv[4 * r4 + 2] + a4.w * gwv[4 * r4 + 3]; }
                const float la = -softplusf_(-x) * (1.f / 16.f);
                bl[q][tt] = (tt ? bl[q][tt - 1] : 0.f) + la;
                qv[q][tt] = bf2f(QKVY[t * QW + h * 64 + lane]); kv[q][tt] = bf2f(QKVY[t * QW + 256 + h * 64 + lane]); }
            ((__attribute__((address_space(3))) float*)(shm3 + q * QSTR + L_TOT))[wid * 64 + lane] = bl[q][7]; }
        asm volatile("s_waitcnt lgkmcnt(0)\n\ts_barrier" ::: "memory");
#pragma unroll
        for (int q = 0; q < 4; ++q) { const int ch = base + q; const long t0 = (long)b * S + (ch & 63) * 64;
            __attribute__((address_space(3))) float* tot = (__attribute__((address_space(3))) float*)(shm3 + q * QSTR + L_TOT);
            __attribute__((address_space(3))) bf16* kp = (__attribute__((address_space(3))) bf16*)(shm3 + q * QSTR + L_KP);
            float off = 0.f, blast = 0.f;
#pragma unroll
            for (int w = 0; w < 8; ++w) { const float v = tot[w * 64 + lane]; if (w < wid) off += v; blast += v; }
#pragma unroll
            for (int tt = 0; tt < 8; ++tt) { const long t = t0 + 8 * wid + tt; const float bb = bl[q][tt] + off; const int tk = 8 * wid + tt;
                const float qi = qv[q][tt] * __expf(bb), ki = kv[q][tt] * __expf(-bb);
                QIN[t * 256 + h * 64 + lane] = (bf16)f2bf(qi); const bf16 kb = (bf16)f2bf(ki); KIN[t * 256 + h * 64 + lane] = kb;
                kp[((lane >> 5) * 4 + (tk >> 4)) * 512 + (tk & 15) * 32 + (lane & 31)] = kb; }
            if (wid == 0) { const float dd = __expf(blast); ((__attribute__((address_space(3))) float*)(shm3 + q * QSTR + L_DL))[lane] = dd; DEC[ch * 64 + lane] = dd; } }
        GLA_WAIT_BAR();
        const int dvt = wid & 3, dt = wid >> 2;
#pragma unroll
        for (int q = 0; q < 4; ++q) { const int ch = base + q;
            f32x16 acc = {};
#pragma unroll
            for (int ks = 0; ks < 4; ++ks) acc = __builtin_amdgcn_mfma_f32_32x32x16_bf16(trfrag(shm3 + q * QSTR + L_VP, dvt * 4 + ks, lane), trfrag(shm3 + q * QSTR + L_KP, dt * 4 + ks, lane), acc, 0, 0, 0);
            const int dcol = 32 * dt + (lane & 31); const float dsc = ((__attribute__((address_space(3))) float*)(shm3 + q * QSTR + L_DL))[dcol];
            float* kvo = KVT + ((size_t)ch * 128 + 32 * dvt) * 64 + dcol;
#pragma unroll
            for (int r = 0; r < 16; ++r) kvo[(size_t)((r & 3) + 8 * (r >> 2) + 4 * (lane >> 5)) * 64] = acc[r] * dsc; }
        GLA_WAIT_BAR();
    }
}
__device__ __forceinline__ void pass_b(const bf16* KVT, const float* DEC, bf16* SINT, int vcu, int G, int tid) {
    if (tid >= 128) return;
    for (int e4 = vcu * 128 + tid; e4 < NB * 4 * 128 * 64 / 4; e4 += G * 128) {
        const int e = 4 * e4, bh = e >> 13, rem = e & 8191, d = e & 63;
        f32x4 st = {0.f, 0.f, 0.f, 0.f};
        for (int n0 = 0; n0 < 64; n0 += 8) {
            v2u kvr[8]; f32x4 dc[8];
#pragma unroll
            for (int i = 0; i < 8; ++i) { const size_t ch = (size_t)bh * 64 + n0 + i; kvr[i] = *(const v2u*)(KVT + ch * 8192 + rem); dc[i] = *(const f32x4*)(DEC + ch * 64 + d); }
#pragma unroll
            for (int i = 0; i < 8; ++i) { const size_t ch = (size_t)bh * 64 + n0 + i;
                v2u o; o.x = pk2(st.x, st.y); o.y = pk2(st.z, st.w); *(v2u*)(SINT + ch * 8192 + rem) = o;
                const f32x4 kv = {bflo(kvr[i].x), bfhi(kvr[i].x), bflo(kvr[i].y), bfhi(kvr[i].y)}; st = dc[i] * st + kv; }
        }
    }
}
__device__ __forceinline__ void pass_c(KA args, const bf16* QKVY, const bf16* QIN, const bf16* KIN, const bf16* SINT, bf16* CAT, char* shm, int vcu, int G, int wid, int lane) {
    const unsigned lds0 = (unsigned)(uintptr_t)shm; const lds_cptr shm3 = (lds_cptr)shm;
    const int r32 = lane & 31, hi = lane >> 5, it = wid >> 2, ct = wid & 3;
    const float* gng = INP(16);
    for (int base = 4 * vcu; base < NCH; base += 4 * G) {
        const int bh = base >> 6, b = bh >> 2, h = bh & 3;
        f32x16 o[4]; unsigned pw[4][2][8];
#pragma unroll
        for (int q = 0; q < 4; ++q) { const int ch = base + q; const long t0 = (long)b * S + (ch & 63) * 64;
            dma_v(QKVY, t0, h, lds0 + q * QSTR, wid, lane);
            bf16x8 qf[4];
#pragma unroll
            for (int d0 = 0; d0 < 4; ++d0) qf[d0] = *(const bf16x8*)(QIN + (t0 + 32 * it + r32) * 256 + h * 64 + 16 * d0 + 8 * hi);
            f32x16 oo = {};
#pragma unroll
            for (int ks = 0; ks < 4; ++ks) { const bf16x8 sf = *(const bf16x8*)(SINT + ((size_t)ch * 128 + 32 * ct + r32) * 64 + 16 * ks + 8 * hi);
                oo = __builtin_amdgcn_mfma_f32_32x32x16_bf16(qf[ks], sf, oo, 0, 0, 0); }
            o[q] = oo;
            f32x16 pt0 = {}, pt1 = {};
#pragma unroll
            for (int d0 = 0; d0 < 4; ++d0) { const bf16x8 kf = *(const bf16x8*)(KIN + (t0 + r32) * 256 + h * 64 + 16 * d0 + 8 * hi);
                pt0 = __builtin_amdgcn_mfma_f32_32x32x16_bf16(kf, qf[d0], pt0, 0, 0, 0); }
            if (it == 1) {
#pragma unroll
                for (int d0 = 0; d0 < 4; ++d0) { const bf16x8 kf = *(const bf16x8*)(KIN + (t0 + 32 + r32) * 256 + h * 64 + 16 * d0 + 8 * hi);
                    pt1 = __builtin_amdgcn_mfma_f32_32x32x16_bf16(kf, qf[d0], pt1, 0, 0, 0); }
            }
#pragma unroll
            for (int r = 0; r < 16; r += 2) { const int j0 = (r & 3) + 8 * (r >> 2) + 4 * hi;
                float a0 = pt0[r], a1 = pt0[r + 1], c0 = pt1[r], c1 = pt1[r + 1];
                if (it == 0) { if (j0 > r32) a0 = 0.f; if (j0 + 1 > r32) a1 = 0.f; } else { if (j0 > r32) c0 = 0.f; if (j0 + 1 > r32) c1 = 0.f; }
                pw[q][0][r >> 1] = pk2(a0, a1); pw[q][1][r >> 1] = pk2(c0, c1); } }
        GLA_WAIT_BAR();
#pragma unroll
        for (int q = 0; q < 4; ++q) { f32x16 oo = o[q];
#pragma unroll
            for (int ks2 = 0; ks2 < 2; ++ks2) { const v4u a = {pw[q][0][4 * ks2], pw[q][0][4 * ks2 + 1], pw[q][0][4 * ks2 + 2], pw[q][0][4 * ks2 + 3]};
                oo = __builtin_amdgcn_mfma_f32_32x32x16_bf16(__builtin_bit_cast(bf16x8, a), trfrag(shm3 + q * QSTR + L_VP, ct * 4 + ks2, lane), oo, 0, 0, 0); }
            if (it == 1) {
#pragma unroll
                for (int ks2 = 0; ks2 < 2; ++ks2) { const v4u a = {pw[q][1][4 * ks2], pw[q][1][4 * ks2 + 1], pw[q][1][4 * ks2 + 2], pw[q][1][4 * ks2 + 3]};
                    oo = __builtin_amdgcn_mfma_f32_32x32x16_bf16(__builtin_bit_cast(bf16x8, a), trfrag(shm3 + q * QSTR + L_VP, ct * 4 + 2 + ks2, lane), oo, 0, 0, 0); }
            }
            o[q] = oo;
            __attribute__((address_space(3))) float* ps = (__attribute__((address_space(3))) float*)(shm3 + q * QSTR + L_PS);
#pragma unroll
            for (int r = 0; r < 16; ++r) { float v = xor16_add(row_sum16(oo[r] * oo[r]));
                if ((lane & 31) == 0) ps[(32 * it + (r & 3) + 8 * (r >> 2) + 4 * hi) * 4 + ct] = v; } }
        asm volatile("s_waitcnt lgkmcnt(0)\n\ts_barrier" ::: "memory");
        const float gv = gng[h * 128 + 32 * ct + r32];
#pragma unroll
        for (int q = 0; q < 4; ++q) { const int ch = base + q; const long t0 = (long)b * S + (ch & 63) * 64;
            const __attribute__((address_space(3))) float* ps = (const __attribute__((address_space(3))) float*)(shm3 + q * QSTR + L_PS);
#pragma unroll
            for (int r = 0; r < 16; ++r) { const int row = 32 * it + (r & 3) + 8 * (r >> 2) + 4 * hi; const long t = t0 + row;
                const f32x4 p4 = *(const __attribute__((address_space(3))) f32x4*)(ps + row * 4);
                const float rr = rsqrtf(((p4.x + p4.y) + (p4.z + p4.w)) * (1.f / 128.f) + 1e-6f);
                const float rg = bf2f(QKVY[t * QW + 1024 + h * 128 + 32 * ct + r32]);
                CAT[t * D + h * 128 + 32 * ct + r32] = (bf16)f2bf(o[q][r] * rr * gv * siluf_(rg)); } }
        asm volatile("s_waitcnt lgkmcnt(0)\n\ts_barrier" ::: "memory");
    }
}
typedef unsigned u32x4 __attribute__((ext_vector_type(4)));
constexpr int W_VP = 0, W_KP = 16384, W_AL = 24576, W_DL = 28672, WSTR = 29696;
__device__ __forceinline__ void stage_v_wave(const bf16* QKVY, long t0, int h, lds_cptr blk, int lane) {
#pragma unroll
    for (int half = 0; half < 2; ++half) { u32x4 r[8];
#pragma unroll
        for (int i = 0; i < 8; ++i) { const int p = half * 8 + i; r[i] = *(const u32x4*)(QKVY + (t0 + 16 * (p & 3) + (lane >> 2)) * QW + 512 + h * 128 + 32 * (p >> 2) + (lane & 3) * 8); }
#pragma unroll
        for (int i = 0; i < 8; ++i) { const int p = half * 8 + i; *(__attribute__((address_space(3))) u32x4*)(blk + W_VP + p * 1024 + lane * 16) = r[i]; } }
}
__device__ __forceinline__ void pass_a_w(KA args, const bf16* QKVY, const float* ALOW, bf16* QIN, bf16* KIN, bf16* KVT, float* DEC, char* shm, int vcu, int G, int wid, int lane) {
    const int role = wid >> 2;
    const lds_cptr blk = (lds_cptr)shm + (wid & 3) * WSTR;
    __attribute__((address_space(3))) float* al = (__attribute__((address_space(3))) float*)(blk + W_AL);
    __attribute__((address_space(3))) float* dl = (__attribute__((address_space(3))) float*)(blk + W_DL);
    __attribute__((address_space(3))) float* totA = dl + 64;
    volatile __attribute__((address_space(3))) unsigned* flg = (volatile __attribute__((address_space(3))) unsigned*)(dl + 128);
    __attribute__((address_space(3))) bf16* kp = (__attribute__((address_space(3))) bf16*)(blk + W_KP);
    __attribute__((address_space(3))) float* blbuf = (__attribute__((address_space(3))) float*)(blk + W_VP + 8192 * role);
    const float* gw = INP(14); const float* gb = INP(15);
    if (lane < 8 && role == 0) flg[lane] = 0u;
    __syncthreads();
    unsigned epoch = 0;
    for (int ch = 4 * vcu + (wid & 3); ch < NCH; ch += 4 * G) {
        ++epoch;
        const int bh = ch >> 6, n = ch & 63, b = bh >> 2, h = bh & 3; const long t0 = (long)b * S + n * 64;
        const int tk0 = 32 * role;
        u32x4 vr[8];
#pragma unroll
        for (int i = 0; i < 8; ++i) { const int p = 8 * role + i; vr[i] = *(const u32x4*)(QKVY + (t0 + 16 * (p & 3) + (lane >> 2)) * QW + 512 + h * 128 + 32 * (p >> 2) + (lane & 3) * 8); }
#pragma unroll
        for (int j = 0; j < 2; ++j) *(__attribute__((address_space(3))) f32x4*)(al + tk0 * 16 + 4 * (lane + 64 * j)) = *(const f32x4*)(ALOW + (t0 + tk0) * 16 + 4 * (lane + 64 * j));
        float gwv[16];
#pragma unroll
        for (int r = 0; r < 16; ++r) gwv[r] = gw[r * 256 + h * 64 + lane];
        const float gbv = gb[h * 64 + lane];
        float qn[8], kn[8];
#pragma unroll
        for (int tt = 0; tt < 8; ++tt) { qn[tt] = bf2f(QKVY[(t0 + tk0 + tt) * QW + h * 64 + lane]); kn[tt] = bf2f(QKVY[(t0 + tk0 + tt) * QW + 256 + h * 64 + lane]); }
        asm volatile("s_waitcnt lgkmcnt(0)" ::: "memory");
        TS_RAW(17);
        float bcum = 0.f;
        for (int tt = 0; tt < 32; ++tt) { float x = gbv;
#pragma unroll
            for (int r4 = 0; r4 < 4; ++r4) { const f32x4 a4 = *(const __attribute__((address_space(3))) f32x4*)(al + (tk0 + tt) * 16 + 4 * r4); x += a4.x * gwv[4 * r4] + a4.y * gwv[4 * r4 + 1] + a4.z * gwv[4 * r4 + 2] + a4.w * gwv[4 * r4 + 3]; }
            bcum += -softplusf_(-x) * (1.f / 16.f); blbuf[tt * 64 + lane] = bcum; }
        float off = 0.f;
        if (role == 0) { totA[lane] = bcum; asm volatile("s_waitcnt lgkmcnt(0)" ::: "memory"); if (lane == 0) flg[0] = epoch; }
        else { while (flg[0] != epoch) __builtin_amdgcn_s_sleep(1); asm volatile("" ::: "memory"); off = totA[lane]; }
        for (int t8 = 0; t8 < 32; t8 += 8) {
            float qv[8], kv[8];
#pragma unroll
            for (int tt = 0; tt < 8; ++tt) { qv[tt] = qn[tt]; kv[tt] = kn[tt]; }
            if (t8 < 24) {
#pragma unroll
                for (int tt = 0; tt < 8; ++tt) { qn[tt] = bf2f(QKVY[(t0 + tk0 + t8 + 8 + tt) * QW + h * 64 + lane]); kn[tt] = bf2f(QKVY[(t0 + tk0 + t8 + 8 + tt) * QW + 256 + h * 64 + lane]); } }
#pragma unroll
            for (int tt = 0; tt < 8; ++tt) { const int tk = tk0 + t8 + tt; const long t = t0 + tk;
                const float bb = blbuf[(t8 + tt) * 64 + lane] + off;
                const float qi = qv[tt] * __expf(bb), ki = kv[tt] * __expf(-bb);
                QIN[t * 256 + h * 64 + lane] = (bf16)f2bf(qi); const bf16 kb = (bf16)f2bf(ki); KIN[t * 256 + h * 64 + lane] = kb;
                kp[((lane >> 5) * 4 + (tk >> 4)) * 512 + (tk & 15) * 32 + (lane & 31)] = kb; }
        }
        if (role == 1) { const float dd = __expf(bcum + off); dl[lane] = dd; DEC[ch * 64 + lane] = dd; }
        asm volatile("s_waitcnt lgkmcnt(0)" ::: "memory");
#pragma unroll
        for (int i = 0; i < 8; ++i) *(__attribute__((address_space(3))) u32x4*)(blk + W_VP + (8 * role + i) * 1024 + lane * 16) = vr[i];
        asm volatile("s_waitcnt lgkmcnt(0)" ::: "memory");
        TS_RAW(18);
        if (lane == 0) flg[1 + role] = epoch;
        while (flg[2 - role] != epoch) __builtin_amdgcn_s_sleep(1);
        asm volatile("" ::: "memory");
        { bf16x8 kf[2][4];
#pragma unroll
          for (int dt = 0; dt < 2; ++dt)
#pragma unroll
              for (int ks = 0; ks < 4; ++ks) kf[dt][ks] = trfrag(blk + W_KP, dt * 4 + ks, lane);
          const float dsc = dl[lane];
#pragma unroll
          for (int dv2 = 0; dv2 < 2; ++dv2) { const int dvt = 2 * role + dv2; f32x16 acc0 = {}, acc1 = {};
#pragma unroll
              for (int ks = 0; ks < 4; ++ks) { const bf16x8 vf = trfrag(blk + W_VP, dvt * 4 + ks, lane);
                  acc0 = __builtin_amdgcn_mfma_f32_32x32x16_bf16(vf, kf[0][ks], acc0, 0, 0, 0); acc1 = __builtin_amdgcn_mfma_f32_32x32x16_bf16(vf, kf[1][ks], acc1, 0, 0, 0); }
              bf16* kvo = KVT + ((size_t)ch * 128 + 32 * dvt) * 64 + lane;
#pragma unroll
              for (int r = 0; r < 16; ++r) { auto rr = __builtin_amdgcn_permlane32_swap(__float_as_uint(acc0[r]), __float_as_uint(acc1[r]), false, false);
                  const int row = (r & 3) + 8 * (r >> 2);
                  kvo[(size_t)row * 64] = (bf16)f2bf(__uint_as_float(rr[0]) * dsc); kvo[(size_t)(row + 4) * 64] = (bf16)f2bf(__uint_as_float(rr[1]) * dsc); } } }
        asm volatile("s_waitcnt lgkmcnt(0)" ::: "memory");
        TS_RAW(19);
        if (lane == 0) flg[3 + role] = epoch;
        while (flg[4 - role] != epoch) __builtin_amdgcn_s_sleep(1);
        asm volatile("" ::: "memory");
    }
}
__device__ __forceinline__ void pass_c_w(KA args, const bf16* QKVY, const bf16* QIN, const bf16* KIN, const bf16* SINT, bf16* CAT, char* shm, int vcu, int G, int wid, int lane) {
    const lds_cptr blk = (lds_cptr)shm + wid * 16384;
    const int r32 = lane & 31, hi = lane >> 5, it = wid >> 2;
    const float* gng = INP(16);
    for (int ch = 4 * vcu + (wid & 3); ch < NCH; ch += 4 * G) {
        const int bh = ch >> 6, n = ch & 63, b = bh >> 2, h = bh & 3; const long t0 = (long)b * S + n * 64;
        stage_v_wave(QKVY, t0, h, blk, lane);
        bf16x8 qf[4];
#pragma unroll
        for (int d0 = 0; d0 < 4; ++d0) qf[d0] = *(const bf16x8*)(QIN + (t0 + 32 * it + r32) * 256 + h * 64 + 16 * d0 + 8 * hi);
        unsigned short rgv[4][16];
#pragma unroll
        for (int ct = 0; ct < 4; ++ct)
#pragma unroll
            for (int r = 0; r < 16; ++r) rgv[ct][r] = QKVY[(t0 + 32 * it + (r & 3) + 8 * (r >> 2) + 4 * hi) * QW + 1024 + h * 128 + 32 * ct + r32];
        f32x16 pt0 = {}, pt1 = {};
#pragma unroll
        for (int d0 = 0; d0 < 4; ++d0) { const bf16x8 kf = *(const bf16x8*)(KIN + (t0 + r32) * 256 + h * 64 + 16 * d0 + 8 * hi);
            pt0 = __builtin_amdgcn_mfma_f32_32x32x16_bf16(kf, qf[d0], pt0, 0, 0, 0); }
        if (it == 1) {
#pragma unroll
            for (int d0 = 0; d0 < 4; ++d0) { const bf16x8 kf = *(const bf16x8*)(KIN + (t0 + 32 + r32) * 256 + h * 64 + 16 * d0 + 8 * hi);
                pt1 = __builtin_amdgcn_mfma_f32_32x32x16_bf16(kf, qf[d0], pt1, 0, 0, 0); } }
        unsigned pw[2][8];
#pragma unroll
        for (int r = 0; r < 16; r += 2) { const int j0 = (r & 3) + 8 * (r >> 2) + 4 * hi;
            float a0 = pt0[r], a1 = pt0[r + 1], c0 = pt1[r], c1 = pt1[r + 1];
            if (it == 0) { if (j0 > r32) a0 = 0.f; if (j0 + 1 > r32) a1 = 0.f; } else { if (j0 > r32) c0 = 0.f; if (j0 + 1 > r32) c1 = 0.f; }
            pw[0][r >> 1] = pk2(a0, a1); pw[1][r >> 1] = pk2(c0, c1); }
        asm volatile("s_waitcnt lgkmcnt(0)" ::: "memory");
        f32x16 o[4]; float ss[16];
#pragma unroll
        for (int r = 0; r < 16; ++r) ss[r] = 0.f;
#pragma unroll
        for (int ct = 0; ct < 4; ++ct) { f32x16 oo = {};
#pragma unroll
            for (int ks = 0; ks < 4; ++ks) { const bf16x8 sf = *(const bf16x8*)(SINT + ((size_t)ch * 128 + 32 * ct + r32) * 64 + 16 * ks + 8 * hi);
                oo = __builtin_amdgcn_mfma_f32_32x32x16_bf16(qf[ks], sf, oo, 0, 0, 0); }
#pragma unroll
            for (int ks2 = 0; ks2 < 2; ++ks2) { const v4u a = {pw[0][4 * ks2], pw[0][4 * ks2 + 1], pw[0][4 * ks2 + 2], pw[0][4 * ks2 + 3]};
                oo = __builtin_amdgcn_mfma_f32_32x32x16_bf16(__builtin_bit_cast(bf16x8, a), trfrag(blk + W_VP, ct * 4 + ks2, lane), oo, 0, 0, 0); }
            if (it == 1) {
#pragma unroll
                for (int ks2 = 0; ks2 < 2; ++ks2) { const v4u a = {pw[1][4 * ks2], pw[1][4 * ks2 + 1], pw[1][4 * ks2 + 2], pw[1][4 * ks2 + 3]};
                    oo = __builtin_amdgcn_mfma_f32_32x32x16_bf16(__builtin_bit_cast(bf16x8, a), trfrag(blk + W_VP, ct * 4 + 2 + ks2, lane), oo, 0, 0, 0); } }
            o[ct] = oo;
#pragma unroll
            for (int r = 0; r < 16; ++r) ss[r] += oo[r] * oo[r]; }
#pragma unroll
        for (int r = 0; r < 16; ++r) ss[r] = rsqrtf(xor16_add(row_sum16(ss[r])) * (1.f / 128.f) + 1e-6f);
#pragma unroll
        for (int ct = 0; ct < 4; ++ct) { const float gv = gng[h * 128 + 32 * ct + r32];
#pragma unroll
            for (int r = 0; r < 16; ++r) { const long t = t0 + 32 * it + (r & 3) + 8 * (r >> 2) + 4 * hi;
                const float rg = bf2f(rgv[ct][r]);
                CAT[t * D + h * 128 + 32 * ct + r32] = (bf16)f2bf(o[ct][r] * ss[r] * gv * siluf_(rg)); } }
        asm volatile("s_waitcnt lgkmcnt(0)" ::: "memory");
    }
}
#undef GLA_WAIT_BAR
}

__device__ __forceinline__ void dot16x2(const f32x4 (&v0)[4], const f32x4 (&v1)[4], const LAS float* tabw, int lane, float (&c0)[4], float (&c1)[4]) {
    typedef float f2 __attribute__((ext_vector_type(2)));
    f2 a[8], b[8];
#pragma unroll
    for (int e = 0; e < 8; ++e) { a[e] = (f2){0.f, 0.f}; b[e] = (f2){0.f, 0.f}; }
    f32x4 wn[4];
    const LAS float* pb0 = tabw + lane * W16_PITCH;
    unsigned pb1u = (unsigned)(uintptr_t)(pb0 + 8 * 64 * W16_PITCH); asm volatile("" : "+v"(pb1u));
    const LAS float* pb1 = (const LAS float*)(uintptr_t)pb1u;
#pragma unroll
    for (int k = 0; k < 4; ++k) wn[k] = *(const LAS f32x4*)(pb0 + 4 * k);
#pragma unroll
    for (int jq = 0; jq < 16; ++jq) { const int j = jq >> 2, q = jq & 3;
        f32x4 w[4];
#pragma unroll
        for (int k = 0; k < 4; ++k) w[k] = wn[k];
        if (jq < 15) { const LAS float* p = (jq + 1 < 8) ? pb0 + (jq + 1) * 64 * W16_PITCH : pb1 + (jq + 1 - 8) * 64 * W16_PITCH;
#pragma unroll
            for (int k = 0; k < 4; ++k) wn[k] = *(const LAS f32x4*)(p + 4 * k); }
        const float h0 = v0[j][q], h1 = v1[j][q]; const f2 hh0 = {h0, h0}, hh1 = {h1, h1};
#pragma unroll
        for (int k = 0; k < 4; ++k) { const f2 wl = {w[k].x, w[k].y}, wh = {w[k].z, w[k].w};
            a[2 * k] = hh0 * wl + a[2 * k]; a[2 * k + 1] = hh0 * wh + a[2 * k + 1];
            b[2 * k] = hh1 * wl + b[2 * k]; b[2 * k + 1] = hh1 * wh + b[2 * k + 1]; } }
    float t8[8];
#pragma unroll
    for (int i = 0; i < 8; ++i) { const float lo = a[i >> 1][i & 1], hi = a[4 + (i >> 1)][i & 1]; auto rr = __builtin_amdgcn_permlane32_swap(__float_as_uint(lo), __float_as_uint(hi), false, false); t8[i] = __uint_as_float(rr[0]) + __uint_as_float(rr[1]); }
#pragma unroll
    for (int i = 0; i < 4; ++i) { auto rr = __builtin_amdgcn_permlane16_swap(__float_as_uint(t8[i]), __float_as_uint(t8[i + 4]), false, false); c0[i] = row_sum16(__uint_as_float(rr[0]) + __uint_as_float(rr[1])); }
#pragma unroll
    for (int i = 0; i < 8; ++i) { const float lo = b[i >> 1][i & 1], hi = b[4 + (i >> 1)][i & 1]; auto rr = __builtin_amdgcn_permlane32_swap(__float_as_uint(lo), __float_as_uint(hi), false, false); t8[i] = __uint_as_float(rr[0]) + __uint_as_float(rr[1]); }
#pragma unroll
    for (int i = 0; i < 4; ++i) { auto rr = __builtin_amdgcn_permlane16_swap(__float_as_uint(t8[i]), __float_as_uint(t8[i + 4]), false, false); c1[i] = row_sum16(__uint_as_float(rr[0]) + __uint_as_float(rr[1])); }
}
__device__ __forceinline__ void router_pass(KA args, Frame& F, int l, const bf16* X1, bf16* XN, int* eidx, float* ew, int* cntw, int* loc, unsigned* pcnt, unsigned pneed) {
    const float* mod = (const float*)(F.ws + WS_MOD) + (size_t)l * 4 * 6144;
    const float* rb = INP(21); const float* g = INP(5) + l * D;
    LAS float* tabw = (LAS float*)F.lds;
    LAS float* lg = (LAS float*)(F.lds + 1024 * W16_PITCH * 4);
    __syncthreads();
    TS_MARK(0);
    for (int chunk = F.vcu; chunk < T / 64; chunk += F.G) {
        if (F.wave == 0) { unsigned sp = 0;
            while ((unsigned)__builtin_amdgcn_readfirstlane(__hip_atomic_load(pcnt + 64 * (chunk >> 2), __ATOMIC_RELAXED, __HIP_MEMORY_SCOPE_AGENT)) < pneed) { __builtin_amdgcn_s_sleep(2); if (++sp > (1u << 20)) break; }
            __builtin_amdgcn_fence(__ATOMIC_ACQUIRE, "agent"); asm volatile("s_waitcnt vmcnt(0)" ::: "memory"); }
        __syncthreads();
        TS_MARK(1);
        const int tb = chunk * 64 + F.wave * 8, b = tb / S;
        f32x4 cA[4], cB[4];
        v2u rw[2][4];
#pragma unroll
        for (int q = 0; q < 2; ++q) { const v2u* xp = (const v2u*)(X1 + (size_t)(tb + q) * D) + F.lane;
#pragma unroll
            for (int j = 0; j < 4; ++j) rw[q][j] = xp[64 * j]; }
        load_colvec(cA, cB, F.lane, g, mod + b * 6144 + 4096, mod + b * 6144 + 3072);
#pragma unroll
        for (int i = 0; i < 4; ++i) { const int t = tb + 2 * i;
            f32x4 v0[4], v1[4];
#pragma unroll
            for (int j = 0; j < 4; ++j) { const v2u a = rw[0][j], c = rw[1][j]; v0[j] = (f32x4){bflo(a.x), bfhi(a.x), bflo(a.y), bfhi(a.y)}; v1[j] = (f32x4){bflo(c.x), bfhi(c.x), bflo(c.y), bfhi(c.y)}; }
            if (i < 3) {
#pragma unroll
                for (int q = 0; q < 2; ++q) { const v2u* xp = (const v2u*)(X1 + (size_t)(t + 2 + q) * D) + F.lane;
#pragma unroll
                    for (int j = 0; j < 4; ++j) rw[q][j] = xp[64 * j]; } }
            norm_row_pre<true>(v0, cA, cB); norm_row_pre<true>(v1, cA, cB);
            store_row_bf16(v0, F.lane, XN + (size_t)t * D); store_row_bf16(v1, F.lane, XN + (size_t)(t + 1) * D);
            float c0[4], c1[4];
            dot16x2(v0, v1, tabw, F.lane, c0, c1);
            if ((F.lane & 15) == 0) { const int r = F.lane >> 4, tl = F.wave * 8 + 2 * i;
                *(LAS f32x4*)(lg + tl * W16_PITCH + 4 * r) = (f32x4){c0[0], c0[1], c0[2], c0[3]}; *(LAS f32x4*)(lg + (tl + 1) * W16_PITCH + 4 * r) = (f32x4){c1[0], c1[1], c1[2], c1[3]}; }
        }
        __syncthreads();
        TS_MARK(2);
        if (F.wave == 0) {
            const int t = chunk * 64 + F.lane;
            float acc[16], rbv[16];
#pragma unroll
            for (int k = 0; k < 4; ++k) { const f32x4 w = *(const LAS f32x4*)(lg + F.lane * W16_PITCH + 4 * k); acc[4 * k] = w.x; acc[4 * k + 1] = w.y; acc[4 * k + 2] = w.z; acc[4 * k + 3] = w.w; }
#pragma unroll
            for (int e = 0; e < 16; ++e) rbv[e] = rb[e];
            float m = acc[0];
#pragma unroll
            for (int e = 1; e < 16; ++e) m = fmaxf(m, acc[e]);
            float sc16[16], ssum = 0.f;
#pragma unroll
            for (int e = 0; e < 16; ++e) { sc16[e] = __builtin_amdgcn_exp2f((acc[e] - m) * 1.4426950408889634f); ssum += sc16[e]; }
            float sel[16];
            const float rsum = 1.f / ssum;
#pragma unroll
            for (int e = 0; e < 16; ++e) { sc16[e] = sc16[e] * rsum; sel[e] = sc16[e] + rbv[e]; }
            int gi = 0; float gbest = -1e30f; int l0s[4], l1s[4];
#pragma unroll
            for (int gg = 0; gg < 4; ++gg) {
                int i0 = 0; float v0 = sel[4 * gg];
#pragma unroll
                for (int k = 1; k < 4; ++k) if (sel[4 * gg + k] > v0) { v0 = sel[4 * gg + k]; i0 = k; }
                int i1 = -1; float v1 = -1e30f;
#pragma unroll
                for (int k = 0; k < 4; ++k) if (k != i0 && sel[4 * gg + k] > v1) { v1 = sel[4 * gg + k]; i1 = k; }
                l0s[gg] = i0; l1s[gg] = i1;
                const float gs = v0 + v1; if (gs > gbest) { gbest = gs; gi = gg; }
            }
            int e0 = 0, e1 = 0;
#pragma unroll
            for (int gg = 0; gg < 4; ++gg) if (gg == gi) { e0 = 4 * gg + l0s[gg]; e1 = 4 * gg + l1s[gg]; }
            float w0 = 0.f, w1 = 0.f;
#pragma unroll
            for (int e = 0; e < 16; ++e) { if (e == e0) w0 = sc16[e]; if (e == e1) w1 = sc16[e]; }
            const float wsum = w0 + w1;
            *(int2*)(eidx + 2 * t) = make_int2(e0, e1); *(float2*)(ew + 2 * t) = make_float2(w0 / wsum, w1 / wsum);
            const unsigned long long below = (1ull << F.lane) - 1ull;
            for (int e = 0; e < 16; ++e) { const unsigned long long m0 = __ballot(e0 == e), m1 = __ballot(e1 == e); const int cc = __popcll(m0);
                if (e0 == e) loc[(chunk * 16 + e) * 64 + __popcll(m0 & below)] = 2 * t;
                if (e1 == e) loc[(chunk * 16 + e) * 64 + cc + __popcll(m1 & below)] = 2 * t + 1;
                if (F.lane == 0) cntw[chunk * 16 + e] = cc + __popcll(m1); }
        }
    }
}
__device__ __forceinline__ void chunk_publish(Frame& F, unsigned* cnt, int panel) {
    asm volatile("s_waitcnt vmcnt(0)" ::: "memory");
    __syncthreads();
    if (F.tid == 0) __hip_atomic_fetch_add(cnt + 64 * panel, 1u, __ATOMIC_RELAXED, __HIP_MEMORY_SCOPE_AGENT);
}
__device__ __forceinline__ void xn0_pass(KA args, Frame& F, bf16* XN, unsigned* cnt) {
    const float* mod = (const float*)(F.ws + WS_MOD);
    for (int chunk = F.vcu; chunk < T / 64; chunk += F.G) {
        const int tb = chunk * 64 + F.wave * 8, b = tb / S;
        f32x4 raw[3][4], cA[4], cB[4];
#pragma unroll
        for (int p = 0; p < 3; ++p) { const f32x4* xr = (const f32x4*)(INP(0) + (size_t)(tb + p) * D) + F.lane;
#pragma unroll
            for (int j = 0; j < 4; ++j) raw[p][j] = xr[64 * j]; }
        load_colvec(cA, cB, F.lane, INP(4), mod + b * 6144 + 1024, mod + b * 6144);
#pragma unroll
        for (int i = 0; i < 8; ++i) { const int t = tb + i; f32x4 v[4];
#pragma unroll
            for (int j = 0; j < 4; ++j) v[j] = raw[i % 3][j];
            if (i + 3 < 8) { const f32x4* xr = (const f32x4*)(INP(0) + (size_t)(t + 3) * D) + F.lane;
#pragma unroll
                for (int j = 0; j < 4; ++j) raw[i % 3][j] = xr[64 * j]; }
            norm_row_pre<true>(v, cA, cB);
            store_row_bf16_wt(v, F.lane, XN + (size_t)t * D); }
        chunk_publish(F, cnt, chunk >> 2);
    }
}
__device__ __forceinline__ void combine_pass(KA args, Frame& F, int l, bf16* X1, const bf16* YS, bf16* XN, float* ALOW, float* out, unsigned* cnt) {
    const float* mod = (const float*)(F.ws + WS_MOD) + (size_t)l * 4 * 6144;
    const float* modn = (const float*)(F.ws + WS_MOD) + (size_t)(l + 1) * 4 * 6144;
    LAS float* tabw = (LAS float*)F.lds;
    __syncthreads();
    for (int chunk = F.vcu; chunk < T / 64; chunk += F.G) {
      const int tb = chunk * 64 + F.wave * 8, b = tb / S;
      v2u rw[3][3][4];
#pragma unroll
      for (int p = 0; p < 3; ++p) { const v2u* x0 = (const v2u*)(X1 + (size_t)(tb + p) * D) + F.lane; const v2u* y0 = (const v2u*)(YS + (size_t)(2 * (tb + p)) * D) + F.lane;
#pragma unroll
          for (int j = 0; j < 4; ++j) { rw[p][0][j] = x0[64 * j]; rw[p][1][j] = y0[64 * j]; rw[p][2][j] = y0[64 * j + 256]; } }
      f32x4 g2v[4], cA[4], cB[4];
#pragma unroll
      for (int j = 0; j < 4; ++j) g2v[j] = *(const f32x4*)(mod + b * 6144 + 5120 + 4 * F.lane + 256 * j);
      if (l == 0) load_colvec(cA, cB, F.lane, INP(4) + D, modn + b * 6144 + 1024, modn + b * 6144); else load_colvec(cA, cB, F.lane, INP(25), nullptr, nullptr);
#pragma unroll
      for (int i = 0; i < 8; ++i) { const int t = tb + i;
        f32x4 v[4];
#pragma unroll
        for (int j = 0; j < 4; ++j) { const f32x4 g2 = g2v[j]; const v2u x = rw[i % 3][0][j], a = rw[i % 3][1][j], c = rw[i % 3][2][j];
            const f32x4 ys = {bflo(a.x) + bflo(c.x), bfhi(a.x) + bfhi(c.x), bflo(a.y) + bflo(c.y), bfhi(a.y) + bfhi(c.y)};
            v[j] = (f32x4){bflo(x.x), bfhi(x.x), bflo(x.y), bfhi(x.y)} + g2 * ys; }
        if (i + 3 < 8) { const v2u* x0 = (const v2u*)(X1 + (size_t)(t + 3) * D) + F.lane; const v2u* y0 = (const v2u*)(YS + (size_t)(2 * (t + 3)) * D) + F.lane;
#pragma unroll
            for (int j = 0; j < 4; ++j) { rw[i % 3][0][j] = x0[64 * j]; rw[i % 3][1][j] = y0[64 * j]; rw[i % 3][2][j] = y0[64 * j + 256]; } }
        if (l == 0) {
            store_row_bf16(v, F.lane, X1 + (size_t)t * D);
            norm_row_pre<true>(v, cA, cB);
            store_row_bf16_wt(v, F.lane, XN + (size_t)t * D);
            float acc[16];
            dot16(v, tabw, F.lane, acc);
            if (F.lane == 0) {
#pragma unroll
                for (int k = 0; k < 4; ++k) *(f32x4*)(ALOW + (size_t)t * 16 + 4 * k) = (f32x4){acc[4 * k], acc[4 * k + 1], acc[4 * k + 2], acc[4 * k + 3]}; }
        } else {
            norm_row_pre<false>(v, cA, cB);
            f32x4* o = (f32x4*)(out + (size_t)t * D) + F.lane;
#pragma unroll
            for (int j = 0; j < 4; ++j) __builtin_nontemporal_store(v[j], o + 64 * j);
        }
      }
      if (cnt) chunk_publish(F, cnt, chunk >> 2);
    }
}

__global__ void __launch_bounds__(512, 2) mega_fwd(Args args_) {
    KA args = kargs();
    extern __shared__ __attribute__((aligned(16))) unsigned char lds[];
    Frame F;
    F.lds = (LAS unsigned char*)lds; F.ws = args->ws;
    F.wave = __builtin_amdgcn_readfirstlane((int)threadIdx.x >> 6); F.lane = lane_id(); F.tid = F.wave * 64 + F.lane;
    { int g_ = (int)gridDim.x, b_ = (int)blockIdx.x; asm volatile("" : "+s"(g_), "+s"(b_)); F.G = g_; F.bx = b_; F.vcu = (g_ % 8 == 0) ? (b_ % 8) * (g_ / 8) + b_ / 8 : b_; }
    unsigned char* ws = args->ws;
    for (int u = F.tid; u < (LDS_BYTES - LDSCTL_OFF) / 4; u += 512) ((LAS unsigned*)(F.lds + LDSCTL_OFF))[u] = 0u;
    __syncthreads();
    (void)xcd_barrier_post((unsigned*)(ws + WS_CTL) + CW_BAR, (volatile LAS unsigned*)(F.lds + L_MISC) + 8, F.wave);
#define MKBAR() XcdBarrier{(unsigned*)(ws + WS_CTL) + CW_BAR, xb_xcc_id(), (volatile LAS unsigned*)(F.lds + L_MISC) + 8, F.wave}
#ifndef PHMASK
#define PHMASK 0xFFFFFFFFu
#endif
#ifndef PROBE_MASK
#define PROBE_MASK 0u
#endif
#define NREP(k) ((((PROBE_MASK) >> (k)) & 1u) ? 4 : 1)
#define IN(k) ((((PHMASK) >> ((k) >= 9 ? (k) - 7 : (k))) & 1u) != 0u)
#define MIDBAR() do { xcd_barrier(MKBAR()); F.lane = lane_id(); F.tid = F.wave * 64 + F.lane; args = kargs(); ws = args->ws; F.ws = ws; { int g_ = (int)gridDim.x, b_ = (int)blockIdx.x; asm volatile("" : "+s"(g_), "+s"(b_)); F.G = g_; F.bx = b_; F.vcu = (g_ % 8 == 0) ? (b_ % 8) * (g_ / 8) + b_ / 8 : b_; } } while (0)
#define SEAM(k) do { if (IN(k) && IN((k) + 1)) { TS_PRE(SEAM_IDX(k)); xcd_barrier(MKBAR()); } F.lane = lane_id(); F.tid = F.wave * 64 + F.lane; args = kargs(); ws = args->ws; F.ws = ws; { int g_ = (int)gridDim.x, b_ = (int)blockIdx.x; asm volatile("" : "+s"(g_), "+s"(b_)); F.G = g_; F.bx = b_; F.vcu = (g_ % 8 == 0) ? (b_ % 8) * (g_ / 8) + b_ / 8 : b_; } TS_POST(SEAM_IDX(k)); } while (0)

    TS_PUT(0);
#define mod ((float*)(ws + WS_MOD))
#define XN ((bf16*)(ws + WS_XN))
#define QKVY ((bf16*)(ws + WS_QKVY))
#define YS ((bf16*)(ws + WS_QKVY))
#define CAT ((bf16*)(ws + WS_CAT))
#define ACT ((bf16*)(ws + WS_CAT))
#define X1 ((bf16*)(ws + WS_X1))
#define ALOW ((float*)(ws + WS_ALOW))
#define cntw ((int*)(ws + WS_CNTW))
#define eidx ((int*)(ws + WS_EIDX))
#define ew ((float*)(ws + WS_EW))
#define loc ((int*)(ws + WS_LOC))
    LAS int* tab = (LAS int*)(F.lds + L_NE); LAS int* rowtab = (LAS int*)(F.lds + L_ROWTAB);

    if (IN(0)) for (int rep_ = 0; rep_ < NREP(0); ++rep_) { if (rep_) MIDBAR(); p0_prologue(args, F); } SEAM(0);
#pragma unroll
    for (int l = 0; l < 2; ++l) {
        const int pb = 2 + 7 * l;
        const float* modl = mod + (size_t)l * 4 * 6144;
        if (IN(pb)) for (int rep_ = 0; rep_ < NREP(pb); ++rep_) { if (rep_) MIDBAR();
            unsigned* acnt = (unsigned*)(ws + WS_CTL) + CW_APANEL + l * 8192;
            if (l == 0) xn0_pass(args, F, XN, acnt); else combine_pass(args, F, 0, X1, YS, XN, ALOW, args->out, acnt);
            TS_MARK(8); TS_MARK1(12);
            pg8::DenseSched Sd; Sd.acnt = acnt; Sd.aneed = 4u * (unsigned)(rep_ + 1);
            if (l == 0) { Sd.init(XN, (const bf16*)(ws + WS_WIN0), T, NIN0, D, F.G, F.bx); EpiIn0 E{QKVY}; pg8::gemm_phase<EpiIn0, pg8::DenseSched, true>(F.lds, D, Sd, E, F.wave); TS_MARK(9);
                int nwg_ = (T / 256) * (NIN0 / 256), bx_ = F.bx; asm volatile("" : "+s"(nwg_), "+s"(bx_));
                const int nidle = F.G - (nwg_ - 2 * F.G), cid = bx_ - (nwg_ - 2 * F.G);
                if (nwg_ > 2 * F.G && nwg_ <= 3 * F.G) { if (cid >= 0) { __syncthreads(); p0_items(args, F, P0_NITEMS - P0_NFILL, P0_NITEMS, cid * 8 + F.wave, nidle * 8); } }
                else { __syncthreads(); p0_items(args, F, P0_NITEMS - P0_NFILL, P0_NITEMS, F.vcu * 8 + F.wave, F.G * 8); } }
            else { Sd.init(XN, (const bf16*)(ws + WS_WIN1), T, NIN1, D, F.G, F.bx); EpiIn1 E{QKVY}; pg8::gemm_phase<EpiIn1, pg8::DenseSched, true>(F.lds, D, Sd, E, F.wave); TS_MARK1(13); }
        } SEAM(pb);
        if (IN(pb + 1)) for (int rep_ = 0; rep_ < NREP(pb + 1); ++rep_) { if (rep_) MIDBAR();
            if (l == 0) {
#if defined(PROBE_CONV)
                for (int r3 = 0; r3 < 3; ++r3) { conv_phase(args, F, QKVY, CAT); __syncthreads(); }
#endif
#if defined(PROBE_SBA)
                for (int r3 = 0; r3 < 3; ++r3) { sba::phase(QKVY, CAT, (char*)lds, F.vcu, F.G, F.wave, F.lane); __syncthreads(); }
#endif
                conv_phase(args, F, QKVY, CAT); __syncthreads(); TS_MARK(10); sba::phase(QKVY, CAT, (char*)lds, F.vcu, F.G, F.wave, F.lane); }
            else {
                bf16* KVT = (bf16*)(ws + WS_XN); bf16* SINT = (bf16*)(ws + WS_WGU); bf16* QIN = SINT + (size_t)gla::NCH * 8192; bf16* KIN = QIN + (size_t)T * 256; float* DEC = (float*)(ws + WS_WD);
#ifndef PROBE_M1SUB
#define PROBE_M1SUB 0
#endif
                for (int r3 = 0; r3 < (PROBE_M1SUB == 1 ? 4 : 1); ++r3) { pool_phase(args, F, QKVY, (const bf16*)(ws + WS_WPT), CAT); __syncthreads(); }
                TS_MARK1(16);
                for (int r3 = 0; r3 < (PROBE_M1SUB == 2 ? 4 : 1); ++r3) { gla::pass_a_w(args, QKVY, ALOW, QIN, KIN, KVT, DEC, (char*)lds, F.vcu, F.G, F.wave, F.lane); __syncthreads(); }
                TS_PRE(6); MIDBAR(); TS_POST(6);
                for (int r3 = 0; r3 < (PROBE_M1SUB == 3 ? 4 : 1); ++r3) { gla::pass_b(KVT, DEC, SINT, F.vcu, F.G, F.tid); __syncthreads(); }
                TS_PRE(7); MIDBAR(); TS_POST(7);
                for (int r3 = 0; r3 < (PROBE_M1SUB == 4 ? 4 : 1); ++r3) { gla::pass_c_w(args, QKVY, QIN, KIN, SINT, CAT, (char*)lds, F.vcu, F.G, F.wave, F.lane); __syncthreads(); } }
        } SEAM(pb + 1);
        if (IN(pb + 2)) for (int rep_ = 0; rep_ < NREP(pb + 2); ++rep_) { if (rep_) MIDBAR();
            unsigned* pcnt = (unsigned*)(ws + WS_CTL) + CW_PANEL + l * 8192;
            pg8::DenseSched Sd; Sd.init(CAT, (const bf16*)(ws + (l == 0 ? WS_WOUT0 : WS_WOUT1)), T, D, D, F.G, F.bx); Sd.pcnt = pcnt;
#ifdef PROBE_TS
            if (l == 0) { EpiOut<true> E{INP(0), X1, modl + 2048, (void*)TSBUF, INP(20)}; pg8::gemm_phase<EpiOut<true>, pg8::DenseSched, false>(F.lds, D, Sd, E, F.wave); }
            else { EpiOut<false> E{X1, X1, modl + 2048, nullptr, INP(20)}; pg8::gemm_phase<EpiOut<false>, pg8::DenseSched, false>(F.lds, D, Sd, E, F.wave); }
#else
            if (l == 0) { EpiOut<true> E{INP(0), X1, modl + 2048, INP(20)}; pg8::gemm_phase<EpiOut<true>, pg8::DenseSched, false>(F.lds, D, Sd, E, F.wave); }
            else { EpiOut<false> E{X1, X1, modl + 2048, INP(20)}; pg8::gemm_phase<EpiOut<false>, pg8::DenseSched, false>(F.lds, D, Sd, E, F.wave); }
#endif
            router_pass(args, F, l, X1, XN, eidx, ew, cntw, loc, pcnt, 32u * (unsigned)(rep_ + 1));
        } SEAM(pb + 2);
        if (IN(pb + 4)) for (int rep_ = 0; rep_ < NREP(pb + 4); ++rep_) { if (rep_) MIDBAR();
            TS_MARK(4); moe_plan(F, cntw, loc, F.vcu); TS_MARK(5);
            unsigned* mcnt = (unsigned*)(ws + WS_CTL) + CW_MOECNT + l * 16384;
            { MoeSched<1> Sm{XN, (const bf16*)(ws + WS_WGU) + (size_t)l * NE * 1024 * D, D, (size_t)1024 * D * 2, tab, rowtab, mcnt, F.G, F.vcu};
              EpiM1 E{ACT, ew, rowtab};
              pg8::gemm_phase<EpiM1, MoeSched<1>, true>(F.lds, D, Sm, E, F.wave); TS_MARK(6); }
            { MoeSched<2> Sm{ACT, (const bf16*)(ws + WS_WD) + (size_t)l * NE * D * DE, DE, (size_t)D * DE * 2, tab, rowtab, mcnt, F.G, F.vcu};
              EpiM2 E{YS, rowtab, l == 0 ? (const float*)(ws + WS_ALOWW) : nullptr};
              pg8::gemm_phase<EpiM2, MoeSched<2>, true>(F.lds, DE, Sm, E, F.wave); }
        } SEAM(pb + 4);
        if (l == 1) { if (IN(pb + 6)) { combine_pass(args, F, 1, X1, YS, XN, ALOW, args->out, nullptr); } }
    }
#ifdef PROBE_TS
    { TS_PRE(11); MIDBAR();
      if (F.bx == 0 && F.wave == 0) {
          const unsigned long long rlast = __builtin_amdgcn_s_memrealtime();
          int qq[2];
#pragma unroll
          for (int j = 0; j < 2; ++j) { const int id = j == 0 ? (PROBE_Q1) : (PROBE_Q2); int q;
              if (id == 31) q = 10;
              else { const int k = id & 15; const unsigned long long prev = (k == 0) ? TSBUF[0] : TSBUF[(2 + 2 * (k - 1)) * 256];
                  float dt;
                  if (id < 16) { const unsigned long long cur = (k == 11) ? rlast : TSBUF[(2 + 2 * k) * 256]; dt = (float)(long long)(cur - prev); }
                  else if (id >= 200 || (id >= 64 && id < 80)) {
                      float mx = 0.f; const int mx_ = id - 200; const unsigned long long p0_ = (id >= 200) ? TSBUF[(2 + 2 * (mx_ >= 16 ? 5 : mx_ >= 12 ? 4 : mx_ >= 10 ? 1 : mx_ >= 8 ? 0 : mx_ >= 4 ? 3 : 2)) * 256] : prev; const int slot = (id >= 200) ? 26 + (id - 200) : 1 + 2 * k;
                      for (int w = F.lane; w < F.G; w += 64) mx = fmaxf(mx, (float)(long long)(TSBUF[slot * 256 + w] - p0_));
                      for (int o = 1; o < 64; o <<= 1) mx = fmaxf(mx, __int_as_float(__builtin_amdgcn_ds_bpermute(((F.lane ^ o) & 63) << 2, __float_as_int(mx))));
                      dt = mx; }
                  else if (id >= 100) { float sacc = 0.f; const int mm_ = id - 100; const unsigned long long p2 = TSBUF[(2 + 2 * (mm_ >= 16 ? 5 : mm_ >= 12 ? 4 : mm_ >= 10 ? 1 : mm_ >= 8 ? 0 : mm_ >= 4 ? 3 : 2)) * 256]; for (int w = F.lane; w < F.G; w += 64) sacc += (float)(long long)(TSBUF[(26 + (id - 100)) * 256 + w] - p2); dt = wave_sum(sacc) / (float)F.G; }
                  else if (id < 32) { float sacc = 0.f; for (int w = F.lane; w < F.G; w += 64) sacc += (float)(long long)(TSBUF[(1 + 2 * k) * 256 + w] - prev); dt = wave_sum(sacc) / (float)F.G; }
                  else { float sacc = 0.f, nacc = 0.f;
                      for (int w = F.lane; w < F.G; w += 64) { const int vc = (w % 8) * (F.G / 8) + w / 8; if (vc >= (PROBE_LO) && vc < (PROBE_HI)) { sacc += (float)(long long)(TSBUF[(1 + 2 * k) * 256 + w] - prev); nacc += 1.f; } }
                      dt = wave_sum(sacc) / fmaxf(wave_sum(nacc), 1.f); }
#ifndef PROBE_UNIT
#define PROBE_UNIT 250
#define PROBE_OFF 0
#endif
                  q = (int)((dt - (float)(PROBE_OFF)) * (1.f / (float)(PROBE_UNIT)) + 0.5f); q = q < 0 ? 0 : q > 63 ? 63 : q; }
              qq[j] = __builtin_amdgcn_readfirstlane(q); }
          const unsigned long long tend = __builtin_amdgcn_s_memrealtime() + (unsigned long long)(qq[0] + 64 * qq[1]) * 1600ull;
          while (__builtin_amdgcn_s_memrealtime() < tend) __builtin_amdgcn_s_sleep(8);
      } }
#endif
#undef IN
#undef SEAM
}

extern "C" void kernel_launch(void* const* d_in, const int* in_sizes, int n_in, void* d_out, int out_size, void* d_ws, size_t ws_size, hipStream_t stream) {
    static int grid = 0;
    if (grid == 0) {
        if (n_in != 26 || out_size != T * D || ws_size < WS_END) { fprintf(stderr, "kernel_launch: unexpected shapes / workspace (%zu < %zu)\n", ws_size, (size_t)WS_END); grid = -1; return; }
        int dev = 0, cus = 0;
        if (hipGetDevice(&dev) != hipSuccess || hipDeviceGetAttribute(&cus, hipDeviceAttributeMultiprocessorCount, dev) != hipSuccess) { grid = -1; return; }
        if (hipFuncSetAttribute((const void*)mega_fwd, hipFuncAttributeMaxDynamicSharedMemorySize, LDS_BYTES) != hipSuccess) { fprintf(stderr, "kernel_launch: hipFuncSetAttribute failed\n"); grid = -1; return; }
        grid = cus;
    }
    if (grid < 0) return;
    (void)hipMemsetAsync((char*)d_ws + WS_CTL, 0, CTL_ZERO_BYTES, stream);
    Args a{};
    for (int i = 0; i < 26; ++i) a.in[i] = (const float*)d_in[i];
    a.out = (float*)d_out; a.ws = (unsigned char*)d_ws;
    hipLaunchKernelGGL(mega_fwd, dim3(grid), dim3(512), LDS_BYTES, stream, a);
}
```
